# Optimizing an MI355X kernel written in HIP

```python
import math
import jax, jax.numpy as jnp
from jax import lax
import numpy as np

D_MODEL = 2048
BATCH = 4
SEQ = 4096
DEPTH = 2

GRID_W = 64
CTX_LEN = 256
Q_BLOCK = 128
ROPE_BASE = 10000.0
EPS = 1e-6

MLA_HEADS = 8
MLA_Q_LORA = 512
MLA_KV_LORA = 512
MLA_NOPE = 128
MLA_ROPE = 64
MLA_V = 128

DIFF_HEADS = 4
DIFF_DIM = 128
DIFF_QK = 2 * DIFF_HEADS * DIFF_DIM

EVEN_SPLITS = (MLA_Q_LORA,
               MLA_Q_LORA + MLA_KV_LORA,
               MLA_Q_LORA + MLA_KV_LORA + MLA_ROPE,
               MLA_Q_LORA + MLA_KV_LORA + MLA_ROPE + DIFF_QK,
               MLA_Q_LORA + MLA_KV_LORA + MLA_ROPE + 2 * DIFF_QK)
EVEN_IN = MLA_Q_LORA + MLA_KV_LORA + MLA_ROPE + 3 * DIFF_QK
EVEN_OUT = MLA_HEADS * MLA_V + DIFF_HEADS * 2 * DIFF_DIM

POOL_WINDOWS = (2, 4, 8, 16)
POOL_WIDTH = D_MODEL // 2
POOL_GROUP = POOL_WIDTH // 4
FOURIER_GROUPS = 4
FOURIER_WIDTH = D_MODEL - POOL_WIDTH
FOURIER_GROUP = FOURIER_WIDTH // FOURIER_GROUPS
ODD_WIDTH = POOL_WIDTH + FOURIER_WIDTH

N_EXPERTS = 16
EC_CAPACITY = 2
EXPERT_FF = D_MODEL

kernel_name = 'hybrid_mla_diffattn_pool_fnet_ecmoe_dit'


def rms_norm(x, g):
    xf = x.astype(jnp.float32)
    y = xf * lax.rsqrt(jnp.mean(xf * xf, axis=-1, keepdims=True) + EPS)
    return (y * g.astype(jnp.float32)).astype(x.dtype)


def rope_2d_tables(n, rot_dim):
    rows = n // GRID_W
    row = jnp.repeat(jnp.arange(rows, dtype=jnp.float32), GRID_W)
    col = jnp.tile(jnp.arange(GRID_W, dtype=jnp.float32), rows)
    quarter = rot_dim // 4
    inv_freq = ROPE_BASE ** (-jnp.arange(quarter, dtype=jnp.float32) / quarter)
    ang = jnp.stack([row[:, None] * inv_freq, col[:, None] * inv_freq], axis=1)
    return jnp.cos(ang)[:, None], jnp.sin(ang)[:, None]


def apply_rope_2d(x, cos, sin):
    shape = x.shape
    r = shape[-1]
    xr = x.reshape(shape[0], shape[1], -1, 2, 2, r // 4).astype(jnp.float32)
    x1, x2 = xr[..., 0, :], xr[..., 1, :]
    out = jnp.stack([x1 * cos - x2 * sin, x2 * cos + x1 * sin], axis=-2)
    return out.reshape(shape).astype(x.dtype)


def block_attention(q, k, v, scale):
    b, nq, m, h, dk = q.shape
    nb = nq // Q_BLOCK
    qb = jnp.moveaxis(q.reshape(b, nb, Q_BLOCK, m, h, dk), 1, 0)

    def one_block(qi):
        s = jnp.einsum('bqmhd,bkmhd->bmhqk', qi, k, preferred_element_type=jnp.float32) * scale
        p = jax.nn.softmax(s, axis=-1).astype(v.dtype)
        return jnp.einsum('bmhqk,bkhd->bqmhd', p, v)

    o = lax.map(one_block, qb)
    return jnp.moveaxis(o, 0, 1).reshape(b, nq, m, h, v.shape[-1])


def even_project(h, w_in, q_norm, w_uq, kv_norm, w_ukv, rope_a, rope_b, need_q):
    b, n, _ = h.shape
    cq, ckv, kr, qd, kd, vd = jnp.split(h @ w_in, EVEN_SPLITS, axis=-1)
    kv = (rms_norm(ckv, kv_norm) @ w_ukv).reshape(b, n, MLA_HEADS, MLA_NOPE + MLA_V)
    k_nope, v_a = kv[..., :MLA_NOPE], kv[..., MLA_NOPE:]
    k_rope = kr.reshape(b, n, 1, MLA_ROPE)
    kd = kd.reshape(b, n, 2, DIFF_HEADS, DIFF_DIM)
    vd = vd.reshape(b, n, DIFF_HEADS, 2 * DIFF_DIM)
    if rope_a is not None:
        k_rope = apply_rope_2d(k_rope, *rope_a)
        kd = apply_rope_2d(kd, *rope_b)
    k_a = jnp.concatenate([k_nope, jnp.broadcast_to(k_rope, (b, n, MLA_HEADS, MLA_ROPE))], axis=-1)[:, :, None]
    if not need_q:
        return None, k_a, v_a, None, kd, vd
    q = (rms_norm(cq, q_norm) @ w_uq).reshape(b, n, MLA_HEADS, MLA_NOPE + MLA_ROPE)
    q_nope, q_rope = q[..., :MLA_NOPE], q[..., MLA_NOPE:]
    qd = qd.reshape(b, n, 2, DIFF_HEADS, DIFF_DIM)
    if rope_a is not None:
        q_rope = apply_rope_2d(q_rope, *rope_a)
        qd = apply_rope_2d(qd, *rope_b)
    q_a = jnp.concatenate([q_nope, q_rope], axis=-1)[:, :, None]
    return q_a, k_a, v_a, qd, kd, vd


def even_heads_out(o_a, o_d, lam, lam_init, subln, w_out):
    b, n = o_a.shape[:2]
    od = o_d[:, :, 0] - lam.astype(o_d.dtype) * o_d[:, :, 1]
    od = rms_norm(od, subln) * (1.0 - lam_init)
    y = jnp.concatenate([o_a.reshape(b, n, -1), od.reshape(b, n, -1)], axis=-1)
    return y @ w_out


def even_mixer(h_lat, h_ctx, layer_idx, w_in, q_norm, w_uq, kv_norm, w_ukv,
               lq1, lk1, lq2, lk2, subln, w_out, with_ctx_out):
    n = h_lat.shape[1]
    rope_a = rope_2d_tables(n, MLA_ROPE)
    rope_b = rope_2d_tables(n, DIFF_DIM)
    qa_l, ka_l, va_l, qd_l, kd_l, vd_l = even_project(h_lat, w_in, q_norm, w_uq, kv_norm, w_ukv, rope_a, rope_b, True)
    qa_c, ka_c, va_c, qd_c, kd_c, vd_c = even_project(h_ctx, w_in, q_norm, w_uq, kv_norm, w_ukv, None, None, with_ctx_out)
    lam_init = 0.8 - 0.6 * math.exp(-0.3 * layer_idx)
    lam = (jnp.exp(jnp.sum(lq1.astype(jnp.float32) * lk1.astype(jnp.float32)))
           - jnp.exp(jnp.sum(lq2.astype(jnp.float32) * lk2.astype(jnp.float32))) + lam_init)
    scale_a = 1.0 / math.sqrt(MLA_NOPE + MLA_ROPE)
    scale_d = 1.0 / math.sqrt(DIFF_DIM)
    oa = block_attention(qa_l, jnp.concatenate([ka_c, ka_l], axis=1), jnp.concatenate([va_c, va_l], axis=1), scale_a)[:, :, 0]
    od = block_attention(qd_l, jnp.concatenate([kd_c, kd_l], axis=1), jnp.concatenate([vd_c, vd_l], axis=1), scale_d)
    y_lat = even_heads_out(oa, od, lam, lam_init, subln, w_out)
    y_ctx = None
    if with_ctx_out:
        oa_c = block_attention(qa_c, ka_c, va_c, scale_a)[:, :, 0]
        od_c = block_attention(qd_c, kd_c, vd_c, scale_d)
        y_ctx = even_heads_out(oa_c, od_c, lam, lam_init, subln, w_out)
    return y_lat, y_ctx


def multi_scale_pool(z):
    b, n, g, cg = z.shape
    zf = z.astype(jnp.float32)
    csum = jnp.concatenate([jnp.zeros((b, 1, g, cg), jnp.float32), jnp.cumsum(zf, axis=1)], axis=1)
    t = jnp.arange(n)[:, None]
    half = jnp.array(POOL_WINDOWS, dtype=jnp.int32)[None, :] // 2
    lo = jnp.clip(t - half, 0, n)
    hi = jnp.clip(t + half, 0, n)
    gidx = jnp.arange(g)[None, :]
    window_sum = csum[:, hi, gidx] - csum[:, lo, gidx]
    mean = window_sum / (hi - lo).astype(jnp.float32)[None, :, :, None]
    return (mean - zf).astype(z.dtype)


def odd_mixer(h, w_in, pool_w, pool_scale, fourier_w, w_out):
    b, n, _ = h.shape
    z = h @ w_in
    zp = z[..., :POOL_WIDTH].reshape(b, n, len(POOL_WINDOWS), POOL_GROUP)
    zf = z[..., POOL_WIDTH:].reshape(b, n, FOURIER_GROUPS, FOURIER_GROUP)
    yp = jnp.einsum('bngc,gcd->bngd', multi_scale_pool(zp), pool_w).reshape(b, n, POOL_WIDTH) * pool_scale
    spec = jnp.fft.fft2(zf.astype(jnp.float32), axes=(1, 3), norm='ortho').real.astype(z.dtype)
    yf = jnp.einsum('bngc,gcd->bngd', spec, fourier_w).reshape(b, n, FOURIER_WIDTH)
    return jnp.concatenate([yp, yf], axis=-1) @ w_out


def expert_choice_ffn(h, w_router, w_gate, w_up, w_down):
    b, n, d = h.shape
    cap = (EC_CAPACITY * n) // N_EXPERTS
    logits = jnp.einsum('bnd,de->ben', h, w_router, preferred_element_type=jnp.float32)
    aff = jax.nn.softmax(logits, axis=1)
    gate, idx = lax.top_k(aff, cap)
    xe = jax.vmap(lambda hb, ib: hb[ib])(h, idx)
    hid = jax.nn.silu(jnp.einsum('becd,edf->becf', xe, w_gate)) * jnp.einsum('becd,edf->becf', xe, w_up)
    ye = jnp.einsum('becf,efd->becd', hid, w_down) * gate[..., None].astype(h.dtype)
    return jax.vmap(lambda yb, ib: jnp.zeros((n, d), yb.dtype).at[ib.reshape(-1)].add(yb.reshape(-1, d)))(ye, idx)


def setup_inputs(seed: int = 0) -> dict:
    key = jax.random.key(seed)
    ks = iter(jax.random.split(key, 40))
    n_even = (DEPTH + 1) // 2
    n_odd = DEPTH // 2

    def nrm(shape, scale):
        return jax.random.normal(next(ks), shape, jnp.float32) * scale

    def gain(shape):
        return 1.0 + nrm(shape, 0.02)

    return {
        'x': nrm((BATCH, SEQ, D_MODEL), 1.0),
        'c': nrm((BATCH, D_MODEL), 1.0),
        'ctx': nrm((BATCH, CTX_LEN, D_MODEL), 1.0),
        'c_ctx': nrm((D_MODEL,), 1.0),
        'mod_w': nrm((DEPTH, D_MODEL, 6 * D_MODEL), 0.5 * D_MODEL ** -0.5),
        'mod_b': nrm((DEPTH, 6 * D_MODEL), 0.02),
        'norm_mix': gain((DEPTH, D_MODEL)),
        'norm_ffn': gain((DEPTH, D_MODEL)),
        'even_w_in': nrm((n_even, D_MODEL, EVEN_IN), D_MODEL ** -0.5),
        'mla_q_norm': gain((n_even, MLA_Q_LORA)),
        'mla_w_uq': nrm((n_even, MLA_Q_LORA, MLA_HEADS * (MLA_NOPE + MLA_ROPE)), MLA_Q_LORA ** -0.5),
        'mla_kv_norm': gain((n_even, MLA_KV_LORA)),
        'mla_w_ukv': nrm((n_even, MLA_KV_LORA, MLA_HEADS * (MLA_NOPE + MLA_V)), MLA_KV_LORA ** -0.5),
        'diff_lambda_q1': nrm((n_even, DIFF_DIM), 0.1),
        'diff_lambda_k1': nrm((n_even, DIFF_DIM), 0.1),
        'diff_lambda_q2': nrm((n_even, DIFF_DIM), 0.1),
        'diff_lambda_k2': nrm((n_even, DIFF_DIM), 0.1),
        'diff_subln': gain((n_even, 2 * DIFF_DIM)),
        'even_w_out': nrm((n_even, EVEN_OUT, D_MODEL), EVEN_OUT ** -0.5),
        'odd_w_in': nrm((n_odd, D_MODEL, ODD_WIDTH), D_MODEL ** -0.5),
        'pool_w': nrm((n_odd, len(POOL_WINDOWS), POOL_GROUP, POOL_GROUP), POOL_GROUP ** -0.5),
        'pool_scale': gain((n_odd, POOL_WIDTH)),
        'fourier_w': nrm((n_odd, FOURIER_GROUPS, FOURIER_GROUP, FOURIER_GROUP), FOURIER_GROUP ** -0.5),
        'odd_w_out': nrm((n_odd, ODD_WIDTH, D_MODEL), ODD_WIDTH ** -0.5),
        'router_w': nrm((DEPTH, D_MODEL, N_EXPERTS), D_MODEL ** -0.5),
        'expert_w_gate': nrm((DEPTH, N_EXPERTS, D_MODEL, EXPERT_FF), D_MODEL ** -0.5),
        'expert_w_up': nrm((DEPTH, N_EXPERTS, D_MODEL, EXPERT_FF), D_MODEL ** -0.5),
        'expert_w_down': nrm((DEPTH, N_EXPERTS, EXPERT_FF, D_MODEL), EXPERT_FF ** -0.5),
        'final_norm': gain((D_MODEL,)),
    }


def reference(x, c, ctx, c_ctx, mod_w, mod_b, norm_mix, norm_ffn,
              even_w_in, mla_q_norm, mla_w_uq, mla_kv_norm, mla_w_ukv,
              diff_lambda_q1, diff_lambda_k1, diff_lambda_q2, diff_lambda_k2, diff_subln, even_w_out,
              odd_w_in, pool_w, pool_scale, fourier_w, odd_w_out,
              router_w, expert_w_gate, expert_w_up, expert_w_down, final_norm):
    xl, xc = x, ctx
    for i in range(DEPTH):
        j = i // 2
        ctx_live = any(k % 2 == 0 for k in range(i + 1, DEPTH))
        ctx_in = (i % 2 == 0) or ctx_live
        ml = (jax.nn.silu(c) @ mod_w[i] + mod_b[i])[:, None, :]
        sh1, sc1, g1, sh2, sc2, g2 = jnp.split(ml, 6, axis=-1)
        hl = rms_norm(xl, norm_mix[i]) * (1.0 + sc1) + sh1
        if ctx_in:
            mc = jax.nn.silu(c_ctx) @ mod_w[i] + mod_b[i]
            csh1, csc1, cg1, csh2, csc2, cg2 = jnp.split(mc, 6, axis=-1)
            hc = rms_norm(xc, norm_mix[i]) * (1.0 + csc1) + csh1
        if i % 2 == 0:
            yl, yc = even_mixer(hl, hc, i, even_w_in[j], mla_q_norm[j], mla_w_uq[j], mla_kv_norm[j], mla_w_ukv[j],
                                diff_lambda_q1[j], diff_lambda_k1[j], diff_lambda_q2[j], diff_lambda_k2[j],
                                diff_subln[j], even_w_out[j], ctx_live)
        else:
            yl = odd_mixer(hl, odd_w_in[j], pool_w[j], pool_scale[j], fourier_w[j], odd_w_out[j])
            yc = odd_mixer(hc, odd_w_in[j], pool_w[j], pool_scale[j], fourier_w[j], odd_w_out[j]) if ctx_live else None
        xl = xl + g1 * yl
        hl = rms_norm(xl, norm_ffn[i]) * (1.0 + sc2) + sh2
        xl = xl + g2 * expert_choice_ffn(hl, router_w[i], expert_w_gate[i], expert_w_up[i], expert_w_down[i])
        if ctx_live:
            xc = xc + cg1 * yc
            hc = rms_norm(xc, norm_ffn[i]) * (1.0 + csc2) + csh2
            xc = xc + cg2 * expert_choice_ffn(hc, router_w[i], expert_w_gate[i], expert_w_up[i], expert_w_down[i])
    return rms_norm(xl, final_norm)
```

```cpp
#include <hip/hip_runtime.h>
#include <stdint.h>
#include <cstdio>

typedef unsigned short bf16_t;
typedef short bf16x8 __attribute__((ext_vector_type(8)));
typedef float f32x4 __attribute__((ext_vector_type(4)));
typedef unsigned u32x4 __attribute__((ext_vector_type(4)));
typedef unsigned u32x2 __attribute__((ext_vector_type(2)));

constexpr int DM = 2048, NB = 4, SEQ = 4096, NT = NB * SEQ, CTXL = 256, NC = NB * CTXL, NA = NT + NC, NKEY = SEQ + CTXL;
constexpr int EIN = 4160, EINP = 4352, P0W = 1088;
constexpr int NE = 16, CAP = 512, FF = 2048, MLW = 6 * DM;
constexpr float EPS = 1e-6f;

constexpr size_t al256(size_t x) { return (x + 255) / 256 * 256; }
constexpr size_t OFF_BAR = 0;
constexpr size_t OFF_ML = 16384;
constexpr size_t OFF_AFF = OFF_ML + al256((size_t)2 * 5 * MLW * 4);
constexpr size_t OFF_IDX = OFF_AFF + (size_t)NB * NE * SEQ * 4;
constexpr size_t OFF_GATE = OFF_IDX + (size_t)NB * NE * CAP * 4;
constexpr size_t OFF_INV = OFF_GATE + (size_t)NB * NE * CAP * 4;
constexpr size_t OFF_WIN0 = OFF_INV + (size_t)NT * NE * 4;
constexpr size_t OFF_WUQ = OFF_WIN0 + (size_t)EINP * DM * 2;
constexpr size_t OFF_WUKV = OFF_WUQ + (size_t)1536 * 512 * 2;
constexpr size_t OFF_WOUT0 = OFF_WUKV + (size_t)2048 * 512 * 2;
constexpr size_t OFF_WIN1 = OFF_WOUT0 + (size_t)DM * DM * 2;
constexpr size_t OFF_WOUT1 = OFF_WIN1 + (size_t)DM * DM * 2;
constexpr size_t OFF_WPOOL = OFF_WOUT1 + (size_t)DM * DM * 2;
constexpr size_t OFF_WFOUR = OFF_WPOOL + (size_t)4 * 256 * 256 * 2;
constexpr size_t OFF_MC = OFF_WFOUR + (size_t)4 * 256 * 256 * 2;
constexpr size_t OFF_TW = OFF_MC + (size_t)4 * 512 * 256 * 2;
constexpr size_t OFF_WGU = OFF_TW + (size_t)4096 * 8192 * 2;
constexpr size_t OFF_WD = OFF_WGU + (size_t)2 * NE * 4096 * 2048 * 2;
constexpr size_t OFF_XL = OFF_WD + (size_t)2 * NE * 2048 * 2048 * 2;
constexpr size_t OFF_H = OFF_XL + (size_t)NT * DM * 4;
constexpr size_t OFF_SCR = OFF_H + (size_t)NA * DM * 2;
constexpr size_t OFF_P0 = OFF_SCR;
constexpr size_t OFF_CQN = OFF_P0 + al256((size_t)NA * EIN * 2);
constexpr size_t OFF_CKVN = OFF_CQN + (size_t)NT * 512 * 2;
constexpr size_t OFF_QA = OFF_CKVN + (size_t)NA * 512 * 2;
constexpr size_t OFF_KA = OFF_QA + (size_t)NT * 1536 * 2;
constexpr size_t OFF_VA = OFF_KA + (size_t)NA * 1536 * 2;
constexpr size_t OFF_QD = OFF_VA + (size_t)NA * 1024 * 2;
constexpr size_t OFF_KD = OFF_QD + (size_t)NT * 1024 * 2;
constexpr size_t OFF_VD = OFF_KD + (size_t)NA * 1024 * 2;
constexpr size_t OFF_OD = OFF_VD + (size_t)NA * 1024 * 2;
constexpr size_t OFF_YIN = OFF_OD + (size_t)NT * 2048 * 4;
constexpr size_t OFF_M0END = OFF_YIN + (size_t)NT * 2048 * 2;
constexpr size_t OFF_XE = OFF_SCR;
constexpr size_t OFF_HID = OFF_XE + (size_t)NE * 2048 * 2048 * 2;
constexpr size_t OFF_YE = OFF_HID + (size_t)NE * 2048 * 2048 * 2;
constexpr size_t OFF_Z = OFF_SCR;
constexpr size_t OFF_POOLED = OFF_Z + (size_t)NT * 2048 * 2;
constexpr size_t OFF_ABT2 = OFF_POOLED + (size_t)NT * 1024 * 2;
constexpr size_t OFF_SPEC = OFF_ABT2 + (size_t)16 * 256 * 8192 * 2;
constexpr size_t OFF_YCAT = OFF_SPEC + (size_t)NT * 1024 * 2;
constexpr size_t OFF_ABTF = OFF_YCAT + (size_t)NT * 2048 * 2;
constexpr size_t OFF_SBUF = OFF_M0END;
constexpr size_t OFF_PBUF = OFF_SBUF + (size_t)SEQ * NKEY * 4;
constexpr size_t OFF_VT = OFF_PBUF + (size_t)SEQ * NKEY * 2;
constexpr size_t WS_NEED = OFF_VT + (size_t)256 * NKEY * 2;

struct Params {
  const float *x, *c, *ctx, *c_ctx, *mod_w, *mod_b, *norm_mix, *norm_ffn, *even_w_in, *q_norm, *w_uq, *kv_norm, *w_ukv,
      *lq1, *lk1, *lq2, *lk2, *subln, *even_w_out, *odd_w_in, *pool_w, *pool_scale, *fourier_w, *odd_w_out, *router_w,
      *w_gate, *w_up, *w_down, *final_norm;
  float* out;
  char* ws;
};
#define WSP(T, off) ((T*)(p.ws + (off)))

typedef float f32x2 __attribute__((ext_vector_type(2)));
typedef __bf16 bf16x2_t __attribute__((ext_vector_type(2)));
__device__ __forceinline__ unsigned cvtpk(float lo, float hi) { f32x2 v = {lo, hi}; bf16x2_t r = __builtin_convertvector(v, bf16x2_t); return __builtin_bit_cast(unsigned, r); }
__device__ __forceinline__ unsigned pack_fp8x4(float a, float b, float c, float d) {
  a = __builtin_amdgcn_fmed3f(a, -448.f, 448.f); b = __builtin_amdgcn_fmed3f(b, -448.f, 448.f); c = __builtin_amdgcn_fmed3f(c, -448.f, 448.f); d = __builtin_amdgcn_fmed3f(d, -448.f, 448.f);
  unsigned w = 0; w = __builtin_amdgcn_cvt_pk_fp8_f32(a, b, w, false); w = __builtin_amdgcn_cvt_pk_fp8_f32(c, d, w, true); return w;
}
__device__ __forceinline__ float bf_lo(unsigned w) { return __uint_as_float(w << 16); }
__device__ __forceinline__ float bf_hi(unsigned w) { return __uint_as_float(w & 0xffff0000u); }
__device__ __forceinline__ float bf2f(bf16_t b) { return __uint_as_float(((unsigned)b) << 16); }
__device__ __forceinline__ bf16_t f2bf(float f) { return (bf16_t)(cvtpk(f, 0.f) & 0xffffu); }
__device__ __forceinline__ float wave_sum(float v) {
#pragma unroll
  for (int o = 32; o > 0; o >>= 1) v += __shfl_xor(v, o, 64);
  return v;
}
__device__ __forceinline__ float wave_max(float v) {
#pragma unroll
  for (int o = 32; o > 0; o >>= 1) v = fmaxf(v, __shfl_xor(v, o, 64));
  return v;
}
__device__ __forceinline__ int otid() { int t = threadIdx.x; asm volatile("" : "+v"(t)); return t; }
__device__ __forceinline__ int gwave() { return blockIdx.x * (blockDim.x >> 6) + (otid() >> 6); }
__device__ __forceinline__ int nwave() { return gridDim.x * (blockDim.x >> 6); }
__device__ __forceinline__ const float* mlp(const Params& p, int l, int row) { return WSP(const float, OFF_ML) + ((size_t)l * 5 + row) * MLW; }

template <int MODE>
__device__ __forceinline__ int rowmap(int n) {
  if (MODE == 0) return n;
  if (MODE == 3) { if (n < 1088 || n >= 3136) return n; const int v = (n - 1088) >> 7, e = (n - 1088) & 127;
    return 1088 + v * 128 + ((2 * (e >> 6) + ((e >> 4) & 1)) << 5) + (((e >> 5) & 1) << 4) + (e & 15); }
  return 32 * (n >> 4) + (n & 15) + (MODE == 2 ? 16 : 0);
}
template <int MODE, bool F8 = false>
__device__ __forceinline__ void tconv(const float* __restrict__ src, int K, int N, int Npad, bf16_t* __restrict__ dst, char* smem) {
  float(*tile)[257] = (float(*)[257])smem;
  const int tid = otid(), tk = K / 64, tn = Npad / 256;
  for (int t = blockIdx.x; t < tk * tn; t += gridDim.x) {
    const int k0 = (t % tk) * 64, n0 = (t / tk) * 256;
#pragma unroll
    for (int i = 0; i < 8; ++i) {
      const int id = tid + i * 512, k = id >> 6, n4 = (id & 63) * 4;
      f32x4 v = {0.f, 0.f, 0.f, 0.f};
      if (n0 + n4 < N) v = *(const f32x4*)(src + (size_t)(k0 + k) * N + n0 + n4);
      tile[k][n4 + 0] = v[0]; tile[k][n4 + 1] = v[1]; tile[k][n4 + 2] = v[2]; tile[k][n4 + 3] = v[3];
    }
    __syncthreads();
    {
      const int n = tid >> 1, kh = (tid & 1) * 32;
      if constexpr (F8) {
        unsigned char* drow8 = (unsigned char*)dst + (size_t)rowmap<MODE>(n0 + n) * K + k0 + kh;
#pragma unroll
        for (int i = 0; i < 2; ++i) {
          u32x4 w;
#pragma unroll
          for (int q = 0; q < 4; ++q) { const int kk = kh + i * 16 + q * 4; w[q] = pack_fp8x4(tile[kk][n] * 32.f, tile[kk + 1][n] * 32.f, tile[kk + 2][n] * 32.f, tile[kk + 3][n] * 32.f); }
          *(u32x4*)(drow8 + i * 16) = w;
        }
      } else {
      bf16_t* drow = dst + (size_t)rowmap<MODE>(n0 + n) * K + k0 + kh;
#pragma unroll
      for (int i = 0; i < 4; ++i) {
        u32x4 w;
        w[0] = cvtpk(tile[kh + i * 8 + 0][n], tile[kh + i * 8 + 1][n]);
        w[1] = cvtpk(tile[kh + i * 8 + 2][n], tile[kh + i * 8 + 3][n]);
        w[2] = cvtpk(tile[kh + i * 8 + 4][n], tile[kh + i * 8 + 5][n]);
        w[3] = cvtpk(tile[kh + i * 8 + 6][n], tile[kh + i * 8 + 7][n]);
        *(u32x4*)(drow + i * 8) = w;
      }
      }
    }
    __syncthreads();
  }
}

constexpr float W8_SCALE = 32.f;
__device__ __forceinline__ void tconv8_tile(const float* __restrict__ src, int K, int N, unsigned char* __restrict__ dst, int mode, int k0, int n0, char* smem) {
  unsigned* img = (unsigned*)smem;
  const int tid = otid();
  f32x4 va[8], vb[8];
#define T8_LOAD(V, S) do { _Pragma("unroll") for (int j = 0; j < 2; ++j) { const int id = tid + j * 512; const float* bp = src + (size_t)(k0 + (S) * 16 + (id >> 8) * 4) * N + n0 + (id & 255) * 4; \
    _Pragma("unroll") for (int r = 0; r < 4; ++r) V[j * 4 + r] = __builtin_nontemporal_load((const f32x4*)(bp + (size_t)r * N)); } } while (0)
#define T8_PUT(V, S) do { _Pragma("unroll") for (int j = 0; j < 2; ++j) { const int id = tid + j * 512; unsigned* ip = img + ((id & 255) * 4) * 33 + (S) * 4 + (id >> 8); \
    _Pragma("unroll") for (int q = 0; q < 4; ++q) ip[q * 33] = pack_fp8x4(V[j * 4 + 0][q] * W8_SCALE, V[j * 4 + 1][q] * W8_SCALE, V[j * 4 + 2][q] * W8_SCALE, V[j * 4 + 3][q] * W8_SCALE); } } while (0)
  T8_LOAD(va, 0);
#pragma unroll
  for (int s2 = 0; s2 < 4; ++s2) {
    T8_LOAD(vb, 2 * s2 + 1);
    T8_PUT(va, 2 * s2);
    if (s2 < 3) T8_LOAD(va, 2 * s2 + 2);
    T8_PUT(vb, 2 * s2 + 1);
  }
  __syncthreads();
#pragma unroll
  for (int i = 0; i < 16; ++i) {
    const int idx = tid + i * 512, n = idx >> 3, ch = idx & 7, ng = n0 + n;
    const int drow = mode == 0 ? ng : (32 * (ng >> 4) + (ng & 15) + (mode == 2 ? 16 : 0));
    const unsigned* ip = img + n * 33 + ch * 4;
    const u32x4 w = {ip[0], ip[1], ip[2], ip[3]};
    __builtin_nontemporal_store(w, (u32x4*)(dst + (size_t)drow * K + k0 + ch * 16));
  }
  __syncthreads();
#undef T8_LOAD
#undef T8_PUT
}
__device__ __forceinline__ void ph_weights_small(const Params& p, char* smem) {
  tconv<3, true>(p.even_w_in, DM, EIN, EINP, WSP(bf16_t, OFF_WIN0), smem);
  tconv<0>(p.w_uq, 512, 1536, 1536, WSP(bf16_t, OFF_WUQ), smem);
  tconv<0>(p.w_ukv, 512, 2048, 2048, WSP(bf16_t, OFF_WUKV), smem);
  tconv<0>(p.even_w_out, DM, DM, DM, WSP(bf16_t, OFF_WOUT0), smem);
  tconv<0>(p.odd_w_in, DM, DM, DM, WSP(bf16_t, OFF_WIN1), smem);
  tconv<0>(p.odd_w_out, DM, DM, DM, WSP(bf16_t, OFF_WOUT1), smem);
  for (int g = 0; g < 4; ++g) {
    tconv<0>(p.pool_w + (size_t)g * 65536, 256, 256, 256, WSP(bf16_t, OFF_WPOOL) + (size_t)g * 65536, smem);
  }
}
__device__ __forceinline__ void conv_item(const Params& p, char* smem, int g) {
  const int mat = g >> 5, st = g & 31, le = mat / 3, which = mat - 3 * le, k0 = (st & 15) * 128, n0 = (st >> 4) * 1024;
  const size_t so = (size_t)le * 2048 * 2048;
  const float* src = (which == 0 ? p.w_gate : (which == 1 ? p.w_up : p.w_down)) + so;
  unsigned char* dst = which == 2 ? WSP(unsigned char, OFF_WD) + so : WSP(unsigned char, OFF_WGU) + (size_t)le * 4096 * 2048;
  tconv8_tile(src, 2048, 2048, dst, which == 2 ? 0 : which + 1, k0, n0, smem);
}
__device__ __forceinline__ void ph_weights_expert(const Params& p, char* smem, int widx, int wcount) {
  for (int g = widx; g < 2 * NE * 3 * 32; g += wcount) conv_item(p, smem, g);
}

__device__ __forceinline__ void ph_mod(const Params& p, char* smem) {
  float* sc = (float*)smem;
  float* part = sc + 5 * 2048;
  const int tid = otid();
  for (int i = tid; i < 5 * 2048; i += 512) {
    const int r = i >> 11, k = i & 2047;
    const float v = r < 4 ? p.c[r * 2048 + k] : p.c_ctx[k];
    sc[i] = v / (1.f + __expf(-v));
  }
  __syncthreads();
  for (int cb = blockIdx.x; cb < 256; cb += gridDim.x) {
    const int l = cb >> 7, j0 = (cb & 127) * 96;
    const int c4 = tid % 24, kg = tid / 24;
    if (tid < 504) {
      f32x4 acc[5];
#pragma unroll
      for (int r = 0; r < 5; ++r) acc[r] = (f32x4){0.f, 0.f, 0.f, 0.f};
      const float* wp = p.mod_w + (size_t)l * 2048 * MLW + j0 + c4 * 4;
#pragma unroll 4
      for (int k = kg; k < 2048; k += 21) {
        const f32x4 w = *(const f32x4*)(wp + (size_t)k * MLW);
#pragma unroll
        for (int r = 0; r < 5; ++r) acc[r] += sc[r * 2048 + k] * w;
      }
#pragma unroll
      for (int r = 0; r < 5; ++r)
#pragma unroll
        for (int q = 0; q < 4; ++q) part[(kg * 5 + r) * 96 + c4 * 4 + q] = acc[r][q];
    }
    __syncthreads();
    if (tid < 480) {
      const int r = tid / 96, col = tid % 96;
      float s = p.mod_b[l * MLW + j0 + col];
      for (int g = 0; g < 21; ++g) s += part[(g * 5 + r) * 96 + col];
      WSP(float, OFF_ML)[((size_t)l * 5 + r) * MLW + j0 + col] = s;
    }
    __syncthreads();
  }
}

__device__ __forceinline__ void ph_twiddle(const Params& p, char* smem) {
  float* ct = (float*)smem;
  for (int j = otid(); j < 4096; j += 512) ct[j] = cospif((float)j * (1.f / 2048.f));
  __syncthreads();
  bf16_t* tw = WSP(bf16_t, OFF_TW);
  const size_t nchunk = (size_t)4096 * 512;
  for (size_t q = (size_t)blockIdx.x * 512 + otid(); q < nchunk; q += (size_t)gridDim.x * 512) {
    const int k1 = (int)(q >> 9), kk0 = (int)(q & 511) * 8;
    float v[8];
#pragma unroll
    for (int j = 0; j < 8; ++j) {
      const int kk = kk0 + j;
      if (kk <= 2048) v[j] = ct[(k1 * kk) & 4095];
      else v[j] = -ct[(k1 * (kk - 2048) - 1024) & 4095];
    }
    u32x4 w = {cvtpk(v[0], v[1]), cvtpk(v[2], v[3]), cvtpk(v[4], v[5]), cvtpk(v[6], v[7])};
    *(u32x4*)(tw + q * 8) = w;
  }
  bf16_t* mc = WSP(bf16_t, OFF_MC);
  for (int i = blockIdx.x * 512 + otid(); i < 4 * 256 * 256; i += gridDim.x * 512) {
    const int d = i & 255, c = (i >> 8) & 255, g = i >> 16;
    const float* fw = p.fourier_w + (size_t)g * 65536 + d;
    float ac = 0.f, as = 0.f;
#pragma unroll 8
    for (int k2 = 0; k2 < 256; ++k2) {
      const int ph = ((k2 * c) & 255) * 16; const float f = fw[k2 * 256];
      ac += f * ct[ph]; as += f * ct[(ph - 1024) & 4095];
    }
    mc[((size_t)(g * 512 + d) * 256) + c] = f2bf(ac); mc[((size_t)(g * 512 + 256 + d) * 256) + c] = f2bf(as);
  }
  __syncthreads();
}

struct Row8 { f32x4 v[8]; };
__device__ __forceinline__ float row_load_ss(const float* src, int lane, Row8& r) {
  float ss = 0.f;
#pragma unroll
  for (int i = 0; i < 8; ++i) { r.v[i] = *(const f32x4*)(src + i * 256 + lane * 4); ss += r.v[i][0] * r.v[i][0] + r.v[i][1] * r.v[i][1] + r.v[i][2] * r.v[i][2] + r.v[i][3] * r.v[i][3]; }
  return wave_sum(ss);
}
__device__ __forceinline__ float row_load_ss_bf16(const bf16_t* src, int lane, Row8& r) {
  float ss = 0.f;
#pragma unroll
  for (int i = 0; i < 8; ++i) { const u32x2 w = *(const u32x2*)(src + i * 256 + lane * 4); r.v[i] = (f32x4){bf_lo(w[0]), bf_hi(w[0]), bf_lo(w[1]), bf_hi(w[1])};
    ss += r.v[i][0] * r.v[i][0] + r.v[i][1] * r.v[i][1] + r.v[i][2] * r.v[i][2] + r.v[i][3] * r.v[i][3]; }
  return wave_sum(ss);
}
__device__ __forceinline__ void row_norm_mod(Row8& r, float inv, const float* gain, const float* sc, const float* sh, int lane) {
#pragma unroll
  for (int i = 0; i < 8; ++i) {
    const int j = i * 256 + lane * 4;
    const f32x4 g = *(const f32x4*)(gain + j);
    f32x4 y = r.v[i] * inv * g;
    if (sc) { const f32x4 s1 = *(const f32x4*)(sc + j), s0 = *(const f32x4*)(sh + j); y = y * (1.f + s1) + s0; }
    r.v[i] = y;
  }
}
__device__ __forceinline__ void row_store_fp8(const Row8& r, unsigned char* dst, int lane) {
#pragma unroll
  for (int i = 0; i < 8; ++i) *(unsigned*)(dst + i * 256 + lane * 4) = pack_fp8x4(r.v[i][0], r.v[i][1], r.v[i][2], r.v[i][3]);
}
__device__ __forceinline__ void row_store_bf16(const Row8& r, bf16_t* dst, int lane) {
#pragma unroll
  for (int i = 0; i < 8; ++i) { u32x2 w = {cvtpk(r.v[i][0], r.v[i][1]), cvtpk(r.v[i][2], r.v[i][3])}; *(u32x2*)(dst + i * 256 + lane * 4) = w; }
}

__device__ __forceinline__ void ph_pre0(const Params& p) {
  const int lane = otid() & 63;
  for (int r = gwave(); r < NA; r += nwave()) {
    const float* src = r < NT ? p.x + (size_t)r * DM : p.ctx + (size_t)(r - NT) * DM;
    const float* ml = mlp(p, 0, r < NT ? r / SEQ : 4);
    Row8 row; const float ss = row_load_ss(src, lane, row);
    row_norm_mod(row, rsqrtf(ss * (1.f / DM) + EPS), p.norm_mix, ml + 2048, ml, lane);
    row_store_fp8(row, WSP(unsigned char, OFF_H) + (size_t)r * DM, lane);
  }
}

__device__ __forceinline__ float rope_inv_freq(int q, int quarter) { return exp2f(-(float)q / (float)quarter * 13.287712379549449f); }

__device__ __forceinline__ void ph_post_inproj(const Params& p) {
  const int lane = otid() & 63;
  const bf16_t* P0 = WSP(const bf16_t, OFF_P0);
  for (int r = gwave(); r < NA; r += nwave()) {
    const bool lat = r < NT;
    int b, keyrow, prow = 0, pcol = 0;
    if (lat) { b = r / SEQ; const int n = r % SEQ; keyrow = b * NKEY + CTXL + n; prow = n >> 6; pcol = n & 63; }
    else { const int i = r - NT; b = i / CTXL; keyrow = b * NKEY + (i % CTXL); }
    const bf16_t* row = P0 + (size_t)r * P0W;
    const u32x4 wq = *(const u32x4*)(row + lane * 8), wkv = *(const u32x4*)(row + 512 + lane * 8);
    const float xkr = bf2f(row[1024 + lane]);
    asm volatile("" ::: "memory");
    if (lat) {
      const u32x4 w = wq;
      float v[8] = {bf_lo(w[0]), bf_hi(w[0]), bf_lo(w[1]), bf_hi(w[1]), bf_lo(w[2]), bf_hi(w[2]), bf_lo(w[3]), bf_hi(w[3])};
      float ss = 0.f;
#pragma unroll
      for (int j = 0; j < 8; ++j) ss += v[j] * v[j];
      const float inv = rsqrtf(wave_sum(ss) * (1.f / 512.f) + EPS);
      const f32x4 g0 = *(const f32x4*)(p.q_norm + lane * 8), g1 = *(const f32x4*)(p.q_norm + lane * 8 + 4);
      u32x4 o = {cvtpk(v[0] * inv * g0[0], v[1] * inv * g0[1]), cvtpk(v[2] * inv * g0[2], v[3] * inv * g0[3]),
                 cvtpk(v[4] * inv * g1[0], v[5] * inv * g1[1]), cvtpk(v[6] * inv * g1[2], v[7] * inv * g1[3])};
      *(u32x4*)(WSP(bf16_t, OFF_CQN) + (size_t)r * 512 + lane * 8) = o;
    }
    {
      const u32x4 w = wkv;
      float v[8] = {bf_lo(w[0]), bf_hi(w[0]), bf_lo(w[1]), bf_hi(w[1]), bf_lo(w[2]), bf_hi(w[2]), bf_lo(w[3]), bf_hi(w[3])};
      float ss = 0.f;
#pragma unroll
      for (int j = 0; j < 8; ++j) ss += v[j] * v[j];
      const float inv = rsqrtf(wave_sum(ss) * (1.f / 512.f) + EPS);
      const f32x4 g0 = *(const f32x4*)(p.kv_norm + lane * 8), g1 = *(const f32x4*)(p.kv_norm + lane * 8 + 4);
      u32x4 o = {cvtpk(v[0] * inv * g0[0], v[1] * inv * g0[1]), cvtpk(v[2] * inv * g0[2], v[3] * inv * g0[3]),
                 cvtpk(v[4] * inv * g1[0], v[5] * inv * g1[1]), cvtpk(v[6] * inv * g1[2], v[7] * inv * g1[3])};
      *(u32x4*)(WSP(bf16_t, OFF_CKVN) + (size_t)r * 512 + lane * 8) = o;
    }
    const float pos = (lane >> 5) ? (float)pcol : (float)prow;
    const bool second = (lane >> 4) & 1;
    float c64 = 1.f, s64 = 0.f;
    if (lat) sincosf(pos * rope_inv_freq(lane & 15, 16), &s64, &c64);
    {
      const float xs = xkr;
      const float xp = __shfl_xor(xs, 16, 64);
      const float o = second ? (xs * c64 + xp * s64) : (xs * c64 - xp * s64);
      const unsigned char ob = (unsigned char)(pack_fp8x4(o, o, o, o) & 0xffu);
      unsigned char* ka = WSP(unsigned char, OFF_KA) + (size_t)keyrow * 1536 + 128 + lane;
#pragma unroll
      for (int h = 0; h < 8; ++h) ka[h * 192] = ob;
    }
  }
}

__device__ __forceinline__ void ph_diffcomb(const Params& p) {
  const int lane = otid() & 63;
  float d1 = p.lq1[lane] * p.lk1[lane] + p.lq1[lane + 64] * p.lk1[lane + 64];
  float d2 = p.lq2[lane] * p.lk2[lane] + p.lq2[lane + 64] * p.lk2[lane + 64];
  d1 = wave_sum(d1); d2 = wave_sum(d2);
  const float lam_init = 0.2f;
  const float lam = expf(d1) - expf(d2) + lam_init;
  const f32x4 sg = *(const f32x4*)(p.subln + lane * 4);
  const bf16_t* OD = WSP(const bf16_t, OFF_OD);
  for (int r = gwave(); r < NT; r += nwave()) {
    u32x2 w0[4], w1[4];
#pragma unroll
    for (int h = 0; h < 4; ++h) { w0[h] = *(const u32x2*)(OD + (size_t)r * 2048 + h * 256 + lane * 4); w1[h] = *(const u32x2*)(OD + (size_t)r * 2048 + 1024 + h * 256 + lane * 4); }
    asm volatile("" ::: "memory");
#pragma unroll
    for (int h = 0; h < 4; ++h) {
      const f32x4 o0 = {bf_lo(w0[h][0]), bf_hi(w0[h][0]), bf_lo(w0[h][1]), bf_hi(w0[h][1])}, o1 = {bf_lo(w1[h][0]), bf_hi(w1[h][0]), bf_lo(w1[h][1]), bf_hi(w1[h][1])};
      const f32x4 d = o0 - lam * o1;
      const float ss = wave_sum(d[0] * d[0] + d[1] * d[1] + d[2] * d[2] + d[3] * d[3]);
      const float inv = rsqrtf(ss * (1.f / 256.f) + EPS) * (1.f - lam_init);
      u32x2 w = {cvtpk(d[0] * inv * sg[0], d[1] * inv * sg[1]), cvtpk(d[2] * inv * sg[2], d[3] * inv * sg[3])};
      *(u32x2*)(WSP(bf16_t, OFF_YIN) + (size_t)r * 2048 + 1024 + h * 256 + lane * 4) = w;
    }
  }
}

__device__ __forceinline__ void ph_ffn_pre(const Params& p, int l, char* smem) {
  const int lane = otid() & 63, tid = otid();
  float* rw = (float*)smem;
  const float* rsrc = p.router_w + (size_t)l * DM * NE;
  for (int id = tid; id < DM * 4; id += 512) {
    const int j = id >> 2, q = id & 3;
    const f32x4 v = *(const f32x4*)(rsrc + j * 16 + q * 4);
    const int i = j >> 8, ln = (j & 255) >> 2, k = j & 3;
    *(f32x4*)(rw + ((((q * 8 + i) * 4 + k) * 64 + ln) << 2)) = v;
  }
  __syncthreads();
  for (int r = gwave(); r < NT; r += nwave()) {
    const int b = r / SEQ, n = r % SEQ;
    const float* ml = mlp(p, l, b);
    Row8 row; const float ss = row_load_ss_bf16(WSP(const bf16_t, OFF_XL) + (size_t)r * DM, lane, row);
    row_norm_mod(row, rsqrtf(ss * (1.f / DM) + EPS), p.norm_ffn + l * DM, ml + 8192, ml + 6144, lane);
    row_store_fp8(row, WSP(unsigned char, OFF_H) + (size_t)r * DM, lane);
    float lg[16];
#pragma unroll
    for (int e = 0; e < 16; ++e) lg[e] = 0.f;
#pragma unroll
    for (int i = 0; i < 8; ++i) {
      __builtin_amdgcn_sched_barrier(0);
#pragma unroll
      for (int k = 0; k < 4; ++k) {
        const float hv = row.v[i][k];
#pragma unroll
        for (int q = 0; q < 4; ++q) {
          const f32x4 w = *(const f32x4*)(rw + ((((q * 8 + i) * 4 + k) * 64 + lane) << 2));
          lg[q * 4 + 0] += hv * w[0]; lg[q * 4 + 1] += hv * w[1]; lg[q * 4 + 2] += hv * w[2]; lg[q * 4 + 3] += hv * w[3];
        }
      }
    }
    float mx = -1e30f;
#pragma unroll
    for (int e = 0; e < 16; ++e) { lg[e] = wave_sum(lg[e]); mx = fmaxf(mx, lg[e]); }
    float den = 0.f;
#pragma unroll
    for (int e = 0; e < 16; ++e) { lg[e] = expf(lg[e] - mx); den += lg[e]; }
    const float rden = 1.f / den;
    float mine = 0.f;
#pragma unroll
    for (int e = 0; e < 16; ++e) mine = (lane == e) ? lg[e] * rden : mine;
    if (lane < 16) {
      WSP(float, OFF_AFF)[((size_t)(b * NE + lane)) * SEQ + n] = mine;
      WSP(int, OFF_INV)[(size_t)r * NE + lane] = -1;
    }
  }
  __syncthreads();
}

__device__ __forceinline__ void ph_topk(const Params& p, char* smem) {
  unsigned* cnt = (unsigned*)smem;
  const int tid = otid(), lane = tid & 63, wid = tid >> 6;
  for (int be = blockIdx.x; be < NB * NE; be += gridDim.x) {
    const int b = be / NE, e = be % NE;
    const float* src = WSP(const float, OFF_AFF) + (size_t)be * SEQ + tid * 8;
    const f32x4 v0 = *(const f32x4*)src, v1 = *(const f32x4*)(src + 4);
    const float val[8] = {v0[0], v0[1], v0[2], v0[3], v1[0], v1[1], v1[2], v1[3]};
    unsigned key[8];
#pragma unroll
    for (int j = 0; j < 8; ++j) key[j] = __float_as_uint(val[j]);
    unsigned lo = 0u, hi = 0x3f800000u; int par = 0;
    __syncthreads();
    while (lo < hi) {
      const unsigned span = hi - lo + 1u;
      const unsigned t1 = lo + (span >> 2), t2 = lo + (span >> 1), t3 = lo + (span >> 1) + (span >> 2);
      unsigned c1 = 0u, c2 = 0u, c3 = 0u;
#pragma unroll
      for (int k = 0; k < 8; ++k) { c1 += (unsigned)__popcll(__ballot(key[k] >= t1)); c2 += (unsigned)__popcll(__ballot(key[k] >= t2)); c3 += (unsigned)__popcll(__ballot(key[k] >= t3)); }
      if (lane < 3) cnt[par * 32 + wid * 4 + lane] = lane == 0 ? c1 : (lane == 1 ? c2 : c3);
      __syncthreads();
      unsigned s1 = 0u, s2 = 0u, s3 = 0u;
#pragma unroll
      for (int w = 0; w < 8; ++w) { s1 += cnt[par * 32 + w * 4]; s2 += cnt[par * 32 + w * 4 + 1]; s3 += cnt[par * 32 + w * 4 + 2]; }
      par ^= 1;
      if (s1 < (unsigned)CAP) hi = t1 - 1u;
      else if (s2 < (unsigned)CAP) { lo = t1; hi = t2 - 1u; }
      else if (s3 < (unsigned)CAP) { lo = t2; hi = t3 - 1u; }
      else lo = t3;
    }
    const unsigned T = lo;
    int ngt = 0, neq = 0;
#pragma unroll
    for (int j = 0; j < 8; ++j) { ngt += key[j] > T ? 1 : 0; neq += key[j] == T ? 1 : 0; }
    int pk = ngt | (neq << 16);
    int inc = pk;
#pragma unroll
    for (int o = 1; o < 64; o <<= 1) { const int t = __shfl_up(inc, o, 64); if (lane >= o) inc += t; }
    if (lane == 63) cnt[128 + wid] = (unsigned)inc;
    __syncthreads();
    int base = 0, total = 0;
#pragma unroll
    for (int w = 0; w < 8; ++w) { const int t = (int)cnt[128 + w]; total += t; if (w < wid) base += t; }
    const int excl = base + inc - pk;
    int gpos = excl & 0xffff, epos = excl >> 16;
    const int total_gt = total & 0xffff, need = CAP - total_gt;
#pragma unroll
    for (int j = 0; j < 8; ++j) {
      int slot = -1;
      if (key[j] > T) slot = gpos++;
      else if (key[j] == T) { if (epos < need) slot = total_gt + epos; ++epos; }
      if (slot >= 0) {
        const int tok = tid * 8 + j;
        WSP(int, OFF_IDX)[be * CAP + slot] = tok; WSP(float, OFF_GATE)[be * CAP + slot] = val[j];
        WSP(int, OFF_INV)[(size_t)(b * SEQ + tok) * NE + e] = slot;
      }
    }
    __syncthreads();
  }
}

__device__ __forceinline__ void ph_combine(const Params& p, int l) {
  const int lane = otid() & 63;
  for (int r = gwave(); r < NT; r += nwave()) {
    const int b = r / SEQ;
    Row8 acc;
#pragma unroll
    for (int i = 0; i < 8; ++i) acc.v[i] = (f32x4){0.f, 0.f, 0.f, 0.f};
    const int myinv = WSP(const int, OFF_INV)[(size_t)r * NE + (lane & 15)];
    unsigned long long mask = __ballot(myinv >= 0) & 0xffffull;
    bf16_t* xl = WSP(bf16_t, OFF_XL) + (size_t)r * DM;
    u32x2 xw[8];
#pragma unroll
    for (int i = 0; i < 8; ++i) xw[i] = *(const u32x2*)(xl + i * 256 + lane * 4);
    while (mask) {
      const int e = __builtin_ctzll(mask); mask &= mask - 1;
      const int s = __builtin_amdgcn_readlane(myinv, e);
      const bf16_t* ye = WSP(const bf16_t, OFF_YE) + ((size_t)e * 2048 + b * CAP + s) * DM;
#pragma unroll
      for (int i = 0; i < 8; ++i) {
        const u32x2 w = *(const u32x2*)(ye + i * 256 + lane * 4);
        acc.v[i][0] += bf_lo(w[0]); acc.v[i][1] += bf_hi(w[0]); acc.v[i][2] += bf_lo(w[1]); acc.v[i][3] += bf_hi(w[1]);
      }
    }
    const float* ml = mlp(p, l, b);
    Row8 row; float ss = 0.f;
#pragma unroll
    for (int i = 0; i < 8; ++i) {
      const int j = i * 256 + lane * 4;
      const f32x4 g2 = *(const f32x4*)(ml + 10240 + j);
      row.v[i] = (f32x4){bf_lo(xw[i][0]), bf_hi(xw[i][0]), bf_lo(xw[i][1]), bf_hi(xw[i][1])} + g2 * acc.v[i];
      ss += row.v[i][0] * row.v[i][0] + row.v[i][1] * row.v[i][1] + row.v[i][2] * row.v[i][2] + row.v[i][3] * row.v[i][3];
    }
    ss = wave_sum(ss);
    const float inv = rsqrtf(ss * (1.f / DM) + EPS);
    if (l == 0) {
#pragma unroll
      for (int i = 0; i < 8; ++i) { u32x2 w = {cvtpk(row.v[i][0], row.v[i][1]), cvtpk(row.v[i][2], row.v[i][3])}; *(u32x2*)(xl + i * 256 + lane * 4) = w; }
      const float* ml1 = mlp(p, 1, b);
      row_norm_mod(row, inv, p.norm_mix + DM, ml1 + 2048, ml1, lane);
      row_store_bf16(row, WSP(bf16_t, OFF_H) + (size_t)r * DM, lane);
    } else {
      row_norm_mod(row, inv, p.final_norm, nullptr, nullptr, lane);
#pragma unroll
      for (int i = 0; i < 8; ++i) *(f32x4*)(p.out + (size_t)r * DM + i * 256 + lane * 4) = row.v[i];
    }
  }
}

__device__ __forceinline__ void ph_fold(const Params& p) {
  const bf16_t* src = WSP(const bf16_t, OFF_ABT2); bf16_t* dst = WSP(bf16_t, OFF_ABTF);
  float* nyq = WSP(float, OFF_IDX);
  for (int id = blockIdx.x * 512 + otid(); id < 4096 * 512; id += gridDim.x * 512) {
    const int rowi = id >> 9, kk0 = (id & 511) * 8;
    const bf16_t* rp = src + (size_t)rowi * 8192;
    float o[8];
    if (kk0 < 2048) {
      const u32x4 w = *(const u32x4*)(rp + kk0);
#pragma unroll
      for (int j = 0; j < 4; ++j) { o[2 * j] = bf_lo(w[j]); o[2 * j + 1] = bf_hi(w[j]); }
#pragma unroll
      for (int j = 0; j < 8; ++j) { const int kk = kk0 + j; if (kk > 0) o[j] += bf2f(rp[4096 - kk]); }
    } else {
      const int j0 = kk0 - 2048;
      const u32x4 w = *(const u32x4*)(rp + 4096 + j0);
#pragma unroll
      for (int j = 0; j < 4; ++j) { o[2 * j] = bf_lo(w[j]); o[2 * j + 1] = bf_hi(w[j]); }
#pragma unroll
      for (int j = 0; j < 8; ++j) { const int jj = j0 + j; if (jj > 0) o[j] -= bf2f(rp[4096 + 4096 - jj]); else o[j] = bf2f(rp[2048]); }
      if (j0 == 0) nyq[rowi] = o[0];
    }
    u32x4 ow = {cvtpk(o[0], o[1]), cvtpk(o[2], o[3]), cvtpk(o[4], o[5]), cvtpk(o[6], o[7])};
    *(u32x4*)(dst + (size_t)rowi * 4096 + kk0) = ow;
  }
}

__device__ __forceinline__ void ph_dftcomb(const Params& p) {
  const bf16_t* PQ = WSP(const bf16_t, OFF_SPEC); const bf16_t* abtf = WSP(const bf16_t, OFF_ABTF); bf16_t* Y = WSP(bf16_t, OFF_YCAT);
  const float sc = 1.f / 1024.f;
  for (int id = blockIdx.x * 512 + otid(); id < 16 * 2048 * 32; id += gridDim.x * 512) {
    const int d8 = (id & 31) * 8, k1 = (id >> 5) & 2047, bg = id >> 16, b = bg >> 2, g = bg & 3;
    const u32x4 wp = *(const u32x4*)(PQ + ((size_t)(2 * bg) * 2048 + k1) * 256 + d8), wq = *(const u32x4*)(PQ + ((size_t)(2 * bg + 1) * 2048 + k1) * 256 + d8);
    float pv[8], qv[8], ny[8];
#pragma unroll
    for (int j = 0; j < 4; ++j) { pv[2 * j] = bf_lo(wp[j]); pv[2 * j + 1] = bf_hi(wp[j]); qv[2 * j] = bf_lo(wq[j]); qv[2 * j + 1] = bf_hi(wq[j]); }
    const float sgn = (k1 & 1) ? -2.f : 2.f;
    { const f32x4 n0 = *(const f32x4*)(WSP(const float, OFF_IDX) + bg * 256 + d8), n1 = *(const f32x4*)(WSP(const float, OFF_IDX) + bg * 256 + d8 + 4);
#pragma unroll
      for (int j = 0; j < 4; ++j) { ny[j] = sgn * n0[j]; ny[4 + j] = sgn * n1[j]; } }
    bf16_t* y0 = Y + ((size_t)b * SEQ + k1) * DM + 1024 + g * 256 + d8;
    u32x4 o;
#pragma unroll
    for (int j = 0; j < 4; ++j) o[j] = cvtpk((pv[2 * j] + qv[2 * j]) * sc, (pv[2 * j + 1] + qv[2 * j + 1]) * sc);
    *(u32x4*)y0 = o;
    if (k1 > 0) {
#pragma unroll
      for (int j = 0; j < 4; ++j) o[j] = cvtpk((pv[2 * j] - qv[2 * j] + ny[2 * j]) * sc, (pv[2 * j + 1] - qv[2 * j + 1] + ny[2 * j + 1]) * sc);
      *(u32x4*)(Y + ((size_t)b * SEQ + (SEQ - k1)) * DM + 1024 + g * 256 + d8) = o;
    }
  }
  const int lane = otid() & 63;
  for (int r = gwave(); r < 16 * 256; r += nwave()) {
    const bf16_t* row = abtf + (size_t)r * 4096;
    float acc = 0.f;
#pragma unroll
    for (int i = 0; i < 4; ++i) { const u32x4 w = *(const u32x4*)(row + i * 512 + lane * 8);
#pragma unroll
      for (int j = 0; j < 4; ++j) acc += bf_lo(w[j]) - bf_hi(w[j]); }
    acc = wave_sum(acc) + bf2f(row[2048]);
    if (lane == 0) { const int bg = r >> 8, d = r & 255; Y[((size_t)(bg >> 2) * SEQ + 2048) * DM + 1024 + (bg & 3) * 256 + d] = f2bf(acc * sc); }
  }
}

__device__ __forceinline__ void ph_pool(const Params& p) {
  const bf16_t* Z = WSP(const bf16_t, OFF_Z);
  for (int id = blockIdx.x * 512 + otid(); id < NT * 128; id += gridDim.x * 512) {
    const int r = id >> 7, c8 = (id & 127) * 8, g = c8 >> 8, half = 1 << g;
    const int b = r / SEQ, n = r % SEQ;
    const int lo = max(n - half, 0), hi = min(n + half, SEQ);
    float s[8];
#pragma unroll
    for (int j = 0; j < 8; ++j) s[j] = 0.f;
    u32x4 wv[16];
#pragma unroll
    for (int d = 0; d < 16; ++d) { int t = n - 8 + d; t = t < lo ? lo : (t >= hi ? hi - 1 : t); wv[d] = *(const u32x4*)(Z + (size_t)(b * SEQ + t) * 2048 + c8); }
#pragma unroll
    for (int d = 0; d < 16; ++d) { const int t = n - 8 + d; const float wt = (t >= lo && t < hi) ? 1.f : 0.f;
#pragma unroll
      for (int j = 0; j < 4; ++j) { s[2 * j] += wt * bf_lo(wv[d][j]); s[2 * j + 1] += wt * bf_hi(wv[d][j]); } }
    const float rc = 1.f / (float)(hi - lo);
    const u32x4 w = *(const u32x4*)(Z + (size_t)r * 2048 + c8);
    u32x4 o;
#pragma unroll
    for (int j = 0; j < 4; ++j) o[j] = cvtpk(s[2 * j] * rc - bf_lo(w[j]), s[2 * j + 1] * rc - bf_hi(w[j]));
    *(u32x4*)(WSP(bf16_t, OFF_POOLED) + (size_t)r * 1024 + c8) = o;
  }
}

#define LAS __attribute__((address_space(3)))
__host__ __device__ __forceinline__ constexpr int vt_pos(int kap) { return (((kap >> 2) & 1) << 5) | ((kap >> 5) << 4) | (((kap >> 3) & 3) << 2) | (kap & 3); }
namespace fg {
constexpr int BM = 256, BK = 64, HALF = 128, HTB = HALF * BK * 2, STAGE_BYTES = 8 * HTB;
__device__ __forceinline__ int lds_byte(int r, int c) { const int st = (r >> 4) * 2 + (c >> 5), rr = r & 15, cc = c & 31, ob = rr * 64 + cc * 2; return st * 1024 + (ob ^ (((ob >> 9) & 1) << 5)); }
__device__ __forceinline__ void stage_rc(int b, int& R, int& C) { const int st = b / 1024, sb = b % 1024, swz = sb ^ (((sb >> 9) & 1) << 5); R = (st >> 1) * 16 + swz / 64; C = (st & 1) * 32 + (swz % 64) / 2; }
struct Unit { const char* a; const char* b; int pm, pn, grp; };
typedef int i32x8 __attribute__((ext_vector_type(8)));
typedef int i32x4 __attribute__((ext_vector_type(4)));
__device__ __forceinline__ void mfma_fp8(f32x4& acc, const i32x8& a, const i32x8& b, int scale) {
  asm volatile("s_nop 1\n\tv_mfma_scale_f32_16x16x128_f8f6f4 %0, %1, %2, %0, %3, %3 op_sel_hi:[0,0,0]" : "+v"(acc) : "v"(a), "v"(b), "v"(scale));
}
template <int H> __device__ __forceinline__ bf16x8 half8(i32x8 v) { const i32x4 h = H ? __builtin_shufflevector(v, v, 4, 5, 6, 7) : __builtin_shufflevector(v, v, 0, 1, 2, 3); return __builtin_bit_cast(bf16x8, h); }
__device__ __forceinline__ i32x8 cat8(bf16x8 lo, bf16x8 hi) { const i32x4 a = __builtin_bit_cast(i32x4, lo), b = __builtin_bit_cast(i32x4, hi); return (i32x8){a[0], a[1], a[2], a[3], b[0], b[1], b[2], b[3]}; }
struct Grid {
  const char* A; const char* B; size_t sA, sB; int lda, ldb, nM, nN, ngrp, G, c; int gd = 1; size_t sA2 = 0, sB2 = 0;
  __device__ __forceinline__ bool next(int i, Unit& u) const {
    const int cc = (G == 256) ? ((c & 7) * 32 + (c >> 3)) : c;
    const int L = i * G + cc, per = nM * nN;
    if (L >= per * ngrp) return false;
    const int g = L / per, w = L - g * per;
    const int nig = 8 * nN, gid = w / nig, fm = gid * 8, gsz = (nM - fm) < 8 ? (nM - fm) : 8, wi = w - gid * nig;
    u.grp = g; u.pn = wi / gsz; u.pm = fm + (wi - u.pn * gsz);
    const int g1 = g / gd, g2 = g - g1 * gd;
    u.a = A + (size_t)g1 * sA + (size_t)g2 * sA2 + (size_t)u.pm * 256 * lda * 2; u.b = B + (size_t)g1 * sB + (size_t)g2 * sB2 + (size_t)u.pn * 256 * ldb * 2;
    return true;
  }
};
template <class Epi, bool GATHER = false, bool FP8 = false>
__device__ __forceinline__ void gemm_fast(LAS unsigned char* lds, const Grid& S, const Epi& E, int K, const int* gidx = nullptr) {
  int tid_ = threadIdx.x; asm volatile("" : "+v"(tid_));
  const int tid = tid_, wid = __builtin_amdgcn_readfirstlane(tid >> 6), lane = tid & 63, wr = wid >> 2, wc = wid & 3, fr = lane & 15, fq = lane >> 4;
  const int nt = K / BK;
  unsigned voffA[2], voffB[2];
#pragma unroll
  for (int i = 0; i < 2; ++i) { int R, C; stage_rc(tid * 16 + i * 8192, R, C); voffA[i] = (unsigned)(R * S.lda + C) * 2u; voffB[i] = (unsigned)(R * S.ldb + C) * 2u; }
  const size_t kstep = (size_t)(BK * 2);
  const size_t hstepA = (size_t)HALF * S.lda * 2, hstepB = (size_t)HALF * S.ldb * 2;
  const unsigned ldsw = (unsigned)wid * 1024u;
  const int aoff = FP8 ? lds_byte(wr * 64 + fr, fq * 16) : lds_byte(wr * 64 + fr, fq * 8), boff = FP8 ? lds_byte(wc * 32 + fr, fq * 16) : lds_byte(wc * 32 + fr, fq * 8);
  constexpr int KOFF = FP8 ? 16 : 1024;
#define FG_SA(b, h) (((b) * 2 + (h)) * HTB)
#define FG_SB(b, h) ((4 + (b) * 2 + (h)) * HTB)
#define FG_STAGE(bufoff, gbase, voff) do { _Pragma("unroll") for (int _i = 0; _i < 2; ++_i) \
    __builtin_amdgcn_global_load_lds((const unsigned*)((const char*)(gbase) + (voff)[_i]), (LAS unsigned*)(lds + (bufoff) + ldsw + _i * 8192), 16, 0, 0); } while (0)
#define FG_STAGE_A(bufoff, usen, kb, h) do { if constexpr (GATHER) { _Pragma("unroll") for (int _i = 0; _i < 2; ++_i) { const unsigned _g = (usen) ? gN[h][_i] : gA[h][_i]; \
      __builtin_amdgcn_global_load_lds((const unsigned*)(S.A + _g + (kb)), (LAS unsigned*)(lds + (bufoff) + ldsw + _i * 8192), 16, 0, 0); } } \
    else { FG_STAGE(bufoff, ((usen) ? nA : cA) + (kb) + (h) * hstepA, voffA); } } while (0)
#define FG_LDA(dst, b, h) do { _Pragma("unroll") for (int m = 0; m < 4; ++m) dst[m] = cat8(*(const LAS bf16x8*)(lds + FG_SA(b, h) + aoff + m * 2048), *(const LAS bf16x8*)(lds + FG_SA(b, h) + aoff + m * 2048 + KOFF)); } while (0)
#define FG_LDB(dst, b, h) do { _Pragma("unroll") for (int n = 0; n < 2; ++n) dst[n] = cat8(*(const LAS bf16x8*)(lds + FG_SB(b, h) + boff + n * 2048), *(const LAS bf16x8*)(lds + FG_SB(b, h) + boff + n * 2048 + KOFF)); } while (0)
#define FG_MMA(ai, bj, At, Bt) do { __builtin_amdgcn_s_setprio(1); _Pragma("unroll") for (int m = 0; m < 4; ++m) _Pragma("unroll") for (int n = 0; n < 2; ++n) { \
    if constexpr (FP8) mfma_fp8(acc[ai][bj][m][n], Bt[n], At[m], one_scale); \
    else { acc[ai][bj][m][n] = __builtin_amdgcn_mfma_f32_16x16x32_bf16(half8<0>(Bt[n]), half8<0>(At[m]), acc[ai][bj][m][n], 0, 0, 0); \
           acc[ai][bj][m][n] = __builtin_amdgcn_mfma_f32_16x16x32_bf16(half8<1>(Bt[n]), half8<1>(At[m]), acc[ai][bj][m][n], 0, 0, 0); } } \
    __builtin_amdgcn_s_setprio(0); } while (0)
#define FG_WAIT_V(n) asm volatile("s_waitcnt vmcnt(" #n ")" ::: "memory")
#define FG_WAIT_L(n) asm volatile("s_waitcnt lgkmcnt(" #n ")" ::: "memory")
#define FG_BAR __builtin_amdgcn_s_barrier()
#define FG_SCHED __builtin_amdgcn_sched_barrier(0)
  Unit cur, nxt; int ui = 0;
  if (!S.next(0, cur)) return;
  f32x4 acc[2][2][4][2];
#pragma unroll
  for (int a = 0; a < 2; ++a)
#pragma unroll
    for (int b = 0; b < 2; ++b)
#pragma unroll
      for (int m = 0; m < 4; ++m)
#pragma unroll
        for (int n = 0; n < 2; ++n) acc[a][b][m][n] = (f32x4){0.f, 0.f, 0.f, 0.f};
  int one_scale = 0x7f7f7f7f; asm volatile("" : "+v"(one_scale));
  i32x8 At[4], B0[2], B1[2];
  const char* cA = cur.a; const char* cB = cur.b; const char* nA = cA;
  unsigned gA[2][2] = {{0u, 0u}, {0u, 0u}}, gN[2][2] = {{0u, 0u}, {0u, 0u}};
  auto goff = [&](const Unit& u, unsigned (&g)[2][2]) {
#pragma unroll
    for (int h = 0; h < 2; ++h)
#pragma unroll
      for (int i = 0; i < 2; ++i) { int R, C; stage_rc(tid * 16 + i * 8192, R, C); const int rr = u.pm * 256 + h * 128 + R, bb = rr >> 9;
        const int tok = bb * SEQ + gidx[(bb * NE + u.grp) * CAP + (rr & 511)]; g[h][i] = (unsigned)(tok * S.lda + C) * 2u; }
  };
  if constexpr (GATHER) goff(cur, gA);
  FG_STAGE(FG_SB(0, 0), cB, voffB); FG_STAGE_A(FG_SA(0, 0), false, 0, 0); FG_STAGE(FG_SB(0, 1), cB + hstepB, voffB); FG_STAGE_A(FG_SA(0, 1), false, 0, 1);
  if (wr == 1) FG_BAR;
  FG_WAIT_V(4); FG_BAR;
  FG_STAGE(FG_SB(1, 0), cB + kstep, voffB); FG_STAGE_A(FG_SA(1, 0), false, kstep, 0); FG_STAGE(FG_SB(1, 1), cB + hstepB + kstep, voffB);
  FG_WAIT_V(6); FG_BAR;
  for (;;) {
    const bool has_next = S.next(ui + 1, nxt);
    nA = has_next ? nxt.a : cA; const char* nB = has_next ? nxt.b : cB;
    if constexpr (GATHER) { if (has_next) goff(nxt, gN); else {
#pragma unroll
      for (int h = 0; h < 2; ++h)
#pragma unroll
        for (int i = 0; i < 2; ++i) gN[h][i] = gA[h][i]; } }
#pragma unroll 1
    for (int t = 0; t < nt; t += 2) {
      const bool last = (t == nt - 2);
      const size_t k1 = (size_t)(t + 1) * kstep, k2 = last ? 0 : (size_t)(t + 2) * kstep, k3 = k2 + kstep;
      const char* b2 = last ? nB : cB + (size_t)(t + 2) * kstep;
      const char* b3 = b2 + kstep;
      FG_LDB(B0, 0, 0); FG_SCHED; FG_LDA(At, 0, 0); FG_STAGE_A(FG_SA(1, 1), false, k1, 1);
      FG_WAIT_L(8); FG_BAR; FG_WAIT_L(0); FG_MMA(0, 0, At, B0); FG_BAR; FG_SCHED;
      FG_LDB(B1, 0, 1); FG_STAGE(FG_SB(0, 0), b2, voffB);
      FG_BAR; FG_WAIT_L(0); FG_MMA(0, 1, At, B1); FG_BAR;
      FG_LDA(At, 0, 1); FG_STAGE_A(FG_SA(0, 0), last, k2, 0);
      FG_BAR; FG_WAIT_L(0); FG_MMA(1, 0, At, B0); FG_BAR; FG_SCHED;
      FG_STAGE(FG_SB(0, 1), b2 + hstepB, voffB);
      FG_WAIT_V(6); FG_BAR; FG_MMA(1, 1, At, B1); FG_BAR;
      FG_LDB(B0, 1, 0); FG_SCHED; FG_LDA(At, 1, 0); FG_STAGE_A(FG_SA(0, 1), last, k2, 1);
      FG_WAIT_L(8); FG_BAR; FG_WAIT_L(0); FG_MMA(0, 0, At, B0); FG_BAR; FG_SCHED;
      FG_LDB(B1, 1, 1); FG_STAGE(FG_SB(1, 0), b3, voffB);
      FG_BAR; FG_WAIT_L(0); FG_MMA(0, 1, At, B1); FG_BAR;
      FG_LDA(At, 1, 1); FG_STAGE_A(FG_SA(1, 0), last, k3, 0);
      FG_BAR; FG_WAIT_L(0); FG_MMA(1, 0, At, B0); FG_BAR; FG_SCHED;
      FG_STAGE(FG_SB(1, 1), b3 + hstepB, voffB);
      FG_WAIT_V(6); FG_BAR; FG_MMA(1, 1, At, B1); FG_BAR;
    }
    if constexpr (FP8) asm volatile("s_nop 15\n\ts_nop 15" ::: "memory");
    {
      int tz = threadIdx.x; asm volatile("" : "+v"(tz));
      const int wz = __builtin_amdgcn_readfirstlane(tz >> 6), lz = tz & 63;
      E(acc, cur, wz >> 2, wz & 3, lz & 15, lz >> 4); }
    if (!has_next) break;
#pragma unroll
    for (int a = 0; a < 2; ++a)
#pragma unroll
      for (int b = 0; b < 2; ++b)
#pragma unroll
        for (int m = 0; m < 4; ++m)
#pragma unroll
          for (int n = 0; n < 2; ++n) acc[a][b][m][n] = (f32x4){0.f, 0.f, 0.f, 0.f};
    cur = nxt; cA = nA; cB = nB; ++ui;
    if constexpr (GATHER) {
#pragma unroll
      for (int h = 0; h < 2; ++h)
#pragma unroll
        for (int i = 0; i < 2; ++i) gA[h][i] = gN[h][i]; }
  }
  FG_WAIT_V(0);
  if (wr == 0) FG_BAR;
  FG_BAR;
#undef FG_SA
#undef FG_SB
#undef FG_STAGE
#undef FG_STAGE_A
#undef FG_LDA
#undef FG_LDB
#undef FG_MMA
#undef FG_WAIT_V
#undef FG_WAIT_L
#undef FG_BAR
#undef FG_SCHED
}
typedef f32x4 Acc[2][2][4][2];
#define FG_FOREACH(...)                                                                                                \
  _Pragma("unroll") for (int ai = 0; ai < 2; ++ai) _Pragma("unroll") for (int m = 0; m < 4; ++m)                       \
  _Pragma("unroll") for (int bj = 0; bj < 2; ++bj) _Pragma("unroll") for (int n = 0; n < 2; ++n) {                     \
    const int row = u.pm * 256 + ai * 128 + wr * 64 + m * 16 + fr, col = u.pn * 256 + bj * 128 + wc * 32 + n * 16 + 4 * fq; \
    const f32x4 v = acc[ai][bj][m][n]; __VA_ARGS__ }
__device__ __forceinline__ u32x2 pack4(f32x4 v) { return (u32x2){cvtpk(v[0], v[1]), cvtpk(v[2], v[3])}; }

struct EpiBf16 {
  bf16_t* O; int ld, nvalid; float scale; int gdiv; size_t s1, s2;
  __device__ __forceinline__ void operator()(const Acc& acc, const Unit& u, int wr, int wc, int fr, int fq) const {
    bf16_t* base = O + (size_t)(u.grp / gdiv) * s1 + (size_t)(u.grp % gdiv) * s2;
    FG_FOREACH(if (col < nvalid) *(u32x2*)(base + (size_t)row * ld + col) = pack4(v * scale);)
  }
};
struct EpiQRope {
  unsigned char* QA;
  __device__ __forceinline__ void operator()(const Acc& acc, const Unit& u, int wr, int wc, int fr, int fq) const {
#pragma unroll
    for (int ai = 0; ai < 2; ++ai)
#pragma unroll
      for (int m = 0; m < 4; ++m)
#pragma unroll
        for (int bj = 0; bj < 2; ++bj) {
          const int row = u.pm * 256 + ai * 128 + wr * 64 + m * 16 + fr, g0 = u.pn * 256 + bj * 128 + wc * 32, w0 = g0 % 192;
          f32x4 x1 = acc[ai][bj][m][0], x2 = acc[ai][bj][m][1];
          if (w0 >= 128) {
            const int ntok = row % SEQ; const float pos = (w0 >= 160) ? (float)(ntok & 63) : (float)(ntok >> 6);
#pragma unroll
            for (int j = 0; j < 4; ++j) { const float ang = pos * rope_inv_freq(4 * fq + j, 16); const float sn = __sinf(ang), cs = __cosf(ang);
              const float a = x1[j], b = x2[j]; x1[j] = a * cs - b * sn; x2[j] = b * cs + a * sn; }
          }
          unsigned char* dst = QA + (size_t)row * 1536 + g0 + 4 * fq;
          *(unsigned*)dst = pack_fp8x4(x1[0], x1[1], x1[2], x1[3]); *(unsigned*)(dst + 16) = pack_fp8x4(x2[0], x2[1], x2[2], x2[3]);
        }
  }
};
struct EpiIn0 {
  bf16_t* P0; unsigned char* QD; unsigned char* KD; unsigned char* VD;
  __device__ __forceinline__ void operator()(const Acc& acc, const Unit& u, int wr, int wc, int fr, int fq) const {
    const bool lat = u.pm < NT / 256;
#pragma unroll
    for (int ai = 0; ai < 2; ++ai)
#pragma unroll
      for (int m = 0; m < 4; ++m) {
        const int row = u.pm * 256 + ai * 128 + wr * 64 + m * 16 + fr;
        int keyrow, ntok = 0;
        if (lat) { ntok = row % SEQ; keyrow = (row / SEQ) * NKEY + CTXL + ntok; } else { const int ii = row - NT; keyrow = (ii / CTXL) * NKEY + (ii % CTXL); }
#pragma unroll
        for (int bj = 0; bj < 2; ++bj) {
          const int g0 = u.pn * 256 + bj * 128 + wc * 32;
          f32x4 x1 = acc[ai][bj][m][0] * (1.f / 32.f), x2 = acc[ai][bj][m][1] * (1.f / 32.f);
          if (g0 < P0W) { bf16_t* dst = P0 + (size_t)row * P0W + g0 + 4 * fq; *(u32x2*)dst = pack4(x1); *(u32x2*)(dst + 16) = pack4(x2); }
          else if (g0 < 3136) {
            const int vv = (g0 - 1088) >> 7, sg = ((g0 - 1088) & 127) >> 5, axis = sg >> 1, qh = sg & 1, e1 = axis * 64 + qh * 16 + 4 * fq;
            if (lat) { const float pos = axis ? (float)(ntok & 63) : (float)(ntok >> 6);
#pragma unroll
              for (int j = 0; j < 4; ++j) { const float ang = pos * rope_inv_freq(qh * 16 + 4 * fq + j, 32); const float sn = __sinf(ang), cs = __cosf(ang);
                const float a = x1[j], b = x2[j]; x1[j] = a * cs - b * sn; x2[j] = b * cs + a * sn; } }
            if (vv < 8) { if (lat) { unsigned char* dst = QD + (size_t)row * 1024 + vv * 128 + e1; *(unsigned*)dst = pack_fp8x4(x1[0], x1[1], x1[2], x1[3]); *(unsigned*)(dst + 32) = pack_fp8x4(x2[0], x2[1], x2[2], x2[3]); } }
            else { unsigned char* dst = KD + (size_t)keyrow * 1024 + (vv - 8) * 128 + e1; *(unsigned*)dst = pack_fp8x4(x1[0], x1[1], x1[2], x1[3]); *(unsigned*)(dst + 32) = pack_fp8x4(x2[0], x2[1], x2[2], x2[3]); }
          } else if (g0 < EIN) {
            const int c = g0 - 3136 + 4 * fq, kb = keyrow / NKEY, key = keyrow - kb * NKEY;
            unsigned char* dst = VD + ((((size_t)(kb * 4 + (c >> 8)) * (NKEY / 64) + (key >> 6)) * 256 + (c & 255)) << 6) + vt_pos(key & 63);
            const unsigned p1 = pack_fp8x4(x1[0], x1[1], x1[2], x1[3]), p2 = pack_fp8x4(x2[0], x2[1], x2[2], x2[3]);
            dst[0] = (unsigned char)p1; dst[64] = (unsigned char)(p1 >> 8); dst[128] = (unsigned char)(p1 >> 16); dst[192] = (unsigned char)(p1 >> 24);
            dst[1024] = (unsigned char)p2; dst[1088] = (unsigned char)(p2 >> 8); dst[1152] = (unsigned char)(p2 >> 16); dst[1216] = (unsigned char)(p2 >> 24); }
        }
      }
  }
};
struct EpiKV {
  unsigned char* KA; unsigned char* VA;
  __device__ __forceinline__ void operator()(const Acc& acc, const Unit& u, int wr, int wc, int fr, int fq) const {
    FG_FOREACH(
      int b; int key; if (row < NT) { b = row / SEQ; key = CTXL + (row % SEQ); } else { const int ii = row - NT; b = ii / CTXL; key = ii % CTXL; }
      const int h = col >> 8, w = col & 255; const unsigned pk = pack_fp8x4(v[0], v[1], v[2], v[3]);
      if (w < 128) *(unsigned*)(KA + ((size_t)b * NKEY + key) * 1536 + h * 192 + w) = pk;
      else { unsigned char* dst = VA + ((((size_t)(b * 8 + h) * (NKEY / 64) + (key >> 6)) * 128 + (w - 128)) << 6) + vt_pos(key & 63);
        dst[0] = (unsigned char)pk; dst[64] = (unsigned char)(pk >> 8); dst[128] = (unsigned char)(pk >> 16); dst[192] = (unsigned char)(pk >> 24); })
  }
};
template <bool BASE_F32>
struct EpiResid {
  bf16_t* XL; const void* base; const float* ml;
  __device__ __forceinline__ void operator()(const Acc& acc, const Unit& u, int wr, int wc, int fr, int fq) const {
    const int row0 = u.pm * 256 + wr * 64 + fr, col0 = u.pn * 256 + wc * 32 + 4 * fq;
    const float* gp = ml + (size_t)(row0 / SEQ) * MLW + 4096 + col0;
    f32x4 g[2][2];
#pragma unroll
    for (int bj = 0; bj < 2; ++bj)
#pragma unroll
      for (int n = 0; n < 2; ++n) g[bj][n] = *(const f32x4*)(gp + bj * 128 + n * 16);
#pragma unroll
    for (int ai = 0; ai < 2; ++ai)
#pragma unroll
      for (int mh = 0; mh < 2; ++mh) {
        f32x4 bs[2][2][2];
#pragma unroll
        for (int m2 = 0; m2 < 2; ++m2)
#pragma unroll
          for (int bj = 0; bj < 2; ++bj)
#pragma unroll
            for (int n = 0; n < 2; ++n) { const size_t o = (size_t)(row0 + ai * 128 + (mh * 2 + m2) * 16) * DM + col0 + bj * 128 + n * 16;
              if constexpr (BASE_F32) bs[m2][bj][n] = *(const f32x4*)((const float*)base + o);
              else { const u32x2 w = *(const u32x2*)((const bf16_t*)base + o); bs[m2][bj][n] = (f32x4){bf_lo(w[0]), bf_hi(w[0]), bf_lo(w[1]), bf_hi(w[1])}; } }
        asm volatile("" ::: "memory");
#pragma unroll
        for (int m2 = 0; m2 < 2; ++m2)
#pragma unroll
          for (int bj = 0; bj < 2; ++bj)
#pragma unroll
            for (int n = 0; n < 2; ++n)
              *(u32x2*)(XL + (size_t)(row0 + ai * 128 + (mh * 2 + m2) * 16) * DM + col0 + bj * 128 + n * 16) = pack4(bs[m2][bj][n] + g[bj][n] * acc[ai][bj][mh * 2 + m2][n]);
        asm volatile("" ::: "memory");
      }
  }
};
struct EpiGU {
  unsigned char* HID;
  __device__ __forceinline__ void operator()(const Acc& acc, const Unit& u, int wr, int wc, int fr, int fq) const {
    unsigned char* base = HID + (size_t)u.grp * 2048 * FF;
#pragma unroll
    for (int ai = 0; ai < 2; ++ai)
#pragma unroll
      for (int m = 0; m < 4; ++m)
#pragma unroll
        for (int bj = 0; bj < 2; ++bj) {
          const int row = u.pm * 256 + ai * 128 + wr * 64 + m * 16 + fr, hid = u.pn * 128 + bj * 64 + wc * 16 + 4 * fq;
          const f32x4 g = acc[ai][bj][m][0], up = acc[ai][bj][m][1];
          float r[4];
#pragma unroll
          for (int j = 0; j < 4; ++j) { const float gg = g[j] * (1.f / W8_SCALE), uu = up[j] * (1.f / W8_SCALE); r[j] = gg * __builtin_amdgcn_rcpf(1.f + __expf(-gg)) * uu; }
          *(unsigned*)(base + (size_t)row * FF + hid) = pack_fp8x4(r[0], r[1], r[2], r[3]);
        }
  }
};
struct EpiDown {
  bf16_t* YE; const float* gate;
  __device__ __forceinline__ void operator()(const Acc& acc, const Unit& u, int wr, int wc, int fr, int fq) const {
    bf16_t* base = YE + (size_t)u.grp * 2048 * DM;
    float gt[2][4];
#pragma unroll
    for (int ai = 0; ai < 2; ++ai)
#pragma unroll
      for (int m = 0; m < 4; ++m) { const int row = u.pm * 256 + ai * 128 + wr * 64 + m * 16 + fr; gt[ai][m] = gate[((row >> 9) * NE + u.grp) * CAP + (row & 511)] * (1.f / W8_SCALE); }
    asm volatile("" ::: "memory");
    FG_FOREACH(*(u32x2*)(base + (size_t)row * DM + col) = pack4(v * gt[ai][m]);)
  }
};
struct EpiScaleCol {
  bf16_t* O; const float* cs;
  __device__ __forceinline__ void operator()(const Acc& acc, const Unit& u, int wr, int wc, int fr, int fq) const {
    f32x4 sc[2][2];
#pragma unroll
    for (int bj = 0; bj < 2; ++bj)
#pragma unroll
      for (int n = 0; n < 2; ++n) sc[bj][n] = *(const f32x4*)(cs + u.grp * 256 + u.pn * 256 + bj * 128 + wc * 32 + n * 16 + 4 * fq);
    asm volatile("" ::: "memory");
    FG_FOREACH(*(u32x2*)(O + (size_t)row * DM + u.grp * 256 + col) = pack4(v * sc[bj][n]);)
  }
};
struct EpiChanDft {
  bf16_t* ABT2;
  __device__ __forceinline__ void operator()(const Acc& acc, const Unit& u, int wr, int wc, int fr, int fq) const {
    FG_FOREACH(const int b = col / SEQ, nn = col % SEQ;
               *(u32x2*)(ABT2 + (((size_t)(b * 4 + u.grp) * 256) + (row & 255)) * 8192 + (row >> 8) * 4096 + nn) = pack4(v * 1.f);)
  }
};
}

namespace at {
typedef float f32x16 __attribute__((ext_vector_type(16)));
typedef int i32x8a __attribute__((ext_vector_type(8)));
typedef int i32x4a __attribute__((ext_vector_type(4)));
constexpr int NW = 8, QBLK = 32, KVBLK = 64;
#define SBAR() __builtin_amdgcn_sched_barrier(0)
#define MFMA8(A, B, Cc) __builtin_amdgcn_mfma_scale_f32_32x32x64_f8f6f4(A, B, Cc, 0, 0, 0, 0x7f7f7f7f, 0, 0x7f7f7f7f)
__device__ __forceinline__ int crow(int r, int hi) { return (r & 3) + 8 * (r >> 2) + 4 * hi; }
template <int DK> __device__ __forceinline__ int kswz(int row) { return DK == 192 ? ((row >> 2) & 3) : ((row >> 1) & 7); }
template <int DK>
__device__ __forceinline__ void qkt(f32x16& p0, f32x16& p1, const LAS char* Ks, const i32x8a* qf, int r32, int hi) {
  p0 = f32x16{}; p1 = f32x16{};
  const int s = kswz<DK>(r32);
  const LAS char* kr = Ks + r32 * DK;
#pragma unroll
  for (int t = 0; t < DK / 64; ++t) {
    const int c0 = ((4 * t + 2 * hi) ^ s) << 4, c1 = ((4 * t + 2 * hi + 1) ^ s) << 4;
    const i32x4a a0 = *reinterpret_cast<const LAS i32x4a*>(kr + c0), a1 = *reinterpret_cast<const LAS i32x4a*>(kr + c1);
    const i32x4a b0 = *reinterpret_cast<const LAS i32x4a*>(kr + c0 + 32 * DK), b1 = *reinterpret_cast<const LAS i32x4a*>(kr + c1 + 32 * DK);
    const i32x8a k0 = {a0[0], a0[1], a0[2], a0[3], a1[0], a1[1], a1[2], a1[3]}, k1 = {b0[0], b0[1], b0[2], b0[3], b1[0], b1[1], b1[2], b1[3]};
    p0 = MFMA8(k0, qf[t], p0);
    p1 = MFMA8(k1, qf[t], p1); }
}
constexpr float PBIAS = 4.f, PTHR = 3.f;
__device__ __forceinline__ void softmax8(const f32x16& p0, const f32x16& p1, float& m_reg, float& alpha, i32x8a& pa, float C, float thr_raw) {
  float pmax = p0[0];
#pragma unroll
  for (int r = 1; r < 16; ++r) pmax = fmaxf(pmax, p0[r]);
#pragma unroll
  for (int r = 0; r < 16; ++r) pmax = fmaxf(pmax, p1[r]);
  { auto rr = __builtin_amdgcn_permlane32_swap(__float_as_uint(pmax), __float_as_uint(pmax), false, false);
    pmax = fmaxf(__uint_as_float(rr[0]), __uint_as_float(rr[1])); }
  float mn;
  if (__builtin_expect(__all(pmax - m_reg <= thr_raw), 1)) { mn = m_reg; alpha = 1.f; }
  else { mn = fmaxf(m_reg, pmax); alpha = __builtin_amdgcn_exp2f((m_reg - mn) * C); m_reg = mn; }
  const float C8 = 8.f * C, b8 = 8.f * (PBIAS - mn * C) + 56.f;
#pragma unroll
  for (int w = 0; w < 4; ++w) {
    unsigned v = 0, v2 = 0;
#pragma unroll
    for (int j = 0; j < 4; ++j) { v = __builtin_amdgcn_cvt_pk_u8_f32(fmaf(p0[4 * w + j], C8, b8), j, v); v2 = __builtin_amdgcn_cvt_pk_u8_f32(fmaf(p1[4 * w + j], C8, b8), j, v2); }
    pa[w] = (int)v; pa[4 + w] = (int)v2; }
}
template <int NDB>
__device__ __forceinline__ void pv(f32x16* o, const LAS char* Vs, const i32x8a pa, int r32, int hi) {
  const int s = (r32 >> 2) & 3;
  const LAS char* v0 = Vs + r32 * 64 + (((2 * hi) ^ s) << 4); const LAS char* v1 = Vs + r32 * 64 + (((2 * hi + 1) ^ s) << 4);
#pragma unroll
  for (int d0 = 0; d0 < NDB; ++d0) {
    const i32x4a a = *reinterpret_cast<const LAS i32x4a*>(v0 + d0 * 2048), b = *reinterpret_cast<const LAS i32x4a*>(v1 + d0 * 2048);
    const i32x8a vf = {a[0], a[1], a[2], a[3], b[0], b[1], b[2], b[3]};
    o[d0] = MFMA8(pa, vf, o[d0]); }
  const int one4 = 0x38383838;
  const i32x8a ones = {one4, one4, one4, one4, one4, one4, one4, one4};
  o[NDB] = MFMA8(pa, ones, o[NDB]);
}
template <int DK, int NDB, bool QK_FIRST>
__device__ __forceinline__ void mm_iter(f32x16* o, f32x16& p0, f32x16& p1, const LAS char* Vs, const LAS char* Ks, const i32x8a pa, const i32x8a* qf, int r32, int hi) {
  constexpr int NKF = DK / 32, NL = NKF + NDB;
  const int sk = kswz<DK>(r32), sv = (r32 >> 2) & 3;
  const LAS char* kr = Ks + r32 * DK;
  const LAS char* v0 = Vs + r32 * 64 + (((2 * hi) ^ sv) << 4); const LAS char* v1 = Vs + r32 * 64 + (((2 * hi + 1) ^ sv) << 4);
  i32x8a w[3];
#define MM_ISK(i) (QK_FIRST ? (i) < NKF : (i) >= NDB)
#define MM_LOAD(i) do { i32x4a a_, b_; if (MM_ISK(i)) { const int kk = QK_FIRST ? (i) : (i) - NDB, t = kk >> 1, blk = kk & 1; \
      a_ = *reinterpret_cast<const LAS i32x4a*>(kr + blk * 32 * DK + (((4 * t + 2 * hi) ^ sk) << 4)); b_ = *reinterpret_cast<const LAS i32x4a*>(kr + blk * 32 * DK + (((4 * t + 2 * hi + 1) ^ sk) << 4)); } \
    else { const int d0 = QK_FIRST ? (i) - NKF : (i); a_ = *reinterpret_cast<const LAS i32x4a*>(v0 + d0 * 2048); b_ = *reinterpret_cast<const LAS i32x4a*>(v1 + d0 * 2048); } \
    w[(i) % 3] = (i32x8a){a_[0], a_[1], a_[2], a_[3], b_[0], b_[1], b_[2], b_[3]}; } while (0)
  MM_LOAD(0); MM_LOAD(1);
#pragma unroll
  for (int i = 0; i < NL; ++i) {
    if (i + 2 < NL) MM_LOAD(i + 2);
    if (MM_ISK(i)) { const int kk = QK_FIRST ? i : i - NDB, t = kk >> 1, blk = kk & 1;
      if (blk == 0) { if (t == 0) p0 = MFMA8(w[i % 3], qf[t], f32x16{}); else p0 = MFMA8(w[i % 3], qf[t], p0); }
      else { if (t == 0) p1 = MFMA8(w[i % 3], qf[t], f32x16{}); else p1 = MFMA8(w[i % 3], qf[t], p1); } }
    else { const int d0 = QK_FIRST ? i - NKF : i; o[d0] = MFMA8(pa, w[i % 3], o[d0]);
      if (d0 == NDB - 1) { const int one4 = 0x38383838; const i32x8a ones = {one4, one4, one4, one4, one4, one4, one4, one4}; o[NDB] = MFMA8(pa, ones, o[NDB]); } }
    __builtin_amdgcn_sched_barrier(0x406);
  }
#undef MM_ISK
#undef MM_LOAD
}
template <class VAR>
__device__ __forceinline__ void attn_body(const unsigned char* __restrict__ Qb, const unsigned char* __restrict__ Kh, const unsigned char* __restrict__ VT, bf16_t* __restrict__ Ob, int seq, char* lds) {
  constexpr int DK = VAR::DK, NDB = VAR::NDB, ldq = VAR::LDQ, ldk = VAR::LDK, ldo = VAR::LDO;
  constexpr float C = VAR::SCALE * 1.4426950408889634f, thr_raw = PTHR / VAR::SCALE;
  constexpr int SHM_V = NDB * 32 * 64, SHM_K = KVBLK * DK, SHM_T = SHM_V + SHM_K, NVC = NDB / 4;
  static_assert(DK == 192 || DK == 128, "K staging is written for 128- and 192-byte key rows");
  int tid_ = threadIdx.x; asm volatile("" : "+v"(tid_));
  const int tid = tid_, wid = tid >> 6, lane = tid & 63, r32 = lane & 31, hi = lane >> 5, wu = __builtin_amdgcn_readfirstlane(wid);
  LAS char* L = (LAS char*)lds;
  LAS float* al_l = (LAS float*)(L + VAR::NB * SHM_T) + wid * 32;
  float m_reg = -1e30f; f32x16 o[NDB + 1] = {}; i32x8a qr[DK / 64];
  const unsigned char* Qw = Qb + (size_t)(wid * QBLK + r32) * ldq + hi * 32;
#pragma unroll
  for (int t = 0; t < DK / 64; ++t) { const i32x4a a = *reinterpret_cast<const i32x4a*>(Qw + t * 64), b2 = *reinterpret_cast<const i32x4a*>(Qw + t * 64 + 16);
    qr[t] = (i32x8a){a[0], a[1], a[2], a[3], b2[0], b2[1], b2[2], b2[3]}; }
  const unsigned vsrc = (unsigned)((tid >> 2) * 64 + (((tid & 3) ^ ((tid >> 4) & 3)) << 4));
  unsigned ksrc0, ksrc1 = 0;
  if constexpr (DK == 128) { const int row = tid >> 3; ksrc0 = (unsigned)(row * ldk + (((tid & 7) ^ kswz<DK>(row)) << 4)); }
  else { const int r0 = tid / 12, c0 = tid - 12 * r0, ci = 512 + wid * 32 + r32, r1 = ci / 12, c1 = ci - 12 * r1;
    ksrc0 = (unsigned)(r0 * ldk + ((c0 ^ kswz<DK>(r0)) << 4)); ksrc1 = (unsigned)(r1 * ldk + ((c1 ^ kswz<DK>(r1)) << 4)); }
#define DMA(B, tile) do { const unsigned char* vt_ = VT + (size_t)(tile) * SHM_V; const unsigned char* kt_ = Kh + (size_t)(tile) * (KVBLK * ldk); \
    _Pragma("unroll") for (int _i = 0; _i < NVC; ++_i) __builtin_amdgcn_global_load_lds((const unsigned*)(vt_ + vsrc + _i * 8192), (LAS unsigned*)(L + (B) + wu * 1024 + _i * 8192), 16, 0, 0); \
    __builtin_amdgcn_global_load_lds((const unsigned*)(kt_ + ksrc0), (LAS unsigned*)(L + (B) + SHM_V + wu * 1024), 16, 0, 0); \
    if constexpr (DK == 192) { if (hi == 0) __builtin_amdgcn_global_load_lds((const unsigned*)(kt_ + ksrc1), (LAS unsigned*)(L + (B) + SHM_V + 8192 + wu * 512), 16, 0, 0); } } while (0)
#define DWAIT() asm volatile("s_waitcnt vmcnt(0)" ::: "memory")
#define RESC(a) do { if (__any((a) < 1.f)) { if (hi == 0) al_l[r32] = (a); asm volatile("s_waitcnt lgkmcnt(0)" ::: "memory"); \
    _Pragma("unroll") for (int d = 0; d <= NDB; ++d) _Pragma("unroll") for (int r = 0; r < 16; ++r) o[d][r] *= al_l[crow(r, hi)]; } } while (0)
  const int NTL = seq / KVBLK;
  constexpr int NB = VAR::NB, IPT = NVC + (DK == 192 ? 2 : 1);
  static_assert(NB >= 3 && NB * SHM_T + NW * 128 <= 135168, "attention tile ring must fit the kernel's LDS");
#define DWAITN(NT_) asm volatile("s_waitcnt vmcnt(%0)" :: "n"((NT_) * IPT) : "memory")
  int b0 = 0, b1 = SHM_T, bn = (NB - 1) * SHM_T;
  f32x16 p0, p1; float al; i32x8a pa;
#pragma unroll 1
  for (int t = 0; t < NB - 1; ++t) DMA(t * SHM_T, t < NTL ? t : NTL - 1);
  SBAR(); DWAITN(NB - 3); __syncthreads();
  qkt<DK>(p0, p1, L + b0 + SHM_V, qr, r32, hi); softmax8(p0, p1, m_reg, al, pa, C, thr_raw);
  for (int j = 0; j + 1 < NTL; ++j) {
    { const int nt = j + NB - 1 < NTL ? j + NB - 1 : NTL - 1; DMA(bn, nt); }
    SBAR(); RESC(al); SBAR();
    mm_iter<DK, NDB, VAR::PIPE>(o, p0, p1, L + b0, L + b1 + SHM_V, pa, qr, r32, hi);
    softmax8(p0, p1, m_reg, al, pa, C, thr_raw); SBAR();
    DWAITN(NB - 3); __syncthreads();
    bn = b0; b0 = b1; b1 = b1 + SHM_T == NB * SHM_T ? 0 : b1 + SHM_T;
  }
  RESC(al); pv<NDB>(o, L + b0, pa, r32, hi);
  DWAIT();
#pragma unroll
  for (int r = 0; r < 16; ++r) { const int orow = wid * QBLK + crow(r, hi); const float rl = __builtin_amdgcn_rcpf(o[NDB][r]);
#pragma unroll
    for (int d0 = 0; d0 < NDB; ++d0) Ob[(size_t)orow * ldo + d0 * 32 + r32] = f2bf(o[d0][r] * rl); }
  __syncthreads();
#undef DMA
#undef DWAIT
#undef DWAITN
#undef RESC
}
}

struct VarMla { static constexpr int DK = 192, NDB = 4, LDQ = 1536, LDK = 1536, LDO = 2048, NB = 5; static constexpr bool PIPE = true; static constexpr float SCALE = 0.07216878364870322f; };
struct VarDiff { static constexpr int DK = 128, NDB = 8, LDQ = 1024, LDK = 1024, LDO = 2048, NB = 5; static constexpr bool PIPE = false; static constexpr float SCALE = 0.08838834764831845f; };
constexpr size_t VTA_INST = (size_t)(NKEY / 64) * 128 * 64, VTD_INST = (size_t)(NKEY / 64) * 256 * 64;
__device__ __forceinline__ void attn_unit_mla(const Params& p, char* smem, int inst, int qb) {
  const int b = inst >> 3, h = inst & 7;
  at::attn_body<VarMla>(WSP(const unsigned char, OFF_QA) + ((size_t)b * SEQ + qb * 256) * 1536 + h * 192, WSP(const unsigned char, OFF_KA) + (size_t)b * NKEY * 1536 + h * 192,
                        WSP(const unsigned char, OFF_VA) + (size_t)inst * VTA_INST, WSP(bf16_t, OFF_YIN) + ((size_t)b * SEQ + qb * 256) * 2048 + h * 128, NKEY, smem);
}
__device__ __forceinline__ void attn_unit_diff(const Params& p, char* smem, int inst, int qb) {
  const int b = inst >> 3, m = (inst >> 2) & 1, h = inst & 3;
  at::attn_body<VarDiff>(WSP(const unsigned char, OFF_QD) + ((size_t)b * SEQ + qb * 256) * 1024 + m * 512 + h * 128, WSP(const unsigned char, OFF_KD) + (size_t)b * NKEY * 1024 + m * 512 + h * 128,
                         WSP(const unsigned char, OFF_VD) + (size_t)(b * 4 + h) * VTD_INST, WSP(bf16_t, OFF_OD) + ((size_t)b * SEQ + qb * 256) * 2048 + m * 1024 + h * 256, NKEY, smem);
}
__device__ __forceinline__ void ph_attn_mla(const Params& p, char* smem) {
  for (int u0 = blockIdx.x; u0 < NB * 8 * 16; u0 += gridDim.x) {
    const int u = (gridDim.x == 256) ? ((u0 & ~255) | ((u0 & 7) << 5) | ((u0 >> 3) & 31)) : u0;
    attn_unit_mla(p, smem, u >> 4, u & 15);
  }
}
__device__ __forceinline__ void ph_attn_diff_wide(const Params& p, char* smem) {
  for (int u0 = blockIdx.x; u0 < NB * 8 * 16; u0 += gridDim.x) {
    const int u = (gridDim.x == 256) ? ((u0 & ~255) | ((u0 & 7) << 5) | ((u0 >> 3) & 31)) : u0;
    attn_unit_diff(p, smem, u >> 4, u & 15);
  }
}
constexpr int QPAT = 4, Q_ATT = 128, Q_CONV = 384, Q_WORD0 = 3584;
__device__ __forceinline__ void ph_attn_queue(const Params& p, char* smem, int* slot) {
  const int x = blockIdx.x & 7;
  unsigned* cnt = WSP(unsigned, OFF_BAR) + Q_WORD0 + 16 * x;
  for (;;) {
    if (threadIdx.x == 0) *(volatile int*)slot = (int)__hip_atomic_fetch_add(cnt, 1u, __ATOMIC_RELAXED, __HIP_MEMORY_SCOPE_AGENT);
    __syncthreads();
    const int e = __builtin_amdgcn_readfirstlane(*(volatile int*)slot);
    __syncthreads();
    if (e >= Q_ATT + Q_CONV) break;
    int att = -1, cv = -1;
    constexpr int MIXED = (Q_CONV / (QPAT - 1) < Q_ATT ? Q_CONV / (QPAT - 1) : Q_ATT) * QPAT;
    if (e < MIXED) { if (e % QPAT == 0) att = e / QPAT; else cv = e - e / QPAT - 1; }
    else { const int r = e - MIXED, na = MIXED / QPAT, nc = MIXED - na; if (na + r < Q_ATT) att = na + r; else cv = nc + (r - (Q_ATT - na)); }
    if (att >= 0) { if (att < 64) attn_unit_mla(p, smem, x * 4 + (att >> 4), att & 15); else attn_unit_diff(p, smem, x * 4 + ((att - 64) >> 4), att & 15); }
    else conv_item(p, smem, cv * 8 + x);
  }
}
#define XB_TMO      128
#define XB_XCNT(j)  (256  + 64 * (j))
#define XB_XSUB(j)  (1280 + 64 * (j))
#define XB_XGEN(j)  (2304 + 64 * (j))
#define XB_TOP      3328
#define XB_TOPGEN   3392
#define XCD_BAR_WORDS 3456
#define XB_SPIN_CAP (1u << 18)
__device__ __forceinline__ unsigned xb_ld(unsigned* p)              { return __hip_atomic_load(p, __ATOMIC_RELAXED, __HIP_MEMORY_SCOPE_AGENT); }
__device__ __forceinline__ unsigned xb_add(unsigned* p, unsigned v) { return __hip_atomic_fetch_add(p, v, __ATOMIC_RELAXED, __HIP_MEMORY_SCOPE_AGENT); }
__device__ __forceinline__ unsigned xb_xcc_id() { return (unsigned)__builtin_amdgcn_s_getreg((3 << 11) | 20) & 0xFu; }
#define XB_SPIN(cond, bar) do { unsigned _sp = 0; while (cond) { __builtin_amdgcn_s_sleep(1); \
    if ((++_sp & 255u) == 0u) { if (xb_ld(&(bar)[XB_TMO])) break; if (_sp > XB_SPIN_CAP) { atomicAdd(&(bar)[XB_TMO], 1u); break; } } } } while (0)
struct XcdBarrier { unsigned* bar; unsigned x; volatile LAS unsigned* st; };
__device__ __forceinline__ XcdBarrier xcd_barrier_post(unsigned* bar, volatile LAS unsigned* st) {
    XcdBarrier b; b.bar = bar; b.x = xb_xcc_id(); b.st = st;
    if (threadIdx.x == 0) (void)xb_add(&bar[XB_XCNT(b.x)], 1u);
    return b;
}
__device__ __forceinline__ void xcd_barrier_complete(unsigned* bar, unsigned x, unsigned& nloc, unsigned& nx) {
    const unsigned G = gridDim.x * gridDim.y * gridDim.z;
    unsigned sum, cnt, mine, sp = 0u;
    for (;;) {
        sum = 0u; cnt = 0u; mine = 0u;
#pragma unroll
        for (unsigned j = 0; j < 16; ++j) { const unsigned c = xb_ld(&bar[XB_XCNT(j)]); sum += c; cnt += (c > 0u) ? 1u : 0u; mine = (j == x) ? c : mine; }
        if (sum == G) break;
        __builtin_amdgcn_s_sleep(1);
        if ((++sp & 255u) == 0u) { if (xb_ld(&bar[XB_TMO])) break; if (sp > XB_SPIN_CAP) { atomicAdd(&bar[XB_TMO], 1u); break; } }
    }
    nloc = mine > 0u ? mine : 1u; nx = cnt > 0u ? cnt : 1u;
}
__device__ __forceinline__ void xcd_barrier(const XcdBarrier& b) {
    asm volatile("s_waitcnt vmcnt(0)" ::: "memory");
    __syncthreads();
    if (threadIdx.x == 0) {
        unsigned* bar = b.bar;
        __builtin_amdgcn_s_waitcnt(0);
        unsigned nloc = b.st[0], nx = b.st[1];
        if (nloc == 0u) { xcd_barrier_complete(bar, b.x, nloc, nx); b.st[0] = nloc; b.st[1] = nx; }
        const unsigned old = xb_add(&bar[XB_XSUB(b.x)], 1u);
        const unsigned gen = old / nloc;
        if (old + 1u == (gen + 1u) * nloc) {
            __builtin_amdgcn_fence(__ATOMIC_RELEASE, "agent");
            asm volatile("s_waitcnt vmcnt(0)" ::: "memory");
            const unsigned og = xb_add(&bar[XB_TOP], 1u);
            const unsigned tg = og / nx;
            if (og + 1u == (tg + 1u) * nx) xb_add(&bar[XB_TOPGEN], 1u);
            else XB_SPIN(xb_ld(&bar[XB_TOPGEN]) == tg, bar);
            __builtin_amdgcn_fence(__ATOMIC_ACQUIRE, "agent");
            xb_add(&bar[XB_XGEN(b.x)], 1u);
            asm volatile("s_waitcnt vmcnt(0)" ::: "memory");
        } else {
            XB_SPIN(xb_ld(&bar[XB_XGEN(b.x)]) == gen, bar);
            __builtin_amdgcn_fence(__ATOMIC_ACQUIRE, "agent");
            asm volatile("s_waitcnt vmcnt(0)" ::: "memory");
        }
    }
    __syncthreads();
}

#define FGRID(A_, sA_, lda_, B_, sB_, ldb_, nM_, nN_, ng_) fg::Grid{(const char*)(A_), (const char*)(B_), (size_t)(sA_), (size_t)(sB_), lda_, ldb_, nM_, nN_, ng_, (int)gridDim.x, (int)blockIdx.x}
#define FLDS ((LAS unsigned char*)smem)
constexpr int SMEM_MAIN = 135168;
template <int L> __device__ __forceinline__ void ph_moe_gemms_gu(const Params& p, char* smem) {
  fg::gemm_fast<fg::EpiGU, true, true>(FLDS, FGRID(WSP(char, OFF_H), 0, 1024, WSP(char, OFF_WGU) + (size_t)L * NE * 4096 * 2048, (size_t)4096 * 2048, 1024, 8, 16, NE),
                                       fg::EpiGU{WSP(unsigned char, OFF_HID)}, 1024, WSP(const int, OFF_IDX));
}
template <int L> __device__ __forceinline__ void ph_moe_gemms_down(const Params& p, char* smem) {
  fg::gemm_fast<fg::EpiDown, false, true>(FLDS, FGRID(WSP(char, OFF_HID), (size_t)2048 * 2048, 1024, WSP(char, OFF_WD) + (size_t)L * NE * 2048 * 2048, (size_t)2048 * 2048, 1024, 8, 8, NE),
                                          fg::EpiDown{WSP(bf16_t, OFF_YE), WSP(const float, OFF_GATE)}, 1024);
}
__global__ __launch_bounds__(512, 2) void mega(Params p) {
  __shared__ __attribute__((aligned(16))) char smem[SMEM_MAIN + 32];
  volatile LAS unsigned* xst = (volatile LAS unsigned*)(smem + SMEM_MAIN);
  if (threadIdx.x == 0) { xst[0] = 0u; xst[1] = 0u; xst[2] = 0u; xst[3] = 0u; }
  __syncthreads();
  const XcdBarrier bar = xcd_barrier_post(WSP(unsigned, OFF_BAR), xst);
#define GSYNC() xcd_barrier(bar)
  const bool split = gridDim.x == 256;
  ph_mod(p, smem); ph_twiddle(p, smem); ph_weights_small(p, smem); if (!split) ph_weights_expert(p, smem, blockIdx.x, gridDim.x);
  GSYNC();
  ph_pre0(p); GSYNC();
  fg::gemm_fast<fg::EpiIn0, false, true>(FLDS, FGRID(WSP(char, OFF_H), 0, DM / 2, WSP(char, OFF_WIN0), 0, DM / 2, 68, 17, 1), fg::EpiIn0{WSP(bf16_t, OFF_P0), WSP(unsigned char, OFF_QD), WSP(unsigned char, OFF_KD), WSP(unsigned char, OFF_VD)}, DM / 2); GSYNC();
  ph_post_inproj(p); GSYNC();
  fg::gemm_fast(FLDS, FGRID(WSP(bf16_t, OFF_CQN), 0, 512, WSP(bf16_t, OFF_WUQ), 0, 512, 64, 6, 1), fg::EpiQRope{WSP(unsigned char, OFF_QA)}, 512);
  fg::gemm_fast(FLDS, FGRID(WSP(bf16_t, OFF_CKVN), 0, 512, WSP(bf16_t, OFF_WUKV), 0, 512, 68, 8, 1), fg::EpiKV{WSP(unsigned char, OFF_KA), WSP(unsigned char, OFF_VA)}, 512); GSYNC();
  if (split) ph_attn_queue(p, smem, (int*)(smem + SMEM_MAIN + 16)); else { ph_attn_mla(p, smem); ph_attn_diff_wide(p, smem); }
  GSYNC();
  ph_diffcomb(p); GSYNC();
  fg::gemm_fast(FLDS, FGRID(WSP(bf16_t, OFF_YIN), 0, DM, WSP(bf16_t, OFF_WOUT0), 0, DM, 64, 8, 1), fg::EpiResid<true>{WSP(bf16_t, OFF_XL), p.x, WSP(const float, OFF_ML)}, DM); GSYNC();
  ph_ffn_pre(p, 0, smem); GSYNC();
  ph_topk(p, smem); GSYNC();
  ph_moe_gemms_gu<0>(p, smem); GSYNC();
  ph_moe_gemms_down<0>(p, smem); GSYNC();
  ph_combine(p, 0); GSYNC();
  fg::gemm_fast(FLDS, FGRID(WSP(bf16_t, OFF_H), 0, DM, WSP(bf16_t, OFF_WIN1), 0, DM, 64, 8, 1), fg::EpiBf16{WSP(bf16_t, OFF_Z), DM, DM, 1.f, 1, 0, 0}, DM); GSYNC();
  ph_pool(p);
  fg::gemm_fast(FLDS, FGRID(WSP(bf16_t, OFF_MC), (size_t)512 * 256 * 2, 256, WSP(bf16_t, OFF_Z) + 1024, 512, DM, 2, 64, 4), fg::EpiChanDft{WSP(bf16_t, OFF_ABT2)}, 256); GSYNC();
  ph_fold(p);
  fg::gemm_fast(FLDS, FGRID(WSP(bf16_t, OFF_POOLED), 512, 1024, WSP(bf16_t, OFF_WPOOL), 65536 * 2, 256, 64, 1, 4), fg::EpiScaleCol{WSP(bf16_t, OFF_YCAT), p.pool_scale}, 256); GSYNC();
  { fg::Grid gq = FGRID(WSP(bf16_t, OFF_TW), 0, 4096, WSP(bf16_t, OFF_ABTF), (size_t)256 * 4096 * 2, 4096, 8, 1, 32);
    gq.gd = 2; gq.sA2 = (size_t)2048 * 2; gq.sB2 = (size_t)2048 * 2;
    fg::gemm_fast(FLDS, gq, fg::EpiBf16{WSP(bf16_t, OFF_SPEC), 256, 256, 1.f, 1, (size_t)2048 * 256, 0}, 2048); }
  GSYNC();
  ph_dftcomb(p); GSYNC();
  fg::gemm_fast(FLDS, FGRID(WSP(bf16_t, OFF_YCAT), 0, DM, WSP(bf16_t, OFF_WOUT1), 0, DM, 64, 8, 1), fg::EpiResid<false>{WSP(bf16_t, OFF_XL), WSP(const bf16_t, OFF_XL), WSP(const float, OFF_ML) + 5 * MLW}, DM); GSYNC();
  ph_ffn_pre(p, 1, smem); GSYNC();
  ph_topk(p, smem); GSYNC();
  ph_moe_gemms_gu<1>(p, smem); GSYNC();
  ph_moe_gemms_down<1>(p, smem); GSYNC();
  ph_combine(p, 1);
}

extern "C" void kernel_launch(void* const* d_in, const int* in_sizes, int n_in, void* d_out, int out_size, void* d_ws, size_t ws_size, hipStream_t stream) {
  if (n_in != 29 || ws_size < WS_NEED) { fprintf(stderr, "kernel_launch: bad args n_in %d ws %zu need %zu\n", n_in, ws_size, WS_NEED); return; }
  Params p{};
  const float** f = (const float**)&p;
  for (int i = 0; i < 29; ++i) f[i] = (const float*)d_in[i];
  p.out = (float*)d_out; p.ws = (char*)d_ws;
  static int grid = 0;
  if (!grid) {
    int dev = 0, cus = 0, per_cu = 0;
    (void)hipGetDevice(&dev);
    (void)hipDeviceGetAttribute(&cus, hipDeviceAttributeMultiprocessorCount, dev);
    (void)hipOccupancyMaxActiveBlocksPerMultiprocessor(&per_cu, (const void*)mega, 512, 0);
    if (cus <= 0) cus = 256;
    grid = per_cu >= 1 ? cus : 0;
    if (!grid) { fprintf(stderr, "kernel_launch: occupancy query says 0 blocks per CU\n"); return; }
  }
  (void)hipMemsetAsync(d_ws, 0, 16384, stream);
  hipLaunchKernelGGL(mega, dim3(grid), dim3(512), 0, stream, p);
}
```

```cpp
#include <hip/hip_runtime.h>
#include <stdint.h>
#include <cstdio>

typedef unsigned short bf16_t;
typedef short bf16x8 __attribute__((ext_vector_type(8)));
typedef float f32x4 __attribute__((ext_vector_type(4)));
typedef unsigned u32x4 __attribute__((ext_vector_type(4)));
typedef unsigned u32x2 __attribute__((ext_vector_type(2)));

constexpr int DM = 2048, NB = 4, SEQ = 4096, NT = NB * SEQ, CTXL = 256, NC = NB * CTXL, NA = NT + NC, NKEY = SEQ + CTXL;
constexpr int EIN = 4160, EINP = 4352, P0W = 1088;
constexpr int NE = 16, CAP = 512, FF = 2048, MLW = 6 * DM;
constexpr float EPS = 1e-6f;

constexpr size_t al256(size_t x) { return (x + 255) / 256 * 256; }
constexpr size_t OFF_BAR = 0;
constexpr size_t OFF_ML = 16384;
constexpr size_t OFF_AFF = OFF_ML + al256((size_t)2 * 5 * MLW * 4);
constexpr size_t OFF_IDX = OFF_AFF + (size_t)NB * NE * SEQ * 4;
constexpr size_t OFF_GATE = OFF_IDX + (size_t)NB * NE * CAP * 4;
constexpr size_t OFF_INV = OFF_GATE + (size_t)NB * NE * CAP * 4;
constexpr size_t OFF_WIN0 = OFF_INV + (size_t)NT * NE * 4;
constexpr size_t OFF_WUQ = OFF_WIN0 + (size_t)EINP * DM * 2;
constexpr size_t OFF_WUKV = OFF_WUQ + (size_t)1536 * 512 * 2;
constexpr size_t OFF_WOUT0 = OFF_WUKV + (size_t)2048 * 512 * 2;
constexpr size_t OFF_WIN1 = OFF_WOUT0 + (size_t)DM * DM * 2;
constexpr size_t OFF_WOUT1 = OFF_WIN1 + (size_t)DM * DM * 2;
constexpr size_t OFF_WPOOL = OFF_WOUT1 + (size_t)DM * DM * 2;
constexpr size_t OFF_WFOUR = OFF_WPOOL + (size_t)4 * 256 * 256 * 2;
constexpr size_t OFF_MC = OFF_WFOUR + (size_t)4 * 256 * 256 * 2;
constexpr size_t OFF_TW = OFF_MC + (size_t)4 * 512 * 256 * 2;
constexpr size_t OFF_WGU = OFF_TW + (size_t)4096 * 8192 * 2;
constexpr size_t OFF_WD = OFF_WGU + (size_t)2 * NE * 4096 * 2048 * 2;
constexpr size_t OFF_XL = OFF_WD + (size_t)2 * NE * 2048 * 2048 * 2;
constexpr size_t OFF_H = OFF_XL + (size_t)NT * DM * 4;
constexpr size_t OFF_SCR = OFF_H + (size_t)NA * DM * 2;
constexpr size_t OFF_P0 = OFF_SCR;
constexpr size_t OFF_CQN = OFF_P0 + al256((size_t)NA * EIN * 2);
constexpr size_t OFF_CKVN = OFF_CQN + (size_t)NT * 512 * 2;
constexpr size_t OFF_QA = OFF_CKVN + (size_t)NA * 512 * 2;
constexpr size_t OFF_KA = OFF_QA + (size_t)NT * 1536 * 2;
constexpr size_t OFF_VA = OFF_KA + (size_t)NA * 1536 * 2;
constexpr size_t OFF_QD = OFF_VA + (size_t)NA * 1024 * 2;
constexpr size_t OFF_KD = OFF_QD + (size_t)NT * 1024 * 2;
constexpr size_t OFF_VD = OFF_KD + (size_t)NA * 1024 * 2;
constexpr size_t OFF_OD = OFF_VD + (size_t)NA * 1024 * 2;
constexpr size_t OFF_YIN = OFF_OD + (size_t)NT * 2048 * 4;
constexpr size_t OFF_M0END = OFF_YIN + (size_t)NT * 2048 * 2;
constexpr size_t OFF_XE = OFF_SCR;
constexpr size_t OFF_HID = OFF_XE + (size_t)NE * 2048 * 2048 * 2;
constexpr size_t OFF_YE = OFF_HID + (size_t)NE * 2048 * 2048 * 2;
constexpr size_t OFF_Z = OFF_SCR;
constexpr size_t OFF_POOLED = OFF_Z + (size_t)NT * 2048 * 2;
constexpr size_t OFF_ABT2 = OFF_POOLED + (size_t)NT * 1024 * 2;
constexpr size_t OFF_SPEC = OFF_ABT2 + (size_t)16 * 256 * 8192 * 2;
constexpr size_t OFF_YCAT = OFF_SPEC + (size_t)NT * 1024 * 2;
constexpr size_t OFF_ABTF = OFF_YCAT + (size_t)NT * 2048 * 2;
constexpr size_t OFF_SBUF = OFF_M0END;
constexpr size_t OFF_PBUF = OFF_SBUF + (size_t)SEQ * NKEY * 4;
constexpr size_t OFF_VT = OFF_PBUF + (size_t)SEQ * NKEY * 2;
constexpr size_t WS_NEED = OFF_VT + (size_t)256 * NKEY * 2;

struct Params {
  const float *x, *c, *ctx, *c_ctx, *mod_w, *mod_b, *norm_mix, *norm_ffn, *even_w_in, *q_norm, *w_uq, *kv_norm, *w_ukv,
      *lq1, *lk1, *lq2, *lk2, *subln, *even_w_out, *odd_w_in, *pool_w, *pool_scale, *fourier_w, *odd_w_out, *router_w,
      *w_gate, *w_up, *w_down, *final_norm;
  float* out;
  char* ws;
};
#define WSP(T, off) ((T*)(p.ws + (off)))

typedef float f32x2 __attribute__((ext_vector_type(2)));
typedef __bf16 bf16x2_t __attribute__((ext_vector_type(2)));
__device__ __forceinline__ unsigned cvtpk(float lo, float hi) { f32x2 v = {lo, hi}; bf16x2_t r = __builtin_convertvector(v, bf16x2_t); return __builtin_bit_cast(unsigned, r); }
__device__ __forceinline__ unsigned pack_fp8x4(float a, float b, float c, float d) {
  a = __builtin_amdgcn_fmed3f(a, -448.f, 448.f); b = __builtin_amdgcn_fmed3f(b, -448.f, 448.f); c = __builtin_amdgcn_fmed3f(c, -448.f, 448.f); d = __builtin_amdgcn_fmed3f(d, -448.f, 448.f);
  unsigned w = 0; w = __builtin_amdgcn_cvt_pk_fp8_f32(a, b, w, false); w = __builtin_amdgcn_cvt_pk_fp8_f32(c, d, w, true); return w;
}
__device__ __forceinline__ float bf_lo(unsigned w) { return __uint_as_float(w << 16); }
__device__ __forceinline__ float bf_hi(unsigned w) { return __uint_as_float(w & 0xffff0000u); }
__device__ __forceinline__ float bf2f(bf16_t b) { return __uint_as_float(((unsigned)b) << 16); }
__device__ __forceinline__ bf16_t f2bf(float f) { return (bf16_t)(cvtpk(f, 0.f) & 0xffffu); }
__device__ __forceinline__ float wave_sum(float v) {
#pragma unroll
  for (int o = 32; o > 0; o >>= 1) v += __shfl_xor(v, o, 64);
  return v;
}
__device__ __forceinline__ float wave_max(float v) {
#pragma unroll
  for (int o = 32; o > 0; o >>= 1) v = fmaxf(v, __shfl_xor(v, o, 64));
  return v;
}
__device__ __forceinline__ int otid() { int t = threadIdx.x; asm volatile("" : "+v"(t)); return t; }
__device__ __forceinline__ int gwave() { return blockIdx.x * (blockDim.x >> 6) + (otid() >> 6); }
__device__ __forceinline__ int nwave() { return gridDim.x * (blockDim.x >> 6); }
__device__ __forceinline__ const float* mlp(const Params& p, int l, int row) { return WSP(const float, OFF_ML) + ((size_t)l * 5 + row) * MLW; }

template <int MODE>
__device__ __forceinline__ int rowmap(int n) {
  if (MODE == 0) return n;
  if (MODE == 3) { if (n < 1088 || n >= 3136) return n; const int v = (n - 1088) >> 7, e = (n - 1088) & 127;
    return 1088 + v * 128 + ((2 * (e >> 6) + ((e >> 4) & 1)) << 5) + (((e >> 5) & 1) << 4) + (e & 15); }
  return 32 * (n >> 4) + (n & 15) + (MODE == 2 ? 16 : 0);
}
template <int MODE, bool F8 = false>
__device__ __forceinline__ void tconv(const float* __restrict__ src, int K, int N, int Npad, bf16_t* __restrict__ dst, char* smem) {
  float(*tile)[257] = (float(*)[257])smem;
  const int tid = otid(), tk = K / 64, tn = Npad / 256;
  for (int t = blockIdx.x; t < tk * tn; t += gridDim.x) {
    const int k0 = (t % tk) * 64, n0 = (t / tk) * 256;
#pragma unroll
    for (int i = 0; i < 8; ++i) {
      const int id = tid + i * 512, k = id >> 6, n4 = (id & 63) * 4;
      f32x4 v = {0.f, 0.f, 0.f, 0.f};
      if (n0 + n4 < N) v = *(const f32x4*)(src + (size_t)(k0 + k) * N + n0 + n4);
      tile[k][n4 + 0] = v[0]; tile[k][n4 + 1] = v[1]; tile[k][n4 + 2] = v[2]; tile[k][n4 + 3] = v[3];
    }
    __syncthreads();
    {
      const int n = tid >> 1, kh = (tid & 1) * 32;
      if constexpr (F8) {
        unsigned char* drow8 = (unsigned char*)dst + (size_t)rowmap<MODE>(n0 + n) * K + k0 + kh;
#pragma unroll
        for (int i = 0; i < 2; ++i) {
          u32x4 w;
#pragma unroll
          for (int q = 0; q < 4; ++q) { const int kk = kh + i * 16 + q * 4; w[q] = pack_fp8x4(tile[kk][n] * 32.f, tile[kk + 1][n] * 32.f, tile[kk + 2][n] * 32.f, tile[kk + 3][n] * 32.f); }
          *(u32x4*)(drow8 + i * 16) = w;
        }
      } else {
      bf16_t* drow = dst + (size_t)rowmap<MODE>(n0 + n) * K + k0 + kh;
#pragma unroll
      for (int i = 0; i < 4; ++i) {
        u32x4 w;
        w[0] = cvtpk(tile[kh + i * 8 + 0][n], tile[kh + i * 8 + 1][n]);
        w[1] = cvtpk(tile[kh + i * 8 + 2][n], tile[kh + i * 8 + 3][n]);
        w[2] = cvtpk(tile[kh + i * 8 + 4][n], tile[kh + i * 8 + 5][n]);
        w[3] = cvtpk(tile[kh + i * 8 + 6][n], tile[kh + i * 8 + 7][n]);
        *(u32x4*)(drow + i * 8) = w;
      }
      }
    }
    __syncthreads();
  }
}

constexpr float W8_SCALE = 32.f;
__device__ __forceinline__ void tconv8_tile(const float* __restrict__ src, int K, int N, unsigned char* __restrict__ dst, int mode, int k0, int n0, char* smem) {
  unsigned* img = (unsigned*)smem;
  const int tid = otid();
  f32x4 va[8], vb[8];
#define T8_LOAD(V, S) do { _Pragma("unroll") for (int j = 0; j < 2; ++j) { const int id = tid + j * 512; const float* bp = src + (size_t)(k0 + (S) * 16 + (id >> 8) * 4) * N + n0 + (id & 255) * 4; \
    _Pragma("unroll") for (int r = 0; r < 4; ++r) V[j * 4 + r] = __builtin_nontemporal_load((const f32x4*)(bp + (size_t)r * N)); } } while (0)
#define T8_PUT(V, S) do { _Pragma("unroll") for (int j = 0; j < 2; ++j) { const int id = tid + j * 512; unsigned* ip = img + ((id & 255) * 4) * 33 + (S) * 4 + (id >> 8); \
    _Pragma("unroll") for (int q = 0; q < 4; ++q) ip[q * 33] = pack_fp8x4(V[j * 4 + 0][q] * W8_SCALE, V[j * 4 + 1][q] * W8_SCALE, V[j * 4 + 2][q] * W8_SCALE, V[j * 4 + 3][q] * W8_SCALE); } } while (0)
  T8_LOAD(va, 0);
#pragma unroll
  for (int s2 = 0; s2 < 4; ++s2) {
    T8_LOAD(vb, 2 * s2 + 1);
    T8_PUT(va, 2 * s2);
    if (s2 < 3) T8_LOAD(va, 2 * s2 + 2);
    T8_PUT(vb, 2 * s2 + 1);
  }
  __syncthreads();
#pragma unroll
  for (int i = 0; i < 16; ++i) {
    const int idx = tid + i * 512, n = idx >> 3, ch = idx & 7, ng = n0 + n;
    const int drow = mode == 0 ? ng : (32 * (ng >> 4) + (ng & 15) + (mode == 2 ? 16 : 0));
    const unsigned* ip = img + n * 33 + ch * 4;
    const u32x4 w = {ip[0], ip[1], ip[2], ip[3]};
    __builtin_nontemporal_store(w, (u32x4*)(dst + (size_t)drow * K + k0 + ch * 16));
  }
  __syncthreads();
#undef T8_LOAD
#undef T8_PUT
}
__device__ __forceinline__ void ph_weights_small(const Params& p, char* smem) {
  tconv<3, true>(p.even_w_in, DM, EIN, EINP, WSP(bf16_t, OFF_WIN0), smem);
  tconv<0>(p.w_uq, 512, 1536, 1536, WSP(bf16_t, OFF_WUQ), smem);
  tconv<0>(p.w_ukv, 512, 2048, 2048, WSP(bf16_t, OFF_WUKV), smem);
  tconv<0>(p.even_w_out, DM, DM, DM, WSP(bf16_t, OFF_WOUT0), smem);
  tconv<0>(p.odd_w_in, DM, DM, DM, WSP(bf16_t, OFF_WIN1), smem);
  tconv<0>(p.odd_w_out, DM, DM, DM, WSP(bf16_t, OFF_WOUT1), smem);
  for (int g = 0; g < 4; ++g) {
    tconv<0>(p.pool_w + (size_t)g * 65536, 256, 256, 256, WSP(bf16_t, OFF_WPOOL) + (size_t)g * 65536, smem);
  }
}
__device__ __forceinline__ void conv_item(const Params& p, char* smem, int g) {
  const int mat = g >> 5, st = g & 31, le = mat / 3, which = mat - 3 * le, k0 = (st & 15) * 128, n0 = (st >> 4) * 1024;
  const size_t so = (size_t)le * 2048 * 2048;
  const float* src = (which == 0 ? p.w_gate : (which == 1 ? p.w_up : p.w_down)) + so;
  unsigned char* dst = which == 2 ? WSP(unsigned char, OFF_WD) + so : WSP(unsigned char, OFF_WGU) + (size_t)le * 4096 * 2048;
  tconv8_tile(src, 2048, 2048, dst, which == 2 ? 0 : which + 1, k0, n0, smem);
}
__device__ __forceinline__ void ph_weights_expert(const Params& p, char* smem, int widx, int wcount) {
  for (int g = widx; g < 2 * NE * 3 * 32; g += wcount) conv_item(p, smem, g);
}

__device__ __forceinline__ void ph_mod(const Params& p, char* smem) {
  float* sc = (float*)smem;
  float* part = sc + 5 * 2048;
  const int tid = otid();
  for (int i = tid; i < 5 * 2048; i += 512) {
    const int r = i >> 11, k = i & 2047;
    const float v = r < 4 ? p.c[r * 2048 + k] : p.c_ctx[k];
    sc[i] = v / (1.f + __expf(-v));
  }
  __syncthreads();
  for (int cb = blockIdx.x; cb < 256; cb += gridDim.x) {
    const int l = cb >> 7, j0 = (cb & 127) * 96;
    const int c4 = tid % 24, kg = tid / 24;
    if (tid < 504) {
      f32x4 acc[5];
#pragma unroll
      for (int r = 0; r < 5; ++r) acc[r] = (f32x4){0.f, 0.f, 0.f, 0.f};
      const float* wp = p.mod_w + (size_t)l * 2048 * MLW + j0 + c4 * 4;
#pragma unroll 4
      for (int k = kg; k < 2048; k += 21) {
        const f32x4 w = *(const f32x4*)(wp + (size_t)k * MLW);
#pragma unroll
        for (int r = 0; r < 5; ++r) acc[r] += sc[r * 2048 + k] * w;
      }
#pragma unroll
      for (int r = 0; r < 5; ++r)
#pragma unroll
        for (int q = 0; q < 4; ++q) part[(kg * 5 + r) * 96 + c4 * 4 + q] = acc[r][q];
    }
    __syncthreads();
    if (tid < 480) {
      const int r = tid / 96, col = tid % 96;
      float s = p.mod_b[l * MLW + j0 + col];
      for (int g = 0; g < 21; ++g) s += part[(g * 5 + r) * 96 + col];
      WSP(float, OFF_ML)[((size_t)l * 5 + r) * MLW + j0 + col] = s;
    }
    __syncthreads();
  }
}

__device__ __forceinline__ void ph_twiddle(const Params& p, char* smem) {
  float* ct = (float*)smem;
  for (int j = otid(); j < 4096; j += 512) ct[j] = cospif((float)j * (1.f / 2048.f));
  __syncthreads();
  bf16_t* tw = WSP(bf16_t, OFF_TW);
  const size_t nchunk = (size_t)4096 * 512;
  for (size_t q = (size_t)blockIdx.x * 512 + otid(); q < nchunk; q += (size_t)gridDim.x * 512) {
    const int k1 = (int)(q >> 9), kk0 = (int)(q & 511) * 8;
    float v[8];
#pragma unroll
    for (int j = 0; j < 8; ++j) {
      const int kk = kk0 + j;
      if (kk <= 2048) v[j] = ct[(k1 * kk) & 4095];
      else v[j] = -ct[(k1 * (kk - 2048) - 1024) & 4095];
    }
    u32x4 w = {cvtpk(v[0], v[1]), cvtpk(v[2], v[3]), cvtpk(v[4], v[5]), cvtpk(v[6], v[7])};
    *(u32x4*)(tw + q * 8) = w;
  }
  bf16_t* mc = WSP(bf16_t, OFF_MC);
  for (int i = blockIdx.x * 512 + otid(); i < 4 * 256 * 256; i += gridDim.x * 512) {
    const int d = i & 255, c = (i >> 8) & 255, g = i >> 16;
    const float* fw = p.fourier_w + (size_t)g * 65536 + d;
    float ac = 0.f, as = 0.f;
#pragma unroll 8
    for (int k2 = 0; k2 < 256; ++k2) {
      const int ph = ((k2 * c) & 255) * 16; const float f = fw[k2 * 256];
      ac += f * ct[ph]; as += f * ct[(ph - 1024) & 4095];
    }
    mc[((size_t)(g * 512 + d) * 256) + c] = f2bf(ac); mc[((size_t)(g * 512 + 256 + d) * 256) + c] = f2bf(as);
  }
  __syncthreads();
}

struct Row8 { f32x4 v[8]; };
__device__ __forceinline__ float row_load_ss(const float* src, int lane, Row8& r) {
  float ss = 0.f;
#pragma unroll
  for (int i = 0; i < 8; ++i) { r.v[i] = *(const f32x4*)(src + i * 256 + lane * 4); ss += r.v[i][0] * r.v[i][0] + r.v[i][1] * r.v[i][1] + r.v[i][2] * r.v[i][2] + r.v[i][3] * r.v[i][3]; }
  return wave_sum(ss);
}
__device__ __forceinline__ float row_load_ss_bf16(const bf16_t* src, int lane, Row8& r) {
  float ss = 0.f;
#pragma unroll
  for (int i = 0; i < 8; ++i) { const u32x2 w = *(const u32x2*)(src + i * 256 + lane * 4); r.v[i] = (f32x4){bf_lo(w[0]), bf_hi(w[0]), bf_lo(w[1]), bf_hi(w[1])};
    ss += r.v[i][0] * r.v[i][0] + r.v[i][1] * r.v[i][1] + r.v[i][2] * r.v[i][2] + r.v[i][3] * r.v[i][3]; }
  return wave_sum(ss);
}
__device__ __forceinline__ void row_norm_mod(Row8& r, float inv, const float* gain, const float* sc, const float* sh, int lane) {
#pragma unroll
  for (int i = 0; i < 8; ++i) {
    const int j = i * 256 + lane * 4;
    const f32x4 g = *(const f32x4*)(gain + j);
    f32x4 y = r.v[i] * inv * g;
    if (sc) { const f32x4 s1 = *(const f32x4*)(sc + j), s0 = *(const f32x4*)(sh + j); y = y * (1.f + s1) + s0; }
    r.v[i] = y;
  }
}
__device__ __forceinline__ void row_store_fp8(const Row8& r, unsigned char* dst, int lane) {
#pragma unroll
  for (int i = 0; i < 8; ++i) *(unsigned*)(dst + i * 256 + lane * 4) = pack_fp8x4(r.v[i][0], r.v[i][1], r.v[i][2], r.v[i][3]);
}
__device__ __forceinline__ void row_store_bf16(const Row8& r, bf16_t* dst, int lane) {
#pragma unroll
  for (int i = 0; i < 8; ++i) { u32x2 w = {cvtpk(r.v[i][0], r.v[i][1]), cvtpk(r.v[i][2], r.v[i][3])}; *(u32x2*)(dst + i * 256 + lane * 4) = w; }
}

__device__ __forceinline__ void ph_pre0(const Params& p) {
  const int lane = otid() & 63;
  for (int r = gwave(); r < NA; r += nwave()) {
    const float* src = r < NT ? p.x + (size_t)r * DM : p.ctx + (size_t)(r - NT) * DM;
    const float* ml = mlp(p, 0, r < NT ? r / SEQ : 4);
    Row8 row; const float ss = row_load_ss(src, lane, row);
    row_norm_mod(row, rsqrtf(ss * (1.f / DM) + EPS), p.norm_mix, ml + 2048, ml, lane);
    row_store_fp8(row, WSP(unsigned char, OFF_H) + (size_t)r * DM, lane);
  }
}

__device__ __forceinline__ float rope_inv_freq(int q, int quarter) { return exp2f(-(float)q / (float)quarter * 13.287712379549449f); }

__device__ __forceinline__ void ph_post_inproj(const Params& p) {
  const int lane = otid() & 63;
  const bf16_t* P0 = WSP(const bf16_t, OFF_P0);
  for (int r = gwave(); r < NA; r += nwave()) {
    const bool lat = r < NT;
    int b, keyrow, prow = 0, pcol = 0;
    if (lat) { b = r / SEQ; const int n = r % SEQ; keyrow = b * NKEY + CTXL + n; prow = n >> 6; pcol = n & 63; }
    else { const int i = r - NT; b = i / CTXL; keyrow = b * NKEY + (i % CTXL); }
    const bf16_t* row = P0 + (size_t)r * P0W;
    const u32x4 wq = *(const u32x4*)(row + lane * 8), wkv = *(const u32x4*)(row + 512 + lane * 8);
    const float xkr = bf2f(row[1024 + lane]);
    asm volatile("" ::: "memory");
    if (lat) {
      const u32x4 w = wq;
      float v[8] = {bf_lo(w[0]), bf_hi(w[0]), bf_lo(w[1]), bf_hi(w[1]), bf_lo(w[2]), bf_hi(w[2]), bf_lo(w[3]), bf_hi(w[3])};
      float ss = 0.f;
#pragma unroll
      for (int j = 0; j < 8; ++j) ss += v[j] * v[j];
      const float inv = rsqrtf(wave_sum(ss) * (1.f / 512.f) + EPS);
      const f32x4 g0 = *(const f32x4*)(p.q_norm + lane * 8), g1 = *(const f32x4*)(p.q_norm + lane * 8 + 4);
      u32x4 o = {cvtpk(v[0] * inv * g0[0], v[1] * inv * g0[1]), cvtpk(v[2] * inv * g0[2], v[3] * inv * g0[3]),
                 cvtpk(v[4] * inv * g1[0], v[5] * inv * g1[1]), cvtpk(v[6] * inv * g1[2], v[7] * inv * g1[3])};
      *(u32x4*)(WSP(bf16_t, OFF_CQN) + (size_t)r * 512 + lane * 8) = o;
    }
    {
      const u32x4 w = wkv;
      float v[8] = {bf_lo(w[0]), bf_hi(w[0]), bf_lo(w[1]), bf_hi(w[1]), bf_lo(w[2]), bf_hi(w[2]), bf_lo(w[3]), bf_hi(w[3])};
      float ss = 0.f;
#pragma unroll
      for (int j = 0; j < 8; ++j) ss += v[j] * v[j];
      const float inv = rsqrtf(wave_sum(ss) * (1.f / 512.f) + EPS);
      const f32x4 g0 = *(const f32x4*)(p.kv_norm + lane * 8), g1 = *(const f32x4*)(p.kv_norm + lane * 8 + 4);
      u32x4 o = {cvtpk(v[0] * inv * g0[0], v[1] * inv * g0[1]), cvtpk(v[2] * inv * g0[2], v[3] * inv * g0[3]),
                 cvtpk(v[4] * inv * g1[0], v[5] * inv * g1[1]), cvtpk(v[6] * inv * g1[2], v[7] * inv * g1[3])};
      *(u32x4*)(WSP(bf16_t, OFF_CKVN) + (size_t)r * 512 + lane * 8) = o;
    }
    const float pos = (lane >> 5) ? (float)pcol : (float)prow;
    const bool second = (lane >> 4) & 1;
    float c64 = 1.f, s64 = 0.f;
    if (lat) sincosf(pos * rope_inv_freq(lane & 15, 16), &s64, &c64);
    {
      const float xs = xkr;
      const float xp = __shfl_xor(xs, 16, 64);
      const float o = second ? (xs * c64 + xp * s64) : (xs * c64 - xp * s64);
      const unsigned char ob = (unsigned char)(pack_fp8x4(o, o, o, o) & 0xffu);
      unsigned char* ka = WSP(unsigned char, OFF_KA) + (size_t)keyrow * 1536 + 128 + lane;
#pragma unroll
      for (int h = 0; h < 8; ++h) ka[h * 192] = ob;
    }
  }
}

__device__ __forceinline__ void ph_diffcomb(const Params& p) {
  const int lane = otid() & 63;
  float d1 = p.lq1[lane] * p.lk1[lane] + p.lq1[lane + 64] * p.lk1[lane + 64];
  float d2 = p.lq2[lane] * p.lk2[lane] + p.lq2[lane + 64] * p.lk2[lane + 64];
  d1 = wave_sum(d1); d2 = wave_sum(d2);
  const float lam_init = 0.2f;
  const float lam = expf(d1) - expf(d2) + lam_init;
  const f32x4 sg = *(const f32x4*)(p.subln + lane * 4);
  const bf16_t* OD = WSP(const bf16_t, OFF_OD);
  for (int r = gwave(); r < NT; r += nwave()) {
    u32x2 w0[4], w1[4];
#pragma unroll
    for (int h = 0; h < 4; ++h) { w0[h] = *(const u32x2*)(OD + (size_t)r * 2048 + h * 256 + lane * 4); w1[h] = *(const u32x2*)(OD + (size_t)r * 2048 + 1024 + h * 256 + lane * 4); }
    asm volatile("" ::: "memory");
#pragma unroll
    for (int h = 0; h < 4; ++h) {
      const f32x4 o0 = {bf_lo(w0[h][0]), bf_hi(w0[h][0]), bf_lo(w0[h][1]), bf_hi(w0[h][1])}, o1 = {bf_lo(w1[h][0]), bf_hi(w1[h][0]), bf_lo(w1[h][1]), bf_hi(w1[h][1])};
      const f32x4 d = o0 - lam * o1;
      const float ss = wave_sum(d[0] * d[0] + d[1] * d[1] + d[2] * d[2] + d[3] * d[3]);
      const float inv = rsqrtf(ss * (1.f / 256.f) + EPS) * (1.f - lam_init);
      u32x2 w = {cvtpk(d[0] * inv * sg[0], d[1] * inv * sg[1]), cvtpk(d[2] * inv * sg[2], d[3] * inv * sg[3])};
      *(u32x2*)(WSP(bf16_t, OFF_YIN) + (size_t)r * 2048 + 1024 + h * 256 + lane * 4) = w;
    }
  }
}

__device__ __forceinline__ void ph_ffn_pre(const Params& p, int l, char* smem) {
  const int lane = otid() & 63, tid = otid();
  float* rw = (float*)smem;
  const float* rsrc = p.router_w + (size_t)l * DM * NE;
  for (int id = tid; id < DM * 4; id += 512) {
    const int j = id >> 2, q = id & 3;
    const f32x4 v = *(const f32x4*)(rsrc + j * 16 + q * 4);
    const int i = j >> 8, ln = (j & 255) >> 2, k = j & 3;
    *(f32x4*)(rw + ((((q * 8 + i) * 4 + k) * 64 + ln) << 2)) = v;
  }
  __syncthreads();
  for (int r = gwave(); r < NT; r += nwave()) {
    const int b = r / SEQ, n = r % SEQ;
    const float* ml = mlp(p, l, b);
    Row8 row; const float ss = row_load_ss_bf16(WSP(const bf16_t, OFF_XL) + (size_t)r * DM, lane, row);
    row_norm_mod(row, rsqrtf(ss * (1.f / DM) + EPS), p.norm_ffn + l * DM, ml + 8192, ml + 6144, lane);
    row_store_fp8(row, WSP(unsigned char, OFF_H) + (size_t)r * DM, lane);
    float lg[16];
#pragma unroll
    for (int e = 0; e < 16; ++e) lg[e] = 0.f;
#pragma unroll
    for (int i = 0; i < 8; ++i) {
      __builtin_amdgcn_sched_barrier(0);
#pragma unroll
      for (int k = 0; k < 4; ++k) {
        const float hv = row.v[i][k];
#pragma unroll
        for (int q = 0; q < 4; ++q) {
          const f32x4 w = *(const f32x4*)(rw + ((((q * 8 + i) * 4 + k) * 64 + lane) << 2));
          lg[q * 4 + 0] += hv * w[0]; lg[q * 4 + 1] += hv * w[1]; lg[q * 4 + 2] += hv * w[2]; lg[q * 4 + 3] += hv * w[3];
        }
      }
    }
    float mx = -1e30f;
#pragma unroll
    for (int e = 0; e < 16; ++e) { lg[e] = wave_sum(lg[e]); mx = fmaxf(mx, lg[e]); }
    float den = 0.f;
#pragma unroll
    for (int e = 0; e < 16; ++e) { lg[e] = expf(lg[e] - mx); den += lg[e]; }
    const float rden = 1.f / den;
    float mine = 0.f;
#pragma unroll
    for (int e = 0; e < 16; ++e) mine = (lane == e) ? lg[e] * rden : mine;
    if (lane < 16) {
      WSP(float, OFF_AFF)[((size_t)(b * NE + lane)) * SEQ + n] = mine;
      WSP(int, OFF_INV)[(size_t)r * NE + lane] = -1;
    }
  }
  __syncthreads();
}

__device__ __forceinline__ void ph_topk(const Params& p, char* smem) {
  unsigned* cnt = (unsigned*)smem;
  const int tid = otid(), lane = tid & 63, wid = tid >> 6;
  for (int be = blockIdx.x; be < NB * NE; be += gridDim.x) {
    const int b = be / NE, e = be % NE;
    const float* src = WSP(const float, OFF_AFF) + (size_t)be * SEQ + tid * 8;
    const f32x4 v0 = *(const f32x4*)src, v1 = *(const f32x4*)(src + 4);
    const float val[8] = {v0[0], v0[1], v0[2], v0[3], v1[0], v1[1], v1[2], v1[3]};
    unsigned key[8];
#pragma unroll
    for (int j = 0; j < 8; ++j) key[j] = __float_as_uint(val[j]);
    unsigned lo = 0u, hi = 0x3f800000u; int par = 0;
    __syncthreads();
    while (lo < hi) {
      const unsigned span = hi - lo + 1u;
      const unsigned t1 = lo + (span >> 2), t2 = lo + (span >> 1), t3 = lo + (span >> 1) + (span >> 2);
      unsigned c1 = 0u, c2 = 0u, c3 = 0u;
#pragma unroll
      for (int k = 0; k < 8; ++k) { c1 += (unsigned)__popcll(__ballot(key[k] >= t1)); c2 += (unsigned)__popcll(__ballot(key[k] >= t2)); c3 += (unsigned)__popcll(__ballot(key[k] >= t3)); }
      if (lane < 3) cnt[par * 32 + wid * 4 + lane] = lane == 0 ? c1 : (lane == 1 ? c2 : c3);
      __syncthreads();
      unsigned s1 = 0u, s2 = 0u, s3 = 0u;
#pragma unroll
      for (int w = 0; w < 8; ++w) { s1 += cnt[par * 32 + w * 4]; s2 += cnt[par * 32 + w * 4 + 1]; s3 += cnt[par * 32 + w * 4 + 2]; }
      par ^= 1;
      if (s1 < (unsigned)CAP) hi = t1 - 1u;
      else if (s2 < (unsigned)CAP) { lo = t1; hi = t2 - 1u; }
      else if (s3 < (unsigned)CAP) { lo = t2; hi = t3 - 1u; }
      else lo = t3;
    }
    const unsigned T = lo;
    int ngt = 0, neq = 0;
#pragma unroll
    for (int j = 0; j < 8; ++j) { ngt += key[j] > T ? 1 : 0; neq += key[j] == T ? 1 : 0; }
    int pk = ngt | (neq << 16);
    int inc = pk;
#pragma unroll
    for (int o = 1; o < 64; o <<= 1) { const int t = __shfl_up(inc, o, 64); if (lane >= o) inc += t; }
    if (lane == 63) cnt[128 + wid] = (unsigned)inc;
    __syncthreads();
    int base = 0, total = 0;
#pragma unroll
    for (int w = 0; w < 8; ++w) { const int t = (int)cnt[128 + w]; total += t; if (w < wid) base += t; }
    const int excl = base + inc - pk;
    int gpos = excl & 0xffff, epos = excl >> 16;
    const int total_gt = total & 0xffff, need = CAP - total_gt;
#pragma unroll
    for (int j = 0; j < 8; ++j) {
      int slot = -1;
      if (key[j] > T) slot = gpos++;
      else if (key[j] == T) { if (epos < need) slot = total_gt + epos; ++epos; }
      if (slot >= 0) {
        const int tok = tid * 8 + j;
        WSP(int, OFF_IDX)[be * CAP + slot] = tok; WSP(float, OFF_GATE)[be * CAP + slot] = val[j];
        WSP(int, OFF_INV)[(size_t)(b * SEQ + tok) * NE + e] = slot;
      }
    }
    __syncthreads();
  }
}

__device__ __forceinline__ void ph_combine(const Params& p, int l) {
  const int lane = otid() & 63;
  for (int r = gwave(); r < NT; r += nwave()) {
    const int b = r / SEQ;
    Row8 acc;
#pragma unroll
    for (int i = 0; i < 8; ++i) acc.v[i] = (f32x4){0.f, 0.f, 0.f, 0.f};
    const int myinv = WSP(const int, OFF_INV)[(size_t)r * NE + (lane & 15)];
    unsigned long long mask = __ballot(myinv >= 0) & 0xffffull;
    bf16_t* xl = WSP(bf16_t, OFF_XL) + (size_t)r * DM;
    u32x2 xw[8];
#pragma unroll
    for (int i = 0; i < 8; ++i) xw[i] = *(const u32x2*)(xl + i * 256 + lane * 4);
    while (mask) {
      const int e = __builtin_ctzll(mask); mask &= mask - 1;
      const int s = __builtin_amdgcn_readlane(myinv, e);
      const bf16_t* ye = WSP(const bf16_t, OFF_YE) + ((size_t)e * 2048 + b * CAP + s) * DM;
#pragma unroll
      for (int i = 0; i < 8; ++i) {
        const u32x2 w = *(const u32x2*)(ye + i * 256 + lane * 4);
        acc.v[i][0] += bf_lo(w[0]); acc.v[i][1] += bf_hi(w[0]); acc.v[i][2] += bf_lo(w[1]); acc.v[i][3] += bf_hi(w[1]);
      }
    }
    const float* ml = mlp(p, l, b);
    Row8 row; float ss = 0.f;
#pragma unroll
    for (int i = 0; i < 8; ++i) {
      const int j = i * 256 + lane * 4;
      const f32x4 g2 = *(const f32x4*)(ml + 10240 + j);
      row.v[i] = (f32x4){bf_lo(xw[i][0]), bf_hi(xw[i][0]), bf_lo(xw[i][1]), bf_hi(xw[i][1])} + g2 * acc.v[i];
      ss += row.v[i][0] * row.v[i][0] + row.v[i][1] * row.v[i][1] + row.v[i][2] * row.v[i][2] + row.v[i][3] * row.v[i][3];
    }
    ss = wave_sum(ss);
    const float inv = rsqrtf(ss * (1.f / DM) + EPS);
    if (l == 0) {
#pragma unroll
      for (int i = 0; i < 8; ++i) { u32x2 w = {cvtpk(row.v[i][0], row.v[i][1]), cvtpk(row.v[i][2], row.v[i][3])}; *(u32x2*)(xl + i * 256 + lane * 4) = w; }
      const float* ml1 = mlp(p, 1, b);
      row_norm_mod(row, inv, p.norm_mix + DM, ml1 + 2048, ml1, lane);
      row_store_bf16(row, WSP(bf16_t, OFF_H) + (size_t)r * DM, lane);
    } else {
      row_norm_mod(row, inv, p.final_norm, nullptr, nullptr, lane);
#pragma unroll
      for (int i = 0; i < 8; ++i) *(f32x4*)(p.out + (size_t)r * DM + i * 256 + lane * 4) = row.v[i];
    }
  }
}

__device__ __forceinline__ void ph_fold(const Params& p) {
  const bf16_t* src = WSP(const bf16_t, OFF_ABT2); bf16_t* dst = WSP(bf16_t, OFF_ABTF);
  float* nyq = WSP(float, OFF_IDX);
  for (int id = blockIdx.x * 512 + otid(); id < 4096 * 512; id += gridDim.x * 512) {
    const int rowi = id >> 9, kk0 = (id & 511) * 8;
    const bf16_t* rp = src + (size_t)rowi * 8192;
    float o[8];
    if (kk0 < 2048) {
      const u32x4 w = *(const u32x4*)(rp + kk0);
#pragma unroll
      for (int j = 0; j < 4; ++j) { o[2 * j] = bf_lo(w[j]); o[2 * j + 1] = bf_hi(w[j]); }
#pragma unroll
      for (int j = 0; j < 8; ++j) { const int kk = kk0 + j; if (kk > 0) o[j] += bf2f(rp[4096 - kk]); }
    } else {
      const int j0 = kk0 - 2048;
      const u32x4 w = *(const u32x4*)(rp + 4096 + j0);
#pragma unroll
      for (int j = 0; j < 4; ++j) { o[2 * j] = bf_lo(w[j]); o[2 * j + 1] = bf_hi(w[j]); }
#pragma unroll
      for (int j = 0; j < 8; ++j) { const int jj = j0 + j; if (jj > 0) o[j] -= bf2f(rp[4096 + 4096 - jj]); else o[j] = bf2f(rp[2048]); }
      if (j0 == 0) nyq[rowi] = o[0];
    }
    u32x4 ow = {cvtpk(o[0], o[1]), cvtpk(o[2], o[3]), cvtpk(o[4], o[5]), cvtpk(o[6], o[7])};
    *(u32x4*)(dst + (size_t)rowi * 4096 + kk0) = ow;
  }
}

__device__ __forceinline__ void ph_dftcomb(const Params& p) {
  const bf16_t* PQ = WSP(const bf16_t, OFF_SPEC); const bf16_t* abtf = WSP(const bf16_t, OFF_ABTF); bf16_t* Y = WSP(bf16_t, OFF_YCAT);
  const float sc = 1.f / 1024.f;
  for (int id = blockIdx.x * 512 + otid(); id < 16 * 2048 * 32; id += gridDim.x * 512) {
    const int d8 = (id & 31) * 8, k1 = (id >> 5) & 2047, bg = id >> 16, b = bg >> 2, g = bg & 3;
    const u32x4 wp = *(const u32x4*)(PQ + ((size_t)(2 * bg) * 2048 + k1) * 256 + d8), wq = *(const u32x4*)(PQ + ((size_t)(2 * bg + 1) * 2048 + k1) * 256 + d8);
    float pv[8], qv[8], ny[8];
#pragma unroll
    for (int j = 0; j < 4; ++j) { pv[2 * j] = bf_lo(wp[j]); pv[2 * j + 1] = bf_hi(wp[j]); qv[2 * j] = bf_lo(wq[j]); qv[2 * j + 1] = bf_hi(wq[j]); }
    const float sgn = (k1 & 1) ? -2.f : 2.f;
    { const f32x4 n0 = *(const f32x4*)(WSP(const float, OFF_IDX) + bg * 256 + d8), n1 = *(const f32x4*)(WSP(const float, OFF_IDX) + bg * 256 + d8 + 4);
#pragma unroll
      for (int j = 0; j < 4; ++j) { ny[j] = sgn * n0[j]; ny[4 + j] = sgn * n1[j]; } }
    bf16_t* y0 = Y + ((size_t)b * SEQ + k1) * DM + 1024 + g * 256 + d8;
    u32x4 o;
#pragma unroll
    for (int j = 0; j < 4; ++j) o[j] = cvtpk((pv[2 * j] + qv[2 * j]) * sc, (pv[2 * j + 1] + qv[2 * j + 1]) * sc);
    *(u32x4*)y0 = o;
    if (k1 > 0) {
#pragma unroll
      for (int j = 0; j < 4; ++j) o[j] = cvtpk((pv[2 * j] - qv[2 * j] + ny[2 * j]) * sc, (pv[2 * j + 1] - qv[2 * j + 1] + ny[2 * j + 1]) * sc);
      *(u32x4*)(Y + ((size_t)b * SEQ + (SEQ - k1)) * DM + 1024 + g * 256 + d8) = o;
    }
  }
  const int lane = otid() & 63;
  for (int r = gwave(); r < 16 * 256; r += nwave()) {
    const bf16_t* row = abtf + (size_t)r * 4096;
    float acc = 0.f;
#pragma unroll
    for (int i = 0; i < 4; ++i) { const u32x4 w = *(const u32x4*)(row + i * 512 + lane * 8);
#pragma unroll
      for (int j = 0; j < 4; ++j) acc += bf_lo(w[j]) - bf_hi(w[j]); }
    acc = wave_sum(acc) + bf2f(row[2048]);
    if (lane == 0) { const int bg = r >> 8, d = r & 255; Y[((size_t)(bg >> 2) * SEQ + 2048) * DM + 1024 + (bg & 3) * 256 + d] = f2bf(acc * sc); }
  }
}

__device__ __forceinline__ void ph_pool(const Params& p) {
  const bf16_t* Z = WSP(const bf16_t, OFF_Z);
  for (int id = blockIdx.x * 512 + otid(); id < NT * 128; id += gridDim.x * 512) {
    const int r = id >> 7, c8 = (id & 127) * 8, g = c8 >> 8, half = 1 << g;
    const int b = r / SEQ, n = r % SEQ;
    const int lo = max(n - half, 0), hi = min(n + half, SEQ);
    float s[8];
#pragma unroll
    for (int j = 0; j < 8; ++j) s[j] = 0.f;
    u32x4 wv[16];
#pragma unroll
    for (int d = 0; d < 16; ++d) { int t = n - 8 + d; t = t < lo ? lo : (t >= hi ? hi - 1 : t); wv[d] = *(const u32x4*)(Z + (size_t)(b * SEQ + t) * 2048 + c8); }
#pragma unroll
    for (int d = 0; d < 16; ++d) { const int t = n - 8 + d; const float wt = (t >= lo && t < hi) ? 1.f : 0.f;
#pragma unroll
      for (int j = 0; j < 4; ++j) { s[2 * j] += wt * bf_lo(wv[d][j]); s[2 * j + 1] += wt * bf_hi(wv[d][j]); } }
    const float rc = 1.f / (float)(hi - lo);
    const u32x4 w = *(const u32x4*)(Z + (size_t)r * 2048 + c8);
    u32x4 o;
#pragma unroll
    for (int j = 0; j < 4; ++j) o[j] = cvtpk(s[2 * j] * rc - bf_lo(w[j]), s[2 * j + 1] * rc - bf_hi(w[j]));
    *(u32x4*)(WSP(bf16_t, OFF_POOLED) + (size_t)r * 1024 + c8) = o;
  }
}

#define LAS __attribute__((address_space(3)))
__host__ __device__ __forceinline__ constexpr int vt_pos(int kap) { return (((kap >> 2) & 1) << 5) | ((kap >> 5) << 4) | (((kap >> 3) & 3) << 2) | (kap & 3); }
namespace fg {
constexpr int BM = 256, BK = 64, HALF = 128, HTB = HALF * BK * 2, STAGE_BYTES = 8 * HTB;
__device__ __forceinline__ int lds_byte(int r, int c) { const int st = (r >> 4) * 2 + (c >> 5), rr = r & 15, cc = c & 31, ob = rr * 64 + cc * 2; return st * 1024 + (ob ^ (((ob >> 9) & 1) << 5)); }
__device__ __forceinline__ void stage_rc(int b, int& R, int& C) { const int st = b / 1024, sb = b % 1024, swz = sb ^ (((sb >> 9) & 1) << 5); R = (st >> 1) * 16 + swz / 64; C = (st & 1) * 32 + (swz % 64) / 2; }
struct Unit { const char* a; const char* b; int pm, pn, grp; };
typedef int i32x8 __attribute__((ext_vector_type(8)));
typedef int i32x4 __attribute__((ext_vector_type(4)));
__device__ __forceinline__ void mfma_fp8(f32x4& acc, const i32x8& a, const i32x8& b, int scale) {
  asm volatile("s_nop 1\n\tv_mfma_scale_f32_16x16x128_f8f6f4 %0, %1, %2, %0, %3, %3 op_sel_hi:[0,0,0]" : "+v"(acc) : "v"(a), "v"(b), "v"(scale));
}
template <int H> __device__ __forceinline__ bf16x8 half8(i32x8 v) { const i32x4 h = H ? __builtin_shufflevector(v, v, 4, 5, 6, 7) : __builtin_shufflevector(v, v, 0, 1, 2, 3); return __builtin_bit_cast(bf16x8, h); }
__device__ __forceinline__ i32x8 cat8(bf16x8 lo, bf16x8 hi) { const i32x4 a = __builtin_bit_cast(i32x4, lo), b = __builtin_bit_cast(i32x4, hi); return (i32x8){a[0], a[1], a[2], a[3], b[0], b[1], b[2], b[3]}; }
struct Grid {
  const char* A; const char* B; size_t sA, sB; int lda, ldb, nM, nN, ngrp, G, c; int gd = 1; size_t sA2 = 0, sB2 = 0;
  __device__ __forceinline__ bool next(int i, Unit& u) const {
    const int cc = (G == 256) ? ((c & 7) * 32 + (c >> 3)) : c;
    const int L = i * G + cc, per = nM * nN;
    if (L >= per * ngrp) return false;
    const int g = L / per, w = L - g * per;
    const int nig = 8 * nN, gid = w / nig, fm = gid * 8, gsz = (nM - fm) < 8 ? (nM - fm) : 8, wi = w - gid * nig;
    u.grp = g; u.pn = wi / gsz; u.pm = fm + (wi - u.pn * gsz);
    const int g1 = g / gd, g2 = g - g1 * gd;
    u.a = A + (size_t)g1 * sA + (size_t)g2 * sA2 + (size_t)u.pm * 256 * lda * 2; u.b = B + (size_t)g1 * sB + (size_t)g2 * sB2 + (size_t)u.pn * 256 * ldb * 2;
    return true;
  }
};
template <class Epi, bool GATHER = false, bool FP8 = false>
__device__ __forceinline__ void gemm_fast(LAS unsigned char* lds, const Grid& S, const Epi& E, int K, const int* gidx = nullptr) {
  int tid_ = threadIdx.x; asm volatile("" : "+v"(tid_));
  const int tid = tid_, wid = __builtin_amdgcn_readfirstlane(tid >> 6), lane = tid & 63, wr = wid >> 2, wc = wid & 3, fr = lane & 15, fq = lane >> 4;
  const int nt = K / BK;
  unsigned voffA[2], voffB[2];
#pragma unroll
  for (int i = 0; i < 2; ++i) { int R, C; stage_rc(tid * 16 + i * 8192, R, C); voffA[i] = (unsigned)(R * S.lda + C) * 2u; voffB[i] = (unsigned)(R * S.ldb + C) * 2u; }
  const size_t kstep = (size_t)(BK * 2);
  const size_t hstepA = (size_t)HALF * S.lda * 2, hstepB = (size_t)HALF * S.ldb * 2;
  const unsigned ldsw = (unsigned)wid * 1024u;
  const int aoff = FP8 ? lds_byte(wr * 64 + fr, fq * 16) : lds_byte(wr * 64 + fr, fq * 8), boff = FP8 ? lds_byte(wc * 32 + fr, fq * 16) : lds_byte(wc * 32 + fr, fq * 8);
  constexpr int KOFF = FP8 ? 16 : 1024;
#define FG_SA(b, h) (((b) * 2 + (h)) * HTB)
#define FG_SB(b, h) ((4 + (b) * 2 + (h)) * HTB)
#define FG_STAGE(bufoff, gbase, voff) do { _Pragma("unroll") for (int _i = 0; _i < 2; ++_i) \
    __builtin_amdgcn_global_load_lds((const unsigned*)((const char*)(gbase) + (voff)[_i]), (LAS unsigned*)(lds + (bufoff) + ldsw + _i * 8192), 16, 0, 0); } while (0)
#define FG_STAGE_A(bufoff, usen, kb, h) do { if constexpr (GATHER) { _Pragma("unroll") for (int _i = 0; _i < 2; ++_i) { const unsigned _g = (usen) ? gN[h][_i] : gA[h][_i]; \
      __builtin_amdgcn_global_load_lds((const unsigned*)(S.A + _g + (kb)), (LAS unsigned*)(lds + (bufoff) + ldsw + _i * 8192), 16, 0, 0); } } \
    else { FG_STAGE(bufoff, ((usen) ? nA : cA) + (kb) + (h) * hstepA, voffA); } } while (0)
#define FG_LDA(dst, b, h) do { _Pragma("unroll") for (int m = 0; m < 4; ++m) dst[m] = cat8(*(const LAS bf16x8*)(lds + FG_SA(b, h) + aoff + m * 2048), *(const LAS bf16x8*)(lds + FG_SA(b, h) + aoff + m * 2048 + KOFF)); } while (0)
#define FG_LDB(dst, b, h) do { _Pragma("unroll") for (int n = 0; n < 2; ++n) dst[n] = cat8(*(const LAS bf16x8*)(lds + FG_SB(b, h) + boff + n * 2048), *(const LAS bf16x8*)(lds + FG_SB(b, h) + boff + n * 2048 + KOFF)); } while (0)
#define FG_MMA(ai, bj, At, Bt) do { __builtin_amdgcn_s_setprio(1); _Pragma("unroll") for (int m = 0; m < 4; ++m) _Pragma("unroll") for (int n = 0; n < 2; ++n) { \
    if constexpr (FP8) mfma_fp8(acc[ai][bj][m][n], Bt[n], At[m], one_scale); \
    else { acc[ai][bj][m][n] = __builtin_amdgcn_mfma_f32_16x16x32_bf16(half8<0>(Bt[n]), half8<0>(At[m]), acc[ai][bj][m][n], 0, 0, 0); \
           acc[ai][bj][m][n] = __builtin_amdgcn_mfma_f32_16x16x32_bf16(half8<1>(Bt[n]), half8<1>(At[m]), acc[ai][bj][m][n], 0, 0, 0); } } \
    __builtin_amdgcn_s_setprio(0); } while (0)
#define FG_WAIT_V(n) asm volatile("s_waitcnt vmcnt(" #n ")" ::: "memory")
#define FG_WAIT_L(n) asm volatile("s_waitcnt lgkmcnt(" #n ")" ::: "memory")
#define FG_BAR __builtin_amdgcn_s_barrier()
#define FG_SCHED __builtin_amdgcn_sched_barrier(0)
  Unit cur, nxt; int ui = 0;
  if (!S.next(0, cur)) return;
  f32x4 acc[2][2][4][2];
#pragma unroll
  for (int a = 0; a < 2; ++a)
#pragma unroll
    for (int b = 0; b < 2; ++b)
#pragma unroll
      for (int m = 0; m < 4; ++m)
#pragma unroll
        for (int n = 0; n < 2; ++n) acc[a][b][m][n] = (f32x4){0.f, 0.f, 0.f, 0.f};
  int one_scale = 0x7f7f7f7f; asm volatile("" : "+v"(one_scale));
  i32x8 At[4], B0[2], B1[2];
  const char* cA = cur.a; const char* cB = cur.b; const char* nA = cA;
  unsigned gA[2][2] = {{0u, 0u}, {0u, 0u}}, gN[2][2] = {{0u, 0u}, {0u, 0u}};
  auto goff = [&](const Unit& u, unsigned (&g)[2][2]) {
#pragma unroll
    for (int h = 0; h < 2; ++h)
#pragma unroll
      for (int i = 0; i < 2; ++i) { int R, C; stage_rc(tid * 16 + i * 8192, R, C); const int rr = u.pm * 256 + h * 128 + R, bb = rr >> 9;
        const int tok = bb * SEQ + gidx[(bb * NE + u.grp) * CAP + (rr & 511)]; g[h][i] = (unsigned)(tok * S.lda + C) * 2u; }
  };
  if constexpr (GATHER) goff(cur, gA);
  FG_STAGE(FG_SB(0, 0), cB, voffB); FG_STAGE_A(FG_SA(0, 0), false, 0, 0); FG_STAGE(FG_SB(0, 1), cB + hstepB, voffB); FG_STAGE_A(FG_SA(0, 1), false, 0, 1);
  if (wr == 1) FG_BAR;
  FG_WAIT_V(4); FG_BAR;
  FG_STAGE(FG_SB(1, 0), cB + kstep, voffB); FG_STAGE_A(FG_SA(1, 0), false, kstep, 0); FG_STAGE(FG_SB(1, 1), cB + hstepB + kstep, voffB);
  FG_WAIT_V(6); FG_BAR;
  for (;;) {
    const bool has_next = S.next(ui + 1, nxt);
    nA = has_next ? nxt.a : cA; const char* nB = has_next ? nxt.b : cB;
    if constexpr (GATHER) { if (has_next) goff(nxt, gN); else {
#pragma unroll
      for (int h = 0; h < 2; ++h)
#pragma unroll
        for (int i = 0; i < 2; ++i) gN[h][i] = gA[h][i]; } }
#pragma unroll 1
    for (int t = 0; t < nt; t += 2) {
      const bool last = (t == nt - 2);
      const size_t k1 = (size_t)(t + 1) * kstep, k2 = last ? 0 : (size_t)(t + 2) * kstep, k3 = k2 + kstep;
      const char* b2 = last ? nB : cB + (size_t)(t + 2) * kstep;
      const char* b3 = b2 + kstep;
      FG_LDB(B0, 0, 0); FG_SCHED; FG_LDA(At, 0, 0); FG_STAGE_A(FG_SA(1, 1), false, k1, 1);
      FG_WAIT_L(8); FG_BAR; FG_WAIT_L(0); FG_MMA(0, 0, At, B0); FG_BAR; FG_SCHED;
      FG_LDB(B1, 0, 1); FG_STAGE(FG_SB(0, 0), b2, voffB);
      FG_BAR; FG_WAIT_L(0); FG_MMA(0, 1, At, B1); FG_BAR;
      FG_LDA(At, 0, 1); FG_STAGE_A(FG_SA(0, 0), last, k2, 0);
      FG_BAR; FG_WAIT_L(0); FG_MMA(1, 0, At, B0); FG_BAR; FG_SCHED;
      FG_STAGE(FG_SB(0, 1), b2 + hstepB, voffB);
      FG_WAIT_V(6); FG_BAR; FG_MMA(1, 1, At, B1); FG_BAR;
      FG_LDB(B0, 1, 0); FG_SCHED; FG_LDA(At, 1, 0); FG_STAGE_A(FG_SA(0, 1), last, k2, 1);
      FG_WAIT_L(8); FG_BAR; FG_WAIT_L(0); FG_MMA(0, 0, At, B0); FG_BAR; FG_SCHED;
      FG_LDB(B1, 1, 1); FG_STAGE(FG_SB(1, 0), b3, voffB);
      FG_BAR; FG_WAIT_L(0); FG_MMA(0, 1, At, B1); FG_BAR;
      FG_LDA(At, 1, 1); FG_STAGE_A(FG_SA(1, 0), last, k3, 0);
      FG_BAR; FG_WAIT_L(0); FG_MMA(1, 0, At, B0); FG_BAR; FG_SCHED;
      FG_STAGE(FG_SB(1, 1), b3 + hstepB, voffB);
      FG_WAIT_V(6); FG_BAR; FG_MMA(1, 1, At, B1); FG_BAR;
    }
    if constexpr (FP8) asm volatile("s_nop 15\n\ts_nop 15" ::: "memory");
    {
      int tz = threadIdx.x; asm volatile("" : "+v"(tz));
      const int wz = __builtin_amdgcn_readfirstlane(tz >> 6), lz = tz & 63;
      E(acc, cur, wz >> 2, wz & 3, lz & 15, lz >> 4); }
    if (!has_next) break;
#pragma unroll
    for (int a = 0; a < 2; ++a)
#pragma unroll
      for (int b = 0; b < 2; ++b)
#pragma unroll
        for (int m = 0; m < 4; ++m)
#pragma unroll
          for (int n = 0; n < 2; ++n) acc[a][b][m][n] = (f32x4){0.f, 0.f, 0.f, 0.f};
    cur = nxt; cA = nA; cB = nB; ++ui;
    if constexpr (GATHER) {
#pragma unroll
      for (int h = 0; h < 2; ++h)
#pragma unroll
        for (int i = 0; i < 2; ++i) gA[h][i] = gN[h][i]; }
  }
  FG_WAIT_V(0);
  if (wr == 0) FG_BAR;
  FG_BAR;
#undef FG_SA
#undef FG_SB
#undef FG_STAGE
#undef FG_STAGE_A
#undef FG_LDA
#undef FG_LDB
#undef FG_MMA
#undef FG_WAIT_V
#undef FG_WAIT_L
#undef FG_BAR
#undef FG_SCHED
}
typedef f32x4 Acc[2][2][4][2];
#define FG_FOREACH(...)                                                                                                \
  _Pragma("unroll") for (int ai = 0; ai < 2; ++ai) _Pragma("unroll") for (int m = 0; m < 4; ++m)                       \
  _Pragma("unroll") for (int bj = 0; bj < 2; ++bj) _Pragma("unroll") for (int n = 0; n < 2; ++n) {                     \
    const int row = u.pm * 256 + ai * 128 + wr * 64 + m * 16 + fr, col = u.pn * 256 + bj * 128 + wc * 32 + n * 16 + 4 * fq; \
    const f32x4 v = acc[ai][bj][m][n]; __VA_ARGS__ }
__device__ __forceinline__ u32x2 pack4(f32x4 v) { return (u32x2){cvtpk(v[0], v[1]), cvtpk(v[2], v[3])}; }

struct EpiBf16 {
  bf16_t* O; int ld, nvalid; float scale; int gdiv; size_t s1, s2;
  __device__ __forceinline__ void operator()(const Acc& acc, const Unit& u, int wr, int wc, int fr, int fq) const {
    bf16_t* base = O + (size_t)(u.grp / gdiv) * s1 + (size_t)(u.grp % gdiv) * s2;
    FG_FOREACH(if (col < nvalid) *(u32x2*)(base + (size_t)row * ld + col) = pack4(v * scale);)
  }
};
struct EpiQRope {
  unsigned char* QA;
  __device__ __forceinline__ void operator()(const Acc& acc, const Unit& u, int wr, int wc, int fr, int fq) const {
#pragma unroll
    for (int ai = 0; ai < 2; ++ai)
#pragma unroll
      for (int m = 0; m < 4; ++m)
#pragma unroll
        for (int bj = 0; bj < 2; ++bj) {
          const int row = u.pm * 256 + ai * 128 + wr * 64 + m * 16 + fr, g0 = u.pn * 256 + bj * 128 + wc * 32, w0 = g0 % 192;
          f32x4 x1 = acc[ai][bj][m][0], x2 = acc[ai][bj][m][1];
          if (w0 >= 128) {
            const int ntok = row % SEQ; const float pos = (w0 >= 160) ? (float)(ntok & 63) : (float)(ntok >> 6);
#pragma unroll
            for (int j = 0; j < 4; ++j) { const float ang = pos * rope_inv_freq(4 * fq + j, 16); const float sn = __sinf(ang), cs = __cosf(ang);
              const float a = x1[j], b = x2[j]; x1[j] = a * cs - b * sn; x2[j] = b * cs + a * sn; }
          }
          unsigned char* dst = QA + (size_t)row * 1536 + g0 + 4 * fq;
          *(unsigned*)dst = pack_fp8x4(x1[0], x1[1], x1[2], x1[3]); *(unsigned*)(dst + 16) = pack_fp8x4(x2[0], x2[1], x2[2], x2[3]);
        }
  }
};
struct EpiIn0 {
  bf16_t* P0; unsigned char* QD; unsigned char* KD; unsigned char* VD;
  __device__ __forceinline__ void operator()(const Acc& acc, const Unit& u, int wr, int wc, int fr, int fq) const {
    const bool lat = u.pm < NT / 256;
#pragma unroll
    for (int ai = 0; ai < 2; ++ai)
#pragma unroll
      for (int m = 0; m < 4; ++m) {
        const int row = u.pm * 256 + ai * 128 + wr * 64 + m * 16 + fr;
        int keyrow, ntok = 0;
        if (lat) { ntok = row % SEQ; keyrow = (row / SEQ) * NKEY + CTXL + ntok; } else { const int ii = row - NT; keyrow = (ii / CTXL) * NKEY + (ii % CTXL); }
#pragma unroll
        for (int bj = 0; bj < 2; ++bj) {
          const int g0 = u.pn * 256 + bj * 128 + wc * 32;
          f32x4 x1 = acc[ai][bj][m][0] * (1.f / 32.f), x2 = acc[ai][bj][m][1] * (1.f / 32.f);
          if (g0 < P0W) { bf16_t* dst = P0 + (size_t)row * P0W + g0 + 4 * fq; *(u32x2*)dst = pack4(x1); *(u32x2*)(dst + 16) = pack4(x2); }
          else if (g0 < 3136) {
            const int vv = (g0 - 1088) >> 7, sg = ((g0 - 1088) & 127) >> 5, axis = sg >> 1, qh = sg & 1, e1 = axis * 64 + qh * 16 + 4 * fq;
            if (lat) { const float pos = axis ? (float)(ntok & 63) : (float)(ntok >> 6);
#pragma unroll
              for (int j = 0; j < 4; ++j) { const float ang = pos * rope_inv_freq(qh * 16 + 4 * fq + j, 32); const float sn = __sinf(ang), cs = __cosf(ang);
                const float a = x1[j], b = x2[j]; x1[j] = a * cs - b * sn; x2[j] = b * cs + a * sn; } }
            if (vv < 8) { if (lat) { unsigned char* dst = QD + (size_t)row * 1024 + vv * 128 + e1; *(unsigned*)dst = pack_fp8x4(x1[0], x1[1], x1[2], x1[3]); *(unsigned*)(dst + 32) = pack_fp8x4(x2[0], x2[1], x2[2], x2[3]); } }
            else { unsigned char* dst = KD + (size_t)keyrow * 1024 + (vv - 8) * 128 + e1; *(unsigned*)dst = pack_fp8x4(x1[0], x1[1], x1[2], x1[3]); *(unsigned*)(dst + 32) = pack_fp8x4(x2[0], x2[1], x2[2], x2[3]); }
          } else if (g0 < EIN) {
            const int c = g0 - 3136 + 4 * fq, kb = keyrow / NKEY, key = keyrow - kb * NKEY;
            unsigned char* dst = VD + ((((size_t)(kb * 4 + (c >> 8)) * (NKEY / 64) + (key >> 6)) * 256 + (c & 255)) << 6) + vt_pos(key & 63);
            const unsigned p1 = pack_fp8x4(x1[0], x1[1], x1[2], x1[3]), p2 = pack_fp8x4(x2[0], x2[1], x2[2], x2[3]);
            dst[0] = (unsigned char)p1; dst[64] = (unsigned char)(p1 >> 8); dst[128] = (unsigned char)(p1 >> 16); dst[192] = (unsigned char)(p1 >> 24);
            dst[1024] = (unsigned char)p2; dst[1088] = (unsigned char)(p2 >> 8); dst[1152] = (unsigned char)(p2 >> 16); dst[1216] = (unsigned char)(p2 >> 24); }
        }
      }
  }
};
struct EpiKV {
  unsigned char* KA; unsigned char* VA;
  __device__ __forceinline__ void operator()(const Acc& acc, const Unit& u, int wr, int wc, int fr, int fq) const {
    FG_FOREACH(
      int b; int key; if (row < NT) { b = row / SEQ; key = CTXL + (row % SEQ); } else { const int ii = row - NT; b = ii / CTXL; key = ii % CTXL; }
      const int h = col >> 8, w = col & 255; const unsigned pk = pack_fp8x4(v[0], v[1], v[2], v[3]);
      if (w < 128) *(unsigned*)(KA + ((size_t)b * NKEY + key) * 1536 + h * 192 + w) = pk;
      else { unsigned char* dst = VA + ((((size_t)(b * 8 + h) * (NKEY / 64) + (key >> 6)) * 128 + (w - 128)) << 6) + vt_pos(key & 63);
        dst[0] = (unsigned char)pk; dst[64] = (unsigned char)(pk >> 8); dst[128] = (unsigned char)(pk >> 16); dst[192] = (unsigned char)(pk >> 24); })
  }
};
template <bool BASE_F32>
struct EpiResid {
  bf16_t* XL; const void* base; const float* ml;
  __device__ __forceinline__ void operator()(const Acc& acc, const Unit& u, int wr, int wc, int fr, int fq) const {
    const int row0 = u.pm * 256 + wr * 64 + fr, col0 = u.pn * 256 + wc * 32 + 4 * fq;
    const float* gp = ml + (size_t)(row0 / SEQ) * MLW + 4096 + col0;
    f32x4 g[2][2];
#pragma unroll
    for (int bj = 0; bj < 2; ++bj)
#pragma unroll
      for (int n = 0; n < 2; ++n) g[bj][n] = *(const f32x4*)(gp + bj * 128 + n * 16);
#pragma unroll
    for (int ai = 0; ai < 2; ++ai)
#pragma unroll
      for (int mh = 0; mh < 2; ++mh) {
        f32x4 bs[2][2][2];
#pragma unroll
        for (int m2 = 0; m2 < 2; ++m2)
#pragma unroll
          for (int bj = 0; bj < 2; ++bj)
#pragma unroll
            for (int n = 0; n < 2; ++n) { const size_t o = (size_t)(row0 + ai * 128 + (mh * 2 + m2) * 16) * DM + col0 + bj * 128 + n * 16;
              if constexpr (BASE_F32) bs[m2][bj][n] = *(const f32x4*)((const float*)base + o);
              else { const u32x2 w = *(const u32x2*)((const bf16_t*)base + o); bs[m2][bj][n] = (f32x4){bf_lo(w[0]), bf_hi(w[0]), bf_lo(w[1]), bf_hi(w[1])}; } }
        asm volatile("" ::: "memory");
#pragma unroll
        for (int m2 = 0; m2 < 2; ++m2)
#pragma unroll
          for (int bj = 0; bj < 2; ++bj)
#pragma unroll
            for (int n = 0; n < 2; ++n)
              *(u32x2*)(XL + (size_t)(row0 + ai * 128 + (mh * 2 + m2) * 16) * DM + col0 + bj * 128 + n * 16) = pack4(bs[m2][bj][n] + g[bj][n] * acc[ai][bj][mh * 2 + m2][n]);
        asm volatile("" ::: "memory");
      }
  }
};
struct EpiGU {
  unsigned char* HID;
  __device__ __forceinline__ void operator()(const Acc& acc, const Unit& u, int wr, int wc, int fr, int fq) const {
    unsigned char* base = HID + (size_t)u.grp * 2048 * FF;
#pragma unroll
    for (int ai = 0; ai < 2; ++ai)
#pragma unroll
      for (int m = 0; m < 4; ++m)
#pragma unroll
        for (int bj = 0; bj < 2; ++bj) {
          const int row = u.pm * 256 + ai * 128 + wr * 64 + m * 16 + fr, hid = u.pn * 128 + bj * 64 + wc * 16 + 4 * fq;
          const f32x4 g = acc[ai][bj][m][0], up = acc[ai][bj][m][1];
          float r[4];
#pragma unroll
          for (int j = 0; j < 4; ++j) { const float gg = g[j] * (1.f / W8_SCALE), uu = up[j] * (1.f / W8_SCALE); r[j] = gg * __builtin_amdgcn_rcpf(1.f + __expf(-gg)) * uu; }
          *(unsigned*)(base + (size_t)row * FF + hid) = pack_fp8x4(r[0], r[1], r[2], r[3]);
        }
  }
};
struct EpiDown {
  bf16_t* YE; const float* gate;
  __device__ __forceinline__ void operator()(const Acc& acc, const Unit& u, int wr, int wc, int fr, int fq) const {
    bf16_t* base = YE + (size_t)u.grp * 2048 * DM;
    float gt[2][4];
#pragma unroll
    for (int ai = 0; ai < 2; ++ai)
#pragma unroll
      for (int m = 0; m < 4; ++m) { const int row = u.pm * 256 + ai * 128 + wr * 64 + m * 16 + fr; gt[ai][m] = gate[((row >> 9) * NE + u.grp) * CAP + (row & 511)] * (1.f / W8_SCALE); }
    asm volatile("" ::: "memory");
    FG_FOREACH(*(u32x2*)(base + (size_t)row * DM + col) = pack4(v * gt[ai][m]);)
  }
};
struct EpiScaleCol {
  bf16_t* O; const float* cs;
  __device__ __forceinline__ void operator()(const Acc& acc, const Unit& u, int wr, int wc, int fr, int fq) const {
    f32x4 sc[2][2];
#pragma unroll
    for (int bj = 0; bj < 2; ++bj)
#pragma unroll
      for (int n = 0; n < 2; ++n) sc[bj][n] = *(const f32x4*)(cs + u.grp * 256 + u.pn * 256 + bj * 128 + wc * 32 + n * 16 + 4 * fq);
    asm volatile("" ::: "memory");
    FG_FOREACH(*(u32x2*)(O + (size_t)row * DM + u.grp * 256 + col) = pack4(v * sc[bj][n]);)
  }
};
struct EpiChanDft {
  bf16_t* ABT2;
  __device__ __forceinline__ void operator()(const Acc& acc, const Unit& u, int wr, int wc, int fr, int fq) const {
    FG_FOREACH(const int b = col / SEQ, nn = col % SEQ;
               *(u32x2*)(ABT2 + (((size_t)(b * 4 + u.grp) * 256) + (row & 255)) * 8192 + (row >> 8) * 4096 + nn) = pack4(v * 1.f);)
  }
};
}

namespace at {
typedef float f32x16 __attribute__((ext_vector_type(16)));
typedef int i32x8a __attribute__((ext_vector_type(8)));
typedef int i32x4a __attribute__((ext_vector_type(4)));
constexpr int NW = 8, QBLK = 32, KVBLK = 64;
#define SBAR() __builtin_amdgcn_sched_barrier(0)
#define MFMA8(A, B, Cc) __builtin_amdgcn_mfma_scale_f32_32x32x64_f8f6f4(A, B, Cc, 0, 0, 0, 0x7f7f7f7f, 0, 0x7f7f7f7f)
__device__ __forceinline__ int crow(int r, int hi) { return (r & 3) + 8 * (r >> 2) + 4 * hi; }
template <int DK> __device__ __forceinline__ int kswz(int row) { return DK == 192 ? ((row >> 2) & 3) : ((row >> 1) & 7); }
template <int DK>
__device__ __forceinline__ void qkt(f32x16& p0, f32x16& p1, const LAS char* Ks, const i32x8a* qf, int r32, int hi) {
  p0 = f32x16{}; p1 = f32x16{};
  const int s = kswz<DK>(r32);
  const LAS char* kr = Ks + r32 * DK;
#pragma unroll
  for (int t = 0; t < DK / 64; ++t) {
    const int c0 = ((4 * t + 2 * hi) ^ s) << 4, c1 = ((4 * t + 2 * hi + 1) ^ s) << 4;
    const i32x4a a0 = *reinterpret_cast<const LAS i32x4a*>(kr + c0), a1 = *reinterpret_cast<const LAS i32x4a*>(kr + c1);
    const i32x4a b0 = *reinterpret_cast<const LAS i32x4a*>(kr + c0 + 32 * DK), b1 = *reinterpret_cast<const LAS i32x4a*>(kr + c1 + 32 * DK);
    const i32x8a k0 = {a0[0], a0[1], a0[2], a0[3], a1[0], a1[1], a1[2], a1[3]}, k1 = {b0[0], b0[1], b0[2], b0[3], b1[0], b1[1], b1[2], b1[3]};
    p0 = MFMA8(k0, qf[t], p0);
    p1 = MFMA8(k1, qf[t], p1); }
}
constexpr float PBIAS = 4.f, PTHR = 3.f;
__device__ __forceinline__ void softmax8(const f32x16& p0, const f32x16& p1, float& m_reg, float& alpha, i32x8a& pa, float C, float thr_raw) {
  float pmax = p0[0];
#pragma unroll
  for (int r = 1; r < 16; ++r) pmax = fmaxf(pmax, p0[r]);
#pragma unroll
  for (int r = 0; r < 16; ++r) pmax = fmaxf(pmax, p1[r]);
  { auto rr = __builtin_amdgcn_permlane32_swap(__float_as_uint(pmax), __float_as_uint(pmax), false, false);
    pmax = fmaxf(__uint_as_float(rr[0]), __uint_as_float(rr[1])); }
  float mn;
  if (__builtin_expect(__all(pmax - m_reg <= thr_raw), 1)) { mn = m_reg; alpha = 1.f; }
  else { mn = fmaxf(m_reg, pmax); alpha = __builtin_amdgcn_exp2f((m_reg - mn) * C); m_reg = mn; }
  const float C8 = 8.f * C, b8 = 8.f * (PBIAS - mn * C) + 56.f;
#pragma unroll
  for (int w = 0; w < 4; ++w) {
    unsigned v = 0, v2 = 0;
#pragma unroll
    for (int j = 0; j < 4; ++j) { v = __builtin_amdgcn_cvt_pk_u8_f32(fmaf(p0[4 * w + j], C8, b8), j, v); v2 = __builtin_amdgcn_cvt_pk_u8_f32(fmaf(p1[4 * w + j], C8, b8), j, v2); }
    pa[w] = (int)v; pa[4 + w] = (int)v2; }
}
template <int NDB>
__device__ __forceinline__ void pv(f32x16* o, const LAS char* Vs, const i32x8a pa, int r32, int hi) {
  const int s = (r32 >> 2) & 3;
  const LAS char* v0 = Vs + r32 * 64 + (((2 * hi) ^ s) << 4); const LAS char* v1 = Vs + r32 * 64 + (((2 * hi + 1) ^ s) << 4);
#pragma unroll
  for (int d0 = 0; d0 < NDB; ++d0) {
    const i32x4a a = *reinterpret_cast<const LAS i32x4a*>(v0 + d0 * 2048), b = *reinterpret_cast<const LAS i32x4a*>(v1 + d0 * 2048);
    const i32x8a vf = {a[0], a[1], a[2], a[3], b[0], b[1], b[2], b[3]};
    o[d0] = MFMA8(pa, vf, o[d0]); }
  const int one4 = 0x38383838;
  const i32x8a ones = {one4, one4, one4, one4, one4, one4, one4, one4};
  o[NDB] = MFMA8(pa, ones, o[NDB]);
}
template <int DK, int NDB, bool QK_FIRST>
__device__ __forceinline__ void mm_iter(f32x16* o, f32x16& p0, f32x16& p1, const LAS char* Vs, const LAS char* Ks, const i32x8a pa, const i32x8a* qf, int r32, int hi) {
  constexpr int NKF = DK / 32, NL = NKF + NDB;
  const int sk = kswz<DK>(r32), sv = (r32 >> 2) & 3;
  const LAS char* kr = Ks + r32 * DK;
  const LAS char* v0 = Vs + r32 * 64 + (((2 * hi) ^ sv) << 4); const LAS char* v1 = Vs + r32 * 64 + (((2 * hi + 1) ^ sv) << 4);
  i32x8a w[3];
#define MM_ISK(i) (QK_FIRST ? (i) < NKF : (i) >= NDB)
#define MM_LOAD(i) do { i32x4a a_, b_; if (MM_ISK(i)) { const int kk = QK_FIRST ? (i) : (i) - NDB, t = kk >> 1, blk = kk & 1; \
      a_ = *reinterpret_cast<const LAS i32x4a*>(kr + blk * 32 * DK + (((4 * t + 2 * hi) ^ sk) << 4)); b_ = *reinterpret_cast<const LAS i32x4a*>(kr + blk * 32 * DK + (((4 * t + 2 * hi + 1) ^ sk) << 4)); } \
    else { const int d0 = QK_FIRST ? (i) - NKF : (i); a_ = *reinterpret_cast<const LAS i32x4a*>(v0 + d0 * 2048); b_ = *reinterpret_cast<const LAS i32x4a*>(v1 + d0 * 2048); } \
    w[(i) % 3] = (i32x8a){a_[0], a_[1], a_[2], a_[3], b_[0], b_[1], b_[2], b_[3]}; } while (0)
  MM_LOAD(0); MM_LOAD(1);
#pragma unroll
  for (int i = 0; i < NL; ++i) {
    if (i + 2 < NL) MM_LOAD(i + 2);
    if (MM_ISK(i)) { const int kk = QK_FIRST ? i : i - NDB, t = kk >> 1, blk = kk & 1;
      if (blk == 0) { if (t == 0) p0 = MFMA8(w[i % 3], qf[t], f32x16{}); else p0 = MFMA8(w[i % 3], qf[t], p0); }
      else { if (t == 0) p1 = MFMA8(w[i % 3], qf[t], f32x16{}); else p1 = MFMA8(w[i % 3], qf[t], p1); } }
    else { const int d0 = QK_FIRST ? i - NKF : i; o[d0] = MFMA8(pa, w[i % 3], o[d0]);
      if (d0 == NDB - 1) { const int one4 = 0x38383838; const i32x8a ones = {one4, one4, one4, one4, one4, one4, one4, one4}; o[NDB] = MFMA8(pa, ones, o[NDB]); } }
    __builtin_amdgcn_sched_barrier(0x406);
  }
#undef MM_ISK
#undef MM_LOAD
}
template <class VAR>
__device__ __forceinline__ void attn_body(const unsigned char* __restrict__ Qb, const unsigned char* __restrict__ Kh, const unsigned char* __restrict__ VT, bf16_t* __restrict__ Ob, int seq, char* lds) {
  constexpr int DK = VAR::DK, NDB = VAR::NDB, ldq = VAR::LDQ, ldk = VAR::LDK, ldo = VAR::LDO;
  constexpr float C = VAR::SCALE * 1.4426950408889634f, thr_raw = PTHR / VAR::SCALE;
  constexpr int SHM_V = NDB * 32 * 64, SHM_K = KVBLK * DK, SHM_T = SHM_V + SHM_K, NVC = NDB / 4;
  static_assert(DK == 192 || DK == 128, "K staging is written for 128- and 192-byte key rows");
  int tid_ = threadIdx.x; asm volatile("" : "+v"(tid_));
  const int tid = tid_, wid = tid >> 6, lane = tid & 63, r32 = lane & 31, hi = lane >> 5, wu = __builtin_amdgcn_readfirstlane(wid);
  LAS char* L = (LAS char*)lds;
  LAS float* al_l = (LAS float*)(L + VAR::NB * SHM_T) + wid * 32;
  float m_reg = -1e30f; f32x16 o[NDB + 1] = {}; i32x8a qr[DK / 64];
  const unsigned char* Qw = Qb + (size_t)(wid * QBLK + r32) * ldq + hi * 32;
#pragma unroll
  for (int t = 0; t < DK / 64; ++t) { const i32x4a a = *reinterpret_cast<const i32x4a*>(Qw + t * 64), b2 = *reinterpret_cast<const i32x4a*>(Qw + t * 64 + 16);
    qr[t] = (i32x8a){a[0], a[1], a[2], a[3], b2[0], b2[1], b2[2], b2[3]}; }
  const unsigned vsrc = (unsigned)((tid >> 2) * 64 + (((tid & 3) ^ ((tid >> 4) & 3)) << 4));
  unsigned ksrc0, ksrc1 = 0;
  if constexpr (DK == 128) { const int row = tid >> 3; ksrc0 = (unsigned)(row * ldk + (((tid & 7) ^ kswz<DK>(row)) << 4)); }
  else { const int r0 = tid / 12, c0 = tid - 12 * r0, ci = 512 + wid * 32 + r32, r1 = ci / 12, c1 = ci - 12 * r1;
    ksrc0 = (unsigned)(r0 * ldk + ((c0 ^ kswz<DK>(r0)) << 4)); ksrc1 = (unsigned)(r1 * ldk + ((c1 ^ kswz<DK>(r1)) << 4)); }
#define DMA(B, tile) do { const unsigned char* vt_ = VT + (size_t)(tile) * SHM_V; const unsigned char* kt_ = Kh + (size_t)(tile) * (KVBLK * ldk); \
    _Pragma("unroll") for (int _i = 0; _i < NVC; ++_i) __builtin_amdgcn_global_load_lds((const unsigned*)(vt_ + vsrc + _i * 8192), (LAS unsigned*)(L + (B) + wu * 1024 + _i * 8192), 16, 0, 0); \
    __builtin_amdgcn_global_load_lds((const unsigned*)(kt_ + ksrc0), (LAS unsigned*)(L + (B) + SHM_V + wu * 1024), 16, 0, 0); \
    if constexpr (DK == 192) { if (hi == 0) __builtin_amdgcn_global_load_lds((const unsigned*)(kt_ + ksrc1), (LAS unsigned*)(L + (B) + SHM_V + 8192 + wu * 512), 16, 0, 0); } } while (0)
#define DWAIT() asm volatile("s_waitcnt vmcnt(0)" ::: "memory")
#define RESC(a) do { if (__any((a) < 1.f)) { if (hi == 0) al_l[r32] = (a); asm volatile("s_waitcnt lgkmcnt(0)" ::: "memory"); \
    _Pragma("unroll") for (int d = 0; d <= NDB; ++d) _Pragma("unroll") for (int r = 0; r < 16; ++r) o[d][r] *= al_l[crow(r, hi)]; } } while (0)
  const int NTL = seq / KVBLK;
  constexpr int NB = VAR::NB, IPT = NVC + (DK == 192 ? 2 : 1);
  static_assert(NB >= 3 && NB * SHM_T + NW * 128 <= 135168, "attention tile ring must fit the kernel's LDS");
#define DWAITN(NT_) asm volatile("s_waitcnt vmcnt(%0)" :: "n"((NT_) * IPT) : "memory")
  int b0 = 0, b1 = SHM_T, bn = (NB - 1) * SHM_T;
  f32x16 p0, p1; float al; i32x8a pa;
#pragma unroll 1
  for (int t = 0; t < NB - 1; ++t) DMA(t * SHM_T, t < NTL ? t : NTL - 1);
  SBAR(); DWAITN(NB - 3); __syncthreads();
  qkt<DK>(p0, p1, L + b0 + SHM_V, qr, r32, hi); softmax8(p0, p1, m_reg, al, pa, C, thr_raw);
  for (int j = 0; j + 1 < NTL; ++j) {
    { const int nt = j + NB - 1 < NTL ? j + NB - 1 : NTL - 1; DMA(bn, nt); }
    SBAR(); RESC(al); SBAR();
    mm_iter<DK, NDB, VAR::PIPE>(o, p0, p1, L + b0, L + b1 + SHM_V, pa, qr, r32, hi);
    softmax8(p0, p1, m_reg, al, pa, C, thr_raw); SBAR();
    DWAITN(NB - 3); __syncthreads();
    bn = b0; b0 = b1; b1 = b1 + SHM_T == NB * SHM_T ? 0 : b1 + SHM_T;
  }
  RESC(al); pv<NDB>(o, L + b0, pa, r32, hi);
  DWAIT();
#pragma unroll
  for (int r = 0; r < 16; ++r) { const int orow = wid * QBLK + crow(r, hi); const float rl = __builtin_amdgcn_rcpf(o[NDB][r]);
#pragma unroll
    for (int d0 = 0; d0 < NDB; ++d0) Ob[(size_t)orow * ldo + d0 * 32 + r32] = f2bf(o[d0][r] * rl); }
  __syncthreads();
#undef DMA
#undef DWAIT
#undef DWAITN
#undef RESC
}
}

struct VarMla { static constexpr int DK = 192, NDB = 4, LDQ = 1536, LDK = 1536, LDO = 2048, NB = 5; static constexpr bool PIPE = true; static constexpr float SCALE = 0.07216878364870322f; };
struct VarDiff { static constexpr int DK = 128, NDB = 8, LDQ = 1024, LDK = 1024, LDO = 2048, NB = 5; static constexpr bool PIPE = false; static constexpr float SCALE = 0.08838834764831845f; };
constexpr size_t VTA_INST = (size_t)(NKEY / 64) * 128 * 64, VTD_INST = (size_t)(NKEY / 64) * 256 * 64;
__device__ __forceinline__ void attn_unit_mla(const Params& p, char* smem, int inst, int qb) {
  const int b = inst >> 3, h = inst & 7;
  at::attn_body<VarMla>(WSP(const unsigned char, OFF_QA) + ((size_t)b * SEQ + qb * 256) * 1536 + h * 192, WSP(const unsigned char, OFF_KA) + (size_t)b * NKEY * 1536 + h * 192,
                        WSP(const unsigned char, OFF_VA) + (size_t)inst * VTA_INST, WSP(bf16_t, OFF_YIN) + ((size_t)b * SEQ + qb * 256) * 2048 + h * 128, NKEY, smem);
}
__device__ __forceinline__ void attn_unit_diff(const Params& p, char* smem, int inst, int qb) {
  const int b = inst >> 3, m = (inst >> 2) & 1, h = inst & 3;
  at::attn_body<VarDiff>(WSP(const unsigned char, OFF_QD) + ((size_t)b * SEQ + qb * 256) * 1024 + m * 512 + h * 128, WSP(const unsigned char, OFF_KD) + (size_t)b * NKEY * 1024 + m * 512 + h * 128,
                         WSP(const unsigned char, OFF_VD) + (size_t)(b * 4 + h) * VTD_INST, WSP(bf16_t, OFF_OD) + ((size_t)b * SEQ + qb * 256) * 2048 + m * 1024 + h * 256, NKEY, smem);
}
__device__ __forceinline__ void ph_attn_mla(const Params& p, char* smem) {
  for (int u0 = blockIdx.x; u0 < NB * 8 * 16; u0 += gridDim.x) {
    const int u = (gridDim.x == 256) ? ((u0 & ~255) | ((u0 & 7) << 5) | ((u0 >> 3) & 31)) : u0;
    attn_unit_mla(p, smem, u >> 4, u & 15);
  }
}
__device__ __forceinline__ void ph_attn_diff_wide(const Params& p, char* smem) {
  for (int u0 = blockIdx.x; u0 < NB * 8 * 16; u0 += gridDim.x) {
    const int u = (gridDim.x == 256) ? ((u0 & ~255) | ((u0 & 7) << 5) | ((u0 >> 3) & 31)) : u0;
    attn_unit_diff(p, smem, u >> 4, u & 15);
  }
}
constexpr int QPAT = 4, Q_ATT = 128, Q_CONV = 384, Q_WORD0 = 3584;
__device__ __forceinline__ void ph_attn_queue(const Params& p, char* smem, int* slot) {
  const int x = blockIdx.x & 7;
  unsigned* cnt = WSP(unsigned, OFF_BAR) + Q_WORD0 + 16 * x;
  for (;;) {
    if (threadIdx.x == 0) *(volatile int*)slot = (int)__hip_atomic_fetch_add(cnt, 1u, __ATOMIC_RELAXED, __HIP_MEMORY_SCOPE_AGENT);
    __syncthreads();
    const int e = __builtin_amdgcn_readfirstlane(*(volatile int*)slot);
    __syncthreads();
    if (e >= Q_ATT + Q_CONV) break;
    int att = -1, cv = -1;
    constexpr int MIXED = (Q_CONV / (QPAT - 1) < Q_ATT ? Q_CONV / (QPAT - 1) : Q_ATT) * QPAT;
    if (e < MIXED) { if (e % QPAT == 0) att = e / QPAT; else cv = e - e / QPAT - 1; }
    else { const int r = e - MIXED, na = MIXED / QPAT, nc = MIXED - na; if (na + r < Q_ATT) att = na + r; else cv = nc + (r - (Q_ATT - na)); }
    if (att >= 0) { if (att < 64) attn_unit_mla(p, smem, x * 4 + (att >> 4), att & 15); else attn_unit_diff(p, smem, x * 4 + ((att - 64) >> 4), att & 15); }
    else conv_item(p, smem, cv * 8 + x);
  }
}
#define XB_TMO      128
#define XB_XCNT(j)  (256  + 64 * (j))
#define XB_XSUB(j)  (1280 + 64 * (j))
#define XB_XGEN(j)  (2304 + 64 * (j))
#define XB_TOP      3328
#define XB_TOPGEN   3392
#define XCD_BAR_WORDS 3456
#define XB_SPIN_CAP (1u << 18)
__device__ __forceinline__ unsigned xb_ld(unsigned* p)              { return __hip_atomic_load(p, __ATOMIC_RELAXED, __HIP_MEMORY_SCOPE_AGENT); }
__device__ __forceinline__ unsigned xb_add(unsigned* p, unsigned v) { return __hip_atomic_fetch_add(p, v, __ATOMIC_RELAXED, __HIP_MEMORY_SCOPE_AGENT); }
__device__ __forceinline__ unsigned xb_xcc_id() { return (unsigned)__builtin_amdgcn_s_getreg((3 << 11) | 20) & 0xFu; }
#define XB_SPIN(cond, bar) do { unsigned _sp = 0; while (cond) { __builtin_amdgcn_s_sleep(1); \
    if ((++_sp & 255u) == 0u) { if (xb_ld(&(bar)[XB_TMO])) break; if (_sp > XB_SPIN_CAP) { atomicAdd(&(bar)[XB_TMO], 1u); break; } } } } while (0)
struct XcdBarrier { unsigned* bar; unsigned x; volatile LAS unsigned* st; };
__device__ __forceinline__ XcdBarrier xcd_barrier_post(unsigned* bar, volatile LAS unsigned* st) {
    XcdBarrier b; b.bar = bar; b.x = xb_xcc_id(); b.st = st;
    if (threadIdx.x == 0) (void)xb_add(&bar[XB_XCNT(b.x)], 1u);
    return b;
}
__device__ __forceinline__ void xcd_barrier_complete(unsigned* bar, unsigned x, unsigned& nloc, unsigned& nx) {
    const unsigned G = gridDim.x * gridDim.y * gridDim.z;
    unsigned sum, cnt, mine, sp = 0u;
    for (;;) {
        sum = 0u; cnt = 0u; mine = 0u;
#pragma unroll
        for (unsigned j = 0; j < 16; ++j) { const unsigned c = xb_ld(&bar[XB_XCNT(j)]); sum += c; cnt += (c > 0u) ? 1u : 0u; mine = (j == x) ? c : mine; }
        if (sum == G) break;
        __builtin_amdgcn_s_sleep(1);
        if ((++sp & 255u) == 0u) { if (xb_ld(&bar[XB_TMO])) break; if (sp > XB_SPIN_CAP) { atomicAdd(&bar[XB_TMO], 1u); break; } }
    }
    nloc = mine > 0u ? mine : 1u; nx = cnt > 0u ? cnt : 1u;
}
__device__ __forceinline__ void xcd_barrier(const XcdBarrier& b) {
    asm volatile("s_waitcnt vmcnt(0)" ::: "memory");
    __syncthreads();
    if (threadIdx.x == 0) {
        unsigned* bar = b.bar;
        __builtin_amdgcn_s_waitcnt(0);
        unsigned nloc = b.st[0], nx = b.st[1];
        if (nloc == 0u) { xcd_barrier_complete(bar, b.x, nloc, nx); b.st[0] = nloc; b.st[1] = nx; }
        const unsigned old = xb_add(&bar[XB_XSUB(b.x)], 1u);
        const unsigned gen = old / nloc;
        if (old + 1u == (gen + 1u) * nloc) {
            __builtin_amdgcn_fence(__ATOMIC_RELEASE, "agent");
            asm volatile("s_waitcnt vmcnt(0)" ::: "memory");
            const unsigned og = xb_add(&bar[XB_TOP], 1u);
            const unsigned tg = og / nx;
            if (og + 1u == (tg + 1u) * nx) xb_add(&bar[XB_TOPGEN], 1u);
            else XB_SPIN(xb_ld(&bar[XB_TOPGEN]) == tg, bar);
            __builtin_amdgcn_fence(__ATOMIC_ACQUIRE, "agent");
            xb_add(&bar[XB_XGEN(b.x)], 1u);
            asm volatile("s_waitcnt vmcnt(0)" ::: "memory");
        } else {
            XB_SPIN(xb_ld(&bar[XB_XGEN(b.x)]) == gen, bar);
            __builtin_amdgcn_fence(__ATOMIC_ACQUIRE, "agent");
            asm volatile("s_waitcnt vmcnt(0)" ::: "memory");
        }
    }
    __syncthreads();
}

#define FGRID(A_, sA_, lda_, B_, sB_, ldb_, nM_, nN_, ng_) fg::Grid{(const char*)(A_), (const char*)(B_), (size_t)(sA_), (size_t)(sB_), lda_, ldb_, nM_, nN_, ng_, (int)gridDim.x, (int)blockIdx.x}
#define FLDS ((LAS unsigned char*)smem)
constexpr int SMEM_MAIN = 135168;
template <int L> __device__ __forceinline__ void ph_moe_gemms_gu(const Params& p, char* smem) {
  fg::gemm_fast<fg::EpiGU, true, true>(FLDS, FGRID(WSP(char, OFF_H), 0, 1024, WSP(char, OFF_WGU) + (size_t)L * NE * 4096 * 2048, (size_t)4096 * 2048, 1024, 8, 16, NE),
                                       fg::EpiGU{WSP(unsigned char, OFF_HID)}, 1024, WSP(const int, OFF_IDX));
}
template <int L> __device__ __forceinline__ void ph_moe_gemms_down(const Params& p, char* smem) {
  fg::gemm_fast<fg::EpiDown, false, true>(FLDS, FGRID(WSP(char, OFF_HID), (size_t)2048 * 2048, 1024, WSP(char, OFF_WD) + (size_t)L * NE * 2048 * 2048, (size_t)2048 * 2048, 1024, 8, 8, NE),
                                          fg::EpiDown{WSP(bf16_t, OFF_YE), WSP(const float, OFF_GATE)}, 1024);
}
__global__ __launch_bounds__(512, 2) void mega(Params p) {
  __shared__ __attribute__((aligned(16))) char smem[SMEM_MAIN + 32];
  volatile LAS unsigned* xst = (volatile LAS unsigned*)(smem + SMEM_MAIN);
  if (threadIdx.x == 0) { xst[0] = 0u; xst[1] = 0u; xst[2] = 0u; xst[3] = 0u; }
  __syncthreads();
  const XcdBarrier bar = xcd_barrier_post(WSP(unsigned, OFF_BAR), xst);
#define GSYNC() xcd_barrier(bar)
  const bool split = gridDim.x == 256;
  if ((blockIdx.x >> 3) & 1) { ph_twiddle(p, smem); ph_weights_small(p, smem); ph_mod(p, smem); } else { ph_mod(p, smem); ph_weights_small(p, smem); ph_twiddle(p, smem); }
  if (!split) ph_weights_expert(p, smem, blockIdx.x, gridDim.x);
  GSYNC();
  ph_pre0(p); GSYNC();
  fg::gemm_fast<fg::EpiIn0, false, true>(FLDS, FGRID(WSP(char, OFF_H), 0, DM / 2, WSP(char, OFF_WIN0), 0, DM / 2, 68, 17, 1), fg::EpiIn0{WSP(bf16_t, OFF_P0), WSP(unsigned char, OFF_QD), WSP(unsigned char, OFF_KD), WSP(unsigned char, OFF_VD)}, DM / 2); GSYNC();
  ph_post_inproj(p); GSYNC();
  fg::gemm_fast(FLDS, FGRID(WSP(bf16_t, OFF_CQN), 0, 512, WSP(bf16_t, OFF_WUQ), 0, 512, 64, 6, 1), fg::EpiQRope{WSP(unsigned char, OFF_QA)}, 512);
  fg::gemm_fast(FLDS, FGRID(WSP(bf16_t, OFF_CKVN), 0, 512, WSP(bf16_t, OFF_WUKV), 0, 512, 68, 8, 1), fg::EpiKV{WSP(unsigned char, OFF_KA), WSP(unsigned char, OFF_VA)}, 512); GSYNC();
  if (split) ph_attn_queue(p, smem, (int*)(smem + SMEM_MAIN + 16)); else { ph_attn_mla(p, smem); ph_attn_diff_wide(p, smem); }
  GSYNC();
  ph_diffcomb(p); GSYNC();
  fg::gemm_fast(FLDS, FGRID(WSP(bf16_t, OFF_YIN), 0, DM, WSP(bf16_t, OFF_WOUT0), 0, DM, 64, 8, 1), fg::EpiResid<true>{WSP(bf16_t, OFF_XL), p.x, WSP(const float, OFF_ML)}, DM); GSYNC();
  ph_ffn_pre(p, 0, smem); GSYNC();
  ph_topk(p, smem); GSYNC();
  ph_moe_gemms_gu<0>(p, smem); GSYNC();
  ph_moe_gemms_down<0>(p, smem); GSYNC();
  ph_combine(p, 0); GSYNC();
  fg::gemm_fast(FLDS, FGRID(WSP(bf16_t, OFF_H), 0, DM, WSP(bf16_t, OFF_WIN1), 0, DM, 64, 8, 1), fg::EpiBf16{WSP(bf16_t, OFF_Z), DM, DM, 1.f, 1, 0, 0}, DM); GSYNC();
  ph_pool(p);
  fg::gemm_fast(FLDS, FGRID(WSP(bf16_t, OFF_MC), (size_t)512 * 256 * 2, 256, WSP(bf16_t, OFF_Z) + 1024, 512, DM, 2, 64, 4), fg::EpiChanDft{WSP(bf16_t, OFF_ABT2)}, 256); GSYNC();
  ph_fold(p);
  fg::gemm_fast(FLDS, FGRID(WSP(bf16_t, OFF_POOLED), 512, 1024, WSP(bf16_t, OFF_WPOOL), 65536 * 2, 256, 64, 1, 4), fg::EpiScaleCol{WSP(bf16_t, OFF_YCAT), p.pool_scale}, 256); GSYNC();
  { fg::Grid gq = FGRID(WSP(bf16_t, OFF_TW), 0, 4096, WSP(bf16_t, OFF_ABTF), (size_t)256 * 4096 * 2, 4096, 8, 1, 32);
    gq.gd = 2; gq.sA2 = (size_t)2048 * 2; gq.sB2 = (size_t)2048 * 2;
    fg::gemm_fast(FLDS, gq, fg::EpiBf16{WSP(bf16_t, OFF_SPEC), 256, 256, 1.f, 1, (size_t)2048 * 256, 0}, 2048); }
  GSYNC();
  ph_dftcomb(p); GSYNC();
  fg::gemm_fast(FLDS, FGRID(WSP(bf16_t, OFF_YCAT), 0, DM, WSP(bf16_t, OFF_WOUT1), 0, DM, 64, 8, 1), fg::EpiResid<false>{WSP(bf16_t, OFF_XL), WSP(const bf16_t, OFF_XL), WSP(const float, OFF_ML) + 5 * MLW}, DM); GSYNC();
  ph_ffn_pre(p, 1, smem); GSYNC();
  ph_topk(p, smem); GSYNC();
  ph_moe_gemms_gu<1>(p, smem); GSYNC();
  ph_moe_gemms_down<1>(p, smem); GSYNC();
  ph_combine(p, 1);
}

extern "C" void kernel_launch(void* const* d_in, const int* in_sizes, int n_in, void* d_out, int out_size, void* d_ws, size_t ws_size, hipStream_t stream) {
  if (n_in != 29 || ws_size < WS_NEED) { fprintf(stderr, "kernel_launch: bad args n_in %d ws %zu need %zu\n", n_in, ws_size, WS_NEED); return; }
  Params p{};
  const float** f = (const float**)&p;
  for (int i = 0; i < 29; ++i) f[i] = (const float*)d_in[i];
  p.out = (float*)d_out; p.ws = (char*)d_ws;
  static int grid = 0;
  if (!grid) {
    int dev = 0, cus = 0, per_cu = 0;
    (void)hipGetDevice(&dev);
    (void)hipDeviceGetAttribute(&cus, hipDeviceAttributeMultiprocessorCount, dev);
    (void)hipOccupancyMaxActiveBlocksPerMultiprocessor(&per_cu, (const void*)mega, 512, 0);
    if (cus <= 0) cus = 256;
    grid = per_cu >= 1 ? cus : 0;
    if (!grid) { fprintf(stderr, "kernel_launch: occupancy query says 0 blocks per CU\n"); return; }
  }
  (void)hipMemsetAsync(d_ws, 0, 16384, stream);
  hipLaunchKernelGGL(mega, dim3(grid), dim3(512), 0, stream, p);
}
```

```cpp
#include <hip/hip_runtime.h>
#include <stdint.h>
#include <cstdio>

typedef unsigned short bf16_t;
typedef short bf16x8 __attribute__((ext_vector_type(8)));
typedef float f32x4 __attribute__((ext_vector_type(4)));
typedef unsigned u32x4 __attribute__((ext_vector_type(4)));
typedef unsigned u32x2 __attribute__((ext_vector_type(2)));

constexpr int DM = 2048, NB = 4, SEQ = 4096, NT = NB * SEQ, CTXL = 256, NC = NB * CTXL, NA = NT + NC, NKEY = SEQ + CTXL;
constexpr int EIN = 4160, EINP = 4352, P0W = 1088;
constexpr int NE = 16, CAP = 512, FF = 2048, MLW = 6 * DM;
constexpr float EPS = 1e-6f;

constexpr size_t al256(size_t x) { return (x + 255) / 256 * 256; }
constexpr size_t OFF_BAR = 0;
constexpr size_t OFF_ML = 16384;
constexpr size_t OFF_AFF = OFF_ML + al256((size_t)2 * 5 * MLW * 4);
constexpr size_t OFF_IDX = OFF_AFF + (size_t)NB * NE * SEQ * 4;
constexpr size_t OFF_GATE = OFF_IDX + (size_t)NB * NE * CAP * 4;
constexpr size_t OFF_INV = OFF_GATE + (size_t)NB * NE * CAP * 4;
constexpr size_t OFF_WIN0 = OFF_INV + (size_t)NT * NE * 4;
constexpr size_t OFF_WUQ = OFF_WIN0 + (size_t)EINP * DM * 2;
constexpr size_t OFF_WUKV = OFF_WUQ + (size_t)1536 * 512 * 2;
constexpr size_t OFF_WOUT0 = OFF_WUKV + (size_t)2048 * 512 * 2;
constexpr size_t OFF_WIN1 = OFF_WOUT0 + (size_t)DM * DM * 2;
constexpr size_t OFF_WOUT1 = OFF_WIN1 + (size_t)DM * DM * 2;
constexpr size_t OFF_WPOOL = OFF_WOUT1 + (size_t)DM * DM * 2;
constexpr size_t OFF_WFOUR = OFF_WPOOL + (size_t)4 * 256 * 256 * 2;
constexpr size_t OFF_MC = OFF_WFOUR + (size_t)4 * 256 * 256 * 2;
constexpr size_t OFF_TW = OFF_MC + (size_t)4 * 512 * 256 * 2;
constexpr size_t OFF_WGU = OFF_TW + (size_t)4096 * 8192 * 2;
constexpr size_t OFF_WD = OFF_WGU + (size_t)2 * NE * 4096 * 2048 * 2;
constexpr size_t OFF_XL = OFF_WD + (size_t)2 * NE * 2048 * 2048 * 2;
constexpr size_t OFF_H = OFF_XL + (size_t)NT * DM * 4;
constexpr size_t OFF_SCR = OFF_H + (size_t)NA * DM * 2;
constexpr size_t OFF_P0 = OFF_SCR;
constexpr size_t OFF_CQN = OFF_P0 + al256((size_t)NA * EIN * 2);
constexpr size_t OFF_CKVN = OFF_CQN + (size_t)NT * 512 * 2;
constexpr size_t OFF_QA = OFF_CKVN + (size_t)NA * 512 * 2;
constexpr size_t OFF_KA = OFF_QA + (size_t)NT * 1536 * 2;
constexpr size_t OFF_VA = OFF_KA + (size_t)NA * 1536 * 2;
constexpr size_t OFF_QD = OFF_VA + (size_t)NA * 1024 * 2;
constexpr size_t OFF_KD = OFF_QD + (size_t)NT * 1024 * 2;
constexpr size_t OFF_VD = OFF_KD + (size_t)NA * 1024 * 2;
constexpr size_t OFF_OD = OFF_VD + (size_t)NA * 1024 * 2;
constexpr size_t OFF_YIN = OFF_OD + (size_t)NT * 2048 * 4;
constexpr size_t OFF_M0END = OFF_YIN + (size_t)NT * 2048 * 2;
constexpr size_t OFF_XE = OFF_SCR;
constexpr size_t OFF_HID = OFF_XE + (size_t)NE * 2048 * 2048 * 2;
constexpr size_t OFF_YE = OFF_HID + (size_t)NE * 2048 * 2048 * 2;
constexpr size_t OFF_Z = OFF_SCR;
constexpr size_t OFF_POOLED = OFF_Z + (size_t)NT * 2048 * 2;
constexpr size_t OFF_ABT2 = OFF_POOLED + (size_t)NT * 1024 * 2;
constexpr size_t OFF_SPEC = OFF_ABT2 + (size_t)16 * 256 * 8192 * 2;
constexpr size_t OFF_YCAT = OFF_SPEC + (size_t)NT * 1024 * 2;
constexpr size_t OFF_ABTF = OFF_YCAT + (size_t)NT * 2048 * 2;
constexpr size_t OFF_SBUF = OFF_M0END;
constexpr size_t OFF_PBUF = OFF_SBUF + (size_t)SEQ * NKEY * 4;
constexpr size_t OFF_VT = OFF_PBUF + (size_t)SEQ * NKEY * 2;
constexpr size_t WS_NEED = OFF_VT + (size_t)256 * NKEY * 2;

struct Params {
  const float *x, *c, *ctx, *c_ctx, *mod_w, *mod_b, *norm_mix, *norm_ffn, *even_w_in, *q_norm, *w_uq, *kv_norm, *w_ukv,
      *lq1, *lk1, *lq2, *lk2, *subln, *even_w_out, *odd_w_in, *pool_w, *pool_scale, *fourier_w, *odd_w_out, *router_w,
      *w_gate, *w_up, *w_down, *final_norm;
  float* out;
  char* ws;
};
#define WSP(T, off) ((T*)(p.ws + (off)))

typedef float f32x2 __attribute__((ext_vector_type(2)));
typedef __bf16 bf16x2_t __attribute__((ext_vector_type(2)));
__device__ __forceinline__ unsigned cvtpk(float lo, float hi) { f32x2 v = {lo, hi}; bf16x2_t r = __builtin_convertvector(v, bf16x2_t); return __builtin_bit_cast(unsigned, r); }
__device__ __forceinline__ unsigned pack_fp8x4(float a, float b, float c, float d) {
  a = __builtin_amdgcn_fmed3f(a, -448.f, 448.f); b = __builtin_amdgcn_fmed3f(b, -448.f, 448.f); c = __builtin_amdgcn_fmed3f(c, -448.f, 448.f); d = __builtin_amdgcn_fmed3f(d, -448.f, 448.f);
  unsigned w = 0; w = __builtin_amdgcn_cvt_pk_fp8_f32(a, b, w, false); w = __builtin_amdgcn_cvt_pk_fp8_f32(c, d, w, true); return w;
}
__device__ __forceinline__ float bf_lo(unsigned w) { return __uint_as_float(w << 16); }
__device__ __forceinline__ float bf_hi(unsigned w) { return __uint_as_float(w & 0xffff0000u); }
__device__ __forceinline__ float bf2f(bf16_t b) { return __uint_as_float(((unsigned)b) << 16); }
__device__ __forceinline__ bf16_t f2bf(float f) { return (bf16_t)(cvtpk(f, 0.f) & 0xffffu); }
__device__ __forceinline__ float wave_sum(float v) {
#pragma unroll
  for (int o = 32; o > 0; o >>= 1) v += __shfl_xor(v, o, 64);
  return v;
}
__device__ __forceinline__ float wave_max(float v) {
#pragma unroll
  for (int o = 32; o > 0; o >>= 1) v = fmaxf(v, __shfl_xor(v, o, 64));
  return v;
}
__device__ __forceinline__ int otid() { int t = threadIdx.x; asm volatile("" : "+v"(t)); return t; }
__device__ __forceinline__ int gwave() { return blockIdx.x * (blockDim.x >> 6) + (otid() >> 6); }
__device__ __forceinline__ int nwave() { return gridDim.x * (blockDim.x >> 6); }
__device__ __forceinline__ const float* mlp(const Params& p, int l, int row) { return WSP(const float, OFF_ML) + ((size_t)l * 5 + row) * MLW; }

template <int MODE>
__device__ __forceinline__ int rowmap(int n) {
  if (MODE == 0) return n;
  if (MODE == 3) { if (n < 1088 || n >= 3136) return n; const int v = (n - 1088) >> 7, e = (n - 1088) & 127;
    return 1088 + v * 128 + ((2 * (e >> 6) + ((e >> 4) & 1)) << 5) + (((e >> 5) & 1) << 4) + (e & 15); }
  return 32 * (n >> 4) + (n & 15) + (MODE == 2 ? 16 : 0);
}
template <int MODE, bool F8 = false>
__device__ __forceinline__ void tconv(const float* __restrict__ src, int K, int N, int Npad, bf16_t* __restrict__ dst, char* smem) {
  float(*tile)[257] = (float(*)[257])smem;
  const int tid = otid(), tk = K / 64, tn = Npad / 256;
  for (int t = blockIdx.x; t < tk * tn; t += gridDim.x) {
    const int k0 = (t % tk) * 64, n0 = (t / tk) * 256;
#pragma unroll
    for (int i = 0; i < 8; ++i) {
      const int id = tid + i * 512, k = id >> 6, n4 = (id & 63) * 4;
      f32x4 v = {0.f, 0.f, 0.f, 0.f};
      if (n0 + n4 < N) v = *(const f32x4*)(src + (size_t)(k0 + k) * N + n0 + n4);
      tile[k][n4 + 0] = v[0]; tile[k][n4 + 1] = v[1]; tile[k][n4 + 2] = v[2]; tile[k][n4 + 3] = v[3];
    }
    __syncthreads();
    {
      const int n = tid >> 1, kh = (tid & 1) * 32;
      if constexpr (F8) {
        unsigned char* drow8 = (unsigned char*)dst + (size_t)rowmap<MODE>(n0 + n) * K + k0 + kh;
#pragma unroll
        for (int i = 0; i < 2; ++i) {
          u32x4 w;
#pragma unroll
          for (int q = 0; q < 4; ++q) { const int kk = kh + i * 16 + q * 4; w[q] = pack_fp8x4(tile[kk][n] * 32.f, tile[kk + 1][n] * 32.f, tile[kk + 2][n] * 32.f, tile[kk + 3][n] * 32.f); }
          *(u32x4*)(drow8 + i * 16) = w;
        }
      } else {
      bf16_t* drow = dst + (size_t)rowmap<MODE>(n0 + n) * K + k0 + kh;
#pragma unroll
      for (int i = 0; i < 4; ++i) {
        u32x4 w;
        w[0] = cvtpk(tile[kh + i * 8 + 0][n], tile[kh + i * 8 + 1][n]);
        w[1] = cvtpk(tile[kh + i * 8 + 2][n], tile[kh + i * 8 + 3][n]);
        w[2] = cvtpk(tile[kh + i * 8 + 4][n], tile[kh + i * 8 + 5][n]);
        w[3] = cvtpk(tile[kh + i * 8 + 6][n], tile[kh + i * 8 + 7][n]);
        *(u32x4*)(drow + i * 8) = w;
      }
      }
    }
    __syncthreads();
  }
}

constexpr float W8_SCALE = 32.f;
__device__ __forceinline__ void tconv8_tile(const float* __restrict__ src, int K, int N, unsigned char* __restrict__ dst, int mode, int k0, int n0, char* smem) {
  unsigned* img = (unsigned*)smem;
  const int tid = otid();
  f32x4 va[8], vb[8];
#define T8_LOAD(V, S) do { _Pragma("unroll") for (int j = 0; j < 2; ++j) { const int id = tid + j * 512; const float* bp = src + (size_t)(k0 + (S) * 16 + (id >> 8) * 4) * N + n0 + (id & 255) * 4; \
    _Pragma("unroll") for (int r = 0; r < 4; ++r) V[j * 4 + r] = __builtin_nontemporal_load((const f32x4*)(bp + (size_t)r * N)); } } while (0)
#define T8_PUT(V, S) do { _Pragma("unroll") for (int j = 0; j < 2; ++j) { const int id = tid + j * 512; unsigned* ip = img + ((id & 255) * 4) * 33 + (S) * 4 + (id >> 8); \
    _Pragma("unroll") for (int q = 0; q < 4; ++q) ip[q * 33] = pack_fp8x4(V[j * 4 + 0][q] * W8_SCALE, V[j * 4 + 1][q] * W8_SCALE, V[j * 4 + 2][q] * W8_SCALE, V[j * 4 + 3][q] * W8_SCALE); } } while (0)
  T8_LOAD(va, 0);
#pragma unroll
  for (int s2 = 0; s2 < 4; ++s2) {
    T8_LOAD(vb, 2 * s2 + 1);
    T8_PUT(va, 2 * s2);
    if (s2 < 3) T8_LOAD(va, 2 * s2 + 2);
    T8_PUT(vb, 2 * s2 + 1);
  }
  __syncthreads();
#pragma unroll
  for (int i = 0; i < 16; ++i) {
    const int idx = tid + i * 512, n = idx >> 3, ch = idx & 7, ng = n0 + n;
    const int drow = mode == 0 ? ng : (32 * (ng >> 4) + (ng & 15) + (mode == 2 ? 16 : 0));
    const unsigned* ip = img + n * 33 + ch * 4;
    const u32x4 w = {ip[0], ip[1], ip[2], ip[3]};
    __builtin_nontemporal_store(w, (u32x4*)(dst + (size_t)drow * K + k0 + ch * 16));
  }
  __syncthreads();
#undef T8_LOAD
#undef T8_PUT
}
__device__ __forceinline__ void ph_weights_small(const Params& p, char* smem) {
  tconv<3, true>(p.even_w_in, DM, EIN, EINP, WSP(bf16_t, OFF_WIN0), smem);
  tconv<0>(p.w_uq, 512, 1536, 1536, WSP(bf16_t, OFF_WUQ), smem);
  tconv<0>(p.w_ukv, 512, 2048, 2048, WSP(bf16_t, OFF_WUKV), smem);
  tconv<0>(p.even_w_out, DM, DM, DM, WSP(bf16_t, OFF_WOUT0), smem);
  tconv<0>(p.odd_w_in, DM, DM, DM, WSP(bf16_t, OFF_WIN1), smem);
  tconv<0>(p.odd_w_out, DM, DM, DM, WSP(bf16_t, OFF_WOUT1), smem);
  for (int g = 0; g < 4; ++g) {
    tconv<0>(p.pool_w + (size_t)g * 65536, 256, 256, 256, WSP(bf16_t, OFF_WPOOL) + (size_t)g * 65536, smem);
  }
}
__device__ __forceinline__ void conv_item(const Params& p, char* smem, int g) {
  const int mat = g >> 5, st = g & 31, le = mat / 3, which = mat - 3 * le, k0 = (st & 15) * 128, n0 = (st >> 4) * 1024;
  const size_t so = (size_t)le * 2048 * 2048;
  const float* src = (which == 0 ? p.w_gate : (which == 1 ? p.w_up : p.w_down)) + so;
  unsigned char* dst = which == 2 ? WSP(unsigned char, OFF_WD) + so : WSP(unsigned char, OFF_WGU) + (size_t)le * 4096 * 2048;
  tconv8_tile(src, 2048, 2048, dst, which == 2 ? 0 : which + 1, k0, n0, smem);
}
__device__ __forceinline__ void ph_weights_expert(const Params& p, char* smem, int widx, int wcount) {
  for (int g = widx; g < 2 * NE * 3 * 32; g += wcount) conv_item(p, smem, g);
}

__device__ __forceinline__ void ph_mod(const Params& p, char* smem) {
  float* sc = (float*)smem;
  float* part = sc + 5 * 2048;
  const int tid = otid();
  for (int i = tid; i < 5 * 2048; i += 512) {
    const int r = i >> 11, k = i & 2047;
    const float v = r < 4 ? p.c[r * 2048 + k] : p.c_ctx[k];
    sc[i] = v / (1.f + __expf(-v));
  }
  __syncthreads();
  for (int cb = blockIdx.x; cb < 256; cb += gridDim.x) {
    const int l = cb >> 7, j0 = (cb & 127) * 96;
    const int c4 = tid % 24, kg = tid / 24;
    if (tid < 504) {
      f32x4 acc[5];
#pragma unroll
      for (int r = 0; r < 5; ++r) acc[r] = (f32x4){0.f, 0.f, 0.f, 0.f};
      const float* wp = p.mod_w + (size_t)l * 2048 * MLW + j0 + c4 * 4;
#pragma unroll 4
      for (int k = kg; k < 2048; k += 21) {
        const f32x4 w = *(const f32x4*)(wp + (size_t)k * MLW);
#pragma unroll
        for (int r = 0; r < 5; ++r) acc[r] += sc[r * 2048 + k] * w;
      }
#pragma unroll
      for (int r = 0; r < 5; ++r)
#pragma unroll
        for (int q = 0; q < 4; ++q) part[(kg * 5 + r) * 96 + c4 * 4 + q] = acc[r][q];
    }
    __syncthreads();
    if (tid < 480) {
      const int r = tid / 96, col = tid % 96;
      float s = p.mod_b[l * MLW + j0 + col];
      for (int g = 0; g < 21; ++g) s += part[(g * 5 + r) * 96 + col];
      WSP(float, OFF_ML)[((size_t)l * 5 + r) * MLW + j0 + col] = s;
    }
    __syncthreads();
  }
}

__device__ __forceinline__ void ph_twiddle(const Params& p, char* smem) {
  float* ct = (float*)smem;
  for (int j = otid(); j < 4096; j += 512) ct[j] = cospif((float)j * (1.f / 2048.f));
  __syncthreads();
  bf16_t* tw = WSP(bf16_t, OFF_TW);
  const size_t nchunk = (size_t)2048 * 512;
  for (size_t q = (size_t)blockIdx.x * 512 + otid(); q < nchunk; q += (size_t)gridDim.x * 512) {
    const int k1 = (int)(q >> 9), kk0 = (int)(q & 511) * 8;
    float v[8];
#pragma unroll
    for (int j = 0; j < 8; ++j) {
      const int kk = kk0 + j;
      if (kk <= 2048) v[j] = ct[(k1 * kk) & 4095];
      else v[j] = -ct[(k1 * (kk - 2048) - 1024) & 4095];
    }
    u32x4 w = {cvtpk(v[0], v[1]), cvtpk(v[2], v[3]), cvtpk(v[4], v[5]), cvtpk(v[6], v[7])};
    *(u32x4*)(tw + q * 8) = w;
  }
  bf16_t* mc = WSP(bf16_t, OFF_MC);
  for (int i = blockIdx.x * 512 + otid(); i < 4 * 256 * 256; i += gridDim.x * 512) {
    const int d = i & 255, c = (i >> 8) & 255, g = i >> 16;
    const float* fw = p.fourier_w + (size_t)g * 65536 + d;
    float ac = 0.f, as = 0.f;
#pragma unroll 8
    for (int k2 = 0; k2 < 256; ++k2) {
      const int ph = ((k2 * c) & 255) * 16; const float f = fw[k2 * 256];
      ac += f * ct[ph]; as += f * ct[(ph - 1024) & 4095];
    }
    mc[((size_t)(g * 512 + d) * 256) + c] = f2bf(ac); mc[((size_t)(g * 512 + 256 + d) * 256) + c] = f2bf(as);
  }
  __syncthreads();
}

struct Row8 { f32x4 v[8]; };
__device__ __forceinline__ float row_load_ss(const float* src, int lane, Row8& r) {
  float ss = 0.f;
#pragma unroll
  for (int i = 0; i < 8; ++i) { r.v[i] = *(const f32x4*)(src + i * 256 + lane * 4); ss += r.v[i][0] * r.v[i][0] + r.v[i][1] * r.v[i][1] + r.v[i][2] * r.v[i][2] + r.v[i][3] * r.v[i][3]; }
  return wave_sum(ss);
}
__device__ __forceinline__ float row_load_ss_bf16(const bf16_t* src, int lane, Row8& r) {
  float ss = 0.f;
#pragma unroll
  for (int i = 0; i < 8; ++i) { const u32x2 w = *(const u32x2*)(src + i * 256 + lane * 4); r.v[i] = (f32x4){bf_lo(w[0]), bf_hi(w[0]), bf_lo(w[1]), bf_hi(w[1])};
    ss += r.v[i][0] * r.v[i][0] + r.v[i][1] * r.v[i][1] + r.v[i][2] * r.v[i][2] + r.v[i][3] * r.v[i][3]; }
  return wave_sum(ss);
}
__device__ __forceinline__ void row_norm_mod(Row8& r, float inv, const float* gain, const float* sc, const float* sh, int lane) {
#pragma unroll
  for (int i = 0; i < 8; ++i) {
    const int j = i * 256 + lane * 4;
    const f32x4 g = *(const f32x4*)(gain + j);
    f32x4 y = r.v[i] * inv * g;
    if (sc) { const f32x4 s1 = *(const f32x4*)(sc + j), s0 = *(const f32x4*)(sh + j); y = y * (1.f + s1) + s0; }
    r.v[i] = y;
  }
}
__device__ __forceinline__ void row_store_fp8(const Row8& r, unsigned char* dst, int lane) {
#pragma unroll
  for (int i = 0; i < 8; ++i) *(unsigned*)(dst + i * 256 + lane * 4) = pack_fp8x4(r.v[i][0], r.v[i][1], r.v[i][2], r.v[i][3]);
}
__device__ __forceinline__ void row_store_bf16(const Row8& r, bf16_t* dst, int lane) {
#pragma unroll
  for (int i = 0; i < 8; ++i) { u32x2 w = {cvtpk(r.v[i][0], r.v[i][1]), cvtpk(r.v[i][2], r.v[i][3])}; *(u32x2*)(dst + i * 256 + lane * 4) = w; }
}

__device__ __forceinline__ void ph_pre0(const Params& p) {
  const int lane = otid() & 63;
  for (int r = gwave(); r < NA; r += nwave()) {
    const float* src = r < NT ? p.x + (size_t)r * DM : p.ctx + (size_t)(r - NT) * DM;
    const float* ml = mlp(p, 0, r < NT ? r / SEQ : 4);
    Row8 row; const float ss = row_load_ss(src, lane, row);
    row_norm_mod(row, rsqrtf(ss * (1.f / DM) + EPS), p.norm_mix, ml + 2048, ml, lane);
    row_store_fp8(row, WSP(unsigned char, OFF_H) + (size_t)r * DM, lane);
  }
}

__device__ __forceinline__ float rope_inv_freq(int q, int quarter) { return exp2f(-(float)q / (float)quarter * 13.287712379549449f); }

__device__ __forceinline__ void ph_post_inproj(const Params& p) {
  const int lane = otid() & 63;
  const bf16_t* P0 = WSP(const bf16_t, OFF_P0);
  for (int r = gwave(); r < NA; r += nwave()) {
    const bool lat = r < NT;
    int b, keyrow, prow = 0, pcol = 0;
    if (lat) { b = r / SEQ; const int n = r % SEQ; keyrow = b * NKEY + CTXL + n; prow = n >> 6; pcol = n & 63; }
    else { const int i = r - NT; b = i / CTXL; keyrow = b * NKEY + (i % CTXL); }
    const bf16_t* row = P0 + (size_t)r * P0W;
    const u32x4 wq = *(const u32x4*)(row + lane * 8), wkv = *(const u32x4*)(row + 512 + lane * 8);
    const float xkr = bf2f(row[1024 + lane]);
    asm volatile("" ::: "memory");
    if (lat) {
      const u32x4 w = wq;
      float v[8] = {bf_lo(w[0]), bf_hi(w[0]), bf_lo(w[1]), bf_hi(w[1]), bf_lo(w[2]), bf_hi(w[2]), bf_lo(w[3]), bf_hi(w[3])};
      float ss = 0.f;
#pragma unroll
      for (int j = 0; j < 8; ++j) ss += v[j] * v[j];
      const float inv = rsqrtf(wave_sum(ss) * (1.f / 512.f) + EPS);
      const f32x4 g0 = *(const f32x4*)(p.q_norm + lane * 8), g1 = *(const f32x4*)(p.q_norm + lane * 8 + 4);
      u32x4 o = {cvtpk(v[0] * inv * g0[0], v[1] * inv * g0[1]), cvtpk(v[2] * inv * g0[2], v[3] * inv * g0[3]),
                 cvtpk(v[4] * inv * g1[0], v[5] * inv * g1[1]), cvtpk(v[6] * inv * g1[2], v[7] * inv * g1[3])};
      *(u32x4*)(WSP(bf16_t, OFF_CQN) + (size_t)r * 512 + lane * 8) = o;
    }
    {
      const u32x4 w = wkv;
      float v[8] = {bf_lo(w[0]), bf_hi(w[0]), bf_lo(w[1]), bf_hi(w[1]), bf_lo(w[2]), bf_hi(w[2]), bf_lo(w[3]), bf_hi(w[3])};
      float ss = 0.f;
#pragma unroll
      for (int j = 0; j < 8; ++j) ss += v[j] * v[j];
      const float inv = rsqrtf(wave_sum(ss) * (1.f / 512.f) + EPS);
      const f32x4 g0 = *(const f32x4*)(p.kv_norm + lane * 8), g1 = *(const f32x4*)(p.kv_norm + lane * 8 + 4);
      u32x4 o = {cvtpk(v[0] * inv * g0[0], v[1] * inv * g0[1]), cvtpk(v[2] * inv * g0[2], v[3] * inv * g0[3]),
                 cvtpk(v[4] * inv * g1[0], v[5] * inv * g1[1]), cvtpk(v[6] * inv * g1[2], v[7] * inv * g1[3])};
      *(u32x4*)(WSP(bf16_t, OFF_CKVN) + (size_t)r * 512 + lane * 8) = o;
    }
    const float pos = (lane >> 5) ? (float)pcol : (float)prow;
    const bool second = (lane >> 4) & 1;
    float c64 = 1.f, s64 = 0.f;
    if (lat) sincosf(pos * rope_inv_freq(lane & 15, 16), &s64, &c64);
    {
      const float xs = xkr;
      const float xp = __shfl_xor(xs, 16, 64);
      const float o = second ? (xs * c64 + xp * s64) : (xs * c64 - xp * s64);
      const unsigned char ob = (unsigned char)(pack_fp8x4(o, o, o, o) & 0xffu);
      unsigned char* ka = WSP(unsigned char, OFF_KA) + (size_t)keyrow * 1536 + 128 + lane;
#pragma unroll
      for (int h = 0; h < 8; ++h) ka[h * 192] = ob;
    }
  }
}

__device__ __forceinline__ void ph_diffcomb(const Params& p) {
  const int lane = otid() & 63;
  float d1 = p.lq1[lane] * p.lk1[lane] + p.lq1[lane + 64] * p.lk1[lane + 64];
  float d2 = p.lq2[lane] * p.lk2[lane] + p.lq2[lane + 64] * p.lk2[lane + 64];
  d1 = wave_sum(d1); d2 = wave_sum(d2);
  const float lam_init = 0.2f;
  const float lam = expf(d1) - expf(d2) + lam_init;
  const f32x4 sg = *(const f32x4*)(p.subln + lane * 4);
  const bf16_t* OD = WSP(const bf16_t, OFF_OD);
  for (int r = gwave(); r < NT; r += nwave()) {
    u32x2 w0[4], w1[4];
#pragma unroll
    for (int h = 0; h < 4; ++h) { w0[h] = *(const u32x2*)(OD + (size_t)r * 2048 + h * 256 + lane * 4); w1[h] = *(const u32x2*)(OD + (size_t)r * 2048 + 1024 + h * 256 + lane * 4); }
    asm volatile("" ::: "memory");
#pragma unroll
    for (int h = 0; h < 4; ++h) {
      const f32x4 o0 = {bf_lo(w0[h][0]), bf_hi(w0[h][0]), bf_lo(w0[h][1]), bf_hi(w0[h][1])}, o1 = {bf_lo(w1[h][0]), bf_hi(w1[h][0]), bf_lo(w1[h][1]), bf_hi(w1[h][1])};
      const f32x4 d = o0 - lam * o1;
      const float ss = wave_sum(d[0] * d[0] + d[1] * d[1] + d[2] * d[2] + d[3] * d[3]);
      const float inv = rsqrtf(ss * (1.f / 256.f) + EPS) * (1.f - lam_init);
      u32x2 w = {cvtpk(d[0] * inv * sg[0], d[1] * inv * sg[1]), cvtpk(d[2] * inv * sg[2], d[3] * inv * sg[3])};
      *(u32x2*)(WSP(bf16_t, OFF_YIN) + (size_t)r * 2048 + 1024 + h * 256 + lane * 4) = w;
    }
  }
}

__device__ __forceinline__ void ph_ffn_pre(const Params& p, int l, char* smem) {
  const int lane = otid() & 63, tid = otid();
  float* rw = (float*)smem;
  const float* rsrc = p.router_w + (size_t)l * DM * NE;
  for (int id = tid; id < DM * 4; id += 512) {
    const int j = id >> 2, q = id & 3;
    const f32x4 v = *(const f32x4*)(rsrc + j * 16 + q * 4);
    const int i = j >> 8, ln = (j & 255) >> 2, k = j & 3;
    *(f32x4*)(rw + ((((q * 8 + i) * 4 + k) * 64 + ln) << 2)) = v;
  }
  __syncthreads();
  for (int r = gwave(); r < NT; r += nwave()) {
    const int b = r / SEQ, n = r % SEQ;
    const float* ml = mlp(p, l, b);
    Row8 row; const float ss = row_load_ss_bf16(WSP(const bf16_t, OFF_XL) + (size_t)r * DM, lane, row);
    row_norm_mod(row, rsqrtf(ss * (1.f / DM) + EPS), p.norm_ffn + l * DM, ml + 8192, ml + 6144, lane);
    row_store_fp8(row, WSP(unsigned char, OFF_H) + (size_t)r * DM, lane);
    float lg[16];
#pragma unroll
    for (int e = 0; e < 16; ++e) lg[e] = 0.f;
#pragma unroll
    for (int i = 0; i < 8; ++i) {
      __builtin_amdgcn_sched_barrier(0);
#pragma unroll
      for (int k = 0; k < 4; ++k) {
        const float hv = row.v[i][k];
#pragma unroll
        for (int q = 0; q < 4; ++q) {
          const f32x4 w = *(const f32x4*)(rw + ((((q * 8 + i) * 4 + k) * 64 + lane) << 2));
          lg[q * 4 + 0] += hv * w[0]; lg[q * 4 + 1] += hv * w[1]; lg[q * 4 + 2] += hv * w[2]; lg[q * 4 + 3] += hv * w[3];
        }
      }
    }
    float mx = -1e30f;
#pragma unroll
    for (int e = 0; e < 16; ++e) { lg[e] = wave_sum(lg[e]); mx = fmaxf(mx, lg[e]); }
    float den = 0.f;
#pragma unroll
    for (int e = 0; e < 16; ++e) { lg[e] = expf(lg[e] - mx); den += lg[e]; }
    const float rden = 1.f / den;
    float mine = 0.f;
#pragma unroll
    for (int e = 0; e < 16; ++e) mine = (lane == e) ? lg[e] * rden : mine;
    if (lane < 16) {
      WSP(float, OFF_AFF)[((size_t)(b * NE + lane)) * SEQ + n] = mine;
      WSP(int, OFF_INV)[(size_t)r * NE + lane] = -1;
    }
  }
  __syncthreads();
}

__device__ __forceinline__ void ph_topk(const Params& p, char* smem) {
  unsigned* cnt = (unsigned*)smem;
  const int tid = otid(), lane = tid & 63, wid = tid >> 6;
  for (int be = blockIdx.x; be < NB * NE; be += gridDim.x) {
    const int b = be / NE, e = be % NE;
    const float* src = WSP(const float, OFF_AFF) + (size_t)be * SEQ + tid * 8;
    const f32x4 v0 = *(const f32x4*)src, v1 = *(const f32x4*)(src + 4);
    const float val[8] = {v0[0], v0[1], v0[2], v0[3], v1[0], v1[1], v1[2], v1[3]};
    unsigned key[8];
#pragma unroll
    for (int j = 0; j < 8; ++j) key[j] = __float_as_uint(val[j]);
    unsigned lo = 0u, hi = 0x3f800000u; int par = 0;
    __syncthreads();
    while (lo < hi) {
      const unsigned span = hi - lo + 1u;
      const unsigned t1 = lo + (span >> 2), t2 = lo + (span >> 1), t3 = lo + (span >> 1) + (span >> 2);
      unsigned c1 = 0u, c2 = 0u, c3 = 0u;
#pragma unroll
      for (int k = 0; k < 8; ++k) { c1 += (unsigned)__popcll(__ballot(key[k] >= t1)); c2 += (unsigned)__popcll(__ballot(key[k] >= t2)); c3 += (unsigned)__popcll(__ballot(key[k] >= t3)); }
      if (lane < 3) cnt[par * 32 + wid * 4 + lane] = lane == 0 ? c1 : (lane == 1 ? c2 : c3);
      __syncthreads();
      unsigned s1 = 0u, s2 = 0u, s3 = 0u;
#pragma unroll
      for (int w = 0; w < 8; ++w) { s1 += cnt[par * 32 + w * 4]; s2 += cnt[par * 32 + w * 4 + 1]; s3 += cnt[par * 32 + w * 4 + 2]; }
      par ^= 1;
      if (s1 < (unsigned)CAP) hi = t1 - 1u;
      else if (s2 < (unsigned)CAP) { lo = t1; hi = t2 - 1u; }
      else if (s3 < (unsigned)CAP) { lo = t2; hi = t3 - 1u; }
      else lo = t3;
    }
    const unsigned T = lo;
    int ngt = 0, neq = 0;
#pragma unroll
    for (int j = 0; j < 8; ++j) { ngt += key[j] > T ? 1 : 0; neq += key[j] == T ? 1 : 0; }
    int pk = ngt | (neq << 16);
    int inc = pk;
#pragma unroll
    for (int o = 1; o < 64; o <<= 1) { const int t = __shfl_up(inc, o, 64); if (lane >= o) inc += t; }
    if (lane == 63) cnt[128 + wid] = (unsigned)inc;
    __syncthreads();
    int base = 0, total = 0;
#pragma unroll
    for (int w = 0; w < 8; ++w) { const int t = (int)cnt[128 + w]; total += t; if (w < wid) base += t; }
    const int excl = base + inc - pk;
    int gpos = excl & 0xffff, epos = excl >> 16;
    const int total_gt = total & 0xffff, need = CAP - total_gt;
#pragma unroll
    for (int j = 0; j < 8; ++j) {
      int slot = -1;
      if (key[j] > T) slot = gpos++;
      else if (key[j] == T) { if (epos < need) slot = total_gt + epos; ++epos; }
      if (slot >= 0) {
        const int tok = tid * 8 + j;
        WSP(int, OFF_IDX)[be * CAP + slot] = tok; WSP(float, OFF_GATE)[be * CAP + slot] = val[j];
        WSP(int, OFF_INV)[(size_t)(b * SEQ + tok) * NE + e] = slot;
      }
    }
    __syncthreads();
  }
}

__device__ __forceinline__ void ph_combine(const Params& p, int l) {
  const int lane = otid() & 63;
  for (int r = gwave(); r < NT; r += nwave()) {
    const int b = r / SEQ;
    Row8 acc;
#pragma unroll
    for (int i = 0; i < 8; ++i) acc.v[i] = (f32x4){0.f, 0.f, 0.f, 0.f};
    const int myinv = WSP(const int, OFF_INV)[(size_t)r * NE + (lane & 15)];
    unsigned long long mask = __ballot(myinv >= 0) & 0xffffull;
    bf16_t* xl = WSP(bf16_t, OFF_XL) + (size_t)r * DM;
    u32x2 xw[8];
#pragma unroll
    for (int i = 0; i < 8; ++i) xw[i] = *(const u32x2*)(xl + i * 256 + lane * 4);
    while (mask) {
      const int e = __builtin_ctzll(mask); mask &= mask - 1;
      const int s = __builtin_amdgcn_readlane(myinv, e);
      const bf16_t* ye = WSP(const bf16_t, OFF_YE) + ((size_t)e * 2048 + b * CAP + s) * DM;
#pragma unroll
      for (int i = 0; i < 8; ++i) {
        const u32x2 w = *(const u32x2*)(ye + i * 256 + lane * 4);
        acc.v[i][0] += bf_lo(w[0]); acc.v[i][1] += bf_hi(w[0]); acc.v[i][2] += bf_lo(w[1]); acc.v[i][3] += bf_hi(w[1]);
      }
    }
    const float* ml = mlp(p, l, b);
    Row8 row; float ss = 0.f;
#pragma unroll
    for (int i = 0; i < 8; ++i) {
      const int j = i * 256 + lane * 4;
      const f32x4 g2 = *(const f32x4*)(ml + 10240 + j);
      row.v[i] = (f32x4){bf_lo(xw[i][0]), bf_hi(xw[i][0]), bf_lo(xw[i][1]), bf_hi(xw[i][1])} + g2 * acc.v[i];
      ss += row.v[i][0] * row.v[i][0] + row.v[i][1] * row.v[i][1] + row.v[i][2] * row.v[i][2] + row.v[i][3] * row.v[i][3];
    }
    ss = wave_sum(ss);
    const float inv = rsqrtf(ss * (1.f / DM) + EPS);
    if (l == 0) {
#pragma unroll
      for (int i = 0; i < 8; ++i) { u32x2 w = {cvtpk(row.v[i][0], row.v[i][1]), cvtpk(row.v[i][2], row.v[i][3])}; *(u32x2*)(xl + i * 256 + lane * 4) = w; }
      const float* ml1 = mlp(p, 1, b);
      row_norm_mod(row, inv, p.norm_mix + DM, ml1 + 2048, ml1, lane);
      row_store_bf16(row, WSP(bf16_t, OFF_H) + (size_t)r * DM, lane);
    } else {
      row_norm_mod(row, inv, p.final_norm, nullptr, nullptr, lane);
#pragma unroll
      for (int i = 0; i < 8; ++i) *(f32x4*)(p.out + (size_t)r * DM + i * 256 + lane * 4) = row.v[i];
    }
  }
}

__device__ __forceinline__ void ph_fold(const Params& p) {
  const bf16_t* src = WSP(const bf16_t, OFF_ABT2); bf16_t* dst = WSP(bf16_t, OFF_ABTF);
  float* nyq = WSP(float, OFF_IDX);
  for (int id = blockIdx.x * 512 + otid(); id < 4096 * 512; id += gridDim.x * 512) {
    const int rowi = id >> 9, kk0 = (id & 511) * 8;
    const bf16_t* rp = src + (size_t)rowi * 8192;
    float o[8];
    if (kk0 < 2048) {
      const u32x4 w = *(const u32x4*)(rp + kk0);
#pragma unroll
      for (int j = 0; j < 4; ++j) { o[2 * j] = bf_lo(w[j]); o[2 * j + 1] = bf_hi(w[j]); }
#pragma unroll
      for (int j = 0; j < 8; ++j) { const int kk = kk0 + j; if (kk > 0) o[j] += bf2f(rp[4096 - kk]); }
    } else {
      const int j0 = kk0 - 2048;
      const u32x4 w = *(const u32x4*)(rp + 4096 + j0);
#pragma unroll
      for (int j = 0; j < 4; ++j) { o[2 * j] = bf_lo(w[j]); o[2 * j + 1] = bf_hi(w[j]); }
#pragma unroll
      for (int j = 0; j < 8; ++j) { const int jj = j0 + j; if (jj > 0) o[j] -= bf2f(rp[4096 + 4096 - jj]); else o[j] = bf2f(rp[2048]); }
      if (j0 == 0) nyq[rowi] = o[0];
    }
    u32x4 ow = {cvtpk(o[0], o[1]), cvtpk(o[2], o[3]), cvtpk(o[4], o[5]), cvtpk(o[6], o[7])};
    *(u32x4*)(dst + (size_t)rowi * 4096 + kk0) = ow;
  }
}

__device__ __forceinline__ void ph_dftcomb(const Params& p) {
  const bf16_t* PQ = WSP(const bf16_t, OFF_SPEC); const bf16_t* abtf = WSP(const bf16_t, OFF_ABTF); bf16_t* Y = WSP(bf16_t, OFF_YCAT);
  const float sc = 1.f / 1024.f;
  for (int id = blockIdx.x * 512 + otid(); id < 16 * 2048 * 32; id += gridDim.x * 512) {
    const int d8 = (id & 31) * 8, k1 = (id >> 5) & 2047, bg = id >> 16, b = bg >> 2, g = bg & 3;
    const u32x4 wp = *(const u32x4*)(PQ + ((size_t)(2 * bg) * 2048 + k1) * 256 + d8), wq = *(const u32x4*)(PQ + ((size_t)(2 * bg + 1) * 2048 + k1) * 256 + d8);
    float pv[8], qv[8], ny[8];
#pragma unroll
    for (int j = 0; j < 4; ++j) { pv[2 * j] = bf_lo(wp[j]); pv[2 * j + 1] = bf_hi(wp[j]); qv[2 * j] = bf_lo(wq[j]); qv[2 * j + 1] = bf_hi(wq[j]); }
    const float sgn = (k1 & 1) ? -2.f : 2.f;
    { const f32x4 n0 = *(const f32x4*)(WSP(const float, OFF_IDX) + bg * 256 + d8), n1 = *(const f32x4*)(WSP(const float, OFF_IDX) + bg * 256 + d8 + 4);
#pragma unroll
      for (int j = 0; j < 4; ++j) { ny[j] = sgn * n0[j]; ny[4 + j] = sgn * n1[j]; } }
    bf16_t* y0 = Y + ((size_t)b * SEQ + k1) * DM + 1024 + g * 256 + d8;
    u32x4 o;
#pragma unroll
    for (int j = 0; j < 4; ++j) o[j] = cvtpk((pv[2 * j] + qv[2 * j]) * sc, (pv[2 * j + 1] + qv[2 * j + 1]) * sc);
    *(u32x4*)y0 = o;
    if (k1 > 0) {
#pragma unroll
      for (int j = 0; j < 4; ++j) o[j] = cvtpk((pv[2 * j] - qv[2 * j] + ny[2 * j]) * sc, (pv[2 * j + 1] - qv[2 * j + 1] + ny[2 * j + 1]) * sc);
      *(u32x4*)(Y + ((size_t)b * SEQ + (SEQ - k1)) * DM + 1024 + g * 256 + d8) = o;
    }
  }
  const int lane = otid() & 63;
  for (int r = gwave(); r < 16 * 256; r += nwave()) {
    const bf16_t* row = abtf + (size_t)r * 4096;
    float acc = 0.f;
#pragma unroll
    for (int i = 0; i < 4; ++i) { const u32x4 w = *(const u32x4*)(row + i * 512 + lane * 8);
#pragma unroll
      for (int j = 0; j < 4; ++j) acc += bf_lo(w[j]) - bf_hi(w[j]); }
    acc = wave_sum(acc) + bf2f(row[2048]);
    if (lane == 0) { const int bg = r >> 8, d = r & 255; Y[((size_t)(bg >> 2) * SEQ + 2048) * DM + 1024 + (bg & 3) * 256 + d] = f2bf(acc * sc); }
  }
}

__device__ __forceinline__ void ph_pool(const Params& p) {
  const bf16_t* Z = WSP(const bf16_t, OFF_Z);
  for (int id = blockIdx.x * 512 + otid(); id < NT * 128; id += gridDim.x * 512) {
    const int r = id >> 7, c8 = (id & 127) * 8, g = c8 >> 8, half = 1 << g;
    const int b = r / SEQ, n = r % SEQ;
    const int lo = max(n - half, 0), hi = min(n + half, SEQ);
    float s[8];
#pragma unroll
    for (int j = 0; j < 8; ++j) s[j] = 0.f;
    u32x4 wv[16];
#pragma unroll
    for (int d = 0; d < 16; ++d) { int t = n - 8 + d; t = t < lo ? lo : (t >= hi ? hi - 1 : t); wv[d] = *(const u32x4*)(Z + (size_t)(b * SEQ + t) * 2048 + c8); }
#pragma unroll
    for (int d = 0; d < 16; ++d) { const int t = n - 8 + d; const float wt = (t >= lo && t < hi) ? 1.f : 0.f;
#pragma unroll
      for (int j = 0; j < 4; ++j) { s[2 * j] += wt * bf_lo(wv[d][j]); s[2 * j + 1] += wt * bf_hi(wv[d][j]); } }
    const float rc = 1.f / (float)(hi - lo);
    const u32x4 w = *(const u32x4*)(Z + (size_t)r * 2048 + c8);
    u32x4 o;
#pragma unroll
    for (int j = 0; j < 4; ++j) o[j] = cvtpk(s[2 * j] * rc - bf_lo(w[j]), s[2 * j + 1] * rc - bf_hi(w[j]));
    *(u32x4*)(WSP(bf16_t, OFF_POOLED) + (size_t)r * 1024 + c8) = o;
  }
}

#define LAS __attribute__((address_space(3)))
__host__ __device__ __forceinline__ constexpr int vt_pos(int kap) { return (((kap >> 2) & 1) << 5) | ((kap >> 5) << 4) | (((kap >> 3) & 3) << 2) | (kap & 3); }
namespace fg {
constexpr int BM = 256, BK = 64, HALF = 128, HTB = HALF * BK * 2, STAGE_BYTES = 8 * HTB;
__device__ __forceinline__ int lds_byte(int r, int c) { const int st = (r >> 4) * 2 + (c >> 5), rr = r & 15, cc = c & 31, ob = rr * 64 + cc * 2; return st * 1024 + (ob ^ (((ob >> 9) & 1) << 5)); }
__device__ __forceinline__ void stage_rc(int b, int& R, int& C) { const int st = b / 1024, sb = b % 1024, swz = sb ^ (((sb >> 9) & 1) << 5); R = (st >> 1) * 16 + swz / 64; C = (st & 1) * 32 + (swz % 64) / 2; }
struct Unit { const char* a; const char* b; int pm, pn, grp; };
typedef int i32x8 __attribute__((ext_vector_type(8)));
typedef int i32x4 __attribute__((ext_vector_type(4)));
__device__ __forceinline__ void mfma_fp8(f32x4& acc, const i32x8& a, const i32x8& b, int scale) {
  asm volatile("s_nop 1\n\tv_mfma_scale_f32_16x16x128_f8f6f4 %0, %1, %2, %0, %3, %3 op_sel_hi:[0,0,0]" : "+v"(acc) : "v"(a), "v"(b), "v"(scale));
}
template <int H> __device__ __forceinline__ bf16x8 half8(i32x8 v) { const i32x4 h = H ? __builtin_shufflevector(v, v, 4, 5, 6, 7) : __builtin_shufflevector(v, v, 0, 1, 2, 3); return __builtin_bit_cast(bf16x8, h); }
__device__ __forceinline__ i32x8 cat8(bf16x8 lo, bf16x8 hi) { const i32x4 a = __builtin_bit_cast(i32x4, lo), b = __builtin_bit_cast(i32x4, hi); return (i32x8){a[0], a[1], a[2], a[3], b[0], b[1], b[2], b[3]}; }
struct Grid {
  const char* A; const char* B; size_t sA, sB; int lda, ldb, nM, nN, ngrp, G, c; int gd = 1; size_t sA2 = 0, sB2 = 0;
  __device__ __forceinline__ bool next(int i, Unit& u) const {
    const int cc = (G == 256) ? ((c & 7) * 32 + (c >> 3)) : c;
    const int L = i * G + cc, per = nM * nN;
    if (L >= per * ngrp) return false;
    const int g = L / per, w = L - g * per;
    const int nig = 8 * nN, gid = w / nig, fm = gid * 8, gsz = (nM - fm) < 8 ? (nM - fm) : 8, wi = w - gid * nig;
    u.grp = g; u.pn = wi / gsz; u.pm = fm + (wi - u.pn * gsz);
    const int g1 = g / gd, g2 = g - g1 * gd;
    u.a = A + (size_t)g1 * sA + (size_t)g2 * sA2 + (size_t)u.pm * 256 * lda * 2; u.b = B + (size_t)g1 * sB + (size_t)g2 * sB2 + (size_t)u.pn * 256 * ldb * 2;
    return true;
  }
};
template <class Epi, bool GATHER = false, bool FP8 = false>
__device__ __forceinline__ void gemm_fast(LAS unsigned char* lds, const Grid& S, const Epi& E, int K, const int* gidx = nullptr) {
  int tid_ = threadIdx.x; asm volatile("" : "+v"(tid_));
  const int tid = tid_, wid = __builtin_amdgcn_readfirstlane(tid >> 6), lane = tid & 63, wr = wid >> 2, wc = wid & 3, fr = lane & 15, fq = lane >> 4;
  const int nt = K / BK;
  unsigned voffA[2], voffB[2];
#pragma unroll
  for (int i = 0; i < 2; ++i) { int R, C; stage_rc(tid * 16 + i * 8192, R, C); voffA[i] = (unsigned)(R * S.lda + C) * 2u; voffB[i] = (unsigned)(R * S.ldb + C) * 2u; }
  const size_t kstep = (size_t)(BK * 2);
  const size_t hstepA = (size_t)HALF * S.lda * 2, hstepB = (size_t)HALF * S.ldb * 2;
  const unsigned ldsw = (unsigned)wid * 1024u;
  const int aoff = FP8 ? lds_byte(wr * 64 + fr, fq * 16) : lds_byte(wr * 64 + fr, fq * 8), boff = FP8 ? lds_byte(wc * 32 + fr, fq * 16) : lds_byte(wc * 32 + fr, fq * 8);
  constexpr int KOFF = FP8 ? 16 : 1024;
#define FG_SA(b, h) (((b) * 2 + (h)) * HTB)
#define FG_SB(b, h) ((4 + (b) * 2 + (h)) * HTB)
#define FG_STAGE(bufoff, gbase, voff) do { _Pragma("unroll") for (int _i = 0; _i < 2; ++_i) \
    __builtin_amdgcn_global_load_lds((const unsigned*)((const char*)(gbase) + (voff)[_i]), (LAS unsigned*)(lds + (bufoff) + ldsw + _i * 8192), 16, 0, 0); } while (0)
#define FG_STAGE_A(bufoff, usen, kb, h) do { if constexpr (GATHER) { _Pragma("unroll") for (int _i = 0; _i < 2; ++_i) { const unsigned _g = (usen) ? gN[h][_i] : gA[h][_i]; \
      __builtin_amdgcn_global_load_lds((const unsigned*)(S.A + _g + (kb)), (LAS unsigned*)(lds + (bufoff) + ldsw + _i * 8192), 16, 0, 0); } } \
    else { FG_STAGE(bufoff, ((usen) ? nA : cA) + (kb) + (h) * hstepA, voffA); } } while (0)
#define FG_LDA(dst, b, h) do { _Pragma("unroll") for (int m = 0; m < 4; ++m) dst[m] = cat8(*(const LAS bf16x8*)(lds + FG_SA(b, h) + aoff + m * 2048), *(const LAS bf16x8*)(lds + FG_SA(b, h) + aoff + m * 2048 + KOFF)); } while (0)
#define FG_LDB(dst, b, h) do { _Pragma("unroll") for (int n = 0; n < 2; ++n) dst[n] = cat8(*(const LAS bf16x8*)(lds + FG_SB(b, h) + boff + n * 2048), *(const LAS bf16x8*)(lds + FG_SB(b, h) + boff + n * 2048 + KOFF)); } while (0)
#define FG_MMA(ai, bj, At, Bt) do { __builtin_amdgcn_s_setprio(1); _Pragma("unroll") for (int m = 0; m < 4; ++m) _Pragma("unroll") for (int n = 0; n < 2; ++n) { \
    if constexpr (FP8) mfma_fp8(acc[ai][bj][m][n], Bt[n], At[m], one_scale); \
    else { acc[ai][bj][m][n] = __builtin_amdgcn_mfma_f32_16x16x32_bf16(half8<0>(Bt[n]), half8<0>(At[m]), acc[ai][bj][m][n], 0, 0, 0); \
           acc[ai][bj][m][n] = __builtin_amdgcn_mfma_f32_16x16x32_bf16(half8<1>(Bt[n]), half8<1>(At[m]), acc[ai][bj][m][n], 0, 0, 0); } } \
    __builtin_amdgcn_s_setprio(0); } while (0)
#define FG_WAIT_V(n) asm volatile("s_waitcnt vmcnt(" #n ")" ::: "memory")
#define FG_WAIT_L(n) asm volatile("s_waitcnt lgkmcnt(" #n ")" ::: "memory")
#define FG_BAR __builtin_amdgcn_s_barrier()
#define FG_SCHED __builtin_amdgcn_sched_barrier(0)
  Unit cur, nxt; int ui = 0;
  if (!S.next(0, cur)) return;
  f32x4 acc[2][2][4][2];
#pragma unroll
  for (int a = 0; a < 2; ++a)
#pragma unroll
    for (int b = 0; b < 2; ++b)
#pragma unroll
      for (int m = 0; m < 4; ++m)
#pragma unroll
        for (int n = 0; n < 2; ++n) acc[a][b][m][n] = (f32x4){0.f, 0.f, 0.f, 0.f};
  int one_scale = 0x7f7f7f7f; asm volatile("" : "+v"(one_scale));
  i32x8 At[4], B0[2], B1[2];
  const char* cA = cur.a; const char* cB = cur.b; const char* nA = cA;
  unsigned gA[2][2] = {{0u, 0u}, {0u, 0u}}, gN[2][2] = {{0u, 0u}, {0u, 0u}};
  auto goff = [&](const Unit& u, unsigned (&g)[2][2]) {
#pragma unroll
    for (int h = 0; h < 2; ++h)
#pragma unroll
      for (int i = 0; i < 2; ++i) { int R, C; stage_rc(tid * 16 + i * 8192, R, C); const int rr = u.pm * 256 + h * 128 + R, bb = rr >> 9;
        const int tok = bb * SEQ + gidx[(bb * NE + u.grp) * CAP + (rr & 511)]; g[h][i] = (unsigned)(tok * S.lda + C) * 2u; }
  };
  if constexpr (GATHER) goff(cur, gA);
  FG_STAGE(FG_SB(0, 0), cB, voffB); FG_STAGE_A(FG_SA(0, 0), false, 0, 0); FG_STAGE(FG_SB(0, 1), cB + hstepB, voffB); FG_STAGE_A(FG_SA(0, 1), false, 0, 1);
  if (wr == 1) FG_BAR;
  FG_WAIT_V(4); FG_BAR;
  FG_STAGE(FG_SB(1, 0), cB + kstep, voffB); FG_STAGE_A(FG_SA(1, 0), false, kstep, 0); FG_STAGE(FG_SB(1, 1), cB + hstepB + kstep, voffB);
  FG_WAIT_V(6); FG_BAR;
  for (;;) {
    const bool has_next = S.next(ui + 1, nxt);
    nA = has_next ? nxt.a : cA; const char* nB = has_next ? nxt.b : cB;
    if constexpr (GATHER) { if (has_next) goff(nxt, gN); else {
#pragma unroll
      for (int h = 0; h < 2; ++h)
#pragma unroll
        for (int i = 0; i < 2; ++i) gN[h][i] = gA[h][i]; } }
#pragma unroll 1
    for (int t = 0; t < nt; t += 2) {
      const bool last = (t == nt - 2);
      const size_t k1 = (size_t)(t + 1) * kstep, k2 = last ? 0 : (size_t)(t + 2) * kstep, k3 = k2 + kstep;
      const char* b2 = last ? nB : cB + (size_t)(t + 2) * kstep;
      const char* b3 = b2 + kstep;
      FG_LDB(B0, 0, 0); FG_SCHED; FG_LDA(At, 0, 0); FG_STAGE_A(FG_SA(1, 1), false, k1, 1);
      FG_WAIT_L(8); FG_BAR; FG_WAIT_L(0); FG_MMA(0, 0, At, B0); FG_BAR; FG_SCHED;
      FG_LDB(B1, 0, 1); FG_STAGE(FG_SB(0, 0), b2, voffB);
      FG_BAR; FG_WAIT_L(0); FG_MMA(0, 1, At, B1); FG_BAR;
      FG_LDA(At, 0, 1); FG_STAGE_A(FG_SA(0, 0), last, k2, 0);
      FG_BAR; FG_WAIT_L(0); FG_MMA(1, 0, At, B0); FG_BAR; FG_SCHED;
      FG_STAGE(FG_SB(0, 1), b2 + hstepB, voffB);
      FG_WAIT_V(6); FG_BAR; FG_MMA(1, 1, At, B1); FG_BAR;
      FG_LDB(B0, 1, 0); FG_SCHED; FG_LDA(At, 1, 0); FG_STAGE_A(FG_SA(0, 1), last, k2, 1);
      FG_WAIT_L(8); FG_BAR; FG_WAIT_L(0); FG_MMA(0, 0, At, B0); FG_BAR; FG_SCHED;
      FG_LDB(B1, 1, 1); FG_STAGE(FG_SB(1, 0), b3, voffB);
      FG_BAR; FG_WAIT_L(0); FG_MMA(0, 1, At, B1); FG_BAR;
      FG_LDA(At, 1, 1); FG_STAGE_A(FG_SA(1, 0), last, k3, 0);
      FG_BAR; FG_WAIT_L(0); FG_MMA(1, 0, At, B0); FG_BAR; FG_SCHED;
      FG_STAGE(FG_SB(1, 1), b3 + hstepB, voffB);
      FG_WAIT_V(6); FG_BAR; FG_MMA(1, 1, At, B1); FG_BAR;
    }
    if constexpr (FP8) asm volatile("s_nop 15\n\ts_nop 15" ::: "memory");
    {
      int tz = threadIdx.x; asm volatile("" : "+v"(tz));
      const int wz = __builtin_amdgcn_readfirstlane(tz >> 6), lz = tz & 63;
      E(acc, cur, wz >> 2, wz & 3, lz & 15, lz >> 4); }
    if (!has_next) break;
#pragma unroll
    for (int a = 0; a < 2; ++a)
#pragma unroll
      for (int b = 0; b < 2; ++b)
#pragma unroll
        for (int m = 0; m < 4; ++m)
#pragma unroll
          for (int n = 0; n < 2; ++n) acc[a][b][m][n] = (f32x4){0.f, 0.f, 0.f, 0.f};
    cur = nxt; cA = nA; cB = nB; ++ui;
    if constexpr (GATHER) {
#pragma unroll
      for (int h = 0; h < 2; ++h)
#pragma unroll
        for (int i = 0; i < 2; ++i) gA[h][i] = gN[h][i]; }
  }
  FG_WAIT_V(0);
  if (wr == 0) FG_BAR;
  FG_BAR;
#undef FG_SA
#undef FG_SB
#undef FG_STAGE
#undef FG_STAGE_A
#undef FG_LDA
#undef FG_LDB
#undef FG_MMA
#undef FG_WAIT_V
#undef FG_WAIT_L
#undef FG_BAR
#undef FG_SCHED
}
typedef f32x4 Acc[2][2][4][2];
#define FG_FOREACH(...)                                                                                                \
  _Pragma("unroll") for (int ai = 0; ai < 2; ++ai) _Pragma("unroll") for (int m = 0; m < 4; ++m)                       \
  _Pragma("unroll") for (int bj = 0; bj < 2; ++bj) _Pragma("unroll") for (int n = 0; n < 2; ++n) {                     \
    const int row = u.pm * 256 + ai * 128 + wr * 64 + m * 16 + fr, col = u.pn * 256 + bj * 128 + wc * 32 + n * 16 + 4 * fq; \
    const f32x4 v = acc[ai][bj][m][n]; __VA_ARGS__ }
__device__ __forceinline__ u32x2 pack4(f32x4 v) { return (u32x2){cvtpk(v[0], v[1]), cvtpk(v[2], v[3])}; }

struct EpiBf16 {
  bf16_t* O; int ld, nvalid; float scale; int gdiv; size_t s1, s2;
  __device__ __forceinline__ void operator()(const Acc& acc, const Unit& u, int wr, int wc, int fr, int fq) const {
    bf16_t* base = O + (size_t)(u.grp / gdiv) * s1 + (size_t)(u.grp % gdiv) * s2;
    FG_FOREACH(if (col < nvalid) *(u32x2*)(base + (size_t)row * ld + col) = pack4(v * scale);)
  }
};
struct EpiQRope {
  unsigned char* QA;
  __device__ __forceinline__ void operator()(const Acc& acc, const Unit& u, int wr, int wc, int fr, int fq) const {
#pragma unroll
    for (int ai = 0; ai < 2; ++ai)
#pragma unroll
      for (int m = 0; m < 4; ++m)
#pragma unroll
        for (int bj = 0; bj < 2; ++bj) {
          const int row = u.pm * 256 + ai * 128 + wr * 64 + m * 16 + fr, g0 = u.pn * 256 + bj * 128 + wc * 32, w0 = g0 % 192;
          f32x4 x1 = acc[ai][bj][m][0], x2 = acc[ai][bj][m][1];
          if (w0 >= 128) {
            const int ntok = row % SEQ; const float pos = (w0 >= 160) ? (float)(ntok & 63) : (float)(ntok >> 6);
#pragma unroll
            for (int j = 0; j < 4; ++j) { const float ang = pos * rope_inv_freq(4 * fq + j, 16); const float sn = __sinf(ang), cs = __cosf(ang);
              const float a = x1[j], b = x2[j]; x1[j] = a * cs - b * sn; x2[j] = b * cs + a * sn; }
          }
          unsigned char* dst = QA + (size_t)row * 1536 + g0 + 4 * fq;
          *(unsigned*)dst = pack_fp8x4(x1[0], x1[1], x1[2], x1[3]); *(unsigned*)(dst + 16) = pack_fp8x4(x2[0], x2[1], x2[2], x2[3]);
        }
  }
};
struct EpiIn0 {
  bf16_t* P0; unsigned char* QD; unsigned char* KD; unsigned char* VD;
  __device__ __forceinline__ void operator()(const Acc& acc, const Unit& u, int wr, int wc, int fr, int fq) const {
    const bool lat = u.pm < NT / 256;
#pragma unroll
    for (int ai = 0; ai < 2; ++ai)
#pragma unroll
      for (int m = 0; m < 4; ++m) {
        const int row = u.pm * 256 + ai * 128 + wr * 64 + m * 16 + fr;
        int keyrow, ntok = 0;
        if (lat) { ntok = row % SEQ; keyrow = (row / SEQ) * NKEY + CTXL + ntok; } else { const int ii = row - NT; keyrow = (ii / CTXL) * NKEY + (ii % CTXL); }
#pragma unroll
        for (int bj = 0; bj < 2; ++bj) {
          const int g0 = u.pn * 256 + bj * 128 + wc * 32;
          f32x4 x1 = acc[ai][bj][m][0] * (1.f / 32.f), x2 = acc[ai][bj][m][1] * (1.f / 32.f);
          if (g0 < P0W) { bf16_t* dst = P0 + (size_t)row * P0W + g0 + 4 * fq; *(u32x2*)dst = pack4(x1); *(u32x2*)(dst + 16) = pack4(x2); }
          else if (g0 < 3136) {
            const int vv = (g0 - 1088) >> 7, sg = ((g0 - 1088) & 127) >> 5, axis = sg >> 1, qh = sg & 1, e1 = axis * 64 + qh * 16 + 4 * fq;
            if (lat) { const float pos = axis ? (float)(ntok & 63) : (float)(ntok >> 6);
#pragma unroll
              for (int j = 0; j < 4; ++j) { const float ang = pos * rope_inv_freq(qh * 16 + 4 * fq + j, 32); const float sn = __sinf(ang), cs = __cosf(ang);
                const float a = x1[j], b = x2[j]; x1[j] = a * cs - b * sn; x2[j] = b * cs + a * sn; } }
            if (vv < 8) { if (lat) { unsigned char* dst = QD + (size_t)row * 1024 + vv * 128 + e1; *(unsigned*)dst = pack_fp8x4(x1[0], x1[1], x1[2], x1[3]); *(unsigned*)(dst + 32) = pack_fp8x4(x2[0], x2[1], x2[2], x2[3]); } }
            else { unsigned char* dst = KD + (size_t)keyrow * 1024 + (vv - 8) * 128 + e1; *(unsigned*)dst = pack_fp8x4(x1[0], x1[1], x1[2], x1[3]); *(unsigned*)(dst + 32) = pack_fp8x4(x2[0], x2[1], x2[2], x2[3]); }
          } else if (g0 < EIN) {
            const int c = g0 - 3136 + 4 * fq, kb = keyrow / NKEY, key = keyrow - kb * NKEY;
            unsigned char* dst = VD + ((((size_t)(kb * 4 + (c >> 8)) * (NKEY / 64) + (key >> 6)) * 256 + (c & 255)) << 6) + vt_pos(key & 63);
            const unsigned p1 = pack_fp8x4(x1[0], x1[1], x1[2], x1[3]), p2 = pack_fp8x4(x2[0], x2[1], x2[2], x2[3]);
            dst[0] = (unsigned char)p1; dst[64] = (unsigned char)(p1 >> 8); dst[128] = (unsigned char)(p1 >> 16); dst[192] = (unsigned char)(p1 >> 24);
            dst[1024] = (unsigned char)p2; dst[1088] = (unsigned char)(p2 >> 8); dst[1152] = (unsigned char)(p2 >> 16); dst[1216] = (unsigned char)(p2 >> 24); }
        }
      }
  }
};
struct EpiKV {
  unsigned char* KA; unsigned char* VA;
  __device__ __forceinline__ void operator()(const Acc& acc, const Unit& u, int wr, int wc, int fr, int fq) const {
    FG_FOREACH(
      int b; int key; if (row < NT) { b = row / SEQ; key = CTXL + (row % SEQ); } else { const int ii = row - NT; b = ii / CTXL; key = ii % CTXL; }
      const int h = col >> 8, w = col & 255; const unsigned pk = pack_fp8x4(v[0], v[1], v[2], v[3]);
      if (w < 128) *(unsigned*)(KA + ((size_t)b * NKEY + key) * 1536 + h * 192 + w) = pk;
      else { unsigned char* dst = VA + ((((size_t)(b * 8 + h) * (NKEY / 64) + (key >> 6)) * 128 + (w - 128)) << 6) + vt_pos(key & 63);
        dst[0] = (unsigned char)pk; dst[64] = (unsigned char)(pk >> 8); dst[128] = (unsigned char)(pk >> 16); dst[192] = (unsigned char)(pk >> 24); })
  }
};
template <bool BASE_F32>
struct EpiResid {
  bf16_t* XL; const void* base; const float* ml;
  __device__ __forceinline__ void operator()(const Acc& acc, const Unit& u, int wr, int wc, int fr, int fq) const {
    const int row0 = u.pm * 256 + wr * 64 + fr, col0 = u.pn * 256 + wc * 32 + 4 * fq;
    const float* gp = ml + (size_t)(row0 / SEQ) * MLW + 4096 + col0;
    f32x4 g[2][2];
#pragma unroll
    for (int bj = 0; bj < 2; ++bj)
#pragma unroll
      for (int n = 0; n < 2; ++n) g[bj][n] = *(const f32x4*)(gp + bj * 128 + n * 16);
#pragma unroll
    for (int ai = 0; ai < 2; ++ai)
#pragma unroll
      for (int mh = 0; mh < 2; ++mh) {
        f32x4 bs[2][2][2];
#pragma unroll
        for (int m2 = 0; m2 < 2; ++m2)
#pragma unroll
          for (int bj = 0; bj < 2; ++bj)
#pragma unroll
            for (int n = 0; n < 2; ++n) { const size_t o = (size_t)(row0 + ai * 128 + (mh * 2 + m2) * 16) * DM + col0 + bj * 128 + n * 16;
              if constexpr (BASE_F32) bs[m2][bj][n] = *(const f32x4*)((const float*)base + o);
              else { const u32x2 w = *(const u32x2*)((const bf16_t*)base + o); bs[m2][bj][n] = (f32x4){bf_lo(w[0]), bf_hi(w[0]), bf_lo(w[1]), bf_hi(w[1])}; } }
        asm volatile("" ::: "memory");
#pragma unroll
        for (int m2 = 0; m2 < 2; ++m2)
#pragma unroll
          for (int bj = 0; bj < 2; ++bj)
#pragma unroll
            for (int n = 0; n < 2; ++n)
              *(u32x2*)(XL + (size_t)(row0 + ai * 128 + (mh * 2 + m2) * 16) * DM + col0 + bj * 128 + n * 16) = pack4(bs[m2][bj][n] + g[bj][n] * acc[ai][bj][mh * 2 + m2][n]);
        asm volatile("" ::: "memory");
      }
  }
};
struct EpiGU {
  unsigned char* HID;
  __device__ __forceinline__ void operator()(const Acc& acc, const Unit& u, int wr, int wc, int fr, int fq) const {
    unsigned char* base = HID + (size_t)u.grp * 2048 * FF;
#pragma unroll
    for (int ai = 0; ai < 2; ++ai)
#pragma unroll
      for (int m = 0; m < 4; ++m)
#pragma unroll
        for (int bj = 0; bj < 2; ++bj) {
          const int row = u.pm * 256 + ai * 128 + wr * 64 + m * 16 + fr, hid = u.pn * 128 + bj * 64 + wc * 16 + 4 * fq;
          const f32x4 g = acc[ai][bj][m][0], up = acc[ai][bj][m][1];
          float r[4];
#pragma unroll
          for (int j = 0; j < 4; ++j) { const float gg = g[j] * (1.f / W8_SCALE), uu = up[j] * (1.f / W8_SCALE); r[j] = gg * __builtin_amdgcn_rcpf(1.f + __expf(-gg)) * uu; }
          *(unsigned*)(base + (size_t)row * FF + hid) = pack_fp8x4(r[0], r[1], r[2], r[3]);
        }
  }
};
struct EpiDown {
  bf16_t* YE; const float* gate;
  __device__ __forceinline__ void operator()(const Acc& acc, const Unit& u, int wr, int wc, int fr, int fq) const {
    bf16_t* base = YE + (size_t)u.grp * 2048 * DM;
    float gt[2][4];
#pragma unroll
    for (int ai = 0; ai < 2; ++ai)
#pragma unroll
      for (int m = 0; m < 4; ++m) { const int row = u.pm * 256 + ai * 128 + wr * 64 + m * 16 + fr; gt[ai][m] = gate[((row >> 9) * NE + u.grp) * CAP + (row & 511)] * (1.f / W8_SCALE); }
    asm volatile("" ::: "memory");
    FG_FOREACH(*(u32x2*)(base + (size_t)row * DM + col) = pack4(v * gt[ai][m]);)
  }
};
struct EpiScaleCol {
  bf16_t* O; const float* cs;
  __device__ __forceinline__ void operator()(const Acc& acc, const Unit& u, int wr, int wc, int fr, int fq) const {
    f32x4 sc[2][2];
#pragma unroll
    for (int bj = 0; bj < 2; ++bj)
#pragma unroll
      for (int n = 0; n < 2; ++n) sc[bj][n] = *(const f32x4*)(cs + u.grp * 256 + u.pn * 256 + bj * 128 + wc * 32 + n * 16 + 4 * fq);
    asm volatile("" ::: "memory");
    FG_FOREACH(*(u32x2*)(O + (size_t)row * DM + u.grp * 256 + col) = pack4(v * sc[bj][n]);)
  }
};
struct EpiChanDft {
  bf16_t* ABT2;
  __device__ __forceinline__ void operator()(const Acc& acc, const Unit& u, int wr, int wc, int fr, int fq) const {
    FG_FOREACH(const int b = col / SEQ, nn = col % SEQ;
               *(u32x2*)(ABT2 + (((size_t)(b * 4 + u.grp) * 256) + (row & 255)) * 8192 + (row >> 8) * 4096 + nn) = pack4(v * 1.f);)
  }
};
}

namespace at {
typedef float f32x16 __attribute__((ext_vector_type(16)));
typedef int i32x8a __attribute__((ext_vector_type(8)));
typedef int i32x4a __attribute__((ext_vector_type(4)));
constexpr int NW = 8, QBLK = 32, KVBLK = 64;
#define SBAR() __builtin_amdgcn_sched_barrier(0)
#define MFMA8(A, B, Cc) __builtin_amdgcn_mfma_scale_f32_32x32x64_f8f6f4(A, B, Cc, 0, 0, 0, 0x7f7f7f7f, 0, 0x7f7f7f7f)
__device__ __forceinline__ int crow(int r, int hi) { return (r & 3) + 8 * (r >> 2) + 4 * hi; }
template <int DK> __device__ __forceinline__ int kswz(int row) { return DK == 192 ? ((row >> 2) & 3) : ((row >> 1) & 7); }
template <int DK>
__device__ __forceinline__ void qkt(f32x16& p0, f32x16& p1, const LAS char* Ks, const i32x8a* qf, int r32, int hi) {
  p0 = f32x16{}; p1 = f32x16{};
  const int s = kswz<DK>(r32);
  const LAS char* kr = Ks + r32 * DK;
#pragma unroll
  for (int t = 0; t < DK / 64; ++t) {
    const int c0 = ((4 * t + 2 * hi) ^ s) << 4, c1 = ((4 * t + 2 * hi + 1) ^ s) << 4;
    const i32x4a a0 = *reinterpret_cast<const LAS i32x4a*>(kr + c0), a1 = *reinterpret_cast<const LAS i32x4a*>(kr + c1);
    const i32x4a b0 = *reinterpret_cast<const LAS i32x4a*>(kr + c0 + 32 * DK), b1 = *reinterpret_cast<const LAS i32x4a*>(kr + c1 + 32 * DK);
    const i32x8a k0 = {a0[0], a0[1], a0[2], a0[3], a1[0], a1[1], a1[2], a1[3]}, k1 = {b0[0], b0[1], b0[2], b0[3], b1[0], b1[1], b1[2], b1[3]};
    p0 = MFMA8(k0, qf[t], p0);
    p1 = MFMA8(k1, qf[t], p1); }
}
constexpr float PBIAS = 4.f, PTHR = 3.f;
__device__ __forceinline__ void softmax8(const f32x16& p0, const f32x16& p1, float& m_reg, float& alpha, i32x8a& pa, float C, float thr_raw) {
  float pmax = p0[0];
#pragma unroll
  for (int r = 1; r < 16; ++r) pmax = fmaxf(pmax, p0[r]);
#pragma unroll
  for (int r = 0; r < 16; ++r) pmax = fmaxf(pmax, p1[r]);
  { auto rr = __builtin_amdgcn_permlane32_swap(__float_as_uint(pmax), __float_as_uint(pmax), false, false);
    pmax = fmaxf(__uint_as_float(rr[0]), __uint_as_float(rr[1])); }
  float mn;
  if (__builtin_expect(__all(pmax - m_reg <= thr_raw), 1)) { mn = m_reg; alpha = 1.f; }
  else { mn = fmaxf(m_reg, pmax); alpha = __builtin_amdgcn_exp2f((m_reg - mn) * C); m_reg = mn; }
  const float C8 = 8.f * C, b8 = 8.f * (PBIAS - mn * C) + 56.f;
#pragma unroll
  for (int w = 0; w < 4; ++w) {
    unsigned v = 0, v2 = 0;
#pragma unroll
    for (int j = 0; j < 4; ++j) { v = __builtin_amdgcn_cvt_pk_u8_f32(fmaf(p0[4 * w + j], C8, b8), j, v); v2 = __builtin_amdgcn_cvt_pk_u8_f32(fmaf(p1[4 * w + j], C8, b8), j, v2); }
    pa[w] = (int)v; pa[4 + w] = (int)v2; }
}
template <int NDB>
__device__ __forceinline__ void pv(f32x16* o, const LAS char* Vs, const i32x8a pa, int r32, int hi) {
  const int s = (r32 >> 2) & 3;
  const LAS char* v0 = Vs + r32 * 64 + (((2 * hi) ^ s) << 4); const LAS char* v1 = Vs + r32 * 64 + (((2 * hi + 1) ^ s) << 4);
#pragma unroll
  for (int d0 = 0; d0 < NDB; ++d0) {
    const i32x4a a = *reinterpret_cast<const LAS i32x4a*>(v0 + d0 * 2048), b = *reinterpret_cast<const LAS i32x4a*>(v1 + d0 * 2048);
    const i32x8a vf = {a[0], a[1], a[2], a[3], b[0], b[1], b[2], b[3]};
    o[d0] = MFMA8(pa, vf, o[d0]); }
  const int one4 = 0x38383838;
  const i32x8a ones = {one4, one4, one4, one4, one4, one4, one4, one4};
  o[NDB] = MFMA8(pa, ones, o[NDB]);
}
template <int DK, int NDB, bool QK_FIRST>
__device__ __forceinline__ void mm_iter(f32x16* o, f32x16& p0, f32x16& p1, const LAS char* Vs, const LAS char* Ks, const i32x8a pa, const i32x8a* qf, int r32, int hi) {
  constexpr int NKF = DK / 32, NL = NKF + NDB;
  const int sk = kswz<DK>(r32), sv = (r32 >> 2) & 3;
  const LAS char* kr = Ks + r32 * DK;
  const LAS char* v0 = Vs + r32 * 64 + (((2 * hi) ^ sv) << 4); const LAS char* v1 = Vs + r32 * 64 + (((2 * hi + 1) ^ sv) << 4);
  i32x8a w[3];
#define MM_ISK(i) (QK_FIRST ? (i) < NKF : (i) >= NDB)
#define MM_LOAD(i) do { i32x4a a_, b_; if (MM_ISK(i)) { const int kk = QK_FIRST ? (i) : (i) - NDB, t = kk >> 1, blk = kk & 1; \
      a_ = *reinterpret_cast<const LAS i32x4a*>(kr + blk * 32 * DK + (((4 * t + 2 * hi) ^ sk) << 4)); b_ = *reinterpret_cast<const LAS i32x4a*>(kr + blk * 32 * DK + (((4 * t + 2 * hi + 1) ^ sk) << 4)); } \
    else { const int d0 = QK_FIRST ? (i) - NKF : (i); a_ = *reinterpret_cast<const LAS i32x4a*>(v0 + d0 * 2048); b_ = *reinterpret_cast<const LAS i32x4a*>(v1 + d0 * 2048); } \
    w[(i) % 3] = (i32x8a){a_[0], a_[1], a_[2], a_[3], b_[0], b_[1], b_[2], b_[3]}; } while (0)
  MM_LOAD(0); MM_LOAD(1);
#pragma unroll
  for (int i = 0; i < NL; ++i) {
    if (i + 2 < NL) MM_LOAD(i + 2);
    if (MM_ISK(i)) { const int kk = QK_FIRST ? i : i - NDB, t = kk >> 1, blk = kk & 1;
      if (blk == 0) { if (t == 0) p0 = MFMA8(w[i % 3], qf[t], f32x16{}); else p0 = MFMA8(w[i % 3], qf[t], p0); }
      else { if (t == 0) p1 = MFMA8(w[i % 3], qf[t], f32x16{}); else p1 = MFMA8(w[i % 3], qf[t], p1); } }
    else { const int d0 = QK_FIRST ? i - NKF : i; o[d0] = MFMA8(pa, w[i % 3], o[d0]);
      if (d0 == NDB - 1) { const int one4 = 0x38383838; const i32x8a ones = {one4, one4, one4, one4, one4, one4, one4, one4}; o[NDB] = MFMA8(pa, ones, o[NDB]); } }
    __builtin_amdgcn_sched_barrier(0x406);
  }
#undef MM_ISK
#undef MM_LOAD
}
template <class VAR>
__device__ __forceinline__ void attn_body(const unsigned char* __restrict__ Qb, const unsigned char* __restrict__ Kh, const unsigned char* __restrict__ VT, bf16_t* __restrict__ Ob, int seq, char* lds) {
  constexpr int DK = VAR::DK, NDB = VAR::NDB, ldq = VAR::LDQ, ldk = VAR::LDK, ldo = VAR::LDO;
  constexpr float C = VAR::SCALE * 1.4426950408889634f, thr_raw = PTHR / VAR::SCALE;
  constexpr int SHM_V = NDB * 32 * 64, SHM_K = KVBLK * DK, SHM_T = SHM_V + SHM_K, NVC = NDB / 4;
  static_assert(DK == 192 || DK == 128, "K staging is written for 128- and 192-byte key rows");
  int tid_ = threadIdx.x; asm volatile("" : "+v"(tid_));
  const int tid = tid_, wid = tid >> 6, lane = tid & 63, r32 = lane & 31, hi = lane >> 5, wu = __builtin_amdgcn_readfirstlane(wid);
  LAS char* L = (LAS char*)lds;
  LAS float* al_l = (LAS float*)(L + VAR::NB * SHM_T) + wid * 32;
  float m_reg = -1e30f; f32x16 o[NDB + 1] = {}; i32x8a qr[DK / 64];
  const unsigned char* Qw = Qb + (size_t)(wid * QBLK + r32) * ldq + hi * 32;
#pragma unroll
  for (int t = 0; t < DK / 64; ++t) { const i32x4a a = *reinterpret_cast<const i32x4a*>(Qw + t * 64), b2 = *reinterpret_cast<const i32x4a*>(Qw + t * 64 + 16);
    qr[t] = (i32x8a){a[0], a[1], a[2], a[3], b2[0], b2[1], b2[2], b2[3]}; }
  const unsigned vsrc = (unsigned)((tid >> 2) * 64 + (((tid & 3) ^ ((tid >> 4) & 3)) << 4));
  unsigned ksrc0, ksrc1 = 0;
  if constexpr (DK == 128) { const int row = tid >> 3; ksrc0 = (unsigned)(row * ldk + (((tid & 7) ^ kswz<DK>(row)) << 4)); }
  else { const int r0 = tid / 12, c0 = tid - 12 * r0, ci = 512 + wid * 32 + r32, r1 = ci / 12, c1 = ci - 12 * r1;
    ksrc0 = (unsigned)(r0 * ldk + ((c0 ^ kswz<DK>(r0)) << 4)); ksrc1 = (unsigned)(r1 * ldk + ((c1 ^ kswz<DK>(r1)) << 4)); }
#define DMA(B, tile) do { const unsigned char* vt_ = VT + (size_t)(tile) * SHM_V; const unsigned char* kt_ = Kh + (size_t)(tile) * (KVBLK * ldk); \
    _Pragma("unroll") for (int _i = 0; _i < NVC; ++_i) __builtin_amdgcn_global_load_lds((const unsigned*)(vt_ + vsrc + _i * 8192), (LAS unsigned*)(L + (B) + wu * 1024 + _i * 8192), 16, 0, 0); \
    __builtin_amdgcn_global_load_lds((const unsigned*)(kt_ + ksrc0), (LAS unsigned*)(L + (B) + SHM_V + wu * 1024), 16, 0, 0); \
    if constexpr (DK == 192) { if (hi == 0) __builtin_amdgcn_global_load_lds((const unsigned*)(kt_ + ksrc1), (LAS unsigned*)(L + (B) + SHM_V + 8192 + wu * 512), 16, 0, 0); } } while (0)
#define DWAIT() asm volatile("s_waitcnt vmcnt(0)" ::: "memory")
#define RESC(a) do { if (__any((a) < 1.f)) { if (hi == 0) al_l[r32] = (a); asm volatile("s_waitcnt lgkmcnt(0)" ::: "memory"); \
    _Pragma("unroll") for (int d = 0; d <= NDB; ++d) _Pragma("unroll") for (int r = 0; r < 16; ++r) o[d][r] *= al_l[crow(r, hi)]; } } while (0)
  const int NTL = seq / KVBLK;
  constexpr int NB = VAR::NB, IPT = NVC + (DK == 192 ? 2 : 1);
  static_assert(NB >= 3 && NB * SHM_T + NW * 128 <= 135168, "attention tile ring must fit the kernel's LDS");
#define DWAITN(NT_) asm volatile("s_waitcnt vmcnt(%0)" :: "n"((NT_) * IPT) : "memory")
  int b0 = 0, b1 = SHM_T, bn = (NB - 1) * SHM_T;
  f32x16 p0, p1; float al; i32x8a pa;
#pragma unroll 1
  for (int t = 0; t < NB - 1; ++t) DMA(t * SHM_T, t < NTL ? t : NTL - 1);
  SBAR(); DWAITN(NB - 3); __syncthreads();
  qkt<DK>(p0, p1, L + b0 + SHM_V, qr, r32, hi); softmax8(p0, p1, m_reg, al, pa, C, thr_raw);
  for (int j = 0; j + 1 < NTL; ++j) {
    { const int nt = j + NB - 1 < NTL ? j + NB - 1 : NTL - 1; DMA(bn, nt); }
    SBAR(); RESC(al); SBAR();
    mm_iter<DK, NDB, VAR::PIPE>(o, p0, p1, L + b0, L + b1 + SHM_V, pa, qr, r32, hi);
    softmax8(p0, p1, m_reg, al, pa, C, thr_raw); SBAR();
    DWAITN(NB - 3); __syncthreads();
    bn = b0; b0 = b1; b1 = b1 + SHM_T == NB * SHM_T ? 0 : b1 + SHM_T;
  }
  RESC(al); pv<NDB>(o, L + b0, pa, r32, hi);
  DWAIT();
#pragma unroll
  for (int r = 0; r < 16; ++r) { const int orow = wid * QBLK + crow(r, hi); const float rl = __builtin_amdgcn_rcpf(o[NDB][r]);
#pragma unroll
    for (int d0 = 0; d0 < NDB; ++d0) Ob[(size_t)orow * ldo + d0 * 32 + r32] = f2bf(o[d0][r] * rl); }
  __syncthreads();
#undef DMA
#undef DWAIT
#undef DWAITN
#undef RESC
}
}

struct VarMla { static constexpr int DK = 192, NDB = 4, LDQ = 1536, LDK = 1536, LDO = 2048, NB = 5; static constexpr bool PIPE = true; static constexpr float SCALE = 0.07216878364870322f; };
struct VarDiff { static constexpr int DK = 128, NDB = 8, LDQ = 1024, LDK = 1024, LDO = 2048, NB = 5; static constexpr bool PIPE = false; static constexpr float SCALE = 0.08838834764831845f; };
constexpr size_t VTA_INST = (size_t)(NKEY / 64) * 128 * 64, VTD_INST = (size_t)(NKEY / 64) * 256 * 64;
__device__ __forceinline__ void attn_unit_mla(const Params& p, char* smem, int inst, int qb) {
  const int b = inst >> 3, h = inst & 7;
  at::attn_body<VarMla>(WSP(const unsigned char, OFF_QA) + ((size_t)b * SEQ + qb * 256) * 1536 + h * 192, WSP(const unsigned char, OFF_KA) + (size_t)b * NKEY * 1536 + h * 192,
                        WSP(const unsigned char, OFF_VA) + (size_t)inst * VTA_INST, WSP(bf16_t, OFF_YIN) + ((size_t)b * SEQ + qb * 256) * 2048 + h * 128, NKEY, smem);
}
__device__ __forceinline__ void attn_unit_diff(const Params& p, char* smem, int inst, int qb) {
  const int b = inst >> 3, m = (inst >> 2) & 1, h = inst & 3;
  at::attn_body<VarDiff>(WSP(const unsigned char, OFF_QD) + ((size_t)b * SEQ + qb * 256) * 1024 + m * 512 + h * 128, WSP(const unsigned char, OFF_KD) + (size_t)b * NKEY * 1024 + m * 512 + h * 128,
                         WSP(const unsigned char, OFF_VD) + (size_t)(b * 4 + h) * VTD_INST, WSP(bf16_t, OFF_OD) + ((size_t)b * SEQ + qb * 256) * 2048 + m * 1024 + h * 256, NKEY, smem);
}
__device__ __forceinline__ void ph_attn_mla(const Params& p, char* smem) {
  for (int u0 = blockIdx.x; u0 < NB * 8 * 16; u0 += gridDim.x) {
    const int u = (gridDim.x == 256) ? ((u0 & ~255) | ((u0 & 7) << 5) | ((u0 >> 3) & 31)) : u0;
    attn_unit_mla(p, smem, u >> 4, u & 15);
  }
}
__device__ __forceinline__ void ph_attn_diff_wide(const Params& p, char* smem) {
  for (int u0 = blockIdx.x; u0 < NB * 8 * 16; u0 += gridDim.x) {
    const int u = (gridDim.x == 256) ? ((u0 & ~255) | ((u0 & 7) << 5) | ((u0 >> 3) & 31)) : u0;
    attn_unit_diff(p, smem, u >> 4, u & 15);
  }
}
constexpr int QPAT = 4, Q_ATT = 128, Q_CONV = 384, Q_WORD0 = 3584;
__device__ __forceinline__ void ph_attn_queue(const Params& p, char* smem, int* slot) {
  const int x = blockIdx.x & 7;
  unsigned* cnt = WSP(unsigned, OFF_BAR) + Q_WORD0 + 16 * x;
  for (;;) {
    if (threadIdx.x == 0) *(volatile int*)slot = (int)__hip_atomic_fetch_add(cnt, 1u, __ATOMIC_RELAXED, __HIP_MEMORY_SCOPE_AGENT);
    __syncthreads();
    const int e = __builtin_amdgcn_readfirstlane(*(volatile int*)slot);
    __syncthreads();
    if (e >= Q_ATT + Q_CONV) break;
    int att = -1, cv = -1;
    constexpr int MIXED = (Q_CONV / (QPAT - 1) < Q_ATT ? Q_CONV / (QPAT - 1) : Q_ATT) * QPAT;
    if (e < MIXED) { if (e % QPAT == 0) att = e / QPAT; else cv = e - e / QPAT - 1; }
    else { const int r = e - MIXED, na = MIXED / QPAT, nc = MIXED - na; if (na + r < Q_ATT) att = na + r; else cv = nc + (r - (Q_ATT - na)); }
    if (att >= 0) { if (att < 64) attn_unit_mla(p, smem, x * 4 + (att >> 4), att & 15); else attn_unit_diff(p, smem, x * 4 + ((att - 64) >> 4), att & 15); }
    else conv_item(p, smem, cv * 8 + x);
  }
}
#define XB_TMO      128
#define XB_XCNT(j)  (256  + 64 * (j))
#define XB_XSUB(j)  (1280 + 64 * (j))
#define XB_XGEN(j)  (2304 + 64 * (j))
#define XB_TOP      3328
#define XB_TOPGEN   3392
#define XCD_BAR_WORDS 3456
#define XB_SPIN_CAP (1u << 18)
__device__ __forceinline__ unsigned xb_ld(unsigned* p)              { return __hip_atomic_load(p, __ATOMIC_RELAXED, __HIP_MEMORY_SCOPE_AGENT); }
__device__ __forceinline__ unsigned xb_add(unsigned* p, unsigned v) { return __hip_atomic_fetch_add(p, v, __ATOMIC_RELAXED, __HIP_MEMORY_SCOPE_AGENT); }
__device__ __forceinline__ unsigned xb_xcc_id() { return (unsigned)__builtin_amdgcn_s_getreg((3 << 11) | 20) & 0xFu; }
#define XB_SPIN(cond, bar) do { unsigned _sp = 0; while (cond) { __builtin_amdgcn_s_sleep(1); \
    if ((++_sp & 255u) == 0u) { if (xb_ld(&(bar)[XB_TMO])) break; if (_sp > XB_SPIN_CAP) { atomicAdd(&(bar)[XB_TMO], 1u); break; } } } } while (0)
struct XcdBarrier { unsigned* bar; unsigned x; volatile LAS unsigned* st; };
__device__ __forceinline__ XcdBarrier xcd_barrier_post(unsigned* bar, volatile LAS unsigned* st) {
    XcdBarrier b; b.bar = bar; b.x = xb_xcc_id(); b.st = st;
    if (threadIdx.x == 0) (void)xb_add(&bar[XB_XCNT(b.x)], 1u);
    return b;
}
__device__ __forceinline__ void xcd_barrier_complete(unsigned* bar, unsigned x, unsigned& nloc, unsigned& nx) {
    const unsigned G = gridDim.x * gridDim.y * gridDim.z;
    unsigned sum, cnt, mine, sp = 0u;
    for (;;) {
        sum = 0u; cnt = 0u; mine = 0u;
#pragma unroll
        for (unsigned j = 0; j < 16; ++j) { const unsigned c = xb_ld(&bar[XB_XCNT(j)]); sum += c; cnt += (c > 0u) ? 1u : 0u; mine = (j == x) ? c : mine; }
        if (sum == G) break;
        __builtin_amdgcn_s_sleep(1);
        if ((++sp & 255u) == 0u) { if (xb_ld(&bar[XB_TMO])) break; if (sp > XB_SPIN_CAP) { atomicAdd(&bar[XB_TMO], 1u); break; } }
    }
    nloc = mine > 0u ? mine : 1u; nx = cnt > 0u ? cnt : 1u;
}
__device__ __forceinline__ void xcd_barrier(const XcdBarrier& b) {
    asm volatile("s_waitcnt vmcnt(0)" ::: "memory");
    __syncthreads();
    if (threadIdx.x == 0) {
        unsigned* bar = b.bar;
        __builtin_amdgcn_s_waitcnt(0);
        unsigned nloc = b.st[0], nx = b.st[1];
        if (nloc == 0u) { xcd_barrier_complete(bar, b.x, nloc, nx); b.st[0] = nloc; b.st[1] = nx; }
        const unsigned old = xb_add(&bar[XB_XSUB(b.x)], 1u);
        const unsigned gen = old / nloc;
        if (old + 1u == (gen + 1u) * nloc) {
            __builtin_amdgcn_fence(__ATOMIC_RELEASE, "agent");
            asm volatile("s_waitcnt vmcnt(0)" ::: "memory");
            const unsigned og = xb_add(&bar[XB_TOP], 1u);
            const unsigned tg = og / nx;
            if (og + 1u == (tg + 1u) * nx) xb_add(&bar[XB_TOPGEN], 1u);
            else XB_SPIN(xb_ld(&bar[XB_TOPGEN]) == tg, bar);
            __builtin_amdgcn_fence(__ATOMIC_ACQUIRE, "agent");
            xb_add(&bar[XB_XGEN(b.x)], 1u);
            asm volatile("s_waitcnt vmcnt(0)" ::: "memory");
        } else {
            XB_SPIN(xb_ld(&bar[XB_XGEN(b.x)]) == gen, bar);
            __builtin_amdgcn_fence(__ATOMIC_ACQUIRE, "agent");
            asm volatile("s_waitcnt vmcnt(0)" ::: "memory");
        }
    }
    __syncthreads();
}

#define FGRID(A_, sA_, lda_, B_, sB_, ldb_, nM_, nN_, ng_) fg::Grid{(const char*)(A_), (const char*)(B_), (size_t)(sA_), (size_t)(sB_), lda_, ldb_, nM_, nN_, ng_, (int)gridDim.x, (int)blockIdx.x}
#define FLDS ((LAS unsigned char*)smem)
constexpr int SMEM_MAIN = 135168;
template <int L> __device__ __forceinline__ void ph_moe_gemms_gu(const Params& p, char* smem) {
  fg::gemm_fast<fg::EpiGU, true, true>(FLDS, FGRID(WSP(char, OFF_H), 0, 1024, WSP(char, OFF_WGU) + (size_t)L * NE * 4096 * 2048, (size_t)4096 * 2048, 1024, 8, 16, NE),
                                       fg::EpiGU{WSP(unsigned char, OFF_HID)}, 1024, WSP(const int, OFF_IDX));
}
template <int L> __device__ __forceinline__ void ph_moe_gemms_down(const Params& p, char* smem) {
  fg::gemm_fast<fg::EpiDown, false, true>(FLDS, FGRID(WSP(char, OFF_HID), (size_t)2048 * 2048, 1024, WSP(char, OFF_WD) + (size_t)L * NE * 2048 * 2048, (size_t)2048 * 2048, 1024, 8, 8, NE),
                                          fg::EpiDown{WSP(bf16_t, OFF_YE), WSP(const float, OFF_GATE)}, 1024);
}
__global__ __launch_bounds__(512, 2) void mega(Params p) {
  __shared__ __attribute__((aligned(16))) char smem[SMEM_MAIN + 32];
  volatile LAS unsigned* xst = (volatile LAS unsigned*)(smem + SMEM_MAIN);
  if (threadIdx.x == 0) { xst[0] = 0u; xst[1] = 0u; xst[2] = 0u; xst[3] = 0u; }
  __syncthreads();
  const XcdBarrier bar = xcd_barrier_post(WSP(unsigned, OFF_BAR), xst);
#define GSYNC() xcd_barrier(bar)
  const bool split = gridDim.x == 256;
  if ((blockIdx.x >> 3) & 1) { ph_twiddle(p, smem); ph_weights_small(p, smem); ph_mod(p, smem); } else { ph_mod(p, smem); ph_weights_small(p, smem); ph_twiddle(p, smem); }
  if (!split) ph_weights_expert(p, smem, blockIdx.x, gridDim.x);
  GSYNC();
  ph_pre0(p); GSYNC();
  fg::gemm_fast<fg::EpiIn0, false, true>(FLDS, FGRID(WSP(char, OFF_H), 0, DM / 2, WSP(char, OFF_WIN0), 0, DM / 2, 68, 17, 1), fg::EpiIn0{WSP(bf16_t, OFF_P0), WSP(unsigned char, OFF_QD), WSP(unsigned char, OFF_KD), WSP(unsigned char, OFF_VD)}, DM / 2); GSYNC();
  ph_post_inproj(p); GSYNC();
  fg::gemm_fast(FLDS, FGRID(WSP(bf16_t, OFF_CQN), 0, 512, WSP(bf16_t, OFF_WUQ), 0, 512, 64, 6, 1), fg::EpiQRope{WSP(unsigned char, OFF_QA)}, 512);
  fg::gemm_fast(FLDS, FGRID(WSP(bf16_t, OFF_CKVN), 0, 512, WSP(bf16_t, OFF_WUKV), 0, 512, 68, 8, 1), fg::EpiKV{WSP(unsigned char, OFF_KA), WSP(unsigned char, OFF_VA)}, 512); GSYNC();
  if (split) ph_attn_queue(p, smem, (int*)(smem + SMEM_MAIN + 16)); else { ph_attn_mla(p, smem); ph_attn_diff_wide(p, smem); }
  GSYNC();
  ph_diffcomb(p); GSYNC();
  fg::gemm_fast(FLDS, FGRID(WSP(bf16_t, OFF_YIN), 0, DM, WSP(bf16_t, OFF_WOUT0), 0, DM, 64, 8, 1), fg::EpiResid<true>{WSP(bf16_t, OFF_XL), p.x, WSP(const float, OFF_ML)}, DM); GSYNC();
  ph_ffn_pre(p, 0, smem); GSYNC();
  ph_topk(p, smem); GSYNC();
  ph_moe_gemms_gu<0>(p, smem); GSYNC();
  ph_moe_gemms_down<0>(p, smem); GSYNC();
  ph_combine(p, 0); GSYNC();
  fg::gemm_fast(FLDS, FGRID(WSP(bf16_t, OFF_H), 0, DM, WSP(bf16_t, OFF_WIN1), 0, DM, 64, 8, 1), fg::EpiBf16{WSP(bf16_t, OFF_Z), DM, DM, 1.f, 1, 0, 0}, DM); GSYNC();
  ph_pool(p);
  fg::gemm_fast(FLDS, FGRID(WSP(bf16_t, OFF_MC), (size_t)512 * 256 * 2, 256, WSP(bf16_t, OFF_Z) + 1024, 512, DM, 2, 64, 4), fg::EpiChanDft{WSP(bf16_t, OFF_ABT2)}, 256); GSYNC();
  ph_fold(p);
  fg::gemm_fast(FLDS, FGRID(WSP(bf16_t, OFF_POOLED), 512, 1024, WSP(bf16_t, OFF_WPOOL), 65536 * 2, 256, 64, 1, 4), fg::EpiScaleCol{WSP(bf16_t, OFF_YCAT), p.pool_scale}, 256); GSYNC();
  { fg::Grid gq = FGRID(WSP(bf16_t, OFF_TW), 0, 4096, WSP(bf16_t, OFF_ABTF), (size_t)256 * 4096 * 2, 4096, 8, 1, 32);
    gq.gd = 2; gq.sA2 = (size_t)2048 * 2; gq.sB2 = (size_t)2048 * 2;
    fg::gemm_fast(FLDS, gq, fg::EpiBf16{WSP(bf16_t, OFF_SPEC), 256, 256, 1.f, 1, (size_t)2048 * 256, 0}, 2048); }
  GSYNC();
  ph_dftcomb(p); GSYNC();
  fg::gemm_fast(FLDS, FGRID(WSP(bf16_t, OFF_YCAT), 0, DM, WSP(bf16_t, OFF_WOUT1), 0, DM, 64, 8, 1), fg::EpiResid<false>{WSP(bf16_t, OFF_XL), WSP(const bf16_t, OFF_XL), WSP(const float, OFF_ML) + 5 * MLW}, DM); GSYNC();
  ph_ffn_pre(p, 1, smem); GSYNC();
  ph_topk(p, smem); GSYNC();
  ph_moe_gemms_gu<1>(p, smem); GSYNC();
  ph_moe_gemms_down<1>(p, smem); GSYNC();
  ph_combine(p, 1);
}

extern "C" void kernel_launch(void* const* d_in, const int* in_sizes, int n_in, void* d_out, int out_size, void* d_ws, size_t ws_size, hipStream_t stream) {
  if (n_in != 29 || ws_size < WS_NEED) { fprintf(stderr, "kernel_launch: bad args n_in %d ws %zu need %zu\n", n_in, ws_size, WS_NEED); return; }
  Params p{};
  const float** f = (const float**)&p;
  for (int i = 0; i < 29; ++i) f[i] = (const float*)d_in[i];
  p.out = (float*)d_out; p.ws = (char*)d_ws;
  static int grid = 0;
  if (!grid) {
    int dev = 0, cus = 0, per_cu = 0;
    (void)hipGetDevice(&dev);
    (void)hipDeviceGetAttribute(&cus, hipDeviceAttributeMultiprocessorCount, dev);
    (void)hipOccupancyMaxActiveBlocksPerMultiprocessor(&per_cu, (const void*)mega, 512, 0);
    if (cus <= 0) cus = 256;
    grid = per_cu >= 1 ? cus : 0;
    if (!grid) { fprintf(stderr, "kernel_launch: occupancy query says 0 blocks per CU\n"); return; }
  }
  (void)hipMemsetAsync(d_ws, 0, 16384, stream);
  hipLaunchKernelGGL(mega, dim3(grid), dim3(512), 0, stream, p);
}
```

```cpp
#include <hip/hip_runtime.h>
#include <stdint.h>
#include <cstdio>

typedef unsigned short bf16_t;
typedef short bf16x8 __attribute__((ext_vector_type(8)));
typedef float f32x4 __attribute__((ext_vector_type(4)));
typedef unsigned u32x4 __attribute__((ext_vector_type(4)));
typedef unsigned u32x2 __attribute__((ext_vector_type(2)));

constexpr int DM = 2048, NB = 4, SEQ = 4096, NT = NB * SEQ, CTXL = 256, NC = NB * CTXL, NA = NT + NC, NKEY = SEQ + CTXL;
constexpr int EIN = 4160, EINP = 4352, P0W = 1088;
constexpr int NE = 16, CAP = 512, FF = 2048, MLW = 6 * DM;
constexpr float EPS = 1e-6f;

constexpr size_t al256(size_t x) { return (x + 255) / 256 * 256; }
constexpr size_t OFF_BAR = 0;
constexpr size_t OFF_ML = 16384;
constexpr size_t OFF_AFF = OFF_ML + al256((size_t)2 * 5 * MLW * 4);
constexpr size_t OFF_IDX = OFF_AFF + (size_t)NB * NE * SEQ * 4;
constexpr size_t OFF_GATE = OFF_IDX + (size_t)NB * NE * CAP * 4;
constexpr size_t OFF_INV = OFF_GATE + (size_t)NB * NE * CAP * 4;
constexpr size_t OFF_WIN0 = OFF_INV + (size_t)NT * NE * 4;
constexpr size_t OFF_WUQ = OFF_WIN0 + (size_t)EINP * DM * 2;
constexpr size_t OFF_WUKV = OFF_WUQ + (size_t)1536 * 512 * 2;
constexpr size_t OFF_WOUT0 = OFF_WUKV + (size_t)2048 * 512 * 2;
constexpr size_t OFF_WIN1 = OFF_WOUT0 + (size_t)DM * DM * 2;
constexpr size_t OFF_WOUT1 = OFF_WIN1 + (size_t)DM * DM * 2;
constexpr size_t OFF_WPOOL = OFF_WOUT1 + (size_t)DM * DM * 2;
constexpr size_t OFF_WFOUR = OFF_WPOOL + (size_t)4 * 256 * 256 * 2;
constexpr size_t OFF_MC = OFF_WFOUR + (size_t)4 * 256 * 256 * 2;
constexpr size_t OFF_TW = OFF_MC + (size_t)4 * 512 * 256 * 2;
constexpr size_t OFF_WGU = OFF_TW + (size_t)4096 * 8192 * 2;
constexpr size_t OFF_WD = OFF_WGU + (size_t)2 * NE * 4096 * 2048 * 2;
constexpr size_t OFF_XL = OFF_WD + (size_t)2 * NE * 2048 * 2048 * 2;
constexpr size_t OFF_H = OFF_XL + (size_t)NT * DM * 4;
constexpr size_t OFF_SCR = OFF_H + (size_t)NA * DM * 2;
constexpr size_t OFF_P0 = OFF_SCR;
constexpr size_t OFF_CQN = OFF_P0 + al256((size_t)NA * EIN * 2);
constexpr size_t OFF_CKVN = OFF_CQN + (size_t)NT * 512 * 2;
constexpr size_t OFF_QA = OFF_CKVN + (size_t)NA * 512 * 2;
constexpr size_t OFF_KA = OFF_QA + (size_t)NT * 1536 * 2;
constexpr size_t OFF_VA = OFF_KA + (size_t)NA * 1536 * 2;
constexpr size_t OFF_QD = OFF_VA + (size_t)NA * 1024 * 2;
constexpr size_t OFF_KD = OFF_QD + (size_t)NT * 1024 * 2;
constexpr size_t OFF_VD = OFF_KD + (size_t)NA * 1024 * 2;
constexpr size_t OFF_OD = OFF_VD + (size_t)NA * 1024 * 2;
constexpr size_t OFF_YIN = OFF_OD + (size_t)NT * 2048 * 4;
constexpr size_t OFF_M0END = OFF_YIN + (size_t)NT * 2048 * 2;
constexpr size_t OFF_XE = OFF_SCR;
constexpr size_t OFF_HID = OFF_XE + (size_t)NE * 2048 * 2048 * 2;
constexpr size_t OFF_YE = OFF_HID + (size_t)NE * 2048 * 2048 * 2;
constexpr size_t OFF_Z = OFF_SCR;
constexpr size_t OFF_POOLED = OFF_Z + (size_t)NT * 2048 * 2;
constexpr size_t OFF_ABT2 = OFF_POOLED + (size_t)NT * 1024 * 2;
constexpr size_t OFF_SPEC = OFF_ABT2 + (size_t)16 * 256 * 8192 * 2;
constexpr size_t OFF_YCAT = OFF_SPEC + (size_t)NT * 1024 * 2;
constexpr size_t OFF_ABTF = OFF_YCAT + (size_t)NT * 2048 * 2;
constexpr size_t OFF_SBUF = OFF_M0END;
constexpr size_t OFF_PBUF = OFF_SBUF + (size_t)SEQ * NKEY * 4;
constexpr size_t OFF_VT = OFF_PBUF + (size_t)SEQ * NKEY * 2;
constexpr size_t WS_NEED = OFF_VT + (size_t)256 * NKEY * 2;

struct Params {
  const float *x, *c, *ctx, *c_ctx, *mod_w, *mod_b, *norm_mix, *norm_ffn, *even_w_in, *q_norm, *w_uq, *kv_norm, *w_ukv,
      *lq1, *lk1, *lq2, *lk2, *subln, *even_w_out, *odd_w_in, *pool_w, *pool_scale, *fourier_w, *odd_w_out, *router_w,
      *w_gate, *w_up, *w_down, *final_norm;
  float* out;
  char* ws;
};
#define WSP(T, off) ((T*)(p.ws + (off)))

typedef float f32x2 __attribute__((ext_vector_type(2)));
typedef __bf16 bf16x2_t __attribute__((ext_vector_type(2)));
__device__ __forceinline__ unsigned cvtpk(float lo, float hi) { f32x2 v = {lo, hi}; bf16x2_t r = __builtin_convertvector(v, bf16x2_t); return __builtin_bit_cast(unsigned, r); }
__device__ __forceinline__ unsigned pack_fp8x4(float a, float b, float c, float d) {
  a = __builtin_amdgcn_fmed3f(a, -448.f, 448.f); b = __builtin_amdgcn_fmed3f(b, -448.f, 448.f); c = __builtin_amdgcn_fmed3f(c, -448.f, 448.f); d = __builtin_amdgcn_fmed3f(d, -448.f, 448.f);
  unsigned w = 0; w = __builtin_amdgcn_cvt_pk_fp8_f32(a, b, w, false); w = __builtin_amdgcn_cvt_pk_fp8_f32(c, d, w, true); return w;
}
__device__ __forceinline__ float bf_lo(unsigned w) { return __uint_as_float(w << 16); }
__device__ __forceinline__ float bf_hi(unsigned w) { return __uint_as_float(w & 0xffff0000u); }
__device__ __forceinline__ float bf2f(bf16_t b) { return __uint_as_float(((unsigned)b) << 16); }
__device__ __forceinline__ bf16_t f2bf(float f) { return (bf16_t)(cvtpk(f, 0.f) & 0xffffu); }
__device__ __forceinline__ float wave_sum(float v) {
#pragma unroll
  for (int o = 32; o > 0; o >>= 1) v += __shfl_xor(v, o, 64);
  return v;
}
__device__ __forceinline__ float wave_max(float v) {
#pragma unroll
  for (int o = 32; o > 0; o >>= 1) v = fmaxf(v, __shfl_xor(v, o, 64));
  return v;
}
__device__ __forceinline__ int otid() { int t = threadIdx.x; asm volatile("" : "+v"(t)); return t; }
__device__ __forceinline__ int gwave() { return blockIdx.x * (blockDim.x >> 6) + (otid() >> 6); }
__device__ __forceinline__ int nwave() { return gridDim.x * (blockDim.x >> 6); }
__device__ __forceinline__ const float* mlp(const Params& p, int l, int row) { return WSP(const float, OFF_ML) + ((size_t)l * 5 + row) * MLW; }

template <int MODE>
__device__ __forceinline__ int rowmap(int n) {
  if (MODE == 0) return n;
  if (MODE == 4) return ((n & 255) < 128) ? ((n >> 8) * 128 + (n & 127)) : (1024 + (n >> 8) * 128 + (n & 127));
  if (MODE == 3) { if (n < 1088 || n >= 3136) return n; const int v = (n - 1088) >> 7, e = (n - 1088) & 127;
    return 1088 + v * 128 + ((2 * (e >> 6) + ((e >> 4) & 1)) << 5) + (((e >> 5) & 1) << 4) + (e & 15); }
  return 32 * (n >> 4) + (n & 15) + (MODE == 2 ? 16 : 0);
}
template <int MODE, bool F8 = false>
__device__ __forceinline__ void tconv(const float* __restrict__ src, int K, int N, int Npad, bf16_t* __restrict__ dst, char* smem) {
  float(*tile)[257] = (float(*)[257])smem;
  const int tid = otid(), tk = K / 64, tn = Npad / 256;
  for (int t = blockIdx.x; t < tk * tn; t += gridDim.x) {
    const int k0 = (t % tk) * 64, n0 = (t / tk) * 256;
#pragma unroll
    for (int i = 0; i < 8; ++i) {
      const int id = tid + i * 512, k = id >> 6, n4 = (id & 63) * 4;
      f32x4 v = {0.f, 0.f, 0.f, 0.f};
      if (n0 + n4 < N) v = *(const f32x4*)(src + (size_t)(k0 + k) * N + n0 + n4);
      tile[k][n4 + 0] = v[0]; tile[k][n4 + 1] = v[1]; tile[k][n4 + 2] = v[2]; tile[k][n4 + 3] = v[3];
    }
    __syncthreads();
    {
      const int n = tid >> 1, kh = (tid & 1) * 32;
      if constexpr (F8) {
        unsigned char* drow8 = (unsigned char*)dst + (size_t)rowmap<MODE>(n0 + n) * K + k0 + kh;
#pragma unroll
        for (int i = 0; i < 2; ++i) {
          u32x4 w;
#pragma unroll
          for (int q = 0; q < 4; ++q) { const int kk = kh + i * 16 + q * 4; w[q] = pack_fp8x4(tile[kk][n] * 32.f, tile[kk + 1][n] * 32.f, tile[kk + 2][n] * 32.f, tile[kk + 3][n] * 32.f); }
          *(u32x4*)(drow8 + i * 16) = w;
        }
      } else {
      bf16_t* drow = dst + (size_t)rowmap<MODE>(n0 + n) * K + k0 + kh;
#pragma unroll
      for (int i = 0; i < 4; ++i) {
        u32x4 w;
        w[0] = cvtpk(tile[kh + i * 8 + 0][n], tile[kh + i * 8 + 1][n]);
        w[1] = cvtpk(tile[kh + i * 8 + 2][n], tile[kh + i * 8 + 3][n]);
        w[2] = cvtpk(tile[kh + i * 8 + 4][n], tile[kh + i * 8 + 5][n]);
        w[3] = cvtpk(tile[kh + i * 8 + 6][n], tile[kh + i * 8 + 7][n]);
        *(u32x4*)(drow + i * 8) = w;
      }
      }
    }
    __syncthreads();
  }
}

constexpr float W8_SCALE = 32.f;
__device__ __forceinline__ void tconv8_tile(const float* __restrict__ src, int K, int N, unsigned char* __restrict__ dst, int mode, int k0, int n0, char* smem) {
  unsigned* img = (unsigned*)smem;
  const int tid = otid();
  f32x4 va[8], vb[8];
#define T8_LOAD(V, S) do { _Pragma("unroll") for (int j = 0; j < 2; ++j) { const int id = tid + j * 512; const float* bp = src + (size_t)(k0 + (S) * 16 + (id >> 8) * 4) * N + n0 + (id & 255) * 4; \
    _Pragma("unroll") for (int r = 0; r < 4; ++r) V[j * 4 + r] = __builtin_nontemporal_load((const f32x4*)(bp + (size_t)r * N)); } } while (0)
#define T8_PUT(V, S) do { _Pragma("unroll") for (int j = 0; j < 2; ++j) { const int id = tid + j * 512; unsigned* ip = img + ((id & 255) * 4) * 33 + (S) * 4 + (id >> 8); \
    _Pragma("unroll") for (int q = 0; q < 4; ++q) ip[q * 33] = pack_fp8x4(V[j * 4 + 0][q] * W8_SCALE, V[j * 4 + 1][q] * W8_SCALE, V[j * 4 + 2][q] * W8_SCALE, V[j * 4 + 3][q] * W8_SCALE); } } while (0)
  T8_LOAD(va, 0);
#pragma unroll
  for (int s2 = 0; s2 < 4; ++s2) {
    T8_LOAD(vb, 2 * s2 + 1);
    T8_PUT(va, 2 * s2);
    if (s2 < 3) T8_LOAD(va, 2 * s2 + 2);
    T8_PUT(vb, 2 * s2 + 1);
  }
  __syncthreads();
#pragma unroll
  for (int i = 0; i < 16; ++i) {
    const int idx = tid + i * 512, n = idx >> 3, ch = idx & 7, ng = n0 + n;
    const int drow = mode == 0 ? ng : (32 * (ng >> 4) + (ng & 15) + (mode == 2 ? 16 : 0));
    const unsigned* ip = img + n * 33 + ch * 4;
    const u32x4 w = {ip[0], ip[1], ip[2], ip[3]};
    __builtin_nontemporal_store(w, (u32x4*)(dst + (size_t)drow * K + k0 + ch * 16));
  }
  __syncthreads();
#undef T8_LOAD
#undef T8_PUT
}
__device__ __forceinline__ void ph_weights_small(const Params& p, char* smem) {
  tconv<3, true>(p.even_w_in, DM, EIN, EINP, WSP(bf16_t, OFF_WIN0), smem);
  tconv<0>(p.w_uq, 512, 1536, 1536, WSP(bf16_t, OFF_WUQ), smem);
  tconv<4>(p.w_ukv, 512, 2048, 2048, WSP(bf16_t, OFF_WUKV), smem);
  tconv<0>(p.even_w_out, DM, DM, DM, WSP(bf16_t, OFF_WOUT0), smem);
  tconv<0>(p.odd_w_in, DM, DM, DM, WSP(bf16_t, OFF_WIN1), smem);
  tconv<0>(p.odd_w_out, DM, DM, DM, WSP(bf16_t, OFF_WOUT1), smem);
  for (int g = 0; g < 4; ++g) {
    tconv<0>(p.pool_w + (size_t)g * 65536, 256, 256, 256, WSP(bf16_t, OFF_WPOOL) + (size_t)g * 65536, smem);
  }
}
__device__ __forceinline__ void conv_item(const Params& p, char* smem, int g) {
  const int mat = g >> 5, st = g & 31, le = mat / 3, which = mat - 3 * le, k0 = (st & 15) * 128, n0 = (st >> 4) * 1024;
  const size_t so = (size_t)le * 2048 * 2048;
  const float* src = (which == 0 ? p.w_gate : (which == 1 ? p.w_up : p.w_down)) + so;
  unsigned char* dst = which == 2 ? WSP(unsigned char, OFF_WD) + so : WSP(unsigned char, OFF_WGU) + (size_t)le * 4096 * 2048;
  tconv8_tile(src, 2048, 2048, dst, which == 2 ? 0 : which + 1, k0, n0, smem);
}
__device__ __forceinline__ void ph_weights_expert(const Params& p, char* smem, int widx, int wcount) {
  for (int g = widx; g < 2 * NE * 3 * 32; g += wcount) conv_item(p, smem, g);
}

__device__ __forceinline__ void ph_mod(const Params& p, char* smem) {
  float* sc = (float*)smem;
  float* part = sc + 5 * 2048;
  const int tid = otid();
  for (int i = tid; i < 5 * 2048; i += 512) {
    const int r = i >> 11, k = i & 2047;
    const float v = r < 4 ? p.c[r * 2048 + k] : p.c_ctx[k];
    sc[i] = v / (1.f + __expf(-v));
  }
  __syncthreads();
  for (int cb = blockIdx.x; cb < 256; cb += gridDim.x) {
    const int l = cb >> 7, j0 = (cb & 127) * 96;
    const int c4 = tid % 24, kg = tid / 24;
    if (tid < 504) {
      f32x4 acc[5];
#pragma unroll
      for (int r = 0; r < 5; ++r) acc[r] = (f32x4){0.f, 0.f, 0.f, 0.f};
      const float* wp = p.mod_w + (size_t)l * 2048 * MLW + j0 + c4 * 4;
#pragma unroll 4
      for (int k = kg; k < 2048; k += 21) {
        const f32x4 w = *(const f32x4*)(wp + (size_t)k * MLW);
#pragma unroll
        for (int r = 0; r < 5; ++r) acc[r] += sc[r * 2048 + k] * w;
      }
#pragma unroll
      for (int r = 0; r < 5; ++r)
#pragma unroll
        for (int q = 0; q < 4; ++q) part[(kg * 5 + r) * 96 + c4 * 4 + q] = acc[r][q];
    }
    __syncthreads();
    if (tid < 480) {
      const int r = tid / 96, col = tid % 96;
      float s = p.mod_b[l * MLW + j0 + col];
      for (int g = 0; g < 21; ++g) s += part[(g * 5 + r) * 96 + col];
      WSP(float, OFF_ML)[((size_t)l * 5 + r) * MLW + j0 + col] = s;
    }
    __syncthreads();
  }
}

__device__ __forceinline__ void ph_twiddle(const Params& p, char* smem) {
  float* ct = (float*)smem;
  for (int j = otid(); j < 4096; j += 512) ct[j] = cospif((float)j * (1.f / 2048.f));
  __syncthreads();
  bf16_t* tw = WSP(bf16_t, OFF_TW);
  const size_t nchunk = (size_t)2048 * 512;
  for (size_t q = (size_t)blockIdx.x * 512 + otid(); q < nchunk; q += (size_t)gridDim.x * 512) {
    const int k1 = (int)(q >> 9), kk0 = (int)(q & 511) * 8;
    float v[8];
#pragma unroll
    for (int j = 0; j < 8; ++j) {
      const int kk = kk0 + j;
      if (kk <= 2048) v[j] = ct[(k1 * kk) & 4095];
      else v[j] = -ct[(k1 * (kk - 2048) - 1024) & 4095];
    }
    u32x4 w = {cvtpk(v[0], v[1]), cvtpk(v[2], v[3]), cvtpk(v[4], v[5]), cvtpk(v[6], v[7])};
    *(u32x4*)(tw + q * 8) = w;
  }
  bf16_t* mc = WSP(bf16_t, OFF_MC);
  for (int i = blockIdx.x * 512 + otid(); i < 4 * 256 * 256; i += gridDim.x * 512) {
    const int d = i & 255, c = (i >> 8) & 255, g = i >> 16;
    const float* fw = p.fourier_w + (size_t)g * 65536 + d;
    float ac = 0.f, as = 0.f;
#pragma unroll 8
    for (int k2 = 0; k2 < 256; ++k2) {
      const int ph = ((k2 * c) & 255) * 16; const float f = fw[k2 * 256];
      ac += f * ct[ph]; as += f * ct[(ph - 1024) & 4095];
    }
    mc[((size_t)(g * 512 + d) * 256) + c] = f2bf(ac); mc[((size_t)(g * 512 + 256 + d) * 256) + c] = f2bf(as);
  }
  __syncthreads();
}

struct Row8 { f32x4 v[8]; };
__device__ __forceinline__ float row_load_ss(const float* src, int lane, Row8& r) {
  float ss = 0.f;
#pragma unroll
  for (int i = 0; i < 8; ++i) { r.v[i] = *(const f32x4*)(src + i * 256 + lane * 4); ss += r.v[i][0] * r.v[i][0] + r.v[i][1] * r.v[i][1] + r.v[i][2] * r.v[i][2] + r.v[i][3] * r.v[i][3]; }
  return wave_sum(ss);
}
__device__ __forceinline__ float row_load_ss_bf16(const bf16_t* src, int lane, Row8& r) {
  float ss = 0.f;
#pragma unroll
  for (int i = 0; i < 8; ++i) { const u32x2 w = *(const u32x2*)(src + i * 256 + lane * 4); r.v[i] = (f32x4){bf_lo(w[0]), bf_hi(w[0]), bf_lo(w[1]), bf_hi(w[1])};
    ss += r.v[i][0] * r.v[i][0] + r.v[i][1] * r.v[i][1] + r.v[i][2] * r.v[i][2] + r.v[i][3] * r.v[i][3]; }
  return wave_sum(ss);
}
__device__ __forceinline__ void row_norm_mod(Row8& r, float inv, const float* gain, const float* sc, const float* sh, int lane) {
#pragma unroll
  for (int i = 0; i < 8; ++i) {
    const int j = i * 256 + lane * 4;
    const f32x4 g = *(const f32x4*)(gain + j);
    f32x4 y = r.v[i] * inv * g;
    if (sc) { const f32x4 s1 = *(const f32x4*)(sc + j), s0 = *(const f32x4*)(sh + j); y = y * (1.f + s1) + s0; }
    r.v[i] = y;
  }
}
__device__ __forceinline__ void row_store_fp8(const Row8& r, unsigned char* dst, int lane) {
#pragma unroll
  for (int i = 0; i < 8; ++i) *(unsigned*)(dst + i * 256 + lane * 4) = pack_fp8x4(r.v[i][0], r.v[i][1], r.v[i][2], r.v[i][3]);
}
__device__ __forceinline__ void row_store_bf16(const Row8& r, bf16_t* dst, int lane) {
#pragma unroll
  for (int i = 0; i < 8; ++i) { u32x2 w = {cvtpk(r.v[i][0], r.v[i][1]), cvtpk(r.v[i][2], r.v[i][3])}; *(u32x2*)(dst + i * 256 + lane * 4) = w; }
}

__device__ __forceinline__ void ph_pre0(const Params& p) {
  const int lane = otid() & 63;
  for (int r = gwave(); r < NA; r += nwave()) {
    const float* src = r < NT ? p.x + (size_t)r * DM : p.ctx + (size_t)(r - NT) * DM;
    const float* ml = mlp(p, 0, r < NT ? r / SEQ : 4);
    Row8 row; const float ss = row_load_ss(src, lane, row);
    row_norm_mod(row, rsqrtf(ss * (1.f / DM) + EPS), p.norm_mix, ml + 2048, ml, lane);
    row_store_fp8(row, WSP(unsigned char, OFF_H) + (size_t)r * DM, lane);
  }
}

__device__ __forceinline__ float rope_inv_freq(int q, int quarter) { return exp2f(-(float)q / (float)quarter * 13.287712379549449f); }

__device__ __forceinline__ void ph_post_inproj(const Params& p) {
  const int lane = otid() & 63;
  const bf16_t* P0 = WSP(const bf16_t, OFF_P0);
  for (int r = gwave(); r < NA; r += nwave()) {
    const bool lat = r < NT;
    int b, keyrow, prow = 0, pcol = 0;
    if (lat) { b = r / SEQ; const int n = r % SEQ; keyrow = b * NKEY + CTXL + n; prow = n >> 6; pcol = n & 63; }
    else { const int i = r - NT; b = i / CTXL; keyrow = b * NKEY + (i % CTXL); }
    const bf16_t* row = P0 + (size_t)r * P0W;
    const u32x4 wq = *(const u32x4*)(row + lane * 8), wkv = *(const u32x4*)(row + 512 + lane * 8);
    const float xkr = bf2f(row[1024 + lane]);
    asm volatile("" ::: "memory");
    if (lat) {
      const u32x4 w = wq;
      float v[8] = {bf_lo(w[0]), bf_hi(w[0]), bf_lo(w[1]), bf_hi(w[1]), bf_lo(w[2]), bf_hi(w[2]), bf_lo(w[3]), bf_hi(w[3])};
      float ss = 0.f;
#pragma unroll
      for (int j = 0; j < 8; ++j) ss += v[j] * v[j];
      const float inv = rsqrtf(wave_sum(ss) * (1.f / 512.f) + EPS);
      const f32x4 g0 = *(const f32x4*)(p.q_norm + lane * 8), g1 = *(const f32x4*)(p.q_norm + lane * 8 + 4);
      u32x4 o = {cvtpk(v[0] * inv * g0[0], v[1] * inv * g0[1]), cvtpk(v[2] * inv * g0[2], v[3] * inv * g0[3]),
                 cvtpk(v[4] * inv * g1[0], v[5] * inv * g1[1]), cvtpk(v[6] * inv * g1[2], v[7] * inv * g1[3])};
      *(u32x4*)(WSP(bf16_t, OFF_CQN) + (size_t)r * 512 + lane * 8) = o;
    }
    {
      const u32x4 w = wkv;
      float v[8] = {bf_lo(w[0]), bf_hi(w[0]), bf_lo(w[1]), bf_hi(w[1]), bf_lo(w[2]), bf_hi(w[2]), bf_lo(w[3]), bf_hi(w[3])};
      float ss = 0.f;
#pragma unroll
      for (int j = 0; j < 8; ++j) ss += v[j] * v[j];
      const float inv = rsqrtf(wave_sum(ss) * (1.f / 512.f) + EPS);
      const f32x4 g0 = *(const f32x4*)(p.kv_norm + lane * 8), g1 = *(const f32x4*)(p.kv_norm + lane * 8 + 4);
      u32x4 o = {cvtpk(v[0] * inv * g0[0], v[1] * inv * g0[1]), cvtpk(v[2] * inv * g0[2], v[3] * inv * g0[3]),
                 cvtpk(v[4] * inv * g1[0], v[5] * inv * g1[1]), cvtpk(v[6] * inv * g1[2], v[7] * inv * g1[3])};
      *(u32x4*)(WSP(bf16_t, OFF_CKVN) + (size_t)r * 512 + lane * 8) = o;
    }
    const float pos = (lane >> 5) ? (float)pcol : (float)prow;
    const bool second = (lane >> 4) & 1;
    float c64 = 1.f, s64 = 0.f;
    if (lat) sincosf(pos * rope_inv_freq(lane & 15, 16), &s64, &c64);
    {
      const float xs = xkr;
      const float xp = __shfl_xor(xs, 16, 64);
      const float o = second ? (xs * c64 + xp * s64) : (xs * c64 - xp * s64);
      const unsigned char ob = (unsigned char)(pack_fp8x4(o, o, o, o) & 0xffu);
      unsigned char* ka = WSP(unsigned char, OFF_KA) + (size_t)keyrow * 1536 + 128 + (lane & 32) + 8 * ((lane & 15) >> 2) + 4 * ((lane >> 4) & 1) + (lane & 3);
#pragma unroll
      for (int h = 0; h < 8; ++h) ka[h * 192] = ob;
    }
  }
}

__device__ __forceinline__ void ph_diffcomb(const Params& p) {
  const int lane = otid() & 63;
  float d1 = p.lq1[lane] * p.lk1[lane] + p.lq1[lane + 64] * p.lk1[lane + 64];
  float d2 = p.lq2[lane] * p.lk2[lane] + p.lq2[lane + 64] * p.lk2[lane + 64];
  d1 = wave_sum(d1); d2 = wave_sum(d2);
  const float lam_init = 0.2f;
  const float lam = expf(d1) - expf(d2) + lam_init;
  const f32x4 sg = *(const f32x4*)(p.subln + lane * 4);
  const bf16_t* OD = WSP(const bf16_t, OFF_OD);
  for (int r = gwave(); r < NT; r += nwave()) {
    u32x2 w0[4], w1[4];
#pragma unroll
    for (int h = 0; h < 4; ++h) { w0[h] = *(const u32x2*)(OD + (size_t)r * 2048 + h * 256 + lane * 4); w1[h] = *(const u32x2*)(OD + (size_t)r * 2048 + 1024 + h * 256 + lane * 4); }
    asm volatile("" ::: "memory");
#pragma unroll
    for (int h = 0; h < 4; ++h) {
      const f32x4 o0 = {bf_lo(w0[h][0]), bf_hi(w0[h][0]), bf_lo(w0[h][1]), bf_hi(w0[h][1])}, o1 = {bf_lo(w1[h][0]), bf_hi(w1[h][0]), bf_lo(w1[h][1]), bf_hi(w1[h][1])};
      const f32x4 d = o0 - lam * o1;
      const float ss = wave_sum(d[0] * d[0] + d[1] * d[1] + d[2] * d[2] + d[3] * d[3]);
      const float inv = rsqrtf(ss * (1.f / 256.f) + EPS) * (1.f - lam_init);
      u32x2 w = {cvtpk(d[0] * inv * sg[0], d[1] * inv * sg[1]), cvtpk(d[2] * inv * sg[2], d[3] * inv * sg[3])};
      *(u32x2*)(WSP(bf16_t, OFF_YIN) + (size_t)r * 2048 + 1024 + h * 256 + lane * 4) = w;
    }
  }
}

__device__ __forceinline__ void ph_ffn_pre(const Params& p, int l, char* smem) {
  const int lane = otid() & 63, tid = otid();
  float* rw = (float*)smem;
  const float* rsrc = p.router_w + (size_t)l * DM * NE;
  for (int id = tid; id < DM * 4; id += 512) {
    const int j = id >> 2, q = id & 3;
    const f32x4 v = *(const f32x4*)(rsrc + j * 16 + q * 4);
    const int i = j >> 8, ln = (j & 255) >> 2, k = j & 3;
    *(f32x4*)(rw + ((((q * 8 + i) * 4 + k) * 64 + ln) << 2)) = v;
  }
  __syncthreads();
  for (int r = gwave(); r < NT; r += nwave()) {
    const int b = r / SEQ, n = r % SEQ;
    const float* ml = mlp(p, l, b);
    Row8 row; const float ss = row_load_ss_bf16(WSP(const bf16_t, OFF_XL) + (size_t)r * DM, lane, row);
    row_norm_mod(row, rsqrtf(ss * (1.f / DM) + EPS), p.norm_ffn + l * DM, ml + 8192, ml + 6144, lane);
    row_store_fp8(row, WSP(unsigned char, OFF_H) + (size_t)r * DM, lane);
    float lg[16];
#pragma unroll
    for (int e = 0; e < 16; ++e) lg[e] = 0.f;
#pragma unroll
    for (int i = 0; i < 8; ++i) {
      __builtin_amdgcn_sched_barrier(0);
#pragma unroll
      for (int k = 0; k < 4; ++k) {
        const float hv = row.v[i][k];
#pragma unroll
        for (int q = 0; q < 4; ++q) {
          const f32x4 w = *(const f32x4*)(rw + ((((q * 8 + i) * 4 + k) * 64 + lane) << 2));
          lg[q * 4 + 0] += hv * w[0]; lg[q * 4 + 1] += hv * w[1]; lg[q * 4 + 2] += hv * w[2]; lg[q * 4 + 3] += hv * w[3];
        }
      }
    }
    float mx = -1e30f;
#pragma unroll
    for (int e = 0; e < 16; ++e) { lg[e] = wave_sum(lg[e]); mx = fmaxf(mx, lg[e]); }
    float den = 0.f;
#pragma unroll
    for (int e = 0; e < 16; ++e) { lg[e] = expf(lg[e] - mx); den += lg[e]; }
    const float rden = 1.f / den;
    float mine = 0.f;
#pragma unroll
    for (int e = 0; e < 16; ++e) mine = (lane == e) ? lg[e] * rden : mine;
    if (lane < 16) {
      WSP(float, OFF_AFF)[((size_t)(b * NE + lane)) * SEQ + n] = mine;
      WSP(int, OFF_INV)[(size_t)r * NE + lane] = -1;
    }
  }
  __syncthreads();
}

__device__ __forceinline__ void ph_topk(const Params& p, char* smem) {
  unsigned* cnt = (unsigned*)smem;
  const int tid = otid(), lane = tid & 63, wid = tid >> 6;
  for (int be = blockIdx.x; be < NB * NE; be += gridDim.x) {
    const int b = be / NE, e = be % NE;
    const float* src = WSP(const float, OFF_AFF) + (size_t)be * SEQ + tid * 8;
    const f32x4 v0 = *(const f32x4*)src, v1 = *(const f32x4*)(src + 4);
    const float val[8] = {v0[0], v0[1], v0[2], v0[3], v1[0], v1[1], v1[2], v1[3]};
    unsigned key[8];
#pragma unroll
    for (int j = 0; j < 8; ++j) key[j] = __float_as_uint(val[j]);
    unsigned lo = 0u, hi = 0x3f800000u; int par = 0;
    __syncthreads();
    while (lo < hi) {
      const unsigned span = hi - lo + 1u;
      const unsigned t1 = lo + (span >> 2), t2 = lo + (span >> 1), t3 = lo + (span >> 1) + (span >> 2);
      unsigned c1 = 0u, c2 = 0u, c3 = 0u;
#pragma unroll
      for (int k = 0; k < 8; ++k) { c1 += (unsigned)__popcll(__ballot(key[k] >= t1)); c2 += (unsigned)__popcll(__ballot(key[k] >= t2)); c3 += (unsigned)__popcll(__ballot(key[k] >= t3)); }
      if (lane < 3) cnt[par * 32 + wid * 4 + lane] = lane == 0 ? c1 : (lane == 1 ? c2 : c3);
      __syncthreads();
      unsigned s1 = 0u, s2 = 0u, s3 = 0u;
#pragma unroll
      for (int w = 0; w < 8; ++w) { s1 += cnt[par * 32 + w * 4]; s2 += cnt[par * 32 + w * 4 + 1]; s3 += cnt[par * 32 + w * 4 + 2]; }
      par ^= 1;
      if (s1 < (unsigned)CAP) hi = t1 - 1u;
      else if (s2 < (unsigned)CAP) { lo = t1; hi = t2 - 1u; }
      else if (s3 < (unsigned)CAP) { lo = t2; hi = t3 - 1u; }
      else lo = t3;
    }
    const unsigned T = lo;
    int ngt = 0, neq = 0;
#pragma unroll
    for (int j = 0; j < 8; ++j) { ngt += key[j] > T ? 1 : 0; neq += key[j] == T ? 1 : 0; }
    int pk = ngt | (neq << 16);
    int inc = pk;
#pragma unroll
    for (int o = 1; o < 64; o <<= 1) { const int t = __shfl_up(inc, o, 64); if (lane >= o) inc += t; }
    if (lane == 63) cnt[128 + wid] = (unsigned)inc;
    __syncthreads();
    int base = 0, total = 0;
#pragma unroll
    for (int w = 0; w < 8; ++w) { const int t = (int)cnt[128 + w]; total += t; if (w < wid) base += t; }
    const int excl = base + inc - pk;
    int gpos = excl & 0xffff, epos = excl >> 16;
    const int total_gt = total & 0xffff, need = CAP - total_gt;
#pragma unroll
    for (int j = 0; j < 8; ++j) {
      int slot = -1;
      if (key[j] > T) slot = gpos++;
      else if (key[j] == T) { if (epos < need) slot = total_gt + epos; ++epos; }
      if (slot >= 0) {
        const int tok = tid * 8 + j;
        WSP(int, OFF_IDX)[be * CAP + slot] = tok; WSP(float, OFF_GATE)[be * CAP + slot] = val[j];
        WSP(int, OFF_INV)[(size_t)(b * SEQ + tok) * NE + e] = slot;
      }
    }
    __syncthreads();
  }
}

__device__ __forceinline__ void ph_combine(const Params& p, int l) {
  const int lane = otid() & 63;
  for (int r = gwave(); r < NT; r += nwave()) {
    const int b = r / SEQ;
    Row8 acc;
#pragma unroll
    for (int i = 0; i < 8; ++i) acc.v[i] = (f32x4){0.f, 0.f, 0.f, 0.f};
    const int myinv = WSP(const int, OFF_INV)[(size_t)r * NE + (lane & 15)];
    unsigned long long mask = __ballot(myinv >= 0) & 0xffffull;
    bf16_t* xl = WSP(bf16_t, OFF_XL) + (size_t)r * DM;
    u32x2 xw[8];
#pragma unroll
    for (int i = 0; i < 8; ++i) xw[i] = *(const u32x2*)(xl + i * 256 + lane * 4);
    while (mask) {
      const int e = __builtin_ctzll(mask); mask &= mask - 1;
      const int s = __builtin_amdgcn_readlane(myinv, e);
      const bf16_t* ye = WSP(const bf16_t, OFF_YE) + ((size_t)e * 2048 + b * CAP + s) * DM;
#pragma unroll
      for (int i = 0; i < 8; ++i) {
        const u32x2 w = *(const u32x2*)(ye + i * 256 + lane * 4);
        acc.v[i][0] += bf_lo(w[0]); acc.v[i][1] += bf_hi(w[0]); acc.v[i][2] += bf_lo(w[1]); acc.v[i][3] += bf_hi(w[1]);
      }
    }
    const float* ml = mlp(p, l, b);
    Row8 row; float ss = 0.f;
#pragma unroll
    for (int i = 0; i < 8; ++i) {
      const int j = i * 256 + lane * 4;
      const f32x4 g2 = *(const f32x4*)(ml + 10240 + j);
      row.v[i] = (f32x4){bf_lo(xw[i][0]), bf_hi(xw[i][0]), bf_lo(xw[i][1]), bf_hi(xw[i][1])} + g2 * acc.v[i];
      ss += row.v[i][0] * row.v[i][0] + row.v[i][1] * row.v[i][1] + row.v[i][2] * row.v[i][2] + row.v[i][3] * row.v[i][3];
    }
    ss = wave_sum(ss);
    const float inv = rsqrtf(ss * (1.f / DM) + EPS);
    if (l == 0) {
#pragma unroll
      for (int i = 0; i < 8; ++i) { u32x2 w = {cvtpk(row.v[i][0], row.v[i][1]), cvtpk(row.v[i][2], row.v[i][3])}; *(u32x2*)(xl + i * 256 + lane * 4) = w; }
      const float* ml1 = mlp(p, 1, b);
      row_norm_mod(row, inv, p.norm_mix + DM, ml1 + 2048, ml1, lane);
      row_store_bf16(row, WSP(bf16_t, OFF_H) + (size_t)r * DM, lane);
    } else {
      row_norm_mod(row, inv, p.final_norm, nullptr, nullptr, lane);
#pragma unroll
      for (int i = 0; i < 8; ++i) *(f32x4*)(p.out + (size_t)r * DM + i * 256 + lane * 4) = row.v[i];
    }
  }
}

__device__ __forceinline__ void ph_fold(const Params& p) {
  const bf16_t* src = WSP(const bf16_t, OFF_ABT2); bf16_t* dst = WSP(bf16_t, OFF_ABTF);
  float* nyq = WSP(float, OFF_IDX);
  for (int id = blockIdx.x * 512 + otid(); id < 4096 * 512; id += gridDim.x * 512) {
    const int rowi = id >> 9, kk0 = (id & 511) * 8;
    const bf16_t* rp = src + (size_t)rowi * 8192;
    float o[8];
    if (kk0 < 2048) {
      const u32x4 w = *(const u32x4*)(rp + kk0);
#pragma unroll
      for (int j = 0; j < 4; ++j) { o[2 * j] = bf_lo(w[j]); o[2 * j + 1] = bf_hi(w[j]); }
#pragma unroll
      for (int j = 0; j < 8; ++j) { const int kk = kk0 + j; if (kk > 0) o[j] += bf2f(rp[4096 - kk]); }
    } else {
      const int j0 = kk0 - 2048;
      const u32x4 w = *(const u32x4*)(rp + 4096 + j0);
#pragma unroll
      for (int j = 0; j < 4; ++j) { o[2 * j] = bf_lo(w[j]); o[2 * j + 1] = bf_hi(w[j]); }
#pragma unroll
      for (int j = 0; j < 8; ++j) { const int jj = j0 + j; if (jj > 0) o[j] -= bf2f(rp[4096 + 4096 - jj]); else o[j] = bf2f(rp[2048]); }
      if (j0 == 0) nyq[rowi] = o[0];
    }
    u32x4 ow = {cvtpk(o[0], o[1]), cvtpk(o[2], o[3]), cvtpk(o[4], o[5]), cvtpk(o[6], o[7])};
    *(u32x4*)(dst + (size_t)rowi * 4096 + kk0) = ow;
  }
}

__device__ __forceinline__ void ph_dftcomb(const Params& p) {
  const bf16_t* PQ = WSP(const bf16_t, OFF_SPEC); const bf16_t* abtf = WSP(const bf16_t, OFF_ABTF); bf16_t* Y = WSP(bf16_t, OFF_YCAT);
  const float sc = 1.f / 1024.f;
  for (int id = blockIdx.x * 512 + otid(); id < 16 * 2048 * 32; id += gridDim.x * 512) {
    const int d8 = (id & 31) * 8, k1 = (id >> 5) & 2047, bg = id >> 16, b = bg >> 2, g = bg & 3;
    const u32x4 wp = *(const u32x4*)(PQ + ((size_t)(2 * bg) * 2048 + k1) * 256 + d8), wq = *(const u32x4*)(PQ + ((size_t)(2 * bg + 1) * 2048 + k1) * 256 + d8);
    float pv[8], qv[8], ny[8];
#pragma unroll
    for (int j = 0; j < 4; ++j) { pv[2 * j] = bf_lo(wp[j]); pv[2 * j + 1] = bf_hi(wp[j]); qv[2 * j] = bf_lo(wq[j]); qv[2 * j + 1] = bf_hi(wq[j]); }
    const float sgn = (k1 & 1) ? -2.f : 2.f;
    { const f32x4 n0 = *(const f32x4*)(WSP(const float, OFF_IDX) + bg * 256 + d8), n1 = *(const f32x4*)(WSP(const float, OFF_IDX) + bg * 256 + d8 + 4);
#pragma unroll
      for (int j = 0; j < 4; ++j) { ny[j] = sgn * n0[j]; ny[4 + j] = sgn * n1[j]; } }
    bf16_t* y0 = Y + ((size_t)b * SEQ + k1) * DM + 1024 + g * 256 + d8;
    u32x4 o;
#pragma unroll
    for (int j = 0; j < 4; ++j) o[j] = cvtpk((pv[2 * j] + qv[2 * j]) * sc, (pv[2 * j + 1] + qv[2 * j + 1]) * sc);
    *(u32x4*)y0 = o;
    if (k1 > 0) {
#pragma unroll
      for (int j = 0; j < 4; ++j) o[j] = cvtpk((pv[2 * j] - qv[2 * j] + ny[2 * j]) * sc, (pv[2 * j + 1] - qv[2 * j + 1] + ny[2 * j + 1]) * sc);
      *(u32x4*)(Y + ((size_t)b * SEQ + (SEQ - k1)) * DM + 1024 + g * 256 + d8) = o;
    }
  }
  const int lane = otid() & 63;
  for (int r = gwave(); r < 16 * 256; r += nwave()) {
    const bf16_t* row = abtf + (size_t)r * 4096;
    float acc = 0.f;
#pragma unroll
    for (int i = 0; i < 4; ++i) { const u32x4 w = *(const u32x4*)(row + i * 512 + lane * 8);
#pragma unroll
      for (int j = 0; j < 4; ++j) acc += bf_lo(w[j]) - bf_hi(w[j]); }
    acc = wave_sum(acc) + bf2f(row[2048]);
    if (lane == 0) { const int bg = r >> 8, d = r & 255; Y[((size_t)(bg >> 2) * SEQ + 2048) * DM + 1024 + (bg & 3) * 256 + d] = f2bf(acc * sc); }
  }
}

__device__ __forceinline__ void ph_pool(const Params& p) {
  const bf16_t* Z = WSP(const bf16_t, OFF_Z);
  for (int id = blockIdx.x * 512 + otid(); id < NT * 128; id += gridDim.x * 512) {
    const int r = id >> 7, c8 = (id & 127) * 8, g = c8 >> 8, half = 1 << g;
    const int b = r / SEQ, n = r % SEQ;
    const int lo = max(n - half, 0), hi = min(n + half, SEQ);
    float s[8];
#pragma unroll
    for (int j = 0; j < 8; ++j) s[j] = 0.f;
    u32x4 wv[16];
#pragma unroll
    for (int d = 0; d < 16; ++d) { int t = n - 8 + d; t = t < lo ? lo : (t >= hi ? hi - 1 : t); wv[d] = *(const u32x4*)(Z + (size_t)(b * SEQ + t) * 2048 + c8); }
#pragma unroll
    for (int d = 0; d < 16; ++d) { const int t = n - 8 + d; const float wt = (t >= lo && t < hi) ? 1.f : 0.f;
#pragma unroll
      for (int j = 0; j < 4; ++j) { s[2 * j] += wt * bf_lo(wv[d][j]); s[2 * j + 1] += wt * bf_hi(wv[d][j]); } }
    const float rc = 1.f / (float)(hi - lo);
    const u32x4 w = *(const u32x4*)(Z + (size_t)r * 2048 + c8);
    u32x4 o;
#pragma unroll
    for (int j = 0; j < 4; ++j) o[j] = cvtpk(s[2 * j] * rc - bf_lo(w[j]), s[2 * j + 1] * rc - bf_hi(w[j]));
    *(u32x4*)(WSP(bf16_t, OFF_POOLED) + (size_t)r * 1024 + c8) = o;
  }
}

#define LAS __attribute__((address_space(3)))
__host__ __device__ __forceinline__ constexpr int vt_pos(int kap) { return (((kap >> 2) & 1) << 5) | ((kap >> 5) << 4) | (((kap >> 3) & 3) << 2) | (kap & 3); }
namespace fg {
constexpr int BM = 256, BK = 64, HALF = 128, HTB = HALF * BK * 2, STAGE_BYTES = 8 * HTB;
__device__ __forceinline__ int lds_byte(int r, int c) { const int st = (r >> 4) * 2 + (c >> 5), rr = r & 15, cc = c & 31, ob = rr * 64 + cc * 2; return st * 1024 + (ob ^ (((ob >> 9) & 1) << 5)); }
__device__ __forceinline__ void stage_rc(int b, int& R, int& C) { const int st = b / 1024, sb = b % 1024, swz = sb ^ (((sb >> 9) & 1) << 5); R = (st >> 1) * 16 + swz / 64; C = (st & 1) * 32 + (swz % 64) / 2; }
struct Unit { const char* a; const char* b; int pm, pn, grp; };
typedef int i32x8 __attribute__((ext_vector_type(8)));
typedef int i32x4 __attribute__((ext_vector_type(4)));
__device__ __forceinline__ void mfma_fp8(f32x4& acc, const i32x8& a, const i32x8& b, int scale) {
  asm volatile("s_nop 1\n\tv_mfma_scale_f32_16x16x128_f8f6f4 %0, %1, %2, %0, %3, %3 op_sel_hi:[0,0,0]" : "+v"(acc) : "v"(a), "v"(b), "v"(scale));
}
template <int H> __device__ __forceinline__ bf16x8 half8(i32x8 v) { const i32x4 h = H ? __builtin_shufflevector(v, v, 4, 5, 6, 7) : __builtin_shufflevector(v, v, 0, 1, 2, 3); return __builtin_bit_cast(bf16x8, h); }
__device__ __forceinline__ i32x8 cat8(bf16x8 lo, bf16x8 hi) { const i32x4 a = __builtin_bit_cast(i32x4, lo), b = __builtin_bit_cast(i32x4, hi); return (i32x8){a[0], a[1], a[2], a[3], b[0], b[1], b[2], b[3]}; }
struct Grid {
  const char* A; const char* B; size_t sA, sB; int lda, ldb, nM, nN, ngrp, G, c; int gd = 1; size_t sA2 = 0, sB2 = 0;
  int rot = 0;
  __device__ __forceinline__ bool next(int i, Unit& u) const {
    const int cc = (G == 256) ? (((c & 7) * 32 + (c >> 3) + rot) & 255) : c;
    const int L = i * G + cc, per = nM * nN;
    if (L >= per * ngrp) return false;
    const int g = L / per, w = L - g * per;
    const int nig = 8 * nN, gid = w / nig, fm = gid * 8, gsz = (nM - fm) < 8 ? (nM - fm) : 8, wi = w - gid * nig;
    u.grp = g; u.pn = wi / gsz; u.pm = fm + (wi - u.pn * gsz);
    const int g1 = g / gd, g2 = g - g1 * gd;
    u.a = A + (size_t)g1 * sA + (size_t)g2 * sA2 + (size_t)u.pm * 256 * lda * 2; u.b = B + (size_t)g1 * sB + (size_t)g2 * sB2 + (size_t)u.pn * 256 * ldb * 2;
    return true;
  }
};
template <class Epi, bool GATHER = false, bool FP8 = false>
__device__ __forceinline__ void gemm_fast(LAS unsigned char* lds, const Grid& S, const Epi& E, int K, const int* gidx = nullptr) {
  int tid_ = threadIdx.x; asm volatile("" : "+v"(tid_));
  const int tid = tid_, wid = __builtin_amdgcn_readfirstlane(tid >> 6), lane = tid & 63, wr = wid >> 2, wc = wid & 3, fr = lane & 15, fq = lane >> 4;
  const int nt = K / BK;
  unsigned voffA[2], voffB[2];
#pragma unroll
  for (int i = 0; i < 2; ++i) { int R, C; stage_rc(tid * 16 + i * 8192, R, C); voffA[i] = (unsigned)(R * S.lda + C) * 2u; voffB[i] = (unsigned)(R * S.ldb + C) * 2u; }
  const size_t kstep = (size_t)(BK * 2);
  const size_t hstepA = (size_t)HALF * S.lda * 2, hstepB = (size_t)HALF * S.ldb * 2;
  const unsigned ldsw = (unsigned)wid * 1024u;
  const int aoff = FP8 ? lds_byte(wr * 64 + fr, fq * 16) : lds_byte(wr * 64 + fr, fq * 8), boff = FP8 ? lds_byte(wc * 32 + fr, fq * 16) : lds_byte(wc * 32 + fr, fq * 8);
  constexpr int KOFF = FP8 ? 16 : 1024;
#define FG_SA(b, h) (((b) * 2 + (h)) * HTB)
#define FG_SB(b, h) ((4 + (b) * 2 + (h)) * HTB)
#define FG_STAGE(bufoff, gbase, voff) do { _Pragma("unroll") for (int _i = 0; _i < 2; ++_i) \
    __builtin_amdgcn_global_load_lds((const unsigned*)((const char*)(gbase) + (voff)[_i]), (LAS unsigned*)(lds + (bufoff) + ldsw + _i * 8192), 16, 0, 0); } while (0)
#define FG_STAGE_A(bufoff, usen, kb, h) do { if constexpr (GATHER) { _Pragma("unroll") for (int _i = 0; _i < 2; ++_i) { const unsigned _g = (usen) ? gN[h][_i] : gA[h][_i]; \
      __builtin_amdgcn_global_load_lds((const unsigned*)(S.A + _g + (kb)), (LAS unsigned*)(lds + (bufoff) + ldsw + _i * 8192), 16, 0, 0); } } \
    else { FG_STAGE(bufoff, ((usen) ? nA : cA) + (kb) + (h) * hstepA, voffA); } } while (0)
#define FG_LDA(dst, b, h) do { _Pragma("unroll") for (int m = 0; m < 4; ++m) dst[m] = cat8(*(const LAS bf16x8*)(lds + FG_SA(b, h) + aoff + m * 2048), *(const LAS bf16x8*)(lds + FG_SA(b, h) + aoff + m * 2048 + KOFF)); } while (0)
#define FG_LDB(dst, b, h) do { _Pragma("unroll") for (int n = 0; n < 2; ++n) dst[n] = cat8(*(const LAS bf16x8*)(lds + FG_SB(b, h) + boff + n * 2048), *(const LAS bf16x8*)(lds + FG_SB(b, h) + boff + n * 2048 + KOFF)); } while (0)
#define FG_MMA(ai, bj, At, Bt) do { __builtin_amdgcn_s_setprio(1); _Pragma("unroll") for (int m = 0; m < 4; ++m) _Pragma("unroll") for (int n = 0; n < 2; ++n) { \
    if constexpr (FP8) mfma_fp8(acc[ai][bj][m][n], Bt[n], At[m], one_scale); \
    else { acc[ai][bj][m][n] = __builtin_amdgcn_mfma_f32_16x16x32_bf16(half8<0>(Bt[n]), half8<0>(At[m]), acc[ai][bj][m][n], 0, 0, 0); \
           acc[ai][bj][m][n] = __builtin_amdgcn_mfma_f32_16x16x32_bf16(half8<1>(Bt[n]), half8<1>(At[m]), acc[ai][bj][m][n], 0, 0, 0); } } \
    __builtin_amdgcn_s_setprio(0); } while (0)
#define FG_WAIT_V(n) asm volatile("s_waitcnt vmcnt(" #n ")" ::: "memory")
#define FG_WAIT_L(n) asm volatile("s_waitcnt lgkmcnt(" #n ")" ::: "memory")
#define FG_BAR __builtin_amdgcn_s_barrier()
#define FG_SCHED __builtin_amdgcn_sched_barrier(0)
  Unit cur, nxt; int ui = 0;
  if (!S.next(0, cur)) return;
  f32x4 acc[2][2][4][2];
#pragma unroll
  for (int a = 0; a < 2; ++a)
#pragma unroll
    for (int b = 0; b < 2; ++b)
#pragma unroll
      for (int m = 0; m < 4; ++m)
#pragma unroll
        for (int n = 0; n < 2; ++n) acc[a][b][m][n] = (f32x4){0.f, 0.f, 0.f, 0.f};
  int one_scale = 0x7f7f7f7f; asm volatile("" : "+v"(one_scale));
  i32x8 At[4], B0[2], B1[2];
  const char* cA = cur.a; const char* cB = cur.b; const char* nA = cA;
  unsigned gA[2][2] = {{0u, 0u}, {0u, 0u}}, gN[2][2] = {{0u, 0u}, {0u, 0u}};
  auto goff = [&](const Unit& u, unsigned (&g)[2][2]) {
#pragma unroll
    for (int h = 0; h < 2; ++h)
#pragma unroll
      for (int i = 0; i < 2; ++i) { int R, C; stage_rc(tid * 16 + i * 8192, R, C); const int rr = u.pm * 256 + h * 128 + R, bb = rr >> 9;
        const int tok = bb * SEQ + gidx[(bb * NE + u.grp) * CAP + (rr & 511)]; g[h][i] = (unsigned)(tok * S.lda + C) * 2u; }
  };
  if constexpr (GATHER) goff(cur, gA);
  FG_STAGE(FG_SB(0, 0), cB, voffB); FG_STAGE_A(FG_SA(0, 0), false, 0, 0); FG_STAGE(FG_SB(0, 1), cB + hstepB, voffB); FG_STAGE_A(FG_SA(0, 1), false, 0, 1);
  if (wr == 1) FG_BAR;
  FG_WAIT_V(4); FG_BAR;
  FG_STAGE(FG_SB(1, 0), cB + kstep, voffB); FG_STAGE_A(FG_SA(1, 0), false, kstep, 0); FG_STAGE(FG_SB(1, 1), cB + hstepB + kstep, voffB);
  FG_WAIT_V(6); FG_BAR;
  for (;;) {
    const bool has_next = S.next(ui + 1, nxt);
    nA = has_next ? nxt.a : cA; const char* nB = has_next ? nxt.b : cB;
    if constexpr (GATHER) { if (has_next) goff(nxt, gN); else {
#pragma unroll
      for (int h = 0; h < 2; ++h)
#pragma unroll
        for (int i = 0; i < 2; ++i) gN[h][i] = gA[h][i]; } }
#pragma unroll 1
    for (int t = 0; t < nt; t += 2) {
      const bool last = (t == nt - 2);
      const size_t k1 = (size_t)(t + 1) * kstep, k2 = last ? 0 : (size_t)(t + 2) * kstep, k3 = k2 + kstep;
      const char* b2 = last ? nB : cB + (size_t)(t + 2) * kstep;
      const char* b3 = b2 + kstep;
      FG_LDB(B0, 0, 0); FG_SCHED; FG_LDA(At, 0, 0); FG_STAGE_A(FG_SA(1, 1), false, k1, 1);
      FG_WAIT_L(8); FG_BAR; FG_WAIT_L(0); FG_MMA(0, 0, At, B0); FG_BAR; FG_SCHED;
      FG_LDB(B1, 0, 1); FG_STAGE(FG_SB(0, 0), b2, voffB);
      FG_BAR; FG_WAIT_L(0); FG_MMA(0, 1, At, B1); FG_BAR;
      FG_LDA(At, 0, 1); FG_STAGE_A(FG_SA(0, 0), last, k2, 0);
      FG_BAR; FG_WAIT_L(0); FG_MMA(1, 0, At, B0); FG_BAR; FG_SCHED;
      FG_STAGE(FG_SB(0, 1), b2 + hstepB, voffB);
      FG_WAIT_V(6); FG_BAR; FG_MMA(1, 1, At, B1); FG_BAR;
      FG_LDB(B0, 1, 0); FG_SCHED; FG_LDA(At, 1, 0); FG_STAGE_A(FG_SA(0, 1), last, k2, 1);
      FG_WAIT_L(8); FG_BAR; FG_WAIT_L(0); FG_MMA(0, 0, At, B0); FG_BAR; FG_SCHED;
      FG_LDB(B1, 1, 1); FG_STAGE(FG_SB(1, 0), b3, voffB);
      FG_BAR; FG_WAIT_L(0); FG_MMA(0, 1, At, B1); FG_BAR;
      FG_LDA(At, 1, 1); FG_STAGE_A(FG_SA(1, 0), last, k3, 0);
      FG_BAR; FG_WAIT_L(0); FG_MMA(1, 0, At, B0); FG_BAR; FG_SCHED;
      FG_STAGE(FG_SB(1, 1), b3 + hstepB, voffB);
      FG_WAIT_V(6); FG_BAR; FG_MMA(1, 1, At, B1); FG_BAR;
    }
    if constexpr (FP8) asm volatile("s_nop 15\n\ts_nop 15" ::: "memory");
    {
      int tz = threadIdx.x; asm volatile("" : "+v"(tz));
      const int wz = __builtin_amdgcn_readfirstlane(tz >> 6), lz = tz & 63;
      E(acc, cur, wz >> 2, wz & 3, lz & 15, lz >> 4); }
    if (!has_next) break;
#pragma unroll
    for (int a = 0; a < 2; ++a)
#pragma unroll
      for (int b = 0; b < 2; ++b)
#pragma unroll
        for (int m = 0; m < 4; ++m)
#pragma unroll
          for (int n = 0; n < 2; ++n) acc[a][b][m][n] = (f32x4){0.f, 0.f, 0.f, 0.f};
    cur = nxt; cA = nA; cB = nB; ++ui;
    if constexpr (GATHER) {
#pragma unroll
      for (int h = 0; h < 2; ++h)
#pragma unroll
        for (int i = 0; i < 2; ++i) gA[h][i] = gN[h][i]; }
  }
  FG_WAIT_V(0);
  if (wr == 0) FG_BAR;
  FG_BAR;
#undef FG_SA
#undef FG_SB
#undef FG_STAGE
#undef FG_STAGE_A
#undef FG_LDA
#undef FG_LDB
#undef FG_MMA
#undef FG_WAIT_V
#undef FG_WAIT_L
#undef FG_BAR
#undef FG_SCHED
}
typedef f32x4 Acc[2][2][4][2];
#define FG_FOREACH(...)                                                                                                \
  _Pragma("unroll") for (int ai = 0; ai < 2; ++ai) _Pragma("unroll") for (int m = 0; m < 4; ++m)                       \
  _Pragma("unroll") for (int bj = 0; bj < 2; ++bj) _Pragma("unroll") for (int n = 0; n < 2; ++n) {                     \
    const int row = u.pm * 256 + ai * 128 + wr * 64 + m * 16 + fr, col = u.pn * 256 + bj * 128 + wc * 32 + n * 16 + 4 * fq; \
    const f32x4 v = acc[ai][bj][m][n]; __VA_ARGS__ }
__device__ __forceinline__ u32x2 pack4(f32x4 v) { return (u32x2){cvtpk(v[0], v[1]), cvtpk(v[2], v[3])}; }

struct EpiBf16 {
  bf16_t* O; int ld, nvalid; float scale; int gdiv; size_t s1, s2;
  __device__ __forceinline__ void operator()(const Acc& acc, const Unit& u, int wr, int wc, int fr, int fq) const {
    bf16_t* base = O + (size_t)(u.grp / gdiv) * s1 + (size_t)(u.grp % gdiv) * s2;
    FG_FOREACH(if (col < nvalid) *(u32x2*)(base + (size_t)row * ld + col) = pack4(v * scale);)
  }
};
struct EpiQRope {
  unsigned char* QA;
  __device__ __forceinline__ void operator()(const Acc& acc, const Unit& u, int wr, int wc, int fr, int fq) const {
#pragma unroll
    for (int ai = 0; ai < 2; ++ai)
#pragma unroll
      for (int m = 0; m < 4; ++m)
#pragma unroll
        for (int bj = 0; bj < 2; ++bj) {
          const int row = u.pm * 256 + ai * 128 + wr * 64 + m * 16 + fr, g0 = u.pn * 256 + bj * 128 + wc * 32, w0 = g0 % 192;
          f32x4 x1 = acc[ai][bj][m][0], x2 = acc[ai][bj][m][1];
          if (w0 >= 128) {
            const int ntok = row % SEQ; const float pos = (w0 >= 160) ? (float)(ntok & 63) : (float)(ntok >> 6);
#pragma unroll
            for (int j = 0; j < 4; ++j) { const float ang = pos * rope_inv_freq(4 * fq + j, 16); const float sn = __sinf(ang), cs = __cosf(ang);
              const float a = x1[j], b = x2[j]; x1[j] = a * cs - b * sn; x2[j] = b * cs + a * sn; }
          }
          *(u32x2*)(QA + (size_t)row * 1536 + g0 + 8 * fq) = (u32x2){pack_fp8x4(x1[0], x1[1], x1[2], x1[3]), pack_fp8x4(x2[0], x2[1], x2[2], x2[3])};
        }
  }
};
struct EpiIn0 {
  bf16_t* P0; unsigned char* QD; unsigned char* KD; unsigned char* VD;
  __device__ __forceinline__ void operator()(const Acc& acc, const Unit& u, int wr, int wc, int fr, int fq) const {
    const bool lat = u.pm < NT / 256;
#pragma unroll
    for (int ai = 0; ai < 2; ++ai)
#pragma unroll
      for (int m = 0; m < 4; ++m) {
        const int row = u.pm * 256 + ai * 128 + wr * 64 + m * 16 + fr;
        int keyrow, ntok = 0;
        if (lat) { ntok = row % SEQ; keyrow = (row / SEQ) * NKEY + CTXL + ntok; } else { const int ii = row - NT; keyrow = (ii / CTXL) * NKEY + (ii % CTXL); }
#pragma unroll
        for (int bj = 0; bj < 2; ++bj) {
          const int g0 = u.pn * 256 + bj * 128 + wc * 32;
          f32x4 x1 = acc[ai][bj][m][0] * (1.f / 32.f), x2 = acc[ai][bj][m][1] * (1.f / 32.f);
          if (g0 < P0W) { bf16_t* dst = P0 + (size_t)row * P0W + g0 + 4 * fq; *(u32x2*)dst = pack4(x1); *(u32x2*)(dst + 16) = pack4(x2); }
          else if (g0 < 3136) {
            const int vv = (g0 - 1088) >> 7, sg = ((g0 - 1088) & 127) >> 5, axis = sg >> 1, qh = sg & 1;
            if (lat) { const float pos = axis ? (float)(ntok & 63) : (float)(ntok >> 6);
#pragma unroll
              for (int j = 0; j < 4; ++j) { const float ang = pos * rope_inv_freq(qh * 16 + 4 * fq + j, 32); const float sn = __sinf(ang), cs = __cosf(ang);
                const float a = x1[j], b = x2[j]; x1[j] = a * cs - b * sn; x2[j] = b * cs + a * sn; } }
            const u32x2 pk = {pack_fp8x4(x1[0], x1[1], x1[2], x1[3]), pack_fp8x4(x2[0], x2[1], x2[2], x2[3])};
            if (vv < 8) { if (lat) *(u32x2*)(QD + (size_t)row * 1024 + vv * 128 + sg * 32 + 8 * fq) = pk; }
            else *(u32x2*)(KD + (size_t)keyrow * 1024 + (vv - 8) * 128 + sg * 32 + 8 * fq) = pk;
          }
        }
      }
  }
};
struct EpiKV {
  unsigned char* KA;
  __device__ __forceinline__ void operator()(const Acc& acc, const Unit& u, int wr, int wc, int fr, int fq) const {
#pragma unroll
    for (int ai = 0; ai < 2; ++ai)
#pragma unroll
      for (int m = 0; m < 4; ++m) {
        const int row = u.pm * 256 + ai * 128 + wr * 64 + m * 16 + fr;
        int b; int key; if (row < NT) { b = row / SEQ; key = CTXL + (row % SEQ); } else { const int ii = row - NT; b = ii / CTXL; key = ii % CTXL; }
#pragma unroll
        for (int bj = 0; bj < 2; ++bj) {
          const int g0 = u.pn * 256 + bj * 128 + wc * 32, h = g0 >> 7, w0 = g0 & 127;
          const f32x4 x1 = acc[ai][bj][m][0], x2 = acc[ai][bj][m][1];
          *(u32x2*)(KA + ((size_t)b * NKEY + key) * 1536 + h * 192 + w0 + 8 * fq) = (u32x2){pack_fp8x4(x1[0], x1[1], x1[2], x1[3]), pack_fp8x4(x2[0], x2[1], x2[2], x2[3])};
        }
      }
  }
};
struct EpiVT {
  unsigned char* VT; int dvs, nh; float scale;
  __device__ __forceinline__ void operator()(const Acc& acc, const Unit& u, int wr, int wc, int fr, int fq) const {
    FG_FOREACH(
      int b; int key; if (col < NT) { b = col / SEQ; key = CTXL + (col % SEQ); } else { const int ii = col - NT; b = ii / CTXL; key = ii % CTXL; }
      const int h = row >> dvs; const int d = row & ((1 << dvs) - 1);
      *(unsigned*)(VT + ((((size_t)(b * nh + h) * (NKEY / 64) + (key >> 6)) << dvs) + d) * 64 + vt_pos(key & 63)) = pack_fp8x4(v[0] * scale, v[1] * scale, v[2] * scale, v[3] * scale);)
  }
};
template <bool BASE_F32>
struct EpiResid {
  bf16_t* XL; const void* base; const float* ml;
  __device__ __forceinline__ void operator()(const Acc& acc, const Unit& u, int wr, int wc, int fr, int fq) const {
    const int row0 = u.pm * 256 + wr * 64 + fr, col0 = u.pn * 256 + wc * 32 + 4 * fq;
    const float* gp = ml + (size_t)(row0 / SEQ) * MLW + 4096 + col0;
    f32x4 g[2][2];
#pragma unroll
    for (int bj = 0; bj < 2; ++bj)
#pragma unroll
      for (int n = 0; n < 2; ++n) g[bj][n] = *(const f32x4*)(gp + bj * 128 + n * 16);
#pragma unroll
    for (int ai = 0; ai < 2; ++ai)
#pragma unroll
      for (int mh = 0; mh < 2; ++mh) {
        f32x4 bs[2][2][2];
#pragma unroll
        for (int m2 = 0; m2 < 2; ++m2)
#pragma unroll
          for (int bj = 0; bj < 2; ++bj)
#pragma unroll
            for (int n = 0; n < 2; ++n) { const size_t o = (size_t)(row0 + ai * 128 + (mh * 2 + m2) * 16) * DM + col0 + bj * 128 + n * 16;
              if constexpr (BASE_F32) bs[m2][bj][n] = *(const f32x4*)((const float*)base + o);
              else { const u32x2 w = *(const u32x2*)((const bf16_t*)base + o); bs[m2][bj][n] = (f32x4){bf_lo(w[0]), bf_hi(w[0]), bf_lo(w[1]), bf_hi(w[1])}; } }
        asm volatile("" ::: "memory");
#pragma unroll
        for (int m2 = 0; m2 < 2; ++m2)
#pragma unroll
          for (int bj = 0; bj < 2; ++bj)
#pragma unroll
            for (int n = 0; n < 2; ++n)
              *(u32x2*)(XL + (size_t)(row0 + ai * 128 + (mh * 2 + m2) * 16) * DM + col0 + bj * 128 + n * 16) = pack4(bs[m2][bj][n] + g[bj][n] * acc[ai][bj][mh * 2 + m2][n]);
        asm volatile("" ::: "memory");
      }
  }
};
struct EpiGU {
  unsigned char* HID;
  __device__ __forceinline__ void operator()(const Acc& acc, const Unit& u, int wr, int wc, int fr, int fq) const {
    unsigned char* base = HID + (size_t)u.grp * 2048 * FF;
#pragma unroll
    for (int ai = 0; ai < 2; ++ai)
#pragma unroll
      for (int m = 0; m < 4; ++m)
#pragma unroll
        for (int bj = 0; bj < 2; ++bj) {
          const int row = u.pm * 256 + ai * 128 + wr * 64 + m * 16 + fr, hid = u.pn * 128 + bj * 64 + wc * 16 + 4 * fq;
          const f32x4 g = acc[ai][bj][m][0], up = acc[ai][bj][m][1];
          float r[4];
#pragma unroll
          for (int j = 0; j < 4; ++j) { const float gg = g[j] * (1.f / W8_SCALE), uu = up[j] * (1.f / W8_SCALE); r[j] = gg * __builtin_amdgcn_rcpf(1.f + __expf(-gg)) * uu; }
          *(unsigned*)(base + (size_t)row * FF + hid) = pack_fp8x4(r[0], r[1], r[2], r[3]);
        }
  }
};
struct EpiDown {
  bf16_t* YE; const float* gate;
  __device__ __forceinline__ void operator()(const Acc& acc, const Unit& u, int wr, int wc, int fr, int fq) const {
    bf16_t* base = YE + (size_t)u.grp * 2048 * DM;
    float gt[2][4];
#pragma unroll
    for (int ai = 0; ai < 2; ++ai)
#pragma unroll
      for (int m = 0; m < 4; ++m) { const int row = u.pm * 256 + ai * 128 + wr * 64 + m * 16 + fr; gt[ai][m] = gate[((row >> 9) * NE + u.grp) * CAP + (row & 511)] * (1.f / W8_SCALE); }
    asm volatile("" ::: "memory");
    FG_FOREACH(*(u32x2*)(base + (size_t)row * DM + col) = pack4(v * gt[ai][m]);)
  }
};
struct EpiScaleCol {
  bf16_t* O; const float* cs;
  __device__ __forceinline__ void operator()(const Acc& acc, const Unit& u, int wr, int wc, int fr, int fq) const {
    f32x4 sc[2][2];
#pragma unroll
    for (int bj = 0; bj < 2; ++bj)
#pragma unroll
      for (int n = 0; n < 2; ++n) sc[bj][n] = *(const f32x4*)(cs + u.grp * 256 + u.pn * 256 + bj * 128 + wc * 32 + n * 16 + 4 * fq);
    asm volatile("" ::: "memory");
    FG_FOREACH(*(u32x2*)(O + (size_t)row * DM + u.grp * 256 + col) = pack4(v * sc[bj][n]);)
  }
};
struct EpiChanDft {
  bf16_t* ABT2;
  __device__ __forceinline__ void operator()(const Acc& acc, const Unit& u, int wr, int wc, int fr, int fq) const {
    FG_FOREACH(const int b = col / SEQ, nn = col % SEQ;
               *(u32x2*)(ABT2 + (((size_t)(b * 4 + u.grp) * 256) + (row & 255)) * 8192 + (row >> 8) * 4096 + nn) = pack4(v * 1.f);)
  }
};
}

namespace at {
typedef float f32x16 __attribute__((ext_vector_type(16)));
typedef int i32x8a __attribute__((ext_vector_type(8)));
typedef int i32x4a __attribute__((ext_vector_type(4)));
constexpr int NW = 8, QBLK = 32, KVBLK = 64;
#define SBAR() __builtin_amdgcn_sched_barrier(0)
#define MFMA8(A, B, Cc) __builtin_amdgcn_mfma_scale_f32_32x32x64_f8f6f4(A, B, Cc, 0, 0, 0, 0x7f7f7f7f, 0, 0x7f7f7f7f)
__device__ __forceinline__ int crow(int r, int hi) { return (r & 3) + 8 * (r >> 2) + 4 * hi; }
template <int DK> __device__ __forceinline__ int kswz(int row) { return DK == 192 ? ((row >> 2) & 3) : ((row >> 1) & 7); }
template <int DK>
__device__ __forceinline__ void qkt(f32x16& p0, f32x16& p1, const LAS char* Ks, const i32x8a* qf, int r32, int hi) {
  p0 = f32x16{}; p1 = f32x16{};
  const int s = kswz<DK>(r32);
  const LAS char* kr = Ks + r32 * DK;
#pragma unroll
  for (int t = 0; t < DK / 64; ++t) {
    const int c0 = ((4 * t + 2 * hi) ^ s) << 4, c1 = ((4 * t + 2 * hi + 1) ^ s) << 4;
    const i32x4a a0 = *reinterpret_cast<const LAS i32x4a*>(kr + c0), a1 = *reinterpret_cast<const LAS i32x4a*>(kr + c1);
    const i32x4a b0 = *reinterpret_cast<const LAS i32x4a*>(kr + c0 + 32 * DK), b1 = *reinterpret_cast<const LAS i32x4a*>(kr + c1 + 32 * DK);
    const i32x8a k0 = {a0[0], a0[1], a0[2], a0[3], a1[0], a1[1], a1[2], a1[3]}, k1 = {b0[0], b0[1], b0[2], b0[3], b1[0], b1[1], b1[2], b1[3]};
    p0 = MFMA8(k0, qf[t], p0);
    p1 = MFMA8(k1, qf[t], p1); }
}
constexpr float PBIAS = 4.f, PTHR = 3.f;
__device__ __forceinline__ void softmax8(const f32x16& p0, const f32x16& p1, float& m_reg, float& alpha, i32x8a& pa, float C, float thr_raw) {
  float pmax = p0[0];
#pragma unroll
  for (int r = 1; r < 16; ++r) pmax = fmaxf(pmax, p0[r]);
#pragma unroll
  for (int r = 0; r < 16; ++r) pmax = fmaxf(pmax, p1[r]);
  { auto rr = __builtin_amdgcn_permlane32_swap(__float_as_uint(pmax), __float_as_uint(pmax), false, false);
    pmax = fmaxf(__uint_as_float(rr[0]), __uint_as_float(rr[1])); }
  float mn;
  if (__builtin_expect(__all(pmax - m_reg <= thr_raw), 1)) { mn = m_reg; alpha = 1.f; }
  else { mn = fmaxf(m_reg, pmax); alpha = __builtin_amdgcn_exp2f((m_reg - mn) * C); m_reg = mn; }
  const float C8 = 8.f * C, b8 = 8.f * (PBIAS - mn * C) + 56.f;
#pragma unroll
  for (int w = 0; w < 4; ++w) {
    unsigned v = 0, v2 = 0;
#pragma unroll
    for (int j = 0; j < 4; ++j) { v = __builtin_amdgcn_cvt_pk_u8_f32(fmaf(p0[4 * w + j], C8, b8), j, v); v2 = __builtin_amdgcn_cvt_pk_u8_f32(fmaf(p1[4 * w + j], C8, b8), j, v2); }
    pa[w] = (int)v; pa[4 + w] = (int)v2; }
}
template <int NDB>
__device__ __forceinline__ void pv(f32x16* o, const LAS char* Vs, const i32x8a pa, int r32, int hi) {
  const int s = (r32 >> 2) & 3;
  const LAS char* v0 = Vs + r32 * 64 + (((2 * hi) ^ s) << 4); const LAS char* v1 = Vs + r32 * 64 + (((2 * hi + 1) ^ s) << 4);
#pragma unroll
  for (int d0 = 0; d0 < NDB; ++d0) {
    const i32x4a a = *reinterpret_cast<const LAS i32x4a*>(v0 + d0 * 2048), b = *reinterpret_cast<const LAS i32x4a*>(v1 + d0 * 2048);
    const i32x8a vf = {a[0], a[1], a[2], a[3], b[0], b[1], b[2], b[3]};
    o[d0] = MFMA8(pa, vf, o[d0]); }
  const int one4 = 0x38383838;
  const i32x8a ones = {one4, one4, one4, one4, one4, one4, one4, one4};
  o[NDB] = MFMA8(pa, ones, o[NDB]);
}
template <int DK, int NDB, bool QK_FIRST>
__device__ __forceinline__ void mm_iter(f32x16* o, f32x16& p0, f32x16& p1, const LAS char* Vs, const LAS char* Ks, const i32x8a pa, const i32x8a* qf, int r32, int hi) {
  constexpr int NKF = DK / 32, NL = NKF + NDB;
  const int sk = kswz<DK>(r32), sv = (r32 >> 2) & 3;
  const LAS char* kr = Ks + r32 * DK;
  const LAS char* v0 = Vs + r32 * 64 + (((2 * hi) ^ sv) << 4); const LAS char* v1 = Vs + r32 * 64 + (((2 * hi + 1) ^ sv) << 4);
  i32x8a w[3];
#define MM_ISK(i) (QK_FIRST ? (i) < NKF : (i) >= NDB)
#define MM_LOAD(i) do { i32x4a a_, b_; if (MM_ISK(i)) { const int kk = QK_FIRST ? (i) : (i) - NDB, t = kk >> 1, blk = kk & 1; \
      a_ = *reinterpret_cast<const LAS i32x4a*>(kr + blk * 32 * DK + (((4 * t + 2 * hi) ^ sk) << 4)); b_ = *reinterpret_cast<const LAS i32x4a*>(kr + blk * 32 * DK + (((4 * t + 2 * hi + 1) ^ sk) << 4)); } \
    else { const int d0 = QK_FIRST ? (i) - NKF : (i); a_ = *reinterpret_cast<const LAS i32x4a*>(v0 + d0 * 2048); b_ = *reinterpret_cast<const LAS i32x4a*>(v1 + d0 * 2048); } \
    w[(i) % 3] = (i32x8a){a_[0], a_[1], a_[2], a_[3], b_[0], b_[1], b_[2], b_[3]}; } while (0)
  MM_LOAD(0); MM_LOAD(1);
#pragma unroll
  for (int i = 0; i < NL; ++i) {
    if (i + 2 < NL) MM_LOAD(i + 2);
    if (MM_ISK(i)) { const int kk = QK_FIRST ? i : i - NDB, t = kk >> 1, blk = kk & 1;
      if (blk == 0) { if (t == 0) p0 = MFMA8(w[i % 3], qf[t], f32x16{}); else p0 = MFMA8(w[i % 3], qf[t], p0); }
      else { if (t == 0) p1 = MFMA8(w[i % 3], qf[t], f32x16{}); else p1 = MFMA8(w[i % 3], qf[t], p1); } }
    else { const int d0 = QK_FIRST ? i - NKF : i; o[d0] = MFMA8(pa, w[i % 3], o[d0]);
      if (d0 == NDB - 1) { const int one4 = 0x38383838; const i32x8a ones = {one4, one4, one4, one4, one4, one4, one4, one4}; o[NDB] = MFMA8(pa, ones, o[NDB]); } }
    __builtin_amdgcn_sched_barrier(0x406);
  }
#undef MM_ISK
#undef MM_LOAD
}
template <class VAR>
__device__ __forceinline__ void attn_body(const unsigned char* __restrict__ Qb, const unsigned char* __restrict__ Kh, const unsigned char* __restrict__ VT, bf16_t* __restrict__ Ob, int seq, char* lds) {
  constexpr int DK = VAR::DK, NDB = VAR::NDB, ldq = VAR::LDQ, ldk = VAR::LDK, ldo = VAR::LDO;
  constexpr float C = VAR::SCALE * 1.4426950408889634f, thr_raw = PTHR / VAR::SCALE;
  constexpr int SHM_V = NDB * 32 * 64, SHM_K = KVBLK * DK, SHM_T = SHM_V + SHM_K, NVC = NDB / 4;
  static_assert(DK == 192 || DK == 128, "K staging is written for 128- and 192-byte key rows");
  int tid_ = threadIdx.x; asm volatile("" : "+v"(tid_));
  const int tid = tid_, wid = tid >> 6, lane = tid & 63, r32 = lane & 31, hi = lane >> 5, wu = __builtin_amdgcn_readfirstlane(wid);
  LAS char* L = (LAS char*)lds;
  LAS float* al_l = (LAS float*)(L + VAR::NB * SHM_T) + wid * 32;
  float m_reg = -1e30f; f32x16 o[NDB + 1] = {}; i32x8a qr[DK / 64];
  const unsigned char* Qw = Qb + (size_t)(wid * QBLK + r32) * ldq + hi * 32;
#pragma unroll
  for (int t = 0; t < DK / 64; ++t) { const i32x4a a = *reinterpret_cast<const i32x4a*>(Qw + t * 64), b2 = *reinterpret_cast<const i32x4a*>(Qw + t * 64 + 16);
    qr[t] = (i32x8a){a[0], a[1], a[2], a[3], b2[0], b2[1], b2[2], b2[3]}; }
  const unsigned vsrc = (unsigned)((tid >> 2) * 64 + (((tid & 3) ^ ((tid >> 4) & 3)) << 4));
  unsigned ksrc0, ksrc1 = 0;
  if constexpr (DK == 128) { const int row = tid >> 3; ksrc0 = (unsigned)(row * ldk + (((tid & 7) ^ kswz<DK>(row)) << 4)); }
  else { const int r0 = tid / 12, c0 = tid - 12 * r0, ci = 512 + wid * 32 + r32, r1 = ci / 12, c1 = ci - 12 * r1;
    ksrc0 = (unsigned)(r0 * ldk + ((c0 ^ kswz<DK>(r0)) << 4)); ksrc1 = (unsigned)(r1 * ldk + ((c1 ^ kswz<DK>(r1)) << 4)); }
#define DMA(B, tile) do { const unsigned char* vt_ = VT + (size_t)(tile) * SHM_V; const unsigned char* kt_ = Kh + (size_t)(tile) * (KVBLK * ldk); \
    _Pragma("unroll") for (int _i = 0; _i < NVC; ++_i) __builtin_amdgcn_global_load_lds((const unsigned*)(vt_ + vsrc + _i * 8192), (LAS unsigned*)(L + (B) + wu * 1024 + _i * 8192), 16, 0, 0); \
    __builtin_amdgcn_global_load_lds((const unsigned*)(kt_ + ksrc0), (LAS unsigned*)(L + (B) + SHM_V + wu * 1024), 16, 0, 0); \
    if constexpr (DK == 192) { if (hi == 0) __builtin_amdgcn_global_load_lds((const unsigned*)(kt_ + ksrc1), (LAS unsigned*)(L + (B) + SHM_V + 8192 + wu * 512), 16, 0, 0); } } while (0)
#define DWAIT() asm volatile("s_waitcnt vmcnt(0)" ::: "memory")
#define RESC(a) do { if (__any((a) < 1.f)) { if (hi == 0) al_l[r32] = (a); asm volatile("s_waitcnt lgkmcnt(0)" ::: "memory"); \
    _Pragma("unroll") for (int d = 0; d <= NDB; ++d) _Pragma("unroll") for (int r = 0; r < 16; ++r) o[d][r] *= al_l[crow(r, hi)]; } } while (0)
  const int NTL = seq / KVBLK;
  constexpr int NB = VAR::NB, IPT = NVC + (DK == 192 ? 2 : 1);
  static_assert(NB >= 3 && NB * SHM_T + NW * 128 <= 135168, "attention tile ring must fit the kernel's LDS");
#define DWAITN(NT_) asm volatile("s_waitcnt vmcnt(%0)" :: "n"((NT_) * IPT) : "memory")
  int b0 = 0, b1 = SHM_T, bn = (NB - 1) * SHM_T;
  f32x16 p0, p1; float al; i32x8a pa;
#pragma unroll 1
  for (int t = 0; t < NB - 1; ++t) DMA(t * SHM_T, t < NTL ? t : NTL - 1);
  SBAR(); DWAITN(NB - 3); __syncthreads();
  qkt<DK>(p0, p1, L + b0 + SHM_V, qr, r32, hi); softmax8(p0, p1, m_reg, al, pa, C, thr_raw);
  for (int j = 0; j + 1 < NTL; ++j) {
    { const int nt = j + NB - 1 < NTL ? j + NB - 1 : NTL - 1; DMA(bn, nt); }
    SBAR(); RESC(al); SBAR();
    mm_iter<DK, NDB, VAR::PIPE>(o, p0, p1, L + b0, L + b1 + SHM_V, pa, qr, r32, hi);
    softmax8(p0, p1, m_reg, al, pa, C, thr_raw); SBAR();
    DWAITN(NB - 3); __syncthreads();
    bn = b0; b0 = b1; b1 = b1 + SHM_T == NB * SHM_T ? 0 : b1 + SHM_T;
  }
  RESC(al); pv<NDB>(o, L + b0, pa, r32, hi);
  DWAIT();
#pragma unroll
  for (int r = 0; r < 16; ++r) { const int orow = wid * QBLK + crow(r, hi); const float rl = __builtin_amdgcn_rcpf(o[NDB][r]);
#pragma unroll
    for (int d0 = 0; d0 < NDB; ++d0) Ob[(size_t)orow * ldo + d0 * 32 + r32] = f2bf(o[d0][r] * rl); }
  __syncthreads();
#undef DMA
#undef DWAIT
#undef DWAITN
#undef RESC
}
}

struct VarMla { static constexpr int DK = 192, NDB = 4, LDQ = 1536, LDK = 1536, LDO = 2048, NB = 5; static constexpr bool PIPE = true; static constexpr float SCALE = 0.07216878364870322f; };
struct VarDiff { static constexpr int DK = 128, NDB = 8, LDQ = 1024, LDK = 1024, LDO = 2048, NB = 5; static constexpr bool PIPE = false; static constexpr float SCALE = 0.08838834764831845f; };
constexpr size_t VTA_INST = (size_t)(NKEY / 64) * 128 * 64, VTD_INST = (size_t)(NKEY / 64) * 256 * 64;
__device__ __forceinline__ void attn_unit_mla(const Params& p, char* smem, int inst, int qb) {
  const int b = inst >> 3, h = inst & 7;
  at::attn_body<VarMla>(WSP(const unsigned char, OFF_QA) + ((size_t)b * SEQ + qb * 256) * 1536 + h * 192, WSP(const unsigned char, OFF_KA) + (size_t)b * NKEY * 1536 + h * 192,
                        WSP(const unsigned char, OFF_VA) + (size_t)inst * VTA_INST, WSP(bf16_t, OFF_YIN) + ((size_t)b * SEQ + qb * 256) * 2048 + h * 128, NKEY, smem);
}
__device__ __forceinline__ void attn_unit_diff(const Params& p, char* smem, int inst, int qb) {
  const int b = inst >> 3, m = (inst >> 2) & 1, h = inst & 3;
  at::attn_body<VarDiff>(WSP(const unsigned char, OFF_QD) + ((size_t)b * SEQ + qb * 256) * 1024 + m * 512 + h * 128, WSP(const unsigned char, OFF_KD) + (size_t)b * NKEY * 1024 + m * 512 + h * 128,
                         WSP(const unsigned char, OFF_VD) + (size_t)(b * 4 + h) * VTD_INST, WSP(bf16_t, OFF_OD) + ((size_t)b * SEQ + qb * 256) * 2048 + m * 1024 + h * 256, NKEY, smem);
}
__device__ __forceinline__ void ph_attn_mla(const Params& p, char* smem) {
  for (int u0 = blockIdx.x; u0 < NB * 8 * 16; u0 += gridDim.x) {
    const int u = (gridDim.x == 256) ? ((u0 & ~255) | ((u0 & 7) << 5) | ((u0 >> 3) & 31)) : u0;
    attn_unit_mla(p, smem, u >> 4, u & 15);
  }
}
__device__ __forceinline__ void ph_attn_diff_wide(const Params& p, char* smem) {
  for (int u0 = blockIdx.x; u0 < NB * 8 * 16; u0 += gridDim.x) {
    const int u = (gridDim.x == 256) ? ((u0 & ~255) | ((u0 & 7) << 5) | ((u0 >> 3) & 31)) : u0;
    attn_unit_diff(p, smem, u >> 4, u & 15);
  }
}
constexpr int QPAT = 4, Q_ATT = 128, Q_CONV = 384, Q_WORD0 = 3584;
__device__ __forceinline__ void ph_attn_queue(const Params& p, char* smem, int* slot) {
  const int x = blockIdx.x & 7;
  unsigned* cnt = WSP(unsigned, OFF_BAR) + Q_WORD0 + 16 * x;
  for (;;) {
    if (threadIdx.x == 0) *(volatile int*)slot = (int)__hip_atomic_fetch_add(cnt, 1u, __ATOMIC_RELAXED, __HIP_MEMORY_SCOPE_AGENT);
    __syncthreads();
    const int e = __builtin_amdgcn_readfirstlane(*(volatile int*)slot);
    __syncthreads();
    if (e >= Q_ATT + Q_CONV) break;
    int att = -1, cv = -1;
    constexpr int MIXED = (Q_CONV / (QPAT - 1) < Q_ATT ? Q_CONV / (QPAT - 1) : Q_ATT) * QPAT;
    if (e < MIXED) { if (e % QPAT == 0) att = e / QPAT; else cv = e - e / QPAT - 1; }
    else { const int r = e - MIXED, na = MIXED / QPAT, nc = MIXED - na; if (na + r < Q_ATT) att = na + r; else cv = nc + (r - (Q_ATT - na)); }
    if (att >= 0) { if (att < 64) attn_unit_mla(p, smem, x * 4 + (att >> 4), att & 15); else attn_unit_diff(p, smem, x * 4 + ((att - 64) >> 4), att & 15); }
    else conv_item(p, smem, cv * 8 + x);
  }
}
#define XB_TMO      128
#define XB_XCNT(j)  (256  + 64 * (j))
#define XB_XSUB(j)  (1280 + 64 * (j))
#define XB_XGEN(j)  (2304 + 64 * (j))
#define XB_TOP      3328
#define XB_TOPGEN   3392
#define XCD_BAR_WORDS 3456
#define XB_SPIN_CAP (1u << 18)
__device__ __forceinline__ unsigned xb_ld(unsigned* p)              { return __hip_atomic_load(p, __ATOMIC_RELAXED, __HIP_MEMORY_SCOPE_AGENT); }
__device__ __forceinline__ unsigned xb_add(unsigned* p, unsigned v) { return __hip_atomic_fetch_add(p, v, __ATOMIC_RELAXED, __HIP_MEMORY_SCOPE_AGENT); }
__device__ __forceinline__ unsigned xb_xcc_id() { return (unsigned)__builtin_amdgcn_s_getreg((3 << 11) | 20) & 0xFu; }
#define XB_SPIN(cond, bar) do { unsigned _sp = 0; while (cond) { __builtin_amdgcn_s_sleep(1); \
    if ((++_sp & 255u) == 0u) { if (xb_ld(&(bar)[XB_TMO])) break; if (_sp > XB_SPIN_CAP) { atomicAdd(&(bar)[XB_TMO], 1u); break; } } } } while (0)
struct XcdBarrier { unsigned* bar; unsigned x; volatile LAS unsigned* st; };
__device__ __forceinline__ XcdBarrier xcd_barrier_post(unsigned* bar, volatile LAS unsigned* st) {
    XcdBarrier b; b.bar = bar; b.x = xb_xcc_id(); b.st = st;
    if (threadIdx.x == 0) (void)xb_add(&bar[XB_XCNT(b.x)], 1u);
    return b;
}
__device__ __forceinline__ void xcd_barrier_complete(unsigned* bar, unsigned x, unsigned& nloc, unsigned& nx) {
    const unsigned G = gridDim.x * gridDim.y * gridDim.z;
    unsigned sum, cnt, mine, sp = 0u;
    for (;;) {
        sum = 0u; cnt = 0u; mine = 0u;
#pragma unroll
        for (unsigned j = 0; j < 16; ++j) { const unsigned c = xb_ld(&bar[XB_XCNT(j)]); sum += c; cnt += (c > 0u) ? 1u : 0u; mine = (j == x) ? c : mine; }
        if (sum == G) break;
        __builtin_amdgcn_s_sleep(1);
        if ((++sp & 255u) == 0u) { if (xb_ld(&bar[XB_TMO])) break; if (sp > XB_SPIN_CAP) { atomicAdd(&bar[XB_TMO], 1u); break; } }
    }
    nloc = mine > 0u ? mine : 1u; nx = cnt > 0u ? cnt : 1u;
}
__device__ __forceinline__ void xcd_barrier(const XcdBarrier& b) {
    asm volatile("s_waitcnt vmcnt(0)" ::: "memory");
    __syncthreads();
    if (threadIdx.x == 0) {
        unsigned* bar = b.bar;
        __builtin_amdgcn_s_waitcnt(0);
        unsigned nloc = b.st[0], nx = b.st[1];
        if (nloc == 0u) { xcd_barrier_complete(bar, b.x, nloc, nx); b.st[0] = nloc; b.st[1] = nx; }
        const unsigned old = xb_add(&bar[XB_XSUB(b.x)], 1u);
        const unsigned gen = old / nloc;
        if (old + 1u == (gen + 1u) * nloc) {
            __builtin_amdgcn_fence(__ATOMIC_RELEASE, "agent");
            asm volatile("s_waitcnt vmcnt(0)" ::: "memory");
            const unsigned og = xb_add(&bar[XB_TOP], 1u);
            const unsigned tg = og / nx;
            if (og + 1u == (tg + 1u) * nx) xb_add(&bar[XB_TOPGEN], 1u);
            else XB_SPIN(xb_ld(&bar[XB_TOPGEN]) == tg, bar);
            __builtin_amdgcn_fence(__ATOMIC_ACQUIRE, "agent");
            xb_add(&bar[XB_XGEN(b.x)], 1u);
            asm volatile("s_waitcnt vmcnt(0)" ::: "memory");
        } else {
            XB_SPIN(xb_ld(&bar[XB_XGEN(b.x)]) == gen, bar);
            __builtin_amdgcn_fence(__ATOMIC_ACQUIRE, "agent");
            asm volatile("s_waitcnt vmcnt(0)" ::: "memory");
        }
    }
    __syncthreads();
}

#define FGRID(A_, sA_, lda_, B_, sB_, ldb_, nM_, nN_, ng_) fg::Grid{(const char*)(A_), (const char*)(B_), (size_t)(sA_), (size_t)(sB_), lda_, ldb_, nM_, nN_, ng_, (int)gridDim.x, (int)blockIdx.x}
#define FLDS ((LAS unsigned char*)smem)
constexpr int SMEM_MAIN = 135168;
template <int L> __device__ __forceinline__ void ph_moe_gemms_gu(const Params& p, char* smem) {
  fg::gemm_fast<fg::EpiGU, true, true>(FLDS, FGRID(WSP(char, OFF_H), 0, 1024, WSP(char, OFF_WGU) + (size_t)L * NE * 4096 * 2048, (size_t)4096 * 2048, 1024, 8, 16, NE),
                                       fg::EpiGU{WSP(unsigned char, OFF_HID)}, 1024, WSP(const int, OFF_IDX));
}
template <int L> __device__ __forceinline__ void ph_moe_gemms_down(const Params& p, char* smem) {
  fg::gemm_fast<fg::EpiDown, false, true>(FLDS, FGRID(WSP(char, OFF_HID), (size_t)2048 * 2048, 1024, WSP(char, OFF_WD) + (size_t)L * NE * 2048 * 2048, (size_t)2048 * 2048, 1024, 8, 8, NE),
                                          fg::EpiDown{WSP(bf16_t, OFF_YE), WSP(const float, OFF_GATE)}, 1024);
}
__global__ __launch_bounds__(512, 2) void mega(Params p) {
  __shared__ __attribute__((aligned(16))) char smem[SMEM_MAIN + 32];
  volatile LAS unsigned* xst = (volatile LAS unsigned*)(smem + SMEM_MAIN);
  if (threadIdx.x == 0) { xst[0] = 0u; xst[1] = 0u; xst[2] = 0u; xst[3] = 0u; }
  __syncthreads();
  const XcdBarrier bar = xcd_barrier_post(WSP(unsigned, OFF_BAR), xst);
#define GSYNC() xcd_barrier(bar)
  const bool split = gridDim.x == 256;
  if ((blockIdx.x >> 3) & 1) { ph_twiddle(p, smem); ph_weights_small(p, smem); ph_mod(p, smem); } else { ph_mod(p, smem); ph_weights_small(p, smem); ph_twiddle(p, smem); }
  if (!split) ph_weights_expert(p, smem, blockIdx.x, gridDim.x);
  GSYNC();
  ph_pre0(p); GSYNC();
  fg::gemm_fast<fg::EpiIn0, false, true>(FLDS, FGRID(WSP(char, OFF_H), 0, DM / 2, WSP(char, OFF_WIN0), 0, DM / 2, 68, 13, 1), fg::EpiIn0{WSP(bf16_t, OFF_P0), WSP(unsigned char, OFF_QD), WSP(unsigned char, OFF_KD), WSP(unsigned char, OFF_VD)}, DM / 2);
  { fg::Grid gv = FGRID(WSP(char, OFF_WIN0) + (size_t)3136 * DM, 0, DM / 2, WSP(char, OFF_H), 0, DM / 2, 4, 68, 1); gv.rot = 128;
    fg::gemm_fast<fg::EpiVT, false, true>(FLDS, gv, fg::EpiVT{WSP(unsigned char, OFF_VD), 8, 4, 1.f / 32.f}, DM / 2); }
  GSYNC();
  ph_post_inproj(p); GSYNC();
  fg::gemm_fast(FLDS, FGRID(WSP(bf16_t, OFF_CQN), 0, 512, WSP(bf16_t, OFF_WUQ), 0, 512, 64, 6, 1), fg::EpiQRope{WSP(unsigned char, OFF_QA)}, 512);
  { fg::Grid gk = FGRID(WSP(bf16_t, OFF_CKVN), 0, 512, WSP(bf16_t, OFF_WUKV), 0, 512, 68, 4, 1); gk.rot = 128;
    fg::gemm_fast(FLDS, gk, fg::EpiKV{WSP(unsigned char, OFF_KA)}, 512);
    fg::Grid gv = FGRID(WSP(bf16_t, OFF_WUKV) + (size_t)1024 * 512, 0, 512, WSP(bf16_t, OFF_CKVN), 0, 512, 4, 68, 1); gv.rot = 112;
    fg::gemm_fast(FLDS, gv, fg::EpiVT{WSP(unsigned char, OFF_VA), 7, 8, 1.f}, 512); }
  GSYNC();
  if (split) ph_attn_queue(p, smem, (int*)(smem + SMEM_MAIN + 16)); else { ph_attn_mla(p, smem); ph_attn_diff_wide(p, smem); }
  GSYNC();
  ph_diffcomb(p); GSYNC();
  fg::gemm_fast(FLDS, FGRID(WSP(bf16_t, OFF_YIN), 0, DM, WSP(bf16_t, OFF_WOUT0), 0, DM, 64, 8, 1), fg::EpiResid<true>{WSP(bf16_t, OFF_XL), p.x, WSP(const float, OFF_ML)}, DM); GSYNC();
  ph_ffn_pre(p, 0, smem); GSYNC();
  ph_topk(p, smem); GSYNC();
  ph_moe_gemms_gu<0>(p, smem); GSYNC();
  ph_moe_gemms_down<0>(p, smem); GSYNC();
  ph_combine(p, 0); GSYNC();
  fg::gemm_fast(FLDS, FGRID(WSP(bf16_t, OFF_H), 0, DM, WSP(bf16_t, OFF_WIN1), 0, DM, 64, 8, 1), fg::EpiBf16{WSP(bf16_t, OFF_Z), DM, DM, 1.f, 1, 0, 0}, DM); GSYNC();
  ph_pool(p);
  fg::gemm_fast(FLDS, FGRID(WSP(bf16_t, OFF_MC), (size_t)512 * 256 * 2, 256, WSP(bf16_t, OFF_Z) + 1024, 512, DM, 2, 64, 4), fg::EpiChanDft{WSP(bf16_t, OFF_ABT2)}, 256); GSYNC();
  ph_fold(p);
  fg::gemm_fast(FLDS, FGRID(WSP(bf16_t, OFF_POOLED), 512, 1024, WSP(bf16_t, OFF_WPOOL), 65536 * 2, 256, 64, 1, 4), fg::EpiScaleCol{WSP(bf16_t, OFF_YCAT), p.pool_scale}, 256); GSYNC();
  { fg::Grid gq = FGRID(WSP(bf16_t, OFF_TW), 0, 4096, WSP(bf16_t, OFF_ABTF), (size_t)256 * 4096 * 2, 4096, 8, 1, 32);
    gq.gd = 2; gq.sA2 = (size_t)2048 * 2; gq.sB2 = (size_t)2048 * 2;
    fg::gemm_fast(FLDS, gq, fg::EpiBf16{WSP(bf16_t, OFF_SPEC), 256, 256, 1.f, 1, (size_t)2048 * 256, 0}, 2048); }
  GSYNC();
  ph_dftcomb(p); GSYNC();
  fg::gemm_fast(FLDS, FGRID(WSP(bf16_t, OFF_YCAT), 0, DM, WSP(bf16_t, OFF_WOUT1), 0, DM, 64, 8, 1), fg::EpiResid<false>{WSP(bf16_t, OFF_XL), WSP(const bf16_t, OFF_XL), WSP(const float, OFF_ML) + 5 * MLW}, DM); GSYNC();
  ph_ffn_pre(p, 1, smem); GSYNC();
  ph_topk(p, smem); GSYNC();
  ph_moe_gemms_gu<1>(p, smem); GSYNC();
  ph_moe_gemms_down<1>(p, smem); GSYNC();
  ph_combine(p, 1);
}

extern "C" void kernel_launch(void* const* d_in, const int* in_sizes, int n_in, void* d_out, int out_size, void* d_ws, size_t ws_size, hipStream_t stream) {
  if (n_in != 29 || ws_size < WS_NEED) { fprintf(stderr, "kernel_launch: bad args n_in %d ws %zu need %zu\n", n_in, ws_size, WS_NEED); return; }
  Params p{};
  const float** f = (const float**)&p;
  for (int i = 0; i < 29; ++i) f[i] = (const float*)d_in[i];
  p.out = (float*)d_out; p.ws = (char*)d_ws;
  static int grid = 0;
  if (!grid) {
    int dev = 0, cus = 0, per_cu = 0;
    (void)hipGetDevice(&dev);
    (void)hipDeviceGetAttribute(&cus, hipDeviceAttributeMultiprocessorCount, dev);
    (void)hipOccupancyMaxActiveBlocksPerMultiprocessor(&per_cu, (const void*)mega, 512, 0);
    if (cus <= 0) cus = 256;
    grid = per_cu >= 1 ? cus : 0;
    if (!grid) { fprintf(stderr, "kernel_launch: occupancy query says 0 blocks per CU\n"); return; }
  }
  (void)hipMemsetAsync(d_ws, 0, 16384, stream);
  hipLaunchKernelGGL(mega, dim3(grid), dim3(512), 0, stream, p);
}
```

```cpp
#include <hip/hip_runtime.h>
#include <stdint.h>
#include <cstdio>

typedef unsigned short bf16_t;
typedef short bf16x8 __attribute__((ext_vector_type(8)));
typedef float f32x4 __attribute__((ext_vector_type(4)));
typedef unsigned u32x4 __attribute__((ext_vector_type(4)));
typedef unsigned u32x2 __attribute__((ext_vector_type(2)));

constexpr int DM = 2048, NB = 4, SEQ = 4096, NT = NB * SEQ, CTXL = 256, NC = NB * CTXL, NA = NT + NC, NKEY = SEQ + CTXL;
constexpr int EIN = 4160, EINP = 4352, P0W = 1088;
constexpr int NE = 16, CAP = 512, FF = 2048, MLW = 6 * DM;
constexpr float EPS = 1e-6f;

constexpr size_t al256(size_t x) { return (x + 255) / 256 * 256; }
constexpr size_t OFF_BAR = 0;
constexpr size_t OFF_ML = 16384;
constexpr size_t OFF_AFF = OFF_ML + al256((size_t)2 * 5 * MLW * 4);
constexpr size_t OFF_IDX = OFF_AFF + (size_t)NB * NE * SEQ * 4;
constexpr size_t OFF_GATE = OFF_IDX + (size_t)NB * NE * CAP * 4;
constexpr size_t OFF_INV = OFF_GATE + (size_t)NB * NE * CAP * 4;
constexpr size_t OFF_WIN0 = OFF_INV + (size_t)NT * NE * 4;
constexpr size_t OFF_WUQ = OFF_WIN0 + (size_t)EINP * DM * 2;
constexpr size_t OFF_WUKV = OFF_WUQ + (size_t)1536 * 512 * 2;
constexpr size_t OFF_WOUT0 = OFF_WUKV + (size_t)2048 * 512 * 2;
constexpr size_t OFF_WIN1 = OFF_WOUT0 + (size_t)DM * DM * 2;
constexpr size_t OFF_WOUT1 = OFF_WIN1 + (size_t)DM * DM * 2;
constexpr size_t OFF_WPOOL = OFF_WOUT1 + (size_t)DM * DM * 2;
constexpr size_t OFF_WFOUR = OFF_WPOOL + (size_t)4 * 256 * 256 * 2;
constexpr size_t OFF_MC = OFF_WFOUR + (size_t)4 * 256 * 256 * 2;
constexpr size_t OFF_TW = OFF_MC + (size_t)4 * 512 * 256 * 2;
constexpr size_t OFF_WGU = OFF_TW + (size_t)4096 * 8192 * 2;
constexpr size_t OFF_WD = OFF_WGU + (size_t)2 * NE * 4096 * 2048 * 2;
constexpr size_t OFF_XL = OFF_WD + (size_t)2 * NE * 2048 * 2048 * 2;
constexpr size_t OFF_H = OFF_XL + (size_t)NT * DM * 4;
constexpr size_t OFF_SCR = OFF_H + (size_t)NA * DM * 2;
constexpr size_t OFF_P0 = OFF_SCR;
constexpr size_t OFF_CQN = OFF_P0 + al256((size_t)NA * EIN * 2);
constexpr size_t OFF_CKVN = OFF_CQN + (size_t)NT * 512 * 2;
constexpr size_t OFF_QA = OFF_CKVN + (size_t)NA * 512 * 2;
constexpr size_t OFF_KA = OFF_QA + (size_t)NT * 1536 * 2;
constexpr size_t OFF_VA = OFF_KA + (size_t)NA * 1536 * 2;
constexpr size_t OFF_QD = OFF_VA + (size_t)NA * 1024 * 2;
constexpr size_t OFF_KD = OFF_QD + (size_t)NT * 1024 * 2;
constexpr size_t OFF_VD = OFF_KD + (size_t)NA * 1024 * 2;
constexpr size_t OFF_OD = OFF_VD + (size_t)NA * 1024 * 2;
constexpr size_t OFF_YIN = OFF_OD + (size_t)NT * 2048 * 4;
constexpr size_t OFF_M0END = OFF_YIN + (size_t)NT * 2048 * 2;
constexpr size_t OFF_XE = OFF_SCR;
constexpr size_t OFF_HID = OFF_XE + (size_t)NE * 2048 * 2048 * 2;
constexpr size_t OFF_YE = OFF_HID + (size_t)NE * 2048 * 2048 * 2;
constexpr size_t OFF_Z = OFF_SCR;
constexpr size_t OFF_POOLED = OFF_Z + (size_t)NT * 2048 * 2;
constexpr size_t OFF_ABT2 = OFF_POOLED + (size_t)NT * 1024 * 2;
constexpr size_t OFF_SPEC = OFF_ABT2 + (size_t)16 * 256 * 8192 * 2;
constexpr size_t OFF_YCAT = OFF_SPEC + (size_t)NT * 1024 * 2;
constexpr size_t OFF_ABTF = OFF_YCAT + (size_t)NT * 2048 * 2;
constexpr size_t OFF_SBUF = OFF_M0END;
constexpr size_t OFF_PBUF = OFF_SBUF + (size_t)SEQ * NKEY * 4;
constexpr size_t OFF_VT = OFF_PBUF + (size_t)SEQ * NKEY * 2;
constexpr size_t WS_NEED = OFF_VT + (size_t)256 * NKEY * 2;

struct Params {
  const float *x, *c, *ctx, *c_ctx, *mod_w, *mod_b, *norm_mix, *norm_ffn, *even_w_in, *q_norm, *w_uq, *kv_norm, *w_ukv,
      *lq1, *lk1, *lq2, *lk2, *subln, *even_w_out, *odd_w_in, *pool_w, *pool_scale, *fourier_w, *odd_w_out, *router_w,
      *w_gate, *w_up, *w_down, *final_norm;
  float* out;
  char* ws;
};
#define WSP(T, off) ((T*)(p.ws + (off)))

typedef float f32x2 __attribute__((ext_vector_type(2)));
typedef __bf16 bf16x2_t __attribute__((ext_vector_type(2)));
__device__ __forceinline__ unsigned cvtpk(float lo, float hi) { f32x2 v = {lo, hi}; bf16x2_t r = __builtin_convertvector(v, bf16x2_t); return __builtin_bit_cast(unsigned, r); }
__device__ __forceinline__ unsigned pack_fp8x4(float a, float b, float c, float d) {
  a = __builtin_amdgcn_fmed3f(a, -448.f, 448.f); b = __builtin_amdgcn_fmed3f(b, -448.f, 448.f); c = __builtin_amdgcn_fmed3f(c, -448.f, 448.f); d = __builtin_amdgcn_fmed3f(d, -448.f, 448.f);
  unsigned w = 0; w = __builtin_amdgcn_cvt_pk_fp8_f32(a, b, w, false); w = __builtin_amdgcn_cvt_pk_fp8_f32(c, d, w, true); return w;
}
__device__ __forceinline__ float bf_lo(unsigned w) { return __uint_as_float(w << 16); }
__device__ __forceinline__ float bf_hi(unsigned w) { return __uint_as_float(w & 0xffff0000u); }
__device__ __forceinline__ float bf2f(bf16_t b) { return __uint_as_float(((unsigned)b) << 16); }
__device__ __forceinline__ bf16_t f2bf(float f) { return (bf16_t)(cvtpk(f, 0.f) & 0xffffu); }
__device__ __forceinline__ float wave_sum(float v) {
#pragma unroll
  for (int o = 32; o > 0; o >>= 1) v += __shfl_xor(v, o, 64);
  return v;
}
__device__ __forceinline__ float wave_max(float v) {
#pragma unroll
  for (int o = 32; o > 0; o >>= 1) v = fmaxf(v, __shfl_xor(v, o, 64));
  return v;
}
__device__ __forceinline__ int otid() { int t = threadIdx.x; asm volatile("" : "+v"(t)); return t; }
__device__ __forceinline__ int gwave() { return blockIdx.x * (blockDim.x >> 6) + (otid() >> 6); }
__device__ __forceinline__ int nwave() { return gridDim.x * (blockDim.x >> 6); }
__device__ __forceinline__ const float* mlp(const Params& p, int l, int row) { return WSP(const float, OFF_ML) + ((size_t)l * 5 + row) * MLW; }

template <int MODE>
__device__ __forceinline__ int rowmap(int n) {
  if (MODE == 0) return n;
  if (MODE == 4) return ((n & 255) < 128) ? ((n >> 8) * 128 + (n & 127)) : (1024 + (n >> 8) * 128 + (n & 127));
  if (MODE == 3) { if (n < 1088 || n >= 3136) return n; const int v = (n - 1088) >> 7, e = (n - 1088) & 127;
    return 1088 + v * 128 + ((2 * (e >> 6) + ((e >> 4) & 1)) << 5) + (((e >> 5) & 1) << 4) + (e & 15); }
  return 32 * (n >> 4) + (n & 15) + (MODE == 2 ? 16 : 0);
}
template <int MODE, bool F8 = false>
__device__ __forceinline__ void tconv(const float* __restrict__ src, int K, int N, int Npad, bf16_t* __restrict__ dst, char* smem) {
  float(*tile)[257] = (float(*)[257])smem;
  const int tid = otid(), tk = K / 64, tn = Npad / 256;
  for (int t = blockIdx.x; t < tk * tn; t += gridDim.x) {
    const int k0 = (t % tk) * 64, n0 = (t / tk) * 256;
#pragma unroll
    for (int i = 0; i < 8; ++i) {
      const int id = tid + i * 512, k = id >> 6, n4 = (id & 63) * 4;
      f32x4 v = {0.f, 0.f, 0.f, 0.f};
      if (n0 + n4 < N) v = *(const f32x4*)(src + (size_t)(k0 + k) * N + n0 + n4);
      tile[k][n4 + 0] = v[0]; tile[k][n4 + 1] = v[1]; tile[k][n4 + 2] = v[2]; tile[k][n4 + 3] = v[3];
    }
    __syncthreads();
    {
      const int n = tid >> 1, kh = (tid & 1) * 32;
      if constexpr (F8) {
        unsigned char* drow8 = (unsigned char*)dst + (size_t)rowmap<MODE>(n0 + n) * K + k0 + kh;
#pragma unroll
        for (int i = 0; i < 2; ++i) {
          u32x4 w;
#pragma unroll
          for (int q = 0; q < 4; ++q) { const int kk = kh + i * 16 + q * 4; w[q] = pack_fp8x4(tile[kk][n] * 32.f, tile[kk + 1][n] * 32.f, tile[kk + 2][n] * 32.f, tile[kk + 3][n] * 32.f); }
          *(u32x4*)(drow8 + i * 16) = w;
        }
      } else {
      bf16_t* drow = dst + (size_t)rowmap<MODE>(n0 + n) * K + k0 + kh;
#pragma unroll
      for (int i = 0; i < 4; ++i) {
        u32x4 w;
        w[0] = cvtpk(tile[kh + i * 8 + 0][n], tile[kh + i * 8 + 1][n]);
        w[1] = cvtpk(tile[kh + i * 8 + 2][n], tile[kh + i * 8 + 3][n]);
        w[2] = cvtpk(tile[kh + i * 8 + 4][n], tile[kh + i * 8 + 5][n]);
        w[3] = cvtpk(tile[kh + i * 8 + 6][n], tile[kh + i * 8 + 7][n]);
        *(u32x4*)(drow + i * 8) = w;
      }
      }
    }
    __syncthreads();
  }
}

constexpr float W8_SCALE = 32.f;
__device__ __forceinline__ void tconv8_tile(const float* __restrict__ src, int K, int N, unsigned char* __restrict__ dst, int mode, int k0, int n0, char* smem) {
  unsigned* img = (unsigned*)smem;
  const int tid = otid();
  f32x4 va[8], vb[8];
#define T8_LOAD(V, S) do { _Pragma("unroll") for (int j = 0; j < 2; ++j) { const int id = tid + j * 512; const float* bp = src + (size_t)(k0 + (S) * 16 + (id >> 8) * 4) * N + n0 + (id & 255) * 4; \
    _Pragma("unroll") for (int r = 0; r < 4; ++r) V[j * 4 + r] = __builtin_nontemporal_load((const f32x4*)(bp + (size_t)r * N)); } } while (0)
#define T8_PUT(V, S) do { _Pragma("unroll") for (int j = 0; j < 2; ++j) { const int id = tid + j * 512; unsigned* ip = img + ((id & 255) * 4) * 33 + (S) * 4 + (id >> 8); \
    _Pragma("unroll") for (int q = 0; q < 4; ++q) ip[q * 33] = pack_fp8x4(V[j * 4 + 0][q] * W8_SCALE, V[j * 4 + 1][q] * W8_SCALE, V[j * 4 + 2][q] * W8_SCALE, V[j * 4 + 3][q] * W8_SCALE); } } while (0)
  T8_LOAD(va, 0);
#pragma unroll
  for (int s2 = 0; s2 < 4; ++s2) {
    T8_LOAD(vb, 2 * s2 + 1);
    T8_PUT(va, 2 * s2);
    if (s2 < 3) T8_LOAD(va, 2 * s2 + 2);
    T8_PUT(vb, 2 * s2 + 1);
  }
  __syncthreads();
#pragma unroll
  for (int i = 0; i < 16; ++i) {
    const int idx = tid + i * 512, n = idx >> 3, ch = idx & 7, ng = n0 + n;
    const int drow = mode == 0 ? ng : (32 * (ng >> 4) + (ng & 15) + (mode == 2 ? 16 : 0));
    const unsigned* ip = img + n * 33 + ch * 4;
    const u32x4 w = {ip[0], ip[1], ip[2], ip[3]};
    __builtin_nontemporal_store(w, (u32x4*)(dst + (size_t)drow * K + k0 + ch * 16));
  }
  __syncthreads();
#undef T8_LOAD
#undef T8_PUT
}
__device__ __forceinline__ void ph_weights_small(const Params& p, char* smem) {
  tconv<3, true>(p.even_w_in, DM, EIN, EINP, WSP(bf16_t, OFF_WIN0), smem);
  tconv<0>(p.w_uq, 512, 1536, 1536, WSP(bf16_t, OFF_WUQ), smem);
  tconv<4>(p.w_ukv, 512, 2048, 2048, WSP(bf16_t, OFF_WUKV), smem);
  tconv<0>(p.even_w_out, DM, DM, DM, WSP(bf16_t, OFF_WOUT0), smem);
  tconv<0>(p.odd_w_in, DM, DM, DM, WSP(bf16_t, OFF_WIN1), smem);
  tconv<0>(p.odd_w_out, DM, DM, DM, WSP(bf16_t, OFF_WOUT1), smem);
  for (int g = 0; g < 4; ++g) {
    tconv<0>(p.pool_w + (size_t)g * 65536, 256, 256, 256, WSP(bf16_t, OFF_WPOOL) + (size_t)g * 65536, smem);
  }
}
__device__ __forceinline__ void conv_item(const Params& p, char* smem, int g) {
  const int mat = g >> 5, st = g & 31, le = mat / 3, which = mat - 3 * le, k0 = (st & 15) * 128, n0 = (st >> 4) * 1024;
  const size_t so = (size_t)le * 2048 * 2048;
  const float* src = (which == 0 ? p.w_gate : (which == 1 ? p.w_up : p.w_down)) + so;
  unsigned char* dst = which == 2 ? WSP(unsigned char, OFF_WD) + so : WSP(unsigned char, OFF_WGU) + (size_t)le * 4096 * 2048;
  tconv8_tile(src, 2048, 2048, dst, which == 2 ? 0 : which + 1, k0, n0, smem);
}
__device__ __forceinline__ void ph_weights_expert(const Params& p, char* smem, int widx, int wcount) {
  for (int g = widx; g < 2 * NE * 3 * 32; g += wcount) conv_item(p, smem, g);
}

__device__ __forceinline__ void ph_mod(const Params& p, char* smem) {
  float* sc = (float*)smem;
  float* part = sc + 5 * 2048;
  const int tid = otid();
  for (int i = tid; i < 5 * 2048; i += 512) {
    const int r = i >> 11, k = i & 2047;
    const float v = r < 4 ? p.c[r * 2048 + k] : p.c_ctx[k];
    sc[i] = v / (1.f + __expf(-v));
  }
  __syncthreads();
  for (int cb = blockIdx.x; cb < 256; cb += gridDim.x) {
    const int l = cb >> 7, j0 = (cb & 127) * 96;
    const int c4 = tid % 24, kg = tid / 24;
    if (tid < 504) {
      f32x4 acc[5];
#pragma unroll
      for (int r = 0; r < 5; ++r) acc[r] = (f32x4){0.f, 0.f, 0.f, 0.f};
      const float* wp = p.mod_w + (size_t)l * 2048 * MLW + j0 + c4 * 4;
#pragma unroll 4
      for (int k = kg; k < 2048; k += 21) {
        const f32x4 w = *(const f32x4*)(wp + (size_t)k * MLW);
#pragma unroll
        for (int r = 0; r < 5; ++r) acc[r] += sc[r * 2048 + k] * w;
      }
#pragma unroll
      for (int r = 0; r < 5; ++r)
#pragma unroll
        for (int q = 0; q < 4; ++q) part[(kg * 5 + r) * 96 + c4 * 4 + q] = acc[r][q];
    }
    __syncthreads();
    if (tid < 480) {
      const int r = tid / 96, col = tid % 96;
      float s = p.mod_b[l * MLW + j0 + col];
      for (int g = 0; g < 21; ++g) s += part[(g * 5 + r) * 96 + col];
      WSP(float, OFF_ML)[((size_t)l * 5 + r) * MLW + j0 + col] = s;
    }
    __syncthreads();
  }
}

__device__ __forceinline__ void ph_twiddle(const Params& p, char* smem) {
  float* ct = (float*)smem;
  for (int j = otid(); j < 4096; j += 512) ct[j] = cospif((float)j * (1.f / 2048.f));
  __syncthreads();
  bf16_t* tw = WSP(bf16_t, OFF_TW);
  const size_t nchunk = (size_t)2048 * 512;
  for (size_t q = (size_t)blockIdx.x * 512 + otid(); q < nchunk; q += (size_t)gridDim.x * 512) {
    const int k1 = (int)(q >> 9), kk0 = (int)(q & 511) * 8;
    float v[8];
#pragma unroll
    for (int j = 0; j < 8; ++j) {
      const int kk = kk0 + j;
      if (kk <= 2048) v[j] = ct[(k1 * kk) & 4095];
      else v[j] = -ct[(k1 * (kk - 2048) - 1024) & 4095];
    }
    u32x4 w = {cvtpk(v[0], v[1]), cvtpk(v[2], v[3]), cvtpk(v[4], v[5]), cvtpk(v[6], v[7])};
    *(u32x4*)(tw + q * 8) = w;
  }
  bf16_t* mc = WSP(bf16_t, OFF_MC);
  for (int i = blockIdx.x * 512 + otid(); i < 4 * 256 * 256; i += gridDim.x * 512) {
    const int d = i & 255, c = (i >> 8) & 255, g = i >> 16;
    const float* fw = p.fourier_w + (size_t)g * 65536 + d;
    float ac = 0.f, as = 0.f;
#pragma unroll 8
    for (int k2 = 0; k2 < 256; ++k2) {
      const int ph = ((k2 * c) & 255) * 16; const float f = fw[k2 * 256];
      ac += f * ct[ph]; as += f * ct[(ph - 1024) & 4095];
    }
    mc[((size_t)(g * 512 + d) * 256) + c] = f2bf(ac); mc[((size_t)(g * 512 + 256 + d) * 256) + c] = f2bf(as);
  }
  __syncthreads();
}

struct Row8 { f32x4 v[8]; };
__device__ __forceinline__ float row_load_ss(const float* src, int lane, Row8& r) {
  float ss = 0.f;
#pragma unroll
  for (int i = 0; i < 8; ++i) { r.v[i] = *(const f32x4*)(src + i * 256 + lane * 4); ss += r.v[i][0] * r.v[i][0] + r.v[i][1] * r.v[i][1] + r.v[i][2] * r.v[i][2] + r.v[i][3] * r.v[i][3]; }
  return wave_sum(ss);
}
__device__ __forceinline__ float row_load_ss_bf16(const bf16_t* src, int lane, Row8& r) {
  float ss = 0.f;
#pragma unroll
  for (int i = 0; i < 8; ++i) { const u32x2 w = *(const u32x2*)(src + i * 256 + lane * 4); r.v[i] = (f32x4){bf_lo(w[0]), bf_hi(w[0]), bf_lo(w[1]), bf_hi(w[1])};
    ss += r.v[i][0] * r.v[i][0] + r.v[i][1] * r.v[i][1] + r.v[i][2] * r.v[i][2] + r.v[i][3] * r.v[i][3]; }
  return wave_sum(ss);
}
__device__ __forceinline__ void row_norm_mod(Row8& r, float inv, const float* gain, const float* sc, const float* sh, int lane) {
#pragma unroll
  for (int i = 0; i < 8; ++i) {
    const int j = i * 256 + lane * 4;
    const f32x4 g = *(const f32x4*)(gain + j);
    f32x4 y = r.v[i] * inv * g;
    if (sc) { const f32x4 s1 = *(const f32x4*)(sc + j), s0 = *(const f32x4*)(sh + j); y = y * (1.f + s1) + s0; }
    r.v[i] = y;
  }
}
__device__ __forceinline__ void row_store_fp8(const Row8& r, unsigned char* dst, int lane) {
#pragma unroll
  for (int i = 0; i < 8; ++i) *(unsigned*)(dst + i * 256 + lane * 4) = pack_fp8x4(r.v[i][0], r.v[i][1], r.v[i][2], r.v[i][3]);
}
__device__ __forceinline__ void row_store_bf16(const Row8& r, bf16_t* dst, int lane) {
#pragma unroll
  for (int i = 0; i < 8; ++i) { u32x2 w = {cvtpk(r.v[i][0], r.v[i][1]), cvtpk(r.v[i][2], r.v[i][3])}; *(u32x2*)(dst + i * 256 + lane * 4) = w; }
}

__device__ __forceinline__ void ph_pre0(const Params& p) {
  const int lane = otid() & 63;
  for (int r = gwave(); r < NA; r += nwave()) {
    const float* src = r < NT ? p.x + (size_t)r * DM : p.ctx + (size_t)(r - NT) * DM;
    const float* ml = mlp(p, 0, r < NT ? r / SEQ : 4);
    Row8 row; const float ss = row_load_ss(src, lane, row);
    row_norm_mod(row, rsqrtf(ss * (1.f / DM) + EPS), p.norm_mix, ml + 2048, ml, lane);
    row_store_fp8(row, WSP(unsigned char, OFF_H) + (size_t)r * DM, lane);
  }
}

__device__ __forceinline__ float rope_inv_freq(int q, int quarter) { return exp2f(-(float)q / (float)quarter * 13.287712379549449f); }

__device__ __forceinline__ void ph_post_inproj(const Params& p) {
  const int lane = otid() & 63;
  const bf16_t* P0 = WSP(const bf16_t, OFF_P0);
  for (int r = gwave(); r < NA; r += nwave()) {
    const bool lat = r < NT;
    int b, keyrow, prow = 0, pcol = 0;
    if (lat) { b = r / SEQ; const int n = r % SEQ; keyrow = b * NKEY + CTXL + n; prow = n >> 6; pcol = n & 63; }
    else { const int i = r - NT; b = i / CTXL; keyrow = b * NKEY + (i % CTXL); }
    const bf16_t* row = P0 + (size_t)r * P0W;
    const u32x4 wq = *(const u32x4*)(row + lane * 8), wkv = *(const u32x4*)(row + 512 + lane * 8);
    const float xkr = bf2f(row[1024 + lane]);
    asm volatile("" ::: "memory");
    if (lat) {
      const u32x4 w = wq;
      float v[8] = {bf_lo(w[0]), bf_hi(w[0]), bf_lo(w[1]), bf_hi(w[1]), bf_lo(w[2]), bf_hi(w[2]), bf_lo(w[3]), bf_hi(w[3])};
      float ss = 0.f;
#pragma unroll
      for (int j = 0; j < 8; ++j) ss += v[j] * v[j];
      const float inv = rsqrtf(wave_sum(ss) * (1.f / 512.f) + EPS);
      const f32x4 g0 = *(const f32x4*)(p.q_norm + lane * 8), g1 = *(const f32x4*)(p.q_norm + lane * 8 + 4);
      u32x4 o = {cvtpk(v[0] * inv * g0[0], v[1] * inv * g0[1]), cvtpk(v[2] * inv * g0[2], v[3] * inv * g0[3]),
                 cvtpk(v[4] * inv * g1[0], v[5] * inv * g1[1]), cvtpk(v[6] * inv * g1[2], v[7] * inv * g1[3])};
      *(u32x4*)(WSP(bf16_t, OFF_CQN) + (size_t)r * 512 + lane * 8) = o;
    }
    {
      const u32x4 w = wkv;
      float v[8] = {bf_lo(w[0]), bf_hi(w[0]), bf_lo(w[1]), bf_hi(w[1]), bf_lo(w[2]), bf_hi(w[2]), bf_lo(w[3]), bf_hi(w[3])};
      float ss = 0.f;
#pragma unroll
      for (int j = 0; j < 8; ++j) ss += v[j] * v[j];
      const float inv = rsqrtf(wave_sum(ss) * (1.f / 512.f) + EPS);
      const f32x4 g0 = *(const f32x4*)(p.kv_norm + lane * 8), g1 = *(const f32x4*)(p.kv_norm + lane * 8 + 4);
      u32x4 o = {cvtpk(v[0] * inv * g0[0], v[1] * inv * g0[1]), cvtpk(v[2] * inv * g0[2], v[3] * inv * g0[3]),
                 cvtpk(v[4] * inv * g1[0], v[5] * inv * g1[1]), cvtpk(v[6] * inv * g1[2], v[7] * inv * g1[3])};
      *(u32x4*)(WSP(bf16_t, OFF_CKVN) + (size_t)r * 512 + lane * 8) = o;
    }
    const float pos = (lane >> 5) ? (float)pcol : (float)prow;
    const bool second = (lane >> 4) & 1;
    float c64 = 1.f, s64 = 0.f;
    if (lat) sincosf(pos * rope_inv_freq(lane & 15, 16), &s64, &c64);
    {
      const float xs = xkr;
      const float xp = __shfl_xor(xs, 16, 64);
      const float o = second ? (xs * c64 + xp * s64) : (xs * c64 - xp * s64);
      const unsigned char ob = (unsigned char)(pack_fp8x4(o, o, o, o) & 0xffu);
      unsigned char* ka = WSP(unsigned char, OFF_KA) + (size_t)keyrow * 1536 + 128 + (lane & 32) + 8 * ((lane & 15) >> 2) + 4 * ((lane >> 4) & 1) + (lane & 3);
#pragma unroll
      for (int h = 0; h < 8; ++h) ka[h * 192] = ob;
    }
  }
}

__device__ __forceinline__ void ph_diffcomb(const Params& p) {
  const int lane = otid() & 63;
  float d1 = p.lq1[lane] * p.lk1[lane] + p.lq1[lane + 64] * p.lk1[lane + 64];
  float d2 = p.lq2[lane] * p.lk2[lane] + p.lq2[lane + 64] * p.lk2[lane + 64];
  d1 = wave_sum(d1); d2 = wave_sum(d2);
  const float lam_init = 0.2f;
  const float lam = expf(d1) - expf(d2) + lam_init;
  const f32x4 sg = *(const f32x4*)(p.subln + lane * 4);
  const bf16_t* OD = WSP(const bf16_t, OFF_OD);
  for (int r = gwave(); r < NT; r += nwave()) {
    u32x2 w0[4], w1[4];
#pragma unroll
    for (int h = 0; h < 4; ++h) { w0[h] = *(const u32x2*)(OD + (size_t)r * 2048 + h * 256 + lane * 4); w1[h] = *(const u32x2*)(OD + (size_t)r * 2048 + 1024 + h * 256 + lane * 4); }
    asm volatile("" ::: "memory");
#pragma unroll
    for (int h = 0; h < 4; ++h) {
      const f32x4 o0 = {bf_lo(w0[h][0]), bf_hi(w0[h][0]), bf_lo(w0[h][1]), bf_hi(w0[h][1])}, o1 = {bf_lo(w1[h][0]), bf_hi(w1[h][0]), bf_lo(w1[h][1]), bf_hi(w1[h][1])};
      const f32x4 d = o0 - lam * o1;
      const float ss = wave_sum(d[0] * d[0] + d[1] * d[1] + d[2] * d[2] + d[3] * d[3]);
      const float inv = rsqrtf(ss * (1.f / 256.f) + EPS) * (1.f - lam_init);
      u32x2 w = {cvtpk(d[0] * inv * sg[0], d[1] * inv * sg[1]), cvtpk(d[2] * inv * sg[2], d[3] * inv * sg[3])};
      *(u32x2*)(WSP(bf16_t, OFF_YIN) + (size_t)r * 2048 + 1024 + h * 256 + lane * 4) = w;
    }
  }
}

__device__ __forceinline__ float swapsum32(float a, float b) { auto r = __builtin_amdgcn_permlane32_swap(__float_as_uint(a), __float_as_uint(b), false, false); return __uint_as_float(r[0]) + __uint_as_float(r[1]); }
__device__ __forceinline__ float swapsum16(float a, float b) { auto r = __builtin_amdgcn_permlane16_swap(__float_as_uint(a), __float_as_uint(b), false, false); return __uint_as_float(r[0]) + __uint_as_float(r[1]); }
__device__ __forceinline__ float rowsum16(float v) {
  v += __int_as_float(__builtin_amdgcn_update_dpp(0, __float_as_int(v), 0x128, 0xf, 0xf, false));
  v += __int_as_float(__builtin_amdgcn_update_dpp(0, __float_as_int(v), 0x124, 0xf, 0xf, false));
  v += __int_as_float(__builtin_amdgcn_update_dpp(0, __float_as_int(v), 0x122, 0xf, 0xf, false));
  v += __int_as_float(__builtin_amdgcn_update_dpp(0, __float_as_int(v), 0x121, 0xf, 0xf, false));
  return v;
}
__device__ __forceinline__ void ph_ffn_pre(const Params& p, int l, char* smem) {
  const int lane = otid() & 63, tid = otid();
  float* rw = (float*)smem;
  const float* rsrc = p.router_w + (size_t)l * DM * NE;
  for (int id = tid; id < DM * 4; id += 512) {
    const int j = id >> 2, q = id & 3;
    const f32x4 v = *(const f32x4*)(rsrc + j * 16 + q * 4);
    const int i = j >> 8, ln = (j & 255) >> 2, k = j & 3;
    *(f32x4*)(rw + ((((q * 8 + i) * 4 + k) * 64 + ln) << 2)) = v;
  }
  __syncthreads();
  const int gw = gwave(), nw = nwave();
  const bf16_t* XL = WSP(const bf16_t, OFF_XL);
  for (int pi = gw; pi < NT / 2; pi += nw) {
    u32x2 nx[2][8];
#pragma unroll
    for (int x = 0; x < 2; ++x)
#pragma unroll
      for (int i = 0; i < 8; ++i) nx[x][i] = *(const u32x2*)(XL + (size_t)(2 * pi + x) * DM + i * 256 + lane * 4);
    const int r0 = 2 * pi, b = r0 / SEQ, n0 = r0 % SEQ;
    const float* ml = mlp(p, l, b);
    Row8 row[2]; float ssl[2] = {0.f, 0.f};
#pragma unroll
    for (int x = 0; x < 2; ++x)
#pragma unroll
      for (int i = 0; i < 8; ++i) { const u32x2 w = nx[x][i]; row[x].v[i] = (f32x4){bf_lo(w[0]), bf_hi(w[0]), bf_lo(w[1]), bf_hi(w[1])};
        ssl[x] += row[x].v[i][0] * row[x].v[i][0] + row[x].v[i][1] * row[x].v[i][1] + row[x].v[i][2] * row[x].v[i][2] + row[x].v[i][3] * row[x].v[i][3]; }
    float st = swapsum32(ssl[0], ssl[1]); st = rowsum16(swapsum16(st, st));
    const float inv0 = rsqrtf(__builtin_amdgcn_readlane(st, 0) * (1.f / DM) + EPS), inv1 = rsqrtf(__builtin_amdgcn_readlane(st, 32) * (1.f / DM) + EPS);
#pragma unroll
    for (int i = 0; i < 8; ++i) {
      const int j = i * 256 + lane * 4;
      const f32x4 g = *(const f32x4*)(p.norm_ffn + l * DM + j), s1 = *(const f32x4*)(ml + 8192 + j), s0 = *(const f32x4*)(ml + 6144 + j);
      row[0].v[i] = row[0].v[i] * inv0 * g * (1.f + s1) + s0; row[1].v[i] = row[1].v[i] * inv1 * g * (1.f + s1) + s0;
    }
    row_store_fp8(row[0], WSP(unsigned char, OFF_H) + (size_t)r0 * DM, lane);
    row_store_fp8(row[1], WSP(unsigned char, OFF_H) + (size_t)(r0 + 1) * DM, lane);
    float lg[2][16];
#pragma unroll
    for (int e = 0; e < 16; ++e) { lg[0][e] = 0.f; lg[1][e] = 0.f; }
#pragma unroll
    for (int i = 0; i < 8; ++i) {
      __builtin_amdgcn_sched_barrier(0);
#pragma unroll
      for (int k = 0; k < 4; ++k) {
        __builtin_amdgcn_sched_barrier(0);
        const float h0 = row[0].v[i][k], h1 = row[1].v[i][k];
#pragma unroll
        for (int q = 0; q < 4; ++q) {
          const f32x4 w = *(const f32x4*)(rw + ((((q * 8 + i) * 4 + k) * 64 + lane) << 2));
#pragma unroll
          for (int c = 0; c < 4; ++c) { lg[0][q * 4 + c] += h0 * w[c]; lg[1][q * 4 + c] += h1 * w[c]; }
        }
      }
    }
    float t[8];
#pragma unroll
    for (int e = 0; e < 8; ++e) t[e] = rowsum16(swapsum16(swapsum32(lg[0][e], lg[1][e]), swapsum32(lg[0][e + 8], lg[1][e + 8])));
    float m8 = t[0];
#pragma unroll
    for (int e = 1; e < 8; ++e) m8 = fmaxf(m8, t[e]);
    float mx; { auto r = __builtin_amdgcn_permlane16_swap(__float_as_uint(m8), __float_as_uint(m8), false, false); mx = fmaxf(__uint_as_float(r[0]), __uint_as_float(r[1])); }
    float d8 = 0.f;
#pragma unroll
    for (int e = 0; e < 8; ++e) { t[e] = expf(t[e] - mx); d8 += t[e]; }
    const float rden = 1.f / swapsum16(d8, d8);
    float mine = 0.f;
#pragma unroll
    for (int e = 0; e < 8; ++e) mine = ((lane & 15) == e) ? t[e] * rden : mine;
    if ((lane & 15) < 8) {
      const int x = lane >> 5, e = ((lane >> 4) & 1) * 8 + (lane & 15);
      WSP(float, OFF_AFF)[((size_t)(b * NE + e)) * SEQ + n0 + x] = mine;
      WSP(int, OFF_INV)[(size_t)(r0 + x) * NE + e] = -1;
    }
  }
  __syncthreads();
}

__device__ __forceinline__ void ph_topk(const Params& p, char* smem) {
  unsigned* cnt = (unsigned*)smem;
  const int tid = otid(), lane = tid & 63, wid = tid >> 6;
  for (int be = blockIdx.x; be < NB * NE; be += gridDim.x) {
    const int b = be / NE, e = be % NE;
    const float* src = WSP(const float, OFF_AFF) + (size_t)be * SEQ + tid * 8;
    const f32x4 v0 = *(const f32x4*)src, v1 = *(const f32x4*)(src + 4);
    const float val[8] = {v0[0], v0[1], v0[2], v0[3], v1[0], v1[1], v1[2], v1[3]};
    unsigned key[8];
#pragma unroll
    for (int j = 0; j < 8; ++j) key[j] = __float_as_uint(val[j]);
    unsigned lo = 0u, hi = 0x3f800000u; int par = 0;
    __syncthreads();
    while (lo < hi) {
      const unsigned span = hi - lo + 1u;
      const unsigned t1 = lo + (span >> 2), t2 = lo + (span >> 1), t3 = lo + (span >> 1) + (span >> 2);
      unsigned c1 = 0u, c2 = 0u, c3 = 0u;
#pragma unroll
      for (int k = 0; k < 8; ++k) { c1 += (unsigned)__popcll(__ballot(key[k] >= t1)); c2 += (unsigned)__popcll(__ballot(key[k] >= t2)); c3 += (unsigned)__popcll(__ballot(key[k] >= t3)); }
      if (lane < 3) cnt[par * 32 + wid * 4 + lane] = lane == 0 ? c1 : (lane == 1 ? c2 : c3);
      __syncthreads();
      unsigned s1 = 0u, s2 = 0u, s3 = 0u;
#pragma unroll
      for (int w = 0; w < 8; ++w) { s1 += cnt[par * 32 + w * 4]; s2 += cnt[par * 32 + w * 4 + 1]; s3 += cnt[par * 32 + w * 4 + 2]; }
      par ^= 1;
      if (s1 < (unsigned)CAP) hi = t1 - 1u;
      else if (s2 < (unsigned)CAP) { lo = t1; hi = t2 - 1u; }
      else if (s3 < (unsigned)CAP) { lo = t2; hi = t3 - 1u; }
      else lo = t3;
    }
    const unsigned T = lo;
    int ngt = 0, neq = 0;
#pragma unroll
    for (int j = 0; j < 8; ++j) { ngt += key[j] > T ? 1 : 0; neq += key[j] == T ? 1 : 0; }
    int pk = ngt | (neq << 16);
    int inc = pk;
#pragma unroll
    for (int o = 1; o < 64; o <<= 1) { const int t = __shfl_up(inc, o, 64); if (lane >= o) inc += t; }
    if (lane == 63) cnt[128 + wid] = (unsigned)inc;
    __syncthreads();
    int base = 0, total = 0;
#pragma unroll
    for (int w = 0; w < 8; ++w) { const int t = (int)cnt[128 + w]; total += t; if (w < wid) base += t; }
    const int excl = base + inc - pk;
    int gpos = excl & 0xffff, epos = excl >> 16;
    const int total_gt = total & 0xffff, need = CAP - total_gt;
#pragma unroll
    for (int j = 0; j < 8; ++j) {
      int slot = -1;
      if (key[j] > T) slot = gpos++;
      else if (key[j] == T) { if (epos < need) slot = total_gt + epos; ++epos; }
      if (slot >= 0) {
        const int tok = tid * 8 + j;
        WSP(int, OFF_IDX)[be * CAP + slot] = tok; WSP(float, OFF_GATE)[be * CAP + slot] = val[j];
        WSP(int, OFF_INV)[(size_t)(b * SEQ + tok) * NE + e] = slot;
      }
    }
    __syncthreads();
  }
}

__device__ __forceinline__ void ph_combine(const Params& p, int l) {
  const int lane = otid() & 63;
  for (int r = gwave(); r < NT; r += nwave()) {
    const int b = r / SEQ;
    Row8 acc;
#pragma unroll
    for (int i = 0; i < 8; ++i) acc.v[i] = (f32x4){0.f, 0.f, 0.f, 0.f};
    const int myinv = WSP(const int, OFF_INV)[(size_t)r * NE + (lane & 15)];
    unsigned long long mask = __ballot(myinv >= 0) & 0xffffull;
    bf16_t* xl = WSP(bf16_t, OFF_XL) + (size_t)r * DM;
    u32x2 xw[8];
#pragma unroll
    for (int i = 0; i < 8; ++i) xw[i] = *(const u32x2*)(xl + i * 256 + lane * 4);
    while (mask) {
      const int e = __builtin_ctzll(mask); mask &= mask - 1;
      const int s = __builtin_amdgcn_readlane(myinv, e);
      const bf16_t* ye = WSP(const bf16_t, OFF_YE) + ((size_t)e * 2048 + b * CAP + s) * DM;
#pragma unroll
      for (int i = 0; i < 8; ++i) {
        const u32x2 w = *(const u32x2*)(ye + i * 256 + lane * 4);
        acc.v[i][0] += bf_lo(w[0]); acc.v[i][1] += bf_hi(w[0]); acc.v[i][2] += bf_lo(w[1]); acc.v[i][3] += bf_hi(w[1]);
      }
    }
    const float* ml = mlp(p, l, b);
    Row8 row; float ss = 0.f;
#pragma unroll
    for (int i = 0; i < 8; ++i) {
      const int j = i * 256 + lane * 4;
      const f32x4 g2 = *(const f32x4*)(ml + 10240 + j);
      row.v[i] = (f32x4){bf_lo(xw[i][0]), bf_hi(xw[i][0]), bf_lo(xw[i][1]), bf_hi(xw[i][1])} + g2 * acc.v[i];
      ss += row.v[i][0] * row.v[i][0] + row.v[i][1] * row.v[i][1] + row.v[i][2] * row.v[i][2] + row.v[i][3] * row.v[i][3];
    }
    ss = wave_sum(ss);
    const float inv = rsqrtf(ss * (1.f / DM) + EPS);
    if (l == 0) {
#pragma unroll
      for (int i = 0; i < 8; ++i) { u32x2 w = {cvtpk(row.v[i][0], row.v[i][1]), cvtpk(row.v[i][2], row.v[i][3])}; *(u32x2*)(xl + i * 256 + lane * 4) = w; }
      const float* ml1 = mlp(p, 1, b);
      row_norm_mod(row, inv, p.norm_mix + DM, ml1 + 2048, ml1, lane);
      row_store_bf16(row, WSP(bf16_t, OFF_H) + (size_t)r * DM, lane);
    } else {
      row_norm_mod(row, inv, p.final_norm, nullptr, nullptr, lane);
#pragma unroll
      for (int i = 0; i < 8; ++i) *(f32x4*)(p.out + (size_t)r * DM + i * 256 + lane * 4) = row.v[i];
    }
  }
}

__device__ __forceinline__ void ph_fold(const Params& p) {
  const bf16_t* src = WSP(const bf16_t, OFF_ABT2); bf16_t* dst = WSP(bf16_t, OFF_ABTF);
  float* nyq = WSP(float, OFF_IDX);
  for (int id = blockIdx.x * 512 + otid(); id < 4096 * 512; id += gridDim.x * 512) {
    const int rowi = id >> 9, kk0 = (id & 511) * 8;
    const bf16_t* rp = src + (size_t)rowi * 8192;
    float o[8];
    if (kk0 < 2048) {
      const u32x4 w = *(const u32x4*)(rp + kk0);
#pragma unroll
      for (int j = 0; j < 4; ++j) { o[2 * j] = bf_lo(w[j]); o[2 * j + 1] = bf_hi(w[j]); }
#pragma unroll
      for (int j = 0; j < 8; ++j) { const int kk = kk0 + j; if (kk > 0) o[j] += bf2f(rp[4096 - kk]); }
    } else {
      const int j0 = kk0 - 2048;
      const u32x4 w = *(const u32x4*)(rp + 4096 + j0);
#pragma unroll
      for (int j = 0; j < 4; ++j) { o[2 * j] = bf_lo(w[j]); o[2 * j + 1] = bf_hi(w[j]); }
#pragma unroll
      for (int j = 0; j < 8; ++j) { const int jj = j0 + j; if (jj > 0) o[j] -= bf2f(rp[4096 + 4096 - jj]); else o[j] = bf2f(rp[2048]); }
      if (j0 == 0) nyq[rowi] = o[0];
    }
    u32x4 ow = {cvtpk(o[0], o[1]), cvtpk(o[2], o[3]), cvtpk(o[4], o[5]), cvtpk(o[6], o[7])};
    *(u32x4*)(dst + (size_t)rowi * 4096 + kk0) = ow;
  }
}

__device__ __forceinline__ void ph_dftcomb(const Params& p) {
  const bf16_t* PQ = WSP(const bf16_t, OFF_SPEC); const bf16_t* abtf = WSP(const bf16_t, OFF_ABTF); bf16_t* Y = WSP(bf16_t, OFF_YCAT);
  const float sc = 1.f / 1024.f;
  for (int id = blockIdx.x * 512 + otid(); id < 16 * 2048 * 32; id += gridDim.x * 512) {
    const int d8 = (id & 31) * 8, k1 = (id >> 5) & 2047, bg = id >> 16, b = bg >> 2, g = bg & 3;
    const u32x4 wp = *(const u32x4*)(PQ + ((size_t)(2 * bg) * 2048 + k1) * 256 + d8), wq = *(const u32x4*)(PQ + ((size_t)(2 * bg + 1) * 2048 + k1) * 256 + d8);
    float pv[8], qv[8], ny[8];
#pragma unroll
    for (int j = 0; j < 4; ++j) { pv[2 * j] = bf_lo(wp[j]); pv[2 * j + 1] = bf_hi(wp[j]); qv[2 * j] = bf_lo(wq[j]); qv[2 * j + 1] = bf_hi(wq[j]); }
    const float sgn = (k1 & 1) ? -2.f : 2.f;
    { const f32x4 n0 = *(const f32x4*)(WSP(const float, OFF_IDX) + bg * 256 + d8), n1 = *(const f32x4*)(WSP(const float, OFF_IDX) + bg * 256 + d8 + 4);
#pragma unroll
      for (int j = 0; j < 4; ++j) { ny[j] = sgn * n0[j]; ny[4 + j] = sgn * n1[j]; } }
    bf16_t* y0 = Y + ((size_t)b * SEQ + k1) * DM + 1024 + g * 256 + d8;
    u32x4 o;
#pragma unroll
    for (int j = 0; j < 4; ++j) o[j] = cvtpk((pv[2 * j] + qv[2 * j]) * sc, (pv[2 * j + 1] + qv[2 * j + 1]) * sc);
    *(u32x4*)y0 = o;
    if (k1 > 0) {
#pragma unroll
      for (int j = 0; j < 4; ++j) o[j] = cvtpk((pv[2 * j] - qv[2 * j] + ny[2 * j]) * sc, (pv[2 * j + 1] - qv[2 * j + 1] + ny[2 * j + 1]) * sc);
      *(u32x4*)(Y + ((size_t)b * SEQ + (SEQ - k1)) * DM + 1024 + g * 256 + d8) = o;
    }
  }
  const int lane = otid() & 63;
  for (int r = gwave(); r < 16 * 256; r += nwave()) {
    const bf16_t* row = abtf + (size_t)r * 4096;
    float acc = 0.f;
#pragma unroll
    for (int i = 0; i < 4; ++i) { const u32x4 w = *(const u32x4*)(row + i * 512 + lane * 8);
#pragma unroll
      for (int j = 0; j < 4; ++j) acc += bf_lo(w[j]) - bf_hi(w[j]); }
    acc = wave_sum(acc) + bf2f(row[2048]);
    if (lane == 0) { const int bg = r >> 8, d = r & 255; Y[((size_t)(bg >> 2) * SEQ + 2048) * DM + 1024 + (bg & 3) * 256 + d] = f2bf(acc * sc); }
  }
}

__device__ __forceinline__ void ph_pool(const Params& p) {
  const bf16_t* Z = WSP(const bf16_t, OFF_Z);
  for (int id = blockIdx.x * 512 + otid(); id < NT * 128; id += gridDim.x * 512) {
    const int r = id >> 7, c8 = (id & 127) * 8, g = c8 >> 8, half = 1 << g;
    const int b = r / SEQ, n = r % SEQ;
    const int lo = max(n - half, 0), hi = min(n + half, SEQ);
    float s[8];
#pragma unroll
    for (int j = 0; j < 8; ++j) s[j] = 0.f;
    u32x4 wv[16];
#pragma unroll
    for (int d = 0; d < 16; ++d) { int t = n - 8 + d; t = t < lo ? lo : (t >= hi ? hi - 1 : t); wv[d] = *(const u32x4*)(Z + (size_t)(b * SEQ + t) * 2048 + c8); }
#pragma unroll
    for (int d = 0; d < 16; ++d) { const int t = n - 8 + d; const float wt = (t >= lo && t < hi) ? 1.f : 0.f;
#pragma unroll
      for (int j = 0; j < 4; ++j) { s[2 * j] += wt * bf_lo(wv[d][j]); s[2 * j + 1] += wt * bf_hi(wv[d][j]); } }
    const float rc = 1.f / (float)(hi - lo);
    const u32x4 w = *(const u32x4*)(Z + (size_t)r * 2048 + c8);
    u32x4 o;
#pragma unroll
    for (int j = 0; j < 4; ++j) o[j] = cvtpk(s[2 * j] * rc - bf_lo(w[j]), s[2 * j + 1] * rc - bf_hi(w[j]));
    *(u32x4*)(WSP(bf16_t, OFF_POOLED) + (size_t)r * 1024 + c8) = o;
  }
}

#define LAS __attribute__((address_space(3)))
__host__ __device__ __forceinline__ constexpr int vt_pos(int kap) { return (((kap >> 2) & 1) << 5) | ((kap >> 5) << 4) | (((kap >> 3) & 3) << 2) | (kap & 3); }
namespace fg {
constexpr int BM = 256, BK = 64, HALF = 128, HTB = HALF * BK * 2, STAGE_BYTES = 8 * HTB;
__device__ __forceinline__ int lds_byte(int r, int c) { const int st = (r >> 4) * 2 + (c >> 5), rr = r & 15, cc = c & 31, ob = rr * 64 + cc * 2; return st * 1024 + (ob ^ (((ob >> 9) & 1) << 5)); }
__device__ __forceinline__ void stage_rc(int b, int& R, int& C) { const int st = b / 1024, sb = b % 1024, swz = sb ^ (((sb >> 9) & 1) << 5); R = (st >> 1) * 16 + swz / 64; C = (st & 1) * 32 + (swz % 64) / 2; }
struct Unit { const char* a; const char* b; int pm, pn, grp; };
typedef int i32x8 __attribute__((ext_vector_type(8)));
typedef int i32x4 __attribute__((ext_vector_type(4)));
__device__ __forceinline__ void mfma_fp8(f32x4& acc, const i32x8& a, const i32x8& b, int scale) {
  asm volatile("s_nop 1\n\tv_mfma_scale_f32_16x16x128_f8f6f4 %0, %1, %2, %0, %3, %3 op_sel_hi:[0,0,0]" : "+v"(acc) : "v"(a), "v"(b), "v"(scale));
}
template <int H> __device__ __forceinline__ bf16x8 half8(i32x8 v) { const i32x4 h = H ? __builtin_shufflevector(v, v, 4, 5, 6, 7) : __builtin_shufflevector(v, v, 0, 1, 2, 3); return __builtin_bit_cast(bf16x8, h); }
__device__ __forceinline__ i32x8 cat8(bf16x8 lo, bf16x8 hi) { const i32x4 a = __builtin_bit_cast(i32x4, lo), b = __builtin_bit_cast(i32x4, hi); return (i32x8){a[0], a[1], a[2], a[3], b[0], b[1], b[2], b[3]}; }
struct Grid {
  const char* A; const char* B; size_t sA, sB; int lda, ldb, nM, nN, ngrp, G, c; int gd = 1; size_t sA2 = 0, sB2 = 0;
  int rot = 0;
  __device__ __forceinline__ bool next(int i, Unit& u) const {
    const int cc = (G == 256) ? (((c & 7) * 32 + (c >> 3) + rot) & 255) : c;
    const int L = i * G + cc, per = nM * nN;
    if (L >= per * ngrp) return false;
    const int g = L / per, w = L - g * per;
    const int nig = 8 * nN, gid = w / nig, fm = gid * 8, gsz = (nM - fm) < 8 ? (nM - fm) : 8, wi = w - gid * nig;
    u.grp = g; u.pn = wi / gsz; u.pm = fm + (wi - u.pn * gsz);
    const int g1 = g / gd, g2 = g - g1 * gd;
    u.a = A + (size_t)g1 * sA + (size_t)g2 * sA2 + (size_t)u.pm * 256 * lda * 2; u.b = B + (size_t)g1 * sB + (size_t)g2 * sB2 + (size_t)u.pn * 256 * ldb * 2;
    return true;
  }
};
template <class Epi, bool GATHER = false, bool FP8 = false>
__device__ __forceinline__ void gemm_fast(LAS unsigned char* lds, const Grid& S, const Epi& E, int K, const int* gidx = nullptr) {
  int tid_ = threadIdx.x; asm volatile("" : "+v"(tid_));
  const int tid = tid_, wid = __builtin_amdgcn_readfirstlane(tid >> 6), lane = tid & 63, wr = wid >> 2, wc = wid & 3, fr = lane & 15, fq = lane >> 4;
  const int nt = K / BK;
  unsigned voffA[2], voffB[2];
#pragma unroll
  for (int i = 0; i < 2; ++i) { int R, C; stage_rc(tid * 16 + i * 8192, R, C); voffA[i] = (unsigned)(R * S.lda + C) * 2u; voffB[i] = (unsigned)(R * S.ldb + C) * 2u; }
  const size_t kstep = (size_t)(BK * 2);
  const size_t hstepA = (size_t)HALF * S.lda * 2, hstepB = (size_t)HALF * S.ldb * 2;
  const unsigned ldsw = (unsigned)wid * 1024u;
  const int aoff = FP8 ? lds_byte(wr * 64 + fr, fq * 16) : lds_byte(wr * 64 + fr, fq * 8), boff = FP8 ? lds_byte(wc * 32 + fr, fq * 16) : lds_byte(wc * 32 + fr, fq * 8);
  constexpr int KOFF = FP8 ? 16 : 1024;
#define FG_SA(b, h) (((b) * 2 + (h)) * HTB)
#define FG_SB(b, h) ((4 + (b) * 2 + (h)) * HTB)
#define FG_STAGE(bufoff, gbase, voff) do { _Pragma("unroll") for (int _i = 0; _i < 2; ++_i) \
    __builtin_amdgcn_global_load_lds((const unsigned*)((const char*)(gbase) + (voff)[_i]), (LAS unsigned*)(lds + (bufoff) + ldsw + _i * 8192), 16, 0, 0); } while (0)
#define FG_STAGE_A(bufoff, usen, kb, h) do { if constexpr (GATHER) { _Pragma("unroll") for (int _i = 0; _i < 2; ++_i) { const unsigned _g = (usen) ? gN[h][_i] : gA[h][_i]; \
      __builtin_amdgcn_global_load_lds((const unsigned*)(S.A + _g + (kb)), (LAS unsigned*)(lds + (bufoff) + ldsw + _i * 8192), 16, 0, 0); } } \
    else { FG_STAGE(bufoff, ((usen) ? nA : cA) + (kb) + (h) * hstepA, voffA); } } while (0)
#define FG_LDA(dst, b, h) do { _Pragma("unroll") for (int m = 0; m < 4; ++m) dst[m] = cat8(*(const LAS bf16x8*)(lds + FG_SA(b, h) + aoff + m * 2048), *(const LAS bf16x8*)(lds + FG_SA(b, h) + aoff + m * 2048 + KOFF)); } while (0)
#define FG_LDB(dst, b, h) do { _Pragma("unroll") for (int n = 0; n < 2; ++n) dst[n] = cat8(*(const LAS bf16x8*)(lds + FG_SB(b, h) + boff + n * 2048), *(const LAS bf16x8*)(lds + FG_SB(b, h) + boff + n * 2048 + KOFF)); } while (0)
#define FG_MMA(ai, bj, At, Bt) do { __builtin_amdgcn_s_setprio(1); _Pragma("unroll") for (int m = 0; m < 4; ++m) _Pragma("unroll") for (int n = 0; n < 2; ++n) { \
    if constexpr (FP8) mfma_fp8(acc[ai][bj][m][n], Bt[n], At[m], one_scale); \
    else { acc[ai][bj][m][n] = __builtin_amdgcn_mfma_f32_16x16x32_bf16(half8<0>(Bt[n]), half8<0>(At[m]), acc[ai][bj][m][n], 0, 0, 0); \
           acc[ai][bj][m][n] = __builtin_amdgcn_mfma_f32_16x16x32_bf16(half8<1>(Bt[n]), half8<1>(At[m]), acc[ai][bj][m][n], 0, 0, 0); } } \
    __builtin_amdgcn_s_setprio(0); } while (0)
#define FG_WAIT_V(n) asm volatile("s_waitcnt vmcnt(" #n ")" ::: "memory")
#define FG_WAIT_L(n) asm volatile("s_waitcnt lgkmcnt(" #n ")" ::: "memory")
#define FG_BAR __builtin_amdgcn_s_barrier()
#define FG_SCHED __builtin_amdgcn_sched_barrier(0)
  Unit cur, nxt; int ui = 0;
  if (!S.next(0, cur)) return;
  f32x4 acc[2][2][4][2];
#pragma unroll
  for (int a = 0; a < 2; ++a)
#pragma unroll
    for (int b = 0; b < 2; ++b)
#pragma unroll
      for (int m = 0; m < 4; ++m)
#pragma unroll
        for (int n = 0; n < 2; ++n) acc[a][b][m][n] = (f32x4){0.f, 0.f, 0.f, 0.f};
  int one_scale = 0x7f7f7f7f; asm volatile("" : "+v"(one_scale));
  i32x8 At[4], B0[2], B1[2];
  const char* cA = cur.a; const char* cB = cur.b; const char* nA = cA;
  unsigned gA[2][2] = {{0u, 0u}, {0u, 0u}}, gN[2][2] = {{0u, 0u}, {0u, 0u}};
  auto goff = [&](const Unit& u, unsigned (&g)[2][2]) {
#pragma unroll
    for (int h = 0; h < 2; ++h)
#pragma unroll
      for (int i = 0; i < 2; ++i) { int R, C; stage_rc(tid * 16 + i * 8192, R, C); const int rr = u.pm * 256 + h * 128 + R, bb = rr >> 9;
        const int tok = bb * SEQ + gidx[(bb * NE + u.grp) * CAP + (rr & 511)]; g[h][i] = (unsigned)(tok * S.lda + C) * 2u; }
  };
  if constexpr (GATHER) goff(cur, gA);
  FG_STAGE(FG_SB(0, 0), cB, voffB); FG_STAGE_A(FG_SA(0, 0), false, 0, 0); FG_STAGE(FG_SB(0, 1), cB + hstepB, voffB); FG_STAGE_A(FG_SA(0, 1), false, 0, 1);
  if (wr == 1) FG_BAR;
  FG_WAIT_V(4); FG_BAR;
  FG_STAGE(FG_SB(1, 0), cB + kstep, voffB); FG_STAGE_A(FG_SA(1, 0), false, kstep, 0); FG_STAGE(FG_SB(1, 1), cB + hstepB + kstep, voffB);
  FG_WAIT_V(6); FG_BAR;
  for (;;) {
    const bool has_next = S.next(ui + 1, nxt);
    nA = has_next ? nxt.a : cA; const char* nB = has_next ? nxt.b : cB;
    if constexpr (GATHER) { if (has_next) goff(nxt, gN); else {
#pragma unroll
      for (int h = 0; h < 2; ++h)
#pragma unroll
        for (int i = 0; i < 2; ++i) gN[h][i] = gA[h][i]; } }
#pragma unroll 1
    for (int t = 0; t < nt; t += 2) {
      const bool last = (t == nt - 2);
      const size_t k1 = (size_t)(t + 1) * kstep, k2 = last ? 0 : (size_t)(t + 2) * kstep, k3 = k2 + kstep;
      const char* b2 = last ? nB : cB + (size_t)(t + 2) * kstep;
      const char* b3 = b2 + kstep;
      FG_LDB(B0, 0, 0); FG_SCHED; FG_LDA(At, 0, 0); FG_STAGE_A(FG_SA(1, 1), false, k1, 1);
      FG_WAIT_L(8); FG_BAR; FG_WAIT_L(0); FG_MMA(0, 0, At, B0); FG_BAR; FG_SCHED;
      FG_LDB(B1, 0, 1); FG_STAGE(FG_SB(0, 0), b2, voffB);
      FG_BAR; FG_WAIT_L(0); FG_MMA(0, 1, At, B1); FG_BAR;
      FG_LDA(At, 0, 1); FG_STAGE_A(FG_SA(0, 0), last, k2, 0);
      FG_BAR; FG_WAIT_L(0); FG_MMA(1, 0, At, B0); FG_BAR; FG_SCHED;
      FG_STAGE(FG_SB(0, 1), b2 + hstepB, voffB);
      FG_WAIT_V(6); FG_BAR; FG_MMA(1, 1, At, B1); FG_BAR;
      FG_LDB(B0, 1, 0); FG_SCHED; FG_LDA(At, 1, 0); FG_STAGE_A(FG_SA(0, 1), last, k2, 1);
      FG_WAIT_L(8); FG_BAR; FG_WAIT_L(0); FG_MMA(0, 0, At, B0); FG_BAR; FG_SCHED;
      FG_LDB(B1, 1, 1); FG_STAGE(FG_SB(1, 0), b3, voffB);
      FG_BAR; FG_WAIT_L(0); FG_MMA(0, 1, At, B1); FG_BAR;
      FG_LDA(At, 1, 1); FG_STAGE_A(FG_SA(1, 0), last, k3, 0);
      FG_BAR; FG_WAIT_L(0); FG_MMA(1, 0, At, B0); FG_BAR; FG_SCHED;
      FG_STAGE(FG_SB(1, 1), b3 + hstepB, voffB);
      FG_WAIT_V(6); FG_BAR; FG_MMA(1, 1, At, B1); FG_BAR;
    }
    if constexpr (FP8) asm volatile("s_nop 15\n\ts_nop 15" ::: "memory");
    {
      int tz = threadIdx.x; asm volatile("" : "+v"(tz));
      const int wz = __builtin_amdgcn_readfirstlane(tz >> 6), lz = tz & 63;
      E(acc, cur, wz >> 2, wz & 3, lz & 15, lz >> 4); }
    if (!has_next) break;
#pragma unroll
    for (int a = 0; a < 2; ++a)
#pragma unroll
      for (int b = 0; b < 2; ++b)
#pragma unroll
        for (int m = 0; m < 4; ++m)
#pragma unroll
          for (int n = 0; n < 2; ++n) acc[a][b][m][n] = (f32x4){0.f, 0.f, 0.f, 0.f};
    cur = nxt; cA = nA; cB = nB; ++ui;
    if constexpr (GATHER) {
#pragma unroll
      for (int h = 0; h < 2; ++h)
#pragma unroll
        for (int i = 0; i < 2; ++i) gA[h][i] = gN[h][i]; }
  }
  FG_WAIT_V(0);
  if (wr == 0) FG_BAR;
  FG_BAR;
#undef FG_SA
#undef FG_SB
#undef FG_STAGE
#undef FG_STAGE_A
#undef FG_LDA
#undef FG_LDB
#undef FG_MMA
#undef FG_WAIT_V
#undef FG_WAIT_L
#undef FG_BAR
#undef FG_SCHED
}
typedef f32x4 Acc[2][2][4][2];
#define FG_FOREACH(...)                                                                                                \
  _Pragma("unroll") for (int ai = 0; ai < 2; ++ai) _Pragma("unroll") for (int m = 0; m < 4; ++m)                       \
  _Pragma("unroll") for (int bj = 0; bj < 2; ++bj) _Pragma("unroll") for (int n = 0; n < 2; ++n) {                     \
    const int row = u.pm * 256 + ai * 128 + wr * 64 + m * 16 + fr, col = u.pn * 256 + bj * 128 + wc * 32 + n * 16 + 4 * fq; \
    const f32x4 v = acc[ai][bj][m][n]; __VA_ARGS__ }
__device__ __forceinline__ u32x2 pack4(f32x4 v) { return (u32x2){cvtpk(v[0], v[1]), cvtpk(v[2], v[3])}; }

struct EpiBf16 {
  bf16_t* O; int ld, nvalid; float scale; int gdiv; size_t s1, s2;
  __device__ __forceinline__ void operator()(const Acc& acc, const Unit& u, int wr, int wc, int fr, int fq) const {
    bf16_t* base = O + (size_t)(u.grp / gdiv) * s1 + (size_t)(u.grp % gdiv) * s2;
    FG_FOREACH(if (col < nvalid) *(u32x2*)(base + (size_t)row * ld + col) = pack4(v * scale);)
  }
};
struct EpiQRope {
  unsigned char* QA;
  __device__ __forceinline__ void operator()(const Acc& acc, const Unit& u, int wr, int wc, int fr, int fq) const {
#pragma unroll
    for (int ai = 0; ai < 2; ++ai)
#pragma unroll
      for (int m = 0; m < 4; ++m)
#pragma unroll
        for (int bj = 0; bj < 2; ++bj) {
          const int row = u.pm * 256 + ai * 128 + wr * 64 + m * 16 + fr, g0 = u.pn * 256 + bj * 128 + wc * 32, w0 = g0 % 192;
          f32x4 x1 = acc[ai][bj][m][0], x2 = acc[ai][bj][m][1];
          if (w0 >= 128) {
            const int ntok = row % SEQ; const float pos = (w0 >= 160) ? (float)(ntok & 63) : (float)(ntok >> 6);
#pragma unroll
            for (int j = 0; j < 4; ++j) { const float ang = pos * rope_inv_freq(4 * fq + j, 16); const float sn = __sinf(ang), cs = __cosf(ang);
              const float a = x1[j], b = x2[j]; x1[j] = a * cs - b * sn; x2[j] = b * cs + a * sn; }
          }
          *(u32x2*)(QA + (size_t)row * 1536 + g0 + 8 * fq) = (u32x2){pack_fp8x4(x1[0], x1[1], x1[2], x1[3]), pack_fp8x4(x2[0], x2[1], x2[2], x2[3])};
        }
  }
};
struct EpiIn0 {
  bf16_t* P0; unsigned char* QD; unsigned char* KD; unsigned char* VD;
  __device__ __forceinline__ void operator()(const Acc& acc, const Unit& u, int wr, int wc, int fr, int fq) const {
    const bool lat = u.pm < NT / 256;
#pragma unroll
    for (int ai = 0; ai < 2; ++ai)
#pragma unroll
      for (int m = 0; m < 4; ++m) {
        const int row = u.pm * 256 + ai * 128 + wr * 64 + m * 16 + fr;
        int keyrow, ntok = 0;
        if (lat) { ntok = row % SEQ; keyrow = (row / SEQ) * NKEY + CTXL + ntok; } else { const int ii = row - NT; keyrow = (ii / CTXL) * NKEY + (ii % CTXL); }
#pragma unroll
        for (int bj = 0; bj < 2; ++bj) {
          const int g0 = u.pn * 256 + bj * 128 + wc * 32;
          f32x4 x1 = acc[ai][bj][m][0] * (1.f / 32.f), x2 = acc[ai][bj][m][1] * (1.f / 32.f);
          if (g0 < P0W) { bf16_t* dst = P0 + (size_t)row * P0W + g0 + 4 * fq; *(u32x2*)dst = pack4(x1); *(u32x2*)(dst + 16) = pack4(x2); }
          else if (g0 < 3136) {
            const int vv = (g0 - 1088) >> 7, sg = ((g0 - 1088) & 127) >> 5, axis = sg >> 1, qh = sg & 1;
            if (lat) { const float pos = axis ? (float)(ntok & 63) : (float)(ntok >> 6);
#pragma unroll
              for (int j = 0; j < 4; ++j) { const float ang = pos * rope_inv_freq(qh * 16 + 4 * fq + j, 32); const float sn = __sinf(ang), cs = __cosf(ang);
                const float a = x1[j], b = x2[j]; x1[j] = a * cs - b * sn; x2[j] = b * cs + a * sn; } }
            const u32x2 pk = {pack_fp8x4(x1[0], x1[1], x1[2], x1[3]), pack_fp8x4(x2[0], x2[1], x2[2], x2[3])};
            if (vv < 8) { if (lat) *(u32x2*)(QD + (size_t)row * 1024 + vv * 128 + sg * 32 + 8 * fq) = pk; }
            else *(u32x2*)(KD + (size_t)keyrow * 1024 + (vv - 8) * 128 + sg * 32 + 8 * fq) = pk;
          }
        }
      }
  }
};
struct EpiKV {
  unsigned char* KA;
  __device__ __forceinline__ void operator()(const Acc& acc, const Unit& u, int wr, int wc, int fr, int fq) const {
#pragma unroll
    for (int ai = 0; ai < 2; ++ai)
#pragma unroll
      for (int m = 0; m < 4; ++m) {
        const int row = u.pm * 256 + ai * 128 + wr * 64 + m * 16 + fr;
        int b; int key; if (row < NT) { b = row / SEQ; key = CTXL + (row % SEQ); } else { const int ii = row - NT; b = ii / CTXL; key = ii % CTXL; }
#pragma unroll
        for (int bj = 0; bj < 2; ++bj) {
          const int g0 = u.pn * 256 + bj * 128 + wc * 32, h = g0 >> 7, w0 = g0 & 127;
          const f32x4 x1 = acc[ai][bj][m][0], x2 = acc[ai][bj][m][1];
          *(u32x2*)(KA + ((size_t)b * NKEY + key) * 1536 + h * 192 + w0 + 8 * fq) = (u32x2){pack_fp8x4(x1[0], x1[1], x1[2], x1[3]), pack_fp8x4(x2[0], x2[1], x2[2], x2[3])};
        }
      }
  }
};
struct EpiVT {
  unsigned char* VT; int dvs, nh; float scale;
  __device__ __forceinline__ void operator()(const Acc& acc, const Unit& u, int wr, int wc, int fr, int fq) const {
    FG_FOREACH(
      int b; int key; if (col < NT) { b = col / SEQ; key = CTXL + (col % SEQ); } else { const int ii = col - NT; b = ii / CTXL; key = ii % CTXL; }
      const int h = row >> dvs; const int d = row & ((1 << dvs) - 1);
      *(unsigned*)(VT + ((((size_t)(b * nh + h) * (NKEY / 64) + (key >> 6)) << dvs) + d) * 64 + vt_pos(key & 63)) = pack_fp8x4(v[0] * scale, v[1] * scale, v[2] * scale, v[3] * scale);)
  }
};
template <bool BASE_F32>
struct EpiResid {
  bf16_t* XL; const void* base; const float* ml;
  __device__ __forceinline__ void operator()(const Acc& acc, const Unit& u, int wr, int wc, int fr, int fq) const {
    const int row0 = u.pm * 256 + wr * 64 + fr, col0 = u.pn * 256 + wc * 32 + 4 * fq;
    const float* gp = ml + (size_t)(row0 / SEQ) * MLW + 4096 + col0;
    f32x4 g[2][2];
#pragma unroll
    for (int bj = 0; bj < 2; ++bj)
#pragma unroll
      for (int n = 0; n < 2; ++n) g[bj][n] = *(const f32x4*)(gp + bj * 128 + n * 16);
#pragma unroll
    for (int ai = 0; ai < 2; ++ai)
#pragma unroll
      for (int mh = 0; mh < 2; ++mh) {
        f32x4 bs[2][2][2];
#pragma unroll
        for (int m2 = 0; m2 < 2; ++m2)
#pragma unroll
          for (int bj = 0; bj < 2; ++bj)
#pragma unroll
            for (int n = 0; n < 2; ++n) { const size_t o = (size_t)(row0 + ai * 128 + (mh * 2 + m2) * 16) * DM + col0 + bj * 128 + n * 16;
              if constexpr (BASE_F32) bs[m2][bj][n] = *(const f32x4*)((const float*)base + o);
              else { const u32x2 w = *(const u32x2*)((const bf16_t*)base + o); bs[m2][bj][n] = (f32x4){bf_lo(w[0]), bf_hi(w[0]), bf_lo(w[1]), bf_hi(w[1])}; } }
        asm volatile("" ::: "memory");
#pragma unroll
        for (int m2 = 0; m2 < 2; ++m2)
#pragma unroll
          for (int bj = 0; bj < 2; ++bj)
#pragma unroll
            for (int n = 0; n < 2; ++n)
              *(u32x2*)(XL + (size_t)(row0 + ai * 128 + (mh * 2 + m2) * 16) * DM + col0 + bj * 128 + n * 16) = pack4(bs[m2][bj][n] + g[bj][n] * acc[ai][bj][mh * 2 + m2][n]);
        asm volatile("" ::: "memory");
      }
  }
};
struct EpiGU {
  unsigned char* HID;
  __device__ __forceinline__ void operator()(const Acc& acc, const Unit& u, int wr, int wc, int fr, int fq) const {
    unsigned char* base = HID + (size_t)u.grp * 2048 * FF;
#pragma unroll
    for (int ai = 0; ai < 2; ++ai)
#pragma unroll
      for (int m = 0; m < 4; ++m)
#pragma unroll
        for (int bj = 0; bj < 2; ++bj) {
          const int row = u.pm * 256 + ai * 128 + wr * 64 + m * 16 + fr, hid = u.pn * 128 + bj * 64 + wc * 16 + 4 * fq;
          const f32x4 g = acc[ai][bj][m][0], up = acc[ai][bj][m][1];
          float r[4];
#pragma unroll
          for (int j = 0; j < 4; ++j) { const float gg = g[j] * (1.f / W8_SCALE), uu = up[j] * (1.f / W8_SCALE); r[j] = gg * __builtin_amdgcn_rcpf(1.f + __expf(-gg)) * uu; }
          *(unsigned*)(base + (size_t)row * FF + hid) = pack_fp8x4(r[0], r[1], r[2], r[3]);
        }
  }
};
struct EpiDown {
  bf16_t* YE; const float* gate;
  __device__ __forceinline__ void operator()(const Acc& acc, const Unit& u, int wr, int wc, int fr, int fq) const {
    bf16_t* base = YE + (size_t)u.grp * 2048 * DM;
    float gt[2][4];
#pragma unroll
    for (int ai = 0; ai < 2; ++ai)
#pragma unroll
      for (int m = 0; m < 4; ++m) { const int row = u.pm * 256 + ai * 128 + wr * 64 + m * 16 + fr; gt[ai][m] = gate[((row >> 9) * NE + u.grp) * CAP + (row & 511)] * (1.f / W8_SCALE); }
    asm volatile("" ::: "memory");
    FG_FOREACH(*(u32x2*)(base + (size_t)row * DM + col) = pack4(v * gt[ai][m]);)
  }
};
struct EpiScaleCol {
  bf16_t* O; const float* cs;
  __device__ __forceinline__ void operator()(const Acc& acc, const Unit& u, int wr, int wc, int fr, int fq) const {
    f32x4 sc[2][2];
#pragma unroll
    for (int bj = 0; bj < 2; ++bj)
#pragma unroll
      for (int n = 0; n < 2; ++n) sc[bj][n] = *(const f32x4*)(cs + u.grp * 256 + u.pn * 256 + bj * 128 + wc * 32 + n * 16 + 4 * fq);
    asm volatile("" ::: "memory");
    FG_FOREACH(*(u32x2*)(O + (size_t)row * DM + u.grp * 256 + col) = pack4(v * sc[bj][n]);)
  }
};
struct EpiChanDft {
  bf16_t* ABT2;
  __device__ __forceinline__ void operator()(const Acc& acc, const Unit& u, int wr, int wc, int fr, int fq) const {
    FG_FOREACH(const int b = col / SEQ, nn = col % SEQ;
               *(u32x2*)(ABT2 + (((size_t)(b * 4 + u.grp) * 256) + (row & 255)) * 8192 + (row >> 8) * 4096 + nn) = pack4(v * 1.f);)
  }
};
}

namespace at {
typedef float f32x16 __attribute__((ext_vector_type(16)));
typedef int i32x8a __attribute__((ext_vector_type(8)));
typedef int i32x4a __attribute__((ext_vector_type(4)));
constexpr int NW = 8, QBLK = 32, KVBLK = 64;
#define SBAR() __builtin_amdgcn_sched_barrier(0)
#define MFMA8(A, B, Cc) __builtin_amdgcn_mfma_scale_f32_32x32x64_f8f6f4(A, B, Cc, 0, 0, 0, 0x7f7f7f7f, 0, 0x7f7f7f7f)
__device__ __forceinline__ int crow(int r, int hi) { return (r & 3) + 8 * (r >> 2) + 4 * hi; }
template <int DK> __device__ __forceinline__ int kswz(int row) { return DK == 192 ? ((row >> 2) & 3) : ((row >> 1) & 7); }
template <int DK>
__device__ __forceinline__ void qkt(f32x16& p0, f32x16& p1, const LAS char* Ks, const i32x8a* qf, int r32, int hi) {
  p0 = f32x16{}; p1 = f32x16{};
  const int s = kswz<DK>(r32);
  const LAS char* kr = Ks + r32 * DK;
#pragma unroll
  for (int t = 0; t < DK / 64; ++t) {
    const int c0 = ((4 * t + 2 * hi) ^ s) << 4, c1 = ((4 * t + 2 * hi + 1) ^ s) << 4;
    const i32x4a a0 = *reinterpret_cast<const LAS i32x4a*>(kr + c0), a1 = *reinterpret_cast<const LAS i32x4a*>(kr + c1);
    const i32x4a b0 = *reinterpret_cast<const LAS i32x4a*>(kr + c0 + 32 * DK), b1 = *reinterpret_cast<const LAS i32x4a*>(kr + c1 + 32 * DK);
    const i32x8a k0 = {a0[0], a0[1], a0[2], a0[3], a1[0], a1[1], a1[2], a1[3]}, k1 = {b0[0], b0[1], b0[2], b0[3], b1[0], b1[1], b1[2], b1[3]};
    p0 = MFMA8(k0, qf[t], p0);
    p1 = MFMA8(k1, qf[t], p1); }
}
constexpr float PBIAS = 4.f, PTHR = 3.f;
__device__ __forceinline__ void softmax8(const f32x16& p0, const f32x16& p1, float& m_reg, float& alpha, i32x8a& pa, float C, float thr_raw) {
  float pmax = p0[0];
#pragma unroll
  for (int r = 1; r < 16; ++r) pmax = fmaxf(pmax, p0[r]);
#pragma unroll
  for (int r = 0; r < 16; ++r) pmax = fmaxf(pmax, p1[r]);
  { auto rr = __builtin_amdgcn_permlane32_swap(__float_as_uint(pmax), __float_as_uint(pmax), false, false);
    pmax = fmaxf(__uint_as_float(rr[0]), __uint_as_float(rr[1])); }
  float mn;
  if (__builtin_expect(__all(pmax - m_reg <= thr_raw), 1)) { mn = m_reg; alpha = 1.f; }
  else { mn = fmaxf(m_reg, pmax); alpha = __builtin_amdgcn_exp2f((m_reg - mn) * C); m_reg = mn; }
  const float C8 = 8.f * C, b8 = 8.f * (PBIAS - mn * C) + 56.f;
#pragma unroll
  for (int w = 0; w < 4; ++w) {
    unsigned v = 0, v2 = 0;
#pragma unroll
    for (int j = 0; j < 4; ++j) { v = __builtin_amdgcn_cvt_pk_u8_f32(fmaf(p0[4 * w + j], C8, b8), j, v); v2 = __builtin_amdgcn_cvt_pk_u8_f32(fmaf(p1[4 * w + j], C8, b8), j, v2); }
    pa[w] = (int)v; pa[4 + w] = (int)v2; }
}
template <int NDB>
__device__ __forceinline__ void pv(f32x16* o, const LAS char* Vs, const i32x8a pa, int r32, int hi) {
  const int s = (r32 >> 2) & 3;
  const LAS char* v0 = Vs + r32 * 64 + (((2 * hi) ^ s) << 4); const LAS char* v1 = Vs + r32 * 64 + (((2 * hi + 1) ^ s) << 4);
#pragma unroll
  for (int d0 = 0; d0 < NDB; ++d0) {
    const i32x4a a = *reinterpret_cast<const LAS i32x4a*>(v0 + d0 * 2048), b = *reinterpret_cast<const LAS i32x4a*>(v1 + d0 * 2048);
    const i32x8a vf = {a[0], a[1], a[2], a[3], b[0], b[1], b[2], b[3]};
    o[d0] = MFMA8(pa, vf, o[d0]); }
  const int one4 = 0x38383838;
  const i32x8a ones = {one4, one4, one4, one4, one4, one4, one4, one4};
  o[NDB] = MFMA8(pa, ones, o[NDB]);
}
template <int DK, int NDB, bool QK_FIRST>
__device__ __forceinline__ void mm_iter(f32x16* o, f32x16& p0, f32x16& p1, const LAS char* Vs, const LAS char* Ks, const i32x8a pa, const i32x8a* qf, int r32, int hi) {
  constexpr int NKF = DK / 32, NL = NKF + NDB;
  const int sk = kswz<DK>(r32), sv = (r32 >> 2) & 3;
  const LAS char* kr = Ks + r32 * DK;
  const LAS char* v0 = Vs + r32 * 64 + (((2 * hi) ^ sv) << 4); const LAS char* v1 = Vs + r32 * 64 + (((2 * hi + 1) ^ sv) << 4);
  i32x8a w[3];
#define MM_ISK(i) (QK_FIRST ? (i) < NKF : (i) >= NDB)
#define MM_LOAD(i) do { i32x4a a_, b_; if (MM_ISK(i)) { const int kk = QK_FIRST ? (i) : (i) - NDB, t = kk >> 1, blk = kk & 1; \
      a_ = *reinterpret_cast<const LAS i32x4a*>(kr + blk * 32 * DK + (((4 * t + 2 * hi) ^ sk) << 4)); b_ = *reinterpret_cast<const LAS i32x4a*>(kr + blk * 32 * DK + (((4 * t + 2 * hi + 1) ^ sk) << 4)); } \
    else { const int d0 = QK_FIRST ? (i) - NKF : (i); a_ = *reinterpret_cast<const LAS i32x4a*>(v0 + d0 * 2048); b_ = *reinterpret_cast<const LAS i32x4a*>(v1 + d0 * 2048); } \
    w[(i) % 3] = (i32x8a){a_[0], a_[1], a_[2], a_[3], b_[0], b_[1], b_[2], b_[3]}; } while (0)
  MM_LOAD(0); MM_LOAD(1);
#pragma unroll
  for (int i = 0; i < NL; ++i) {
    if (i + 2 < NL) MM_LOAD(i + 2);
    if (MM_ISK(i)) { const int kk = QK_FIRST ? i : i - NDB, t = kk >> 1, blk = kk & 1;
      if (blk == 0) { if (t == 0) p0 = MFMA8(w[i % 3], qf[t], f32x16{}); else p0 = MFMA8(w[i % 3], qf[t], p0); }
      else { if (t == 0) p1 = MFMA8(w[i % 3], qf[t], f32x16{}); else p1 = MFMA8(w[i % 3], qf[t], p1); } }
    else { const int d0 = QK_FIRST ? i - NKF : i; o[d0] = MFMA8(pa, w[i % 3], o[d0]);
      if (d0 == NDB - 1) { const int one4 = 0x38383838; const i32x8a ones = {one4, one4, one4, one4, one4, one4, one4, one4}; o[NDB] = MFMA8(pa, ones, o[NDB]); } }
    __builtin_amdgcn_sched_barrier(0x406);
  }
#undef MM_ISK
#undef MM_LOAD
}
template <class VAR>
__device__ __forceinline__ void attn_body(const unsigned char* __restrict__ Qb, const unsigned char* __restrict__ Kh, const unsigned char* __restrict__ VT, bf16_t* __restrict__ Ob, int seq, char* lds) {
  constexpr int DK = VAR::DK, NDB = VAR::NDB, ldq = VAR::LDQ, ldk = VAR::LDK, ldo = VAR::LDO;
  constexpr float C = VAR::SCALE * 1.4426950408889634f, thr_raw = PTHR / VAR::SCALE;
  constexpr int SHM_V = NDB * 32 * 64, SHM_K = KVBLK * DK, SHM_T = SHM_V + SHM_K, NVC = NDB / 4;
  static_assert(DK == 192 || DK == 128, "K staging is written for 128- and 192-byte key rows");
  int tid_ = threadIdx.x; asm volatile("" : "+v"(tid_));
  const int tid = tid_, wid = tid >> 6, lane = tid & 63, r32 = lane & 31, hi = lane >> 5, wu = __builtin_amdgcn_readfirstlane(wid);
  LAS char* L = (LAS char*)lds;
  LAS float* al_l = (LAS float*)(L + VAR::NB * SHM_T) + wid * 32;
  float m_reg = -1e30f; f32x16 o[NDB + 1] = {}; i32x8a qr[DK / 64];
  const unsigned char* Qw = Qb + (size_t)(wid * QBLK + r32) * ldq + hi * 32;
#pragma unroll
  for (int t = 0; t < DK / 64; ++t) { const i32x4a a = *reinterpret_cast<const i32x4a*>(Qw + t * 64), b2 = *reinterpret_cast<const i32x4a*>(Qw + t * 64 + 16);
    qr[t] = (i32x8a){a[0], a[1], a[2], a[3], b2[0], b2[1], b2[2], b2[3]}; }
  const unsigned vsrc = (unsigned)((tid >> 2) * 64 + (((tid & 3) ^ ((tid >> 4) & 3)) << 4));
  unsigned ksrc0, ksrc1 = 0;
  if constexpr (DK == 128) { const int row = tid >> 3; ksrc0 = (unsigned)(row * ldk + (((tid & 7) ^ kswz<DK>(row)) << 4)); }
  else { const int r0 = tid / 12, c0 = tid - 12 * r0, ci = 512 + wid * 32 + r32, r1 = ci / 12, c1 = ci - 12 * r1;
    ksrc0 = (unsigned)(r0 * ldk + ((c0 ^ kswz<DK>(r0)) << 4)); ksrc1 = (unsigned)(r1 * ldk + ((c1 ^ kswz<DK>(r1)) << 4)); }
#define DMA(B, tile) do { const unsigned char* vt_ = VT + (size_t)(tile) * SHM_V; const unsigned char* kt_ = Kh + (size_t)(tile) * (KVBLK * ldk); \
    _Pragma("unroll") for (int _i = 0; _i < NVC; ++_i) __builtin_amdgcn_global_load_lds((const unsigned*)(vt_ + vsrc + _i * 8192), (LAS unsigned*)(L + (B) + wu * 1024 + _i * 8192), 16, 0, 0); \
    __builtin_amdgcn_global_load_lds((const unsigned*)(kt_ + ksrc0), (LAS unsigned*)(L + (B) + SHM_V + wu * 1024), 16, 0, 0); \
    if constexpr (DK == 192) { if (hi == 0) __builtin_amdgcn_global_load_lds((const unsigned*)(kt_ + ksrc1), (LAS unsigned*)(L + (B) + SHM_V + 8192 + wu * 512), 16, 0, 0); } } while (0)
#define DWAIT() asm volatile("s_waitcnt vmcnt(0)" ::: "memory")
#define RESC(a) do { if (__any((a) < 1.f)) { if (hi == 0) al_l[r32] = (a); asm volatile("s_waitcnt lgkmcnt(0)" ::: "memory"); \
    _Pragma("unroll") for (int d = 0; d <= NDB; ++d) _Pragma("unroll") for (int r = 0; r < 16; ++r) o[d][r] *= al_l[crow(r, hi)]; } } while (0)
  const int NTL = seq / KVBLK;
  constexpr int NB = VAR::NB, IPT = NVC + (DK == 192 ? 2 : 1);
  static_assert(NB >= 3 && NB * SHM_T + NW * 128 <= 135168, "attention tile ring must fit the kernel's LDS");
#define DWAITN(NT_) asm volatile("s_waitcnt vmcnt(%0)" :: "n"((NT_) * IPT) : "memory")
  int b0 = 0, b1 = SHM_T, bn = (NB - 1) * SHM_T;
  f32x16 p0, p1; float al; i32x8a pa;
#pragma unroll 1
  for (int t = 0; t < NB - 1; ++t) DMA(t * SHM_T, t < NTL ? t : NTL - 1);
  SBAR(); DWAITN(NB - 3); __syncthreads();
  qkt<DK>(p0, p1, L + b0 + SHM_V, qr, r32, hi); softmax8(p0, p1, m_reg, al, pa, C, thr_raw);
  for (int j = 0; j + 1 < NTL; ++j) {
    { const int nt = j + NB - 1 < NTL ? j + NB - 1 : NTL - 1; DMA(bn, nt); }
    SBAR(); RESC(al); SBAR();
    mm_iter<DK, NDB, VAR::PIPE>(o, p0, p1, L + b0, L + b1 + SHM_V, pa, qr, r32, hi);
    softmax8(p0, p1, m_reg, al, pa, C, thr_raw); SBAR();
    DWAITN(NB - 3); __syncthreads();
    bn = b0; b0 = b1; b1 = b1 + SHM_T == NB * SHM_T ? 0 : b1 + SHM_T;
  }
  RESC(al); pv<NDB>(o, L + b0, pa, r32, hi);
  DWAIT();
#pragma unroll
  for (int r = 0; r < 16; ++r) { const int orow = wid * QBLK + crow(r, hi); const float rl = __builtin_amdgcn_rcpf(o[NDB][r]);
#pragma unroll
    for (int d0 = 0; d0 < NDB; ++d0) Ob[(size_t)orow * ldo + d0 * 32 + r32] = f2bf(o[d0][r] * rl); }
  __syncthreads();
#undef DMA
#undef DWAIT
#undef DWAITN
#undef RESC
}
}

struct VarMla { static constexpr int DK = 192, NDB = 4, LDQ = 1536, LDK = 1536, LDO = 2048, NB = 5; static constexpr bool PIPE = true; static constexpr float SCALE = 0.07216878364870322f; };
struct VarDiff { static constexpr int DK = 128, NDB = 8, LDQ = 1024, LDK = 1024, LDO = 2048, NB = 5; static constexpr bool PIPE = false; static constexpr float SCALE = 0.08838834764831845f; };
constexpr size_t VTA_INST = (size_t)(NKEY / 64) * 128 * 64, VTD_INST = (size_t)(NKEY / 64) * 256 * 64;
__device__ __forceinline__ void attn_unit_mla(const Params& p, char* smem, int inst, int qb) {
  const int b = inst >> 3, h = inst & 7;
  at::attn_body<VarMla>(WSP(const unsigned char, OFF_QA) + ((size_t)b * SEQ + qb * 256) * 1536 + h * 192, WSP(const unsigned char, OFF_KA) + (size_t)b * NKEY * 1536 + h * 192,
                        WSP(const unsigned char, OFF_VA) + (size_t)inst * VTA_INST, WSP(bf16_t, OFF_YIN) + ((size_t)b * SEQ + qb * 256) * 2048 + h * 128, NKEY, smem);
}
__device__ __forceinline__ void attn_unit_diff(const Params& p, char* smem, int inst, int qb) {
  const int b = inst >> 3, m = (inst >> 2) & 1, h = inst & 3;
  at::attn_body<VarDiff>(WSP(const unsigned char, OFF_QD) + ((size_t)b * SEQ + qb * 256) * 1024 + m * 512 + h * 128, WSP(const unsigned char, OFF_KD) + (size_t)b * NKEY * 1024 + m * 512 + h * 128,
                         WSP(const unsigned char, OFF_VD) + (size_t)(b * 4 + h) * VTD_INST, WSP(bf16_t, OFF_OD) + ((size_t)b * SEQ + qb * 256) * 2048 + m * 1024 + h * 256, NKEY, smem);
}
__device__ __forceinline__ void ph_attn_mla(const Params& p, char* smem) {
  for (int u0 = blockIdx.x; u0 < NB * 8 * 16; u0 += gridDim.x) {
    const int u = (gridDim.x == 256) ? ((u0 & ~255) | ((u0 & 7) << 5) | ((u0 >> 3) & 31)) : u0;
    attn_unit_mla(p, smem, u >> 4, u & 15);
  }
}
__device__ __forceinline__ void ph_attn_diff_wide(const Params& p, char* smem) {
  for (int u0 = blockIdx.x; u0 < NB * 8 * 16; u0 += gridDim.x) {
    const int u = (gridDim.x == 256) ? ((u0 & ~255) | ((u0 & 7) << 5) | ((u0 >> 3) & 31)) : u0;
    attn_unit_diff(p, smem, u >> 4, u & 15);
  }
}
constexpr int QPAT = 4, Q_ATT = 128, Q_CONV = 384, Q_WORD0 = 3584;
__device__ __forceinline__ void ph_attn_queue(const Params& p, char* smem, int* slot) {
  const int x = blockIdx.x & 7;
  unsigned* cnt = WSP(unsigned, OFF_BAR) + Q_WORD0 + 16 * x;
  for (;;) {
    if (threadIdx.x == 0) *(volatile int*)slot = (int)__hip_atomic_fetch_add(cnt, 1u, __ATOMIC_RELAXED, __HIP_MEMORY_SCOPE_AGENT);
    __syncthreads();
    const int e = __builtin_amdgcn_readfirstlane(*(volatile int*)slot);
    __syncthreads();
    if (e >= Q_ATT + Q_CONV) break;
    int att = -1, cv = -1;
    constexpr int MIXED = (Q_CONV / (QPAT - 1) < Q_ATT ? Q_CONV / (QPAT - 1) : Q_ATT) * QPAT;
    if (e < MIXED) { if (e % QPAT == 0) att = e / QPAT; else cv = e - e / QPAT - 1; }
    else { const int r = e - MIXED, na = MIXED / QPAT, nc = MIXED - na; if (na + r < Q_ATT) att = na + r; else cv = nc + (r - (Q_ATT - na)); }
    if (att >= 0) { if (att < 64) attn_unit_mla(p, smem, x * 4 + (att >> 4), att & 15); else attn_unit_diff(p, smem, x * 4 + ((att - 64) >> 4), att & 15); }
    else conv_item(p, smem, cv * 8 + x);
  }
}
#define XB_TMO      128
#define XB_XCNT(j)  (256  + 64 * (j))
#define XB_XSUB(j)  (1280 + 64 * (j))
#define XB_XGEN(j)  (2304 + 64 * (j))
#define XB_TOP      3328
#define XB_TOPGEN   3392
#define XCD_BAR_WORDS 3456
#define XB_SPIN_CAP (1u << 18)
__device__ __forceinline__ unsigned xb_ld(unsigned* p)              { return __hip_atomic_load(p, __ATOMIC_RELAXED, __HIP_MEMORY_SCOPE_AGENT); }
__device__ __forceinline__ unsigned xb_add(unsigned* p, unsigned v) { return __hip_atomic_fetch_add(p, v, __ATOMIC_RELAXED, __HIP_MEMORY_SCOPE_AGENT); }
__device__ __forceinline__ unsigned xb_xcc_id() { return (unsigned)__builtin_amdgcn_s_getreg((3 << 11) | 20) & 0xFu; }
#define XB_SPIN(cond, bar) do { unsigned _sp = 0; while (cond) { __builtin_amdgcn_s_sleep(1); \
    if ((++_sp & 255u) == 0u) { if (xb_ld(&(bar)[XB_TMO])) break; if (_sp > XB_SPIN_CAP) { atomicAdd(&(bar)[XB_TMO], 1u); break; } } } } while (0)
struct XcdBarrier { unsigned* bar; unsigned x; volatile LAS unsigned* st; };
__device__ __forceinline__ XcdBarrier xcd_barrier_post(unsigned* bar, volatile LAS unsigned* st) {
    XcdBarrier b; b.bar = bar; b.x = xb_xcc_id(); b.st = st;
    if (threadIdx.x == 0) (void)xb_add(&bar[XB_XCNT(b.x)], 1u);
    return b;
}
__device__ __forceinline__ void xcd_barrier_complete(unsigned* bar, unsigned x, unsigned& nloc, unsigned& nx) {
    const unsigned G = gridDim.x * gridDim.y * gridDim.z;
    unsigned sum, cnt, mine, sp = 0u;
    for (;;) {
        sum = 0u; cnt = 0u; mine = 0u;
#pragma unroll
        for (unsigned j = 0; j < 16; ++j) { const unsigned c = xb_ld(&bar[XB_XCNT(j)]); sum += c; cnt += (c > 0u) ? 1u : 0u; mine = (j == x) ? c : mine; }
        if (sum == G) break;
        __builtin_amdgcn_s_sleep(1);
        if ((++sp & 255u) == 0u) { if (xb_ld(&bar[XB_TMO])) break; if (sp > XB_SPIN_CAP) { atomicAdd(&bar[XB_TMO], 1u); break; } }
    }
    nloc = mine > 0u ? mine : 1u; nx = cnt > 0u ? cnt : 1u;
}
__device__ __forceinline__ void xcd_barrier(const XcdBarrier& b) {
    asm volatile("s_waitcnt vmcnt(0)" ::: "memory");
    __syncthreads();
    if (threadIdx.x == 0) {
        unsigned* bar = b.bar;
        __builtin_amdgcn_s_waitcnt(0);
        unsigned nloc = b.st[0], nx = b.st[1];
        if (nloc == 0u) { xcd_barrier_complete(bar, b.x, nloc, nx); b.st[0] = nloc; b.st[1] = nx; }
        const unsigned old = xb_add(&bar[XB_XSUB(b.x)], 1u);
        const unsigned gen = old / nloc;
        if (old + 1u == (gen + 1u) * nloc) {
            __builtin_amdgcn_fence(__ATOMIC_RELEASE, "agent");
            asm volatile("s_waitcnt vmcnt(0)" ::: "memory");
            const unsigned og = xb_add(&bar[XB_TOP], 1u);
            const unsigned tg = og / nx;
            if (og + 1u == (tg + 1u) * nx) xb_add(&bar[XB_TOPGEN], 1u);
            else XB_SPIN(xb_ld(&bar[XB_TOPGEN]) == tg, bar);
            __builtin_amdgcn_fence(__ATOMIC_ACQUIRE, "agent");
            xb_add(&bar[XB_XGEN(b.x)], 1u);
            asm volatile("s_waitcnt vmcnt(0)" ::: "memory");
        } else {
            XB_SPIN(xb_ld(&bar[XB_XGEN(b.x)]) == gen, bar);
            __builtin_amdgcn_fence(__ATOMIC_ACQUIRE, "agent");
            asm volatile("s_waitcnt vmcnt(0)" ::: "memory");
        }
    }
    __syncthreads();
}

#define FGRID(A_, sA_, lda_, B_, sB_, ldb_, nM_, nN_, ng_) fg::Grid{(const char*)(A_), (const char*)(B_), (size_t)(sA_), (size_t)(sB_), lda_, ldb_, nM_, nN_, ng_, (int)gridDim.x, (int)blockIdx.x}
#define FLDS ((LAS unsigned char*)smem)
constexpr int SMEM_MAIN = 135168;
template <int L> __device__ __forceinline__ void ph_moe_gemms_gu(const Params& p, char* smem) {
  fg::gemm_fast<fg::EpiGU, true, true>(FLDS, FGRID(WSP(char, OFF_H), 0, 1024, WSP(char, OFF_WGU) + (size_t)L * NE * 4096 * 2048, (size_t)4096 * 2048, 1024, 8, 16, NE),
                                       fg::EpiGU{WSP(unsigned char, OFF_HID)}, 1024, WSP(const int, OFF_IDX));
}
template <int L> __device__ __forceinline__ void ph_moe_gemms_down(const Params& p, char* smem) {
  fg::gemm_fast<fg::EpiDown, false, true>(FLDS, FGRID(WSP(char, OFF_HID), (size_t)2048 * 2048, 1024, WSP(char, OFF_WD) + (size_t)L * NE * 2048 * 2048, (size_t)2048 * 2048, 1024, 8, 8, NE),
                                          fg::EpiDown{WSP(bf16_t, OFF_YE), WSP(const float, OFF_GATE)}, 1024);
}
__global__ __launch_bounds__(512, 2) void mega(Params p) {
  __shared__ __attribute__((aligned(16))) char smem[SMEM_MAIN + 32];
  volatile LAS unsigned* xst = (volatile LAS unsigned*)(smem + SMEM_MAIN);
  if (threadIdx.x == 0) { xst[0] = 0u; xst[1] = 0u; xst[2] = 0u; xst[3] = 0u; }
  __syncthreads();
  const XcdBarrier bar = xcd_barrier_post(WSP(unsigned, OFF_BAR), xst);
#define GSYNC() xcd_barrier(bar)
  const bool split = gridDim.x == 256;
  if ((blockIdx.x >> 3) & 1) { ph_twiddle(p, smem); ph_weights_small(p, smem); ph_mod(p, smem); } else { ph_mod(p, smem); ph_weights_small(p, smem); ph_twiddle(p, smem); }
  if (!split) ph_weights_expert(p, smem, blockIdx.x, gridDim.x);
  GSYNC();
  ph_pre0(p); GSYNC();
  fg::gemm_fast<fg::EpiIn0, false, true>(FLDS, FGRID(WSP(char, OFF_H), 0, DM / 2, WSP(char, OFF_WIN0), 0, DM / 2, 68, 13, 1), fg::EpiIn0{WSP(bf16_t, OFF_P0), WSP(unsigned char, OFF_QD), WSP(unsigned char, OFF_KD), WSP(unsigned char, OFF_VD)}, DM / 2);
  { fg::Grid gv = FGRID(WSP(char, OFF_WIN0) + (size_t)3136 * DM, 0, DM / 2, WSP(char, OFF_H), 0, DM / 2, 4, 68, 1); gv.rot = 128;
    fg::gemm_fast<fg::EpiVT, false, true>(FLDS, gv, fg::EpiVT{WSP(unsigned char, OFF_VD), 8, 4, 1.f / 32.f}, DM / 2); }
  GSYNC();
  ph_post_inproj(p); GSYNC();
  fg::gemm_fast(FLDS, FGRID(WSP(bf16_t, OFF_CQN), 0, 512, WSP(bf16_t, OFF_WUQ), 0, 512, 64, 6, 1), fg::EpiQRope{WSP(unsigned char, OFF_QA)}, 512);
  { fg::Grid gk = FGRID(WSP(bf16_t, OFF_CKVN), 0, 512, WSP(bf16_t, OFF_WUKV), 0, 512, 68, 4, 1); gk.rot = 128;
    fg::gemm_fast(FLDS, gk, fg::EpiKV{WSP(unsigned char, OFF_KA)}, 512);
    fg::Grid gv = FGRID(WSP(bf16_t, OFF_WUKV) + (size_t)1024 * 512, 0, 512, WSP(bf16_t, OFF_CKVN), 0, 512, 4, 68, 1); gv.rot = 112;
    fg::gemm_fast(FLDS, gv, fg::EpiVT{WSP(unsigned char, OFF_VA), 7, 8, 1.f}, 512); }
  GSYNC();
  if (split) ph_attn_queue(p, smem, (int*)(smem + SMEM_MAIN + 16)); else { ph_attn_mla(p, smem); ph_attn_diff_wide(p, smem); }
  GSYNC();
  ph_diffcomb(p); GSYNC();
  fg::gemm_fast(FLDS, FGRID(WSP(bf16_t, OFF_YIN), 0, DM, WSP(bf16_t, OFF_WOUT0), 0, DM, 64, 8, 1), fg::EpiResid<true>{WSP(bf16_t, OFF_XL), p.x, WSP(const float, OFF_ML)}, DM); GSYNC();
  ph_ffn_pre(p, 0, smem); GSYNC();
  ph_topk(p, smem); GSYNC();
  ph_moe_gemms_gu<0>(p, smem); GSYNC();
  ph_moe_gemms_down<0>(p, smem); GSYNC();
  ph_combine(p, 0); GSYNC();
  fg::gemm_fast(FLDS, FGRID(WSP(bf16_t, OFF_H), 0, DM, WSP(bf16_t, OFF_WIN1), 0, DM, 64, 8, 1), fg::EpiBf16{WSP(bf16_t, OFF_Z), DM, DM, 1.f, 1, 0, 0}, DM); GSYNC();
  ph_pool(p);
  fg::gemm_fast(FLDS, FGRID(WSP(bf16_t, OFF_MC), (size_t)512 * 256 * 2, 256, WSP(bf16_t, OFF_Z) + 1024, 512, DM, 2, 64, 4), fg::EpiChanDft{WSP(bf16_t, OFF_ABT2)}, 256); GSYNC();
  ph_fold(p);
  fg::gemm_fast(FLDS, FGRID(WSP(bf16_t, OFF_POOLED), 512, 1024, WSP(bf16_t, OFF_WPOOL), 65536 * 2, 256, 64, 1, 4), fg::EpiScaleCol{WSP(bf16_t, OFF_YCAT), p.pool_scale}, 256); GSYNC();
  { fg::Grid gq = FGRID(WSP(bf16_t, OFF_TW), 0, 4096, WSP(bf16_t, OFF_ABTF), (size_t)256 * 4096 * 2, 4096, 8, 1, 32);
    gq.gd = 2; gq.sA2 = (size_t)2048 * 2; gq.sB2 = (size_t)2048 * 2;
    fg::gemm_fast(FLDS, gq, fg::EpiBf16{WSP(bf16_t, OFF_SPEC), 256, 256, 1.f, 1, (size_t)2048 * 256, 0}, 2048); }
  GSYNC();
  ph_dftcomb(p); GSYNC();
  fg::gemm_fast(FLDS, FGRID(WSP(bf16_t, OFF_YCAT), 0, DM, WSP(bf16_t, OFF_WOUT1), 0, DM, 64, 8, 1), fg::EpiResid<false>{WSP(bf16_t, OFF_XL), WSP(const bf16_t, OFF_XL), WSP(const float, OFF_ML) + 5 * MLW}, DM); GSYNC();
  ph_ffn_pre(p, 1, smem); GSYNC();
  ph_topk(p, smem); GSYNC();
  ph_moe_gemms_gu<1>(p, smem); GSYNC();
  ph_moe_gemms_down<1>(p, smem); GSYNC();
  ph_combine(p, 1);
}

extern "C" void kernel_launch(void* const* d_in, const int* in_sizes, int n_in, void* d_out, int out_size, void* d_ws, size_t ws_size, hipStream_t stream) {
  if (n_in != 29 || ws_size < WS_NEED) { fprintf(stderr, "kernel_launch: bad args n_in %d ws %zu need %zu\n", n_in, ws_size, WS_NEED); return; }
  Params p{};
  const float** f = (const float**)&p;
  for (int i = 0; i < 29; ++i) f[i] = (const float*)d_in[i];
  p.out = (float*)d_out; p.ws = (char*)d_ws;
  static int grid = 0;
  if (!grid) {
    int dev = 0, cus = 0, per_cu = 0;
    (void)hipGetDevice(&dev);
    (void)hipDeviceGetAttribute(&cus, hipDeviceAttributeMultiprocessorCount, dev);
    (void)hipOccupancyMaxActiveBlocksPerMultiprocessor(&per_cu, (const void*)mega, 512, 0);
    if (cus <= 0) cus = 256;
    grid = per_cu >= 1 ? cus : 0;
    if (!grid) { fprintf(stderr, "kernel_launch: occupancy query says 0 blocks per CU\n"); return; }
  }
  (void)hipMemsetAsync(d_ws, 0, 16384, stream);
  hipLaunchKernelGGL(mega, dim3(grid), dim3(512), 0, stream, p);
}
```

```cpp
#include <hip/hip_runtime.h>
#include <stdint.h>
#include <cstdio>

typedef unsigned short bf16_t;
typedef short bf16x8 __attribute__((ext_vector_type(8)));
typedef float f32x4 __attribute__((ext_vector_type(4)));
typedef unsigned u32x4 __attribute__((ext_vector_type(4)));
typedef unsigned u32x2 __attribute__((ext_vector_type(2)));

constexpr int DM = 2048, NB = 4, SEQ = 4096, NT = NB * SEQ, CTXL = 256, NC = NB * CTXL, NA = NT + NC, NKEY = SEQ + CTXL;
constexpr int EIN = 4160, EINP = 4352, P0W = 1088;
constexpr int NE = 16, CAP = 512, FF = 2048, MLW = 6 * DM;
constexpr float EPS = 1e-6f;

constexpr size_t al256(size_t x) { return (x + 255) / 256 * 256; }
constexpr size_t OFF_BAR = 0;
constexpr size_t OFF_ML = 16384;
constexpr size_t OFF_AFF = OFF_ML + al256((size_t)2 * 5 * MLW * 4);
constexpr size_t OFF_IDX = OFF_AFF + (size_t)NB * NE * SEQ * 4;
constexpr size_t OFF_GATE = OFF_IDX + (size_t)NB * NE * CAP * 4;
constexpr size_t OFF_INV = OFF_GATE + (size_t)NB * NE * CAP * 4;
constexpr size_t OFF_WIN0 = OFF_INV + (size_t)NT * NE * 4;
constexpr size_t OFF_WUQ = OFF_WIN0 + (size_t)EINP * DM * 2;
constexpr size_t OFF_WUKV = OFF_WUQ + (size_t)1536 * 512 * 2;
constexpr size_t OFF_WOUT0 = OFF_WUKV + (size_t)2048 * 512 * 2;
constexpr size_t OFF_WIN1 = OFF_WOUT0 + (size_t)DM * DM * 2;
constexpr size_t OFF_WOUT1 = OFF_WIN1 + (size_t)DM * DM * 2;
constexpr size_t OFF_WPOOL = OFF_WOUT1 + (size_t)DM * DM * 2;
constexpr size_t OFF_WFOUR = OFF_WPOOL + (size_t)4 * 256 * 256 * 2;
constexpr size_t OFF_MC = OFF_WFOUR + (size_t)4 * 256 * 256 * 2;
constexpr size_t OFF_TW = OFF_MC + (size_t)4 * 512 * 256 * 2;
constexpr size_t OFF_WGU = OFF_TW + (size_t)4096 * 8192 * 2;
constexpr size_t OFF_WD = OFF_WGU + (size_t)2 * NE * 4096 * 2048 * 2;
constexpr size_t OFF_XL = OFF_WD + (size_t)2 * NE * 2048 * 2048 * 2;
constexpr size_t OFF_H = OFF_XL + (size_t)NT * DM * 4;
constexpr size_t OFF_SCR = OFF_H + (size_t)NA * DM * 2;
constexpr size_t OFF_P0 = OFF_SCR;
constexpr size_t OFF_CQN = OFF_P0 + al256((size_t)NA * EIN * 2);
constexpr size_t OFF_CKVN = OFF_CQN + (size_t)NT * 512 * 2;
constexpr size_t OFF_QA = OFF_CKVN + (size_t)NA * 512 * 2;
constexpr size_t OFF_KA = OFF_QA + (size_t)NT * 1536 * 2;
constexpr size_t OFF_VA = OFF_KA + (size_t)NA * 1536 * 2;
constexpr size_t OFF_QD = OFF_VA + (size_t)NA * 1024 * 2;
constexpr size_t OFF_KD = OFF_QD + (size_t)NT * 1024 * 2;
constexpr size_t OFF_VD = OFF_KD + (size_t)NA * 1024 * 2;
constexpr size_t OFF_OD = OFF_VD + (size_t)NA * 1024 * 2;
constexpr size_t OFF_YIN = OFF_OD + (size_t)NT * 2048 * 4;
constexpr size_t OFF_M0END = OFF_YIN + (size_t)NT * 2048 * 2;
constexpr size_t OFF_XE = OFF_SCR;
constexpr size_t OFF_HID = OFF_XE + (size_t)NE * 2048 * 2048 * 2;
constexpr size_t OFF_YE = OFF_HID + (size_t)NE * 2048 * 2048 * 2;
constexpr size_t OFF_Z = OFF_SCR;
constexpr size_t OFF_POOLED = OFF_Z + (size_t)NT * 2048 * 2;
constexpr size_t OFF_ABT2 = OFF_POOLED + (size_t)NT * 1024 * 2;
constexpr size_t OFF_SPEC = OFF_ABT2 + (size_t)16 * 256 * 8192 * 2;
constexpr size_t OFF_YCAT = OFF_SPEC + (size_t)NT * 1024 * 2;
constexpr size_t OFF_ABTF = OFF_YCAT + (size_t)NT * 2048 * 2;
constexpr size_t OFF_SBUF = OFF_M0END;
constexpr size_t OFF_PBUF = OFF_SBUF + (size_t)SEQ * NKEY * 4;
constexpr size_t OFF_VT = OFF_PBUF + (size_t)SEQ * NKEY * 2;
constexpr size_t WS_NEED = OFF_VT + (size_t)256 * NKEY * 2;

struct Params {
  const float *x, *c, *ctx, *c_ctx, *mod_w, *mod_b, *norm_mix, *norm_ffn, *even_w_in, *q_norm, *w_uq, *kv_norm, *w_ukv,
      *lq1, *lk1, *lq2, *lk2, *subln, *even_w_out, *odd_w_in, *pool_w, *pool_scale, *fourier_w, *odd_w_out, *router_w,
      *w_gate, *w_up, *w_down, *final_norm;
  float* out;
  char* ws;
};
#define WSP(T, off) ((T*)(p.ws + (off)))

typedef float f32x2 __attribute__((ext_vector_type(2)));
typedef __bf16 bf16x2_t __attribute__((ext_vector_type(2)));
__device__ __forceinline__ unsigned cvtpk(float lo, float hi) { f32x2 v = {lo, hi}; bf16x2_t r = __builtin_convertvector(v, bf16x2_t); return __builtin_bit_cast(unsigned, r); }
__device__ __forceinline__ unsigned pack_fp8x4(float a, float b, float c, float d) {
  a = __builtin_amdgcn_fmed3f(a, -448.f, 448.f); b = __builtin_amdgcn_fmed3f(b, -448.f, 448.f); c = __builtin_amdgcn_fmed3f(c, -448.f, 448.f); d = __builtin_amdgcn_fmed3f(d, -448.f, 448.f);
  unsigned w = 0; w = __builtin_amdgcn_cvt_pk_fp8_f32(a, b, w, false); w = __builtin_amdgcn_cvt_pk_fp8_f32(c, d, w, true); return w;
}
__device__ __forceinline__ float bf_lo(unsigned w) { return __uint_as_float(w << 16); }
__device__ __forceinline__ float bf_hi(unsigned w) { return __uint_as_float(w & 0xffff0000u); }
__device__ __forceinline__ float bf2f(bf16_t b) { return __uint_as_float(((unsigned)b) << 16); }
__device__ __forceinline__ bf16_t f2bf(float f) { return (bf16_t)(cvtpk(f, 0.f) & 0xffffu); }
__device__ __forceinline__ float wave_sum(float v) {
#pragma unroll
  for (int o = 32; o > 0; o >>= 1) v += __shfl_xor(v, o, 64);
  return v;
}
__device__ __forceinline__ float wave_max(float v) {
#pragma unroll
  for (int o = 32; o > 0; o >>= 1) v = fmaxf(v, __shfl_xor(v, o, 64));
  return v;
}
__device__ __forceinline__ int otid() { int t = threadIdx.x; asm volatile("" : "+v"(t)); return t; }
__device__ __forceinline__ int gwave() { return blockIdx.x * (blockDim.x >> 6) + (otid() >> 6); }
__device__ __forceinline__ int nwave() { return gridDim.x * (blockDim.x >> 6); }
__device__ __forceinline__ const float* mlp(const Params& p, int l, int row) { return WSP(const float, OFF_ML) + ((size_t)l * 5 + row) * MLW; }

template <int MODE>
__device__ __forceinline__ int rowmap(int n) {
  if (MODE == 0) return n;
  if (MODE == 4) return ((n & 255) < 128) ? ((n >> 8) * 128 + (n & 127)) : (1024 + (n >> 8) * 128 + (n & 127));
  if (MODE == 3) { if (n < 1088 || n >= 3136) return n; const int v = (n - 1088) >> 7, e = (n - 1088) & 127;
    return 1088 + v * 128 + ((2 * (e >> 6) + ((e >> 4) & 1)) << 5) + (((e >> 5) & 1) << 4) + (e & 15); }
  return 32 * (n >> 4) + (n & 15) + (MODE == 2 ? 16 : 0);
}
template <int MODE, bool F8 = false>
__device__ __forceinline__ void tconv(const float* __restrict__ src, int K, int N, int Npad, bf16_t* __restrict__ dst, char* smem) {
  float(*tile)[257] = (float(*)[257])smem;
  const int tid = otid(), tk = K / 64, tn = Npad / 256;
  for (int t = blockIdx.x; t < tk * tn; t += gridDim.x) {
    const int k0 = (t % tk) * 64, n0 = (t / tk) * 256;
#pragma unroll
    for (int i = 0; i < 8; ++i) {
      const int id = tid + i * 512, k = id >> 6, n4 = (id & 63) * 4;
      f32x4 v = {0.f, 0.f, 0.f, 0.f};
      if (n0 + n4 < N) v = *(const f32x4*)(src + (size_t)(k0 + k) * N + n0 + n4);
      tile[k][n4 + 0] = v[0]; tile[k][n4 + 1] = v[1]; tile[k][n4 + 2] = v[2]; tile[k][n4 + 3] = v[3];
    }
    __syncthreads();
    {
      const int n = tid >> 1, kh = (tid & 1) * 32;
      if constexpr (F8) {
        unsigned char* drow8 = (unsigned char*)dst + (size_t)rowmap<MODE>(n0 + n) * K + k0 + kh;
#pragma unroll
        for (int i = 0; i < 2; ++i) {
          u32x4 w;
#pragma unroll
          for (int q = 0; q < 4; ++q) { const int kk = kh + i * 16 + q * 4; w[q] = pack_fp8x4(tile[kk][n] * 32.f, tile[kk + 1][n] * 32.f, tile[kk + 2][n] * 32.f, tile[kk + 3][n] * 32.f); }
          *(u32x4*)(drow8 + i * 16) = w;
        }
      } else {
      bf16_t* drow = dst + (size_t)rowmap<MODE>(n0 + n) * K + k0 + kh;
#pragma unroll
      for (int i = 0; i < 4; ++i) {
        u32x4 w;
        w[0] = cvtpk(tile[kh + i * 8 + 0][n], tile[kh + i * 8 + 1][n]);
        w[1] = cvtpk(tile[kh + i * 8 + 2][n], tile[kh + i * 8 + 3][n]);
        w[2] = cvtpk(tile[kh + i * 8 + 4][n], tile[kh + i * 8 + 5][n]);
        w[3] = cvtpk(tile[kh + i * 8 + 6][n], tile[kh + i * 8 + 7][n]);
        *(u32x4*)(drow + i * 8) = w;
      }
      }
    }
    __syncthreads();
  }
}

constexpr float W8_SCALE = 32.f;
__device__ __forceinline__ void tconv8_tile(const float* __restrict__ src, int K, int N, unsigned char* __restrict__ dst, int mode, int k0, int n0, char* smem) {
  unsigned* img = (unsigned*)smem;
  const int tid = otid();
  f32x4 va[8], vb[8];
#define T8_LOAD(V, S) do { _Pragma("unroll") for (int j = 0; j < 2; ++j) { const int id = tid + j * 512; const float* bp = src + (size_t)(k0 + (S) * 16 + (id >> 8) * 4) * N + n0 + (id & 255) * 4; \
    _Pragma("unroll") for (int r = 0; r < 4; ++r) V[j * 4 + r] = __builtin_nontemporal_load((const f32x4*)(bp + (size_t)r * N)); } } while (0)
#define T8_PUT(V, S) do { _Pragma("unroll") for (int j = 0; j < 2; ++j) { const int id = tid + j * 512; unsigned* ip = img + ((id & 255) * 4) * 33 + (S) * 4 + (id >> 8); \
    _Pragma("unroll") for (int q = 0; q < 4; ++q) ip[q * 33] = pack_fp8x4(V[j * 4 + 0][q] * W8_SCALE, V[j * 4 + 1][q] * W8_SCALE, V[j * 4 + 2][q] * W8_SCALE, V[j * 4 + 3][q] * W8_SCALE); } } while (0)
  T8_LOAD(va, 0);
#pragma unroll
  for (int s2 = 0; s2 < 4; ++s2) {
    T8_LOAD(vb, 2 * s2 + 1);
    T8_PUT(va, 2 * s2);
    if (s2 < 3) T8_LOAD(va, 2 * s2 + 2);
    T8_PUT(vb, 2 * s2 + 1);
  }
  __syncthreads();
#pragma unroll
  for (int i = 0; i < 16; ++i) {
    const int idx = tid + i * 512, n = idx >> 3, ch = idx & 7, ng = n0 + n;
    const int drow = mode == 0 ? ng : (32 * (ng >> 4) + (ng & 15) + (mode == 2 ? 16 : 0));
    const unsigned* ip = img + n * 33 + ch * 4;
    const u32x4 w = {ip[0], ip[1], ip[2], ip[3]};
    __builtin_nontemporal_store(w, (u32x4*)(dst + (size_t)drow * K + k0 + ch * 16));
  }
  __syncthreads();
#undef T8_LOAD
#undef T8_PUT
}
__device__ __forceinline__ void ph_weights_small(const Params& p, char* smem) {
  tconv<3, true>(p.even_w_in, DM, EIN, EINP, WSP(bf16_t, OFF_WIN0), smem);
  tconv<0>(p.w_uq, 512, 1536, 1536, WSP(bf16_t, OFF_WUQ), smem);
  tconv<4>(p.w_ukv, 512, 2048, 2048, WSP(bf16_t, OFF_WUKV), smem);
  tconv<0>(p.even_w_out, DM, DM, DM, WSP(bf16_t, OFF_WOUT0), smem);
  tconv<0>(p.odd_w_in, DM, DM, DM, WSP(bf16_t, OFF_WIN1), smem);
  tconv<0>(p.odd_w_out, DM, DM, DM, WSP(bf16_t, OFF_WOUT1), smem);
  for (int g = 0; g < 4; ++g) {
    tconv<0>(p.pool_w + (size_t)g * 65536, 256, 256, 256, WSP(bf16_t, OFF_WPOOL) + (size_t)g * 65536, smem);
  }
}
__device__ __forceinline__ void conv_item(const Params& p, char* smem, int g) {
  const int mat = g >> 5, st = g & 31, le = mat / 3, which = mat - 3 * le, k0 = (st & 15) * 128, n0 = (st >> 4) * 1024;
  const size_t so = (size_t)le * 2048 * 2048;
  const float* src = (which == 0 ? p.w_gate : (which == 1 ? p.w_up : p.w_down)) + so;
  unsigned char* dst = which == 2 ? WSP(unsigned char, OFF_WD) + so : WSP(unsigned char, OFF_WGU) + (size_t)le * 4096 * 2048;
  tconv8_tile(src, 2048, 2048, dst, which == 2 ? 0 : which + 1, k0, n0, smem);
}
__device__ __forceinline__ void ph_weights_expert(const Params& p, char* smem, int widx, int wcount) {
  for (int g = widx; g < 2 * NE * 3 * 32; g += wcount) conv_item(p, smem, g);
}

__device__ __forceinline__ void ph_mod(const Params& p, char* smem) {
  float* sc = (float*)smem;
  float* part = sc + 5 * 2048;
  const int tid = otid();
  for (int i = tid; i < 5 * 2048; i += 512) {
    const int r = i >> 11, k = i & 2047;
    const float v = r < 4 ? p.c[r * 2048 + k] : p.c_ctx[k];
    sc[i] = v / (1.f + __expf(-v));
  }
  __syncthreads();
  for (int cb = blockIdx.x; cb < 256; cb += gridDim.x) {
    const int l = cb >> 7, j0 = (cb & 127) * 96;
    const int c4 = tid % 24, kg = tid / 24;
    if (tid < 504) {
      f32x4 acc[5];
#pragma unroll
      for (int r = 0; r < 5; ++r) acc[r] = (f32x4){0.f, 0.f, 0.f, 0.f};
      const float* wp = p.mod_w + (size_t)l * 2048 * MLW + j0 + c4 * 4;
#pragma unroll 4
      for (int k = kg; k < 2048; k += 21) {
        const f32x4 w = *(const f32x4*)(wp + (size_t)k * MLW);
#pragma unroll
        for (int r = 0; r < 5; ++r) acc[r] += sc[r * 2048 + k] * w;
      }
#pragma unroll
      for (int r = 0; r < 5; ++r)
#pragma unroll
        for (int q = 0; q < 4; ++q) part[(kg * 5 + r) * 96 + c4 * 4 + q] = acc[r][q];
    }
    __syncthreads();
    if (tid < 480) {
      const int r = tid / 96, col = tid % 96;
      float s = p.mod_b[l * MLW + j0 + col];
      for (int g = 0; g < 21; ++g) s += part[(g * 5 + r) * 96 + col];
      WSP(float, OFF_ML)[((size_t)l * 5 + r) * MLW + j0 + col] = s;
    }
    __syncthreads();
  }
}

__device__ __forceinline__ void ph_twiddle(const Params& p, char* smem) {
  float* ct = (float*)smem;
  for (int j = otid(); j < 4096; j += 512) ct[j] = cospif((float)j * (1.f / 2048.f));
  __syncthreads();
  bf16_t* tw = WSP(bf16_t, OFF_TW);
  const size_t nchunk = (size_t)2048 * 512;
  for (size_t q = (size_t)blockIdx.x * 512 + otid(); q < nchunk; q += (size_t)gridDim.x * 512) {
    const int k1 = (int)(q >> 9), kk0 = (int)(q & 511) * 8;
    float v[8];
#pragma unroll
    for (int j = 0; j < 8; ++j) {
      const int kk = kk0 + j;
      if (kk <= 2048) v[j] = ct[(k1 * kk) & 4095];
      else v[j] = -ct[(k1 * (kk - 2048) - 1024) & 4095];
    }
    u32x4 w = {cvtpk(v[0], v[1]), cvtpk(v[2], v[3]), cvtpk(v[4], v[5]), cvtpk(v[6], v[7])};
    *(u32x4*)(tw + q * 8) = w;
  }
  bf16_t* mc = WSP(bf16_t, OFF_MC);
  for (int i = blockIdx.x * 512 + otid(); i < 4 * 256 * 256; i += gridDim.x * 512) {
    const int d = i & 255, c = (i >> 8) & 255, g = i >> 16;
    const float* fw = p.fourier_w + (size_t)g * 65536 + d;
    float ac = 0.f, as = 0.f;
#pragma unroll 8
    for (int k2 = 0; k2 < 256; ++k2) {
      const int ph = ((k2 * c) & 255) * 16; const float f = fw[k2 * 256];
      ac += f * ct[ph]; as += f * ct[(ph - 1024) & 4095];
    }
    mc[((size_t)(g * 512 + d) * 256) + c] = f2bf(ac); mc[((size_t)(g * 512 + 256 + d) * 256) + c] = f2bf(as);
  }
  __syncthreads();
}

struct Row8 { f32x4 v[8]; };
__device__ __forceinline__ float row_load_ss(const float* src, int lane, Row8& r) {
  float ss = 0.f;
#pragma unroll
  for (int i = 0; i < 8; ++i) { r.v[i] = *(const f32x4*)(src + i * 256 + lane * 4); ss += r.v[i][0] * r.v[i][0] + r.v[i][1] * r.v[i][1] + r.v[i][2] * r.v[i][2] + r.v[i][3] * r.v[i][3]; }
  return wave_sum(ss);
}
__device__ __forceinline__ float row_load_ss_bf16(const bf16_t* src, int lane, Row8& r) {
  float ss = 0.f;
#pragma unroll
  for (int i = 0; i < 8; ++i) { const u32x2 w = *(const u32x2*)(src + i * 256 + lane * 4); r.v[i] = (f32x4){bf_lo(w[0]), bf_hi(w[0]), bf_lo(w[1]), bf_hi(w[1])};
    ss += r.v[i][0] * r.v[i][0] + r.v[i][1] * r.v[i][1] + r.v[i][2] * r.v[i][2] + r.v[i][3] * r.v[i][3]; }
  return wave_sum(ss);
}
__device__ __forceinline__ void row_norm_mod(Row8& r, float inv, const float* gain, const float* sc, const float* sh, int lane) {
#pragma unroll
  for (int i = 0; i < 8; ++i) {
    const int j = i * 256 + lane * 4;
    const f32x4 g = *(const f32x4*)(gain + j);
    f32x4 y = r.v[i] * inv * g;
    if (sc) { const f32x4 s1 = *(const f32x4*)(sc + j), s0 = *(const f32x4*)(sh + j); y = y * (1.f + s1) + s0; }
    r.v[i] = y;
  }
}
__device__ __forceinline__ void row_store_fp8(const Row8& r, unsigned char* dst, int lane) {
#pragma unroll
  for (int i = 0; i < 8; ++i) *(unsigned*)(dst + i * 256 + lane * 4) = pack_fp8x4(r.v[i][0], r.v[i][1], r.v[i][2], r.v[i][3]);
}
__device__ __forceinline__ void row_store_bf16(const Row8& r, bf16_t* dst, int lane) {
#pragma unroll
  for (int i = 0; i < 8; ++i) { u32x2 w = {cvtpk(r.v[i][0], r.v[i][1]), cvtpk(r.v[i][2], r.v[i][3])}; *(u32x2*)(dst + i * 256 + lane * 4) = w; }
}

__device__ __forceinline__ void ph_pre0(const Params& p) {
  const int lane = otid() & 63;
  for (int r = gwave(); r < NA; r += nwave()) {
    const float* src = r < NT ? p.x + (size_t)r * DM : p.ctx + (size_t)(r - NT) * DM;
    const float* ml = mlp(p, 0, r < NT ? r / SEQ : 4);
    Row8 row; const float ss = row_load_ss(src, lane, row);
    row_norm_mod(row, rsqrtf(ss * (1.f / DM) + EPS), p.norm_mix, ml + 2048, ml, lane);
    row_store_fp8(row, WSP(unsigned char, OFF_H) + (size_t)r * DM, lane);
  }
}

__device__ __forceinline__ float rope_inv_freq(int q, int quarter) { return exp2f(-(float)q / (float)quarter * 13.287712379549449f); }

__device__ __forceinline__ void ph_post_inproj(const Params& p) {
  const int lane = otid() & 63;
  const bf16_t* P0 = WSP(const bf16_t, OFF_P0);
  for (int r = gwave(); r < NA; r += nwave()) {
    const bool lat = r < NT;
    int b, keyrow, prow = 0, pcol = 0;
    if (lat) { b = r / SEQ; const int n = r % SEQ; keyrow = b * NKEY + CTXL + n; prow = n >> 6; pcol = n & 63; }
    else { const int i = r - NT; b = i / CTXL; keyrow = b * NKEY + (i % CTXL); }
    const bf16_t* row = P0 + (size_t)r * P0W;
    const u32x4 wq = *(const u32x4*)(row + lane * 8), wkv = *(const u32x4*)(row + 512 + lane * 8);
    const float xkr = bf2f(row[1024 + lane]);
    asm volatile("" ::: "memory");
    if (lat) {
      const u32x4 w = wq;
      float v[8] = {bf_lo(w[0]), bf_hi(w[0]), bf_lo(w[1]), bf_hi(w[1]), bf_lo(w[2]), bf_hi(w[2]), bf_lo(w[3]), bf_hi(w[3])};
      float ss = 0.f;
#pragma unroll
      for (int j = 0; j < 8; ++j) ss += v[j] * v[j];
      const float inv = rsqrtf(wave_sum(ss) * (1.f / 512.f) + EPS);
      const f32x4 g0 = *(const f32x4*)(p.q_norm + lane * 8), g1 = *(const f32x4*)(p.q_norm + lane * 8 + 4);
      u32x4 o = {cvtpk(v[0] * inv * g0[0], v[1] * inv * g0[1]), cvtpk(v[2] * inv * g0[2], v[3] * inv * g0[3]),
                 cvtpk(v[4] * inv * g1[0], v[5] * inv * g1[1]), cvtpk(v[6] * inv * g1[2], v[7] * inv * g1[3])};
      *(u32x4*)(WSP(bf16_t, OFF_CQN) + (size_t)r * 512 + lane * 8) = o;
    }
    {
      const u32x4 w = wkv;
      float v[8] = {bf_lo(w[0]), bf_hi(w[0]), bf_lo(w[1]), bf_hi(w[1]), bf_lo(w[2]), bf_hi(w[2]), bf_lo(w[3]), bf_hi(w[3])};
      float ss = 0.f;
#pragma unroll
      for (int j = 0; j < 8; ++j) ss += v[j] * v[j];
      const float inv = rsqrtf(wave_sum(ss) * (1.f / 512.f) + EPS);
      const f32x4 g0 = *(const f32x4*)(p.kv_norm + lane * 8), g1 = *(const f32x4*)(p.kv_norm + lane * 8 + 4);
      u32x4 o = {cvtpk(v[0] * inv * g0[0], v[1] * inv * g0[1]), cvtpk(v[2] * inv * g0[2], v[3] * inv * g0[3]),
                 cvtpk(v[4] * inv * g1[0], v[5] * inv * g1[1]), cvtpk(v[6] * inv * g1[2], v[7] * inv * g1[3])};
      *(u32x4*)(WSP(bf16_t, OFF_CKVN) + (size_t)r * 512 + lane * 8) = o;
    }
    const float pos = (lane >> 5) ? (float)pcol : (float)prow;
    const bool second = (lane >> 4) & 1;
    float c64 = 1.f, s64 = 0.f;
    if (lat) sincosf(pos * rope_inv_freq(lane & 15, 16), &s64, &c64);
    {
      const float xs = xkr;
      const float xp = __shfl_xor(xs, 16, 64);
      const float o = second ? (xs * c64 + xp * s64) : (xs * c64 - xp * s64);
      const unsigned char ob = (unsigned char)(pack_fp8x4(o, o, o, o) & 0xffu);
      unsigned char* ka = WSP(unsigned char, OFF_KA) + (size_t)keyrow * 1536 + 128 + (lane & 32) + 8 * ((lane & 15) >> 2) + 4 * ((lane >> 4) & 1) + (lane & 3);
#pragma unroll
      for (int h = 0; h < 8; ++h) ka[h * 192] = ob;
    }
  }
}

__device__ __forceinline__ void ph_diffcomb(const Params& p) {
  const int lane = otid() & 63;
  float d1 = p.lq1[lane] * p.lk1[lane] + p.lq1[lane + 64] * p.lk1[lane + 64];
  float d2 = p.lq2[lane] * p.lk2[lane] + p.lq2[lane + 64] * p.lk2[lane + 64];
  d1 = wave_sum(d1); d2 = wave_sum(d2);
  const float lam_init = 0.2f;
  const float lam = expf(d1) - expf(d2) + lam_init;
  const f32x4 sg = *(const f32x4*)(p.subln + lane * 4);
  const bf16_t* OD = WSP(const bf16_t, OFF_OD);
  for (int r = gwave(); r < NT; r += nwave()) {
    u32x2 w0[4], w1[4];
#pragma unroll
    for (int h = 0; h < 4; ++h) { w0[h] = *(const u32x2*)(OD + (size_t)r * 2048 + h * 256 + lane * 4); w1[h] = *(const u32x2*)(OD + (size_t)r * 2048 + 1024 + h * 256 + lane * 4); }
    asm volatile("" ::: "memory");
#pragma unroll
    for (int h = 0; h < 4; ++h) {
      const f32x4 o0 = {bf_lo(w0[h][0]), bf_hi(w0[h][0]), bf_lo(w0[h][1]), bf_hi(w0[h][1])}, o1 = {bf_lo(w1[h][0]), bf_hi(w1[h][0]), bf_lo(w1[h][1]), bf_hi(w1[h][1])};
      const f32x4 d = o0 - lam * o1;
      const float ss = wave_sum(d[0] * d[0] + d[1] * d[1] + d[2] * d[2] + d[3] * d[3]);
      const float inv = rsqrtf(ss * (1.f / 256.f) + EPS) * (1.f - lam_init);
      u32x2 w = {cvtpk(d[0] * inv * sg[0], d[1] * inv * sg[1]), cvtpk(d[2] * inv * sg[2], d[3] * inv * sg[3])};
      *(u32x2*)(WSP(bf16_t, OFF_YIN) + (size_t)r * 2048 + 1024 + h * 256 + lane * 4) = w;
    }
  }
}

__device__ __forceinline__ float swapsum32(float a, float b) { auto r = __builtin_amdgcn_permlane32_swap(__float_as_uint(a), __float_as_uint(b), false, false); return __uint_as_float(r[0]) + __uint_as_float(r[1]); }
__device__ __forceinline__ float swapsum16(float a, float b) { auto r = __builtin_amdgcn_permlane16_swap(__float_as_uint(a), __float_as_uint(b), false, false); return __uint_as_float(r[0]) + __uint_as_float(r[1]); }
__device__ __forceinline__ float rowsum16(float v) {
  v += __int_as_float(__builtin_amdgcn_update_dpp(0, __float_as_int(v), 0x128, 0xf, 0xf, false));
  v += __int_as_float(__builtin_amdgcn_update_dpp(0, __float_as_int(v), 0x124, 0xf, 0xf, false));
  v += __int_as_float(__builtin_amdgcn_update_dpp(0, __float_as_int(v), 0x122, 0xf, 0xf, false));
  v += __int_as_float(__builtin_amdgcn_update_dpp(0, __float_as_int(v), 0x121, 0xf, 0xf, false));
  return v;
}
__device__ __forceinline__ void ph_ffn_pre(const Params& p, int l, char* smem) {
  const int lane = otid() & 63, tid = otid();
  float* rw = (float*)smem;
  const float* rsrc = p.router_w + (size_t)l * DM * NE;
  for (int id = tid; id < DM * 4; id += 512) {
    const int j = id >> 2, q = id & 3;
    const f32x4 v = *(const f32x4*)(rsrc + j * 16 + q * 4);
    const int i = j >> 8, ln = (j & 255) >> 2, k = j & 3;
    *(f32x4*)(rw + ((((q * 8 + i) * 4 + k) * 64 + ln) << 2)) = v;
  }
  __syncthreads();
  const int gw = gwave(), nw = nwave();
  const bf16_t* XL = WSP(const bf16_t, OFF_XL);
  for (int pi = gw; pi < NT / 2; pi += nw) {
    u32x2 nx[2][8];
#pragma unroll
    for (int x = 0; x < 2; ++x)
#pragma unroll
      for (int i = 0; i < 8; ++i) nx[x][i] = *(const u32x2*)(XL + (size_t)(2 * pi + x) * DM + i * 256 + lane * 4);
    const int r0 = 2 * pi, b = r0 / SEQ, n0 = r0 % SEQ;
    const float* ml = mlp(p, l, b);
    Row8 row[2]; float ssl[2] = {0.f, 0.f};
#pragma unroll
    for (int x = 0; x < 2; ++x)
#pragma unroll
      for (int i = 0; i < 8; ++i) { const u32x2 w = nx[x][i]; row[x].v[i] = (f32x4){bf_lo(w[0]), bf_hi(w[0]), bf_lo(w[1]), bf_hi(w[1])};
        ssl[x] += row[x].v[i][0] * row[x].v[i][0] + row[x].v[i][1] * row[x].v[i][1] + row[x].v[i][2] * row[x].v[i][2] + row[x].v[i][3] * row[x].v[i][3]; }
    float st = swapsum32(ssl[0], ssl[1]); st = rowsum16(swapsum16(st, st));
    const float inv0 = rsqrtf(__builtin_amdgcn_readlane(st, 0) * (1.f / DM) + EPS), inv1 = rsqrtf(__builtin_amdgcn_readlane(st, 32) * (1.f / DM) + EPS);
#pragma unroll
    for (int i = 0; i < 8; ++i) {
      const int j = i * 256 + lane * 4;
      const f32x4 g = *(const f32x4*)(p.norm_ffn + l * DM + j), s1 = *(const f32x4*)(ml + 8192 + j), s0 = *(const f32x4*)(ml + 6144 + j);
      row[0].v[i] = row[0].v[i] * inv0 * g * (1.f + s1) + s0; row[1].v[i] = row[1].v[i] * inv1 * g * (1.f + s1) + s0;
    }
    row_store_fp8(row[0], WSP(unsigned char, OFF_H) + (size_t)r0 * DM, lane);
    row_store_fp8(row[1], WSP(unsigned char, OFF_H) + (size_t)(r0 + 1) * DM, lane);
    float lg[2][16];
#pragma unroll
    for (int e = 0; e < 16; ++e) { lg[0][e] = 0.f; lg[1][e] = 0.f; }
#pragma unroll
    for (int i = 0; i < 8; ++i) {
      __builtin_amdgcn_sched_barrier(0);
#pragma unroll
      for (int k = 0; k < 4; ++k) {
        __builtin_amdgcn_sched_barrier(0);
        const float h0 = row[0].v[i][k], h1 = row[1].v[i][k];
#pragma unroll
        for (int q = 0; q < 4; ++q) {
          const f32x4 w = *(const f32x4*)(rw + ((((q * 8 + i) * 4 + k) * 64 + lane) << 2));
#pragma unroll
          for (int c = 0; c < 4; ++c) { lg[0][q * 4 + c] += h0 * w[c]; lg[1][q * 4 + c] += h1 * w[c]; }
        }
      }
    }
    float t[8];
#pragma unroll
    for (int e = 0; e < 8; ++e) t[e] = rowsum16(swapsum16(swapsum32(lg[0][e], lg[1][e]), swapsum32(lg[0][e + 8], lg[1][e + 8])));
    float m8 = t[0];
#pragma unroll
    for (int e = 1; e < 8; ++e) m8 = fmaxf(m8, t[e]);
    float mx; { auto r = __builtin_amdgcn_permlane16_swap(__float_as_uint(m8), __float_as_uint(m8), false, false); mx = fmaxf(__uint_as_float(r[0]), __uint_as_float(r[1])); }
    float d8 = 0.f;
#pragma unroll
    for (int e = 0; e < 8; ++e) { t[e] = expf(t[e] - mx); d8 += t[e]; }
    const float rden = 1.f / swapsum16(d8, d8);
    float mine = 0.f;
#pragma unroll
    for (int e = 0; e < 8; ++e) mine = ((lane & 15) == e) ? t[e] * rden : mine;
    if ((lane & 15) < 8) {
      const int x = lane >> 5, e = ((lane >> 4) & 1) * 8 + (lane & 15);
      WSP(float, OFF_AFF)[((size_t)(b * NE + e)) * SEQ + n0 + x] = mine;
      WSP(int, OFF_INV)[(size_t)(r0 + x) * NE + e] = -1;
    }
  }
  __syncthreads();
}

__device__ __forceinline__ void ph_topk(const Params& p, char* smem) {
  unsigned* cnt = (unsigned*)smem;
  const int tid = otid(), lane = tid & 63, wid = tid >> 6;
  for (int be = blockIdx.x; be < NB * NE; be += gridDim.x) {
    const int b = be / NE, e = be % NE;
    const float* src = WSP(const float, OFF_AFF) + (size_t)be * SEQ + tid * 8;
    const f32x4 v0 = *(const f32x4*)src, v1 = *(const f32x4*)(src + 4);
    const float val[8] = {v0[0], v0[1], v0[2], v0[3], v1[0], v1[1], v1[2], v1[3]};
    unsigned key[8];
#pragma unroll
    for (int j = 0; j < 8; ++j) key[j] = __float_as_uint(val[j]);
    unsigned lo = 0u, hi = 0x3f800000u; int par = 0;
    __syncthreads();
    while (lo < hi) {
      const unsigned span = hi - lo + 1u;
      const unsigned t1 = lo + (span >> 2), t2 = lo + (span >> 1), t3 = lo + (span >> 1) + (span >> 2);
      unsigned c1 = 0u, c2 = 0u, c3 = 0u;
#pragma unroll
      for (int k = 0; k < 8; ++k) { c1 += (unsigned)__popcll(__ballot(key[k] >= t1)); c2 += (unsigned)__popcll(__ballot(key[k] >= t2)); c3 += (unsigned)__popcll(__ballot(key[k] >= t3)); }
      if (lane < 3) cnt[par * 32 + wid * 4 + lane] = lane == 0 ? c1 : (lane == 1 ? c2 : c3);
      __syncthreads();
      unsigned s1 = 0u, s2 = 0u, s3 = 0u;
#pragma unroll
      for (int w = 0; w < 8; ++w) { s1 += cnt[par * 32 + w * 4]; s2 += cnt[par * 32 + w * 4 + 1]; s3 += cnt[par * 32 + w * 4 + 2]; }
      par ^= 1;
      if (s1 < (unsigned)CAP) hi = t1 - 1u;
      else if (s2 < (unsigned)CAP) { lo = t1; hi = t2 - 1u; }
      else if (s3 < (unsigned)CAP) { lo = t2; hi = t3 - 1u; }
      else lo = t3;
    }
    const unsigned T = lo;
    int ngt = 0, neq = 0;
#pragma unroll
    for (int j = 0; j < 8; ++j) { ngt += key[j] > T ? 1 : 0; neq += key[j] == T ? 1 : 0; }
    int pk = ngt | (neq << 16);
    int inc = pk;
#pragma unroll
    for (int o = 1; o < 64; o <<= 1) { const int t = __shfl_up(inc, o, 64); if (lane >= o) inc += t; }
    if (lane == 63) cnt[128 + wid] = (unsigned)inc;
    __syncthreads();
    int base = 0, total = 0;
#pragma unroll
    for (int w = 0; w < 8; ++w) { const int t = (int)cnt[128 + w]; total += t; if (w < wid) base += t; }
    const int excl = base + inc - pk;
    int gpos = excl & 0xffff, epos = excl >> 16;
    const int total_gt = total & 0xffff, need = CAP - total_gt;
#pragma unroll
    for (int j = 0; j < 8; ++j) {
      int slot = -1;
      if (key[j] > T) slot = gpos++;
      else if (key[j] == T) { if (epos < need) slot = total_gt + epos; ++epos; }
      if (slot >= 0) {
        const int tok = tid * 8 + j;
        WSP(int, OFF_IDX)[be * CAP + slot] = tok; WSP(float, OFF_GATE)[be * CAP + slot] = val[j];
        WSP(int, OFF_INV)[(size_t)(b * SEQ + tok) * NE + e] = slot;
      }
    }
    __syncthreads();
  }
}

__device__ __forceinline__ void ph_combine(const Params& p, int l) {
  const int lane = otid() & 63;
  for (int r = gwave(); r < NT; r += nwave()) {
    const int b = r / SEQ;
    Row8 acc;
#pragma unroll
    for (int i = 0; i < 8; ++i) acc.v[i] = (f32x4){0.f, 0.f, 0.f, 0.f};
    const int myinv = WSP(const int, OFF_INV)[(size_t)r * NE + (lane & 15)];
    unsigned long long mask = __ballot(myinv >= 0) & 0xffffull;
    bf16_t* xl = WSP(bf16_t, OFF_XL) + (size_t)r * DM;
    u32x2 xw[8];
#pragma unroll
    for (int i = 0; i < 8; ++i) xw[i] = *(const u32x2*)(xl + i * 256 + lane * 4);
    while (mask) {
      const int e = __builtin_ctzll(mask); mask &= mask - 1;
      const int s = __builtin_amdgcn_readlane(myinv, e);
      const bf16_t* ye = WSP(const bf16_t, OFF_YE) + ((size_t)e * 2048 + b * CAP + s) * DM;
#pragma unroll
      for (int i = 0; i < 8; ++i) {
        const u32x2 w = *(const u32x2*)(ye + i * 256 + lane * 4);
        acc.v[i][0] += bf_lo(w[0]); acc.v[i][1] += bf_hi(w[0]); acc.v[i][2] += bf_lo(w[1]); acc.v[i][3] += bf_hi(w[1]);
      }
    }
    const float* ml = mlp(p, l, b);
    Row8 row; float ss = 0.f;
#pragma unroll
    for (int i = 0; i < 8; ++i) {
      const int j = i * 256 + lane * 4;
      const f32x4 g2 = *(const f32x4*)(ml + 10240 + j);
      row.v[i] = (f32x4){bf_lo(xw[i][0]), bf_hi(xw[i][0]), bf_lo(xw[i][1]), bf_hi(xw[i][1])} + g2 * acc.v[i];
      ss += row.v[i][0] * row.v[i][0] + row.v[i][1] * row.v[i][1] + row.v[i][2] * row.v[i][2] + row.v[i][3] * row.v[i][3];
    }
    ss = wave_sum(ss);
    const float inv = rsqrtf(ss * (1.f / DM) + EPS);
    if (l == 0) {
#pragma unroll
      for (int i = 0; i < 8; ++i) { u32x2 w = {cvtpk(row.v[i][0], row.v[i][1]), cvtpk(row.v[i][2], row.v[i][3])}; *(u32x2*)(xl + i * 256 + lane * 4) = w; }
      const float* ml1 = mlp(p, 1, b);
      row_norm_mod(row, inv, p.norm_mix + DM, ml1 + 2048, ml1, lane);
      row_store_bf16(row, WSP(bf16_t, OFF_H) + (size_t)r * DM, lane);
    } else {
      row_norm_mod(row, inv, p.final_norm, nullptr, nullptr, lane);
#pragma unroll
      for (int i = 0; i < 8; ++i) *(f32x4*)(p.out + (size_t)r * DM + i * 256 + lane * 4) = row.v[i];
    }
  }
}

__device__ __forceinline__ void ph_fold(const Params& p) {
  const bf16_t* src = WSP(const bf16_t, OFF_ABT2); bf16_t* dst = WSP(bf16_t, OFF_ABTF);
  float* nyq = WSP(float, OFF_IDX);
  for (int id = blockIdx.x * 512 + otid(); id < 4096 * 512; id += gridDim.x * 512) {
    const int rowi = id >> 9, kk0 = (id & 511) * 8;
    const bf16_t* rp = src + (size_t)rowi * 8192;
    float o[8];
    if (kk0 < 2048) {
      const u32x4 w = *(const u32x4*)(rp + kk0);
#pragma unroll
      for (int j = 0; j < 4; ++j) { o[2 * j] = bf_lo(w[j]); o[2 * j + 1] = bf_hi(w[j]); }
#pragma unroll
      for (int j = 0; j < 8; ++j) { const int kk = kk0 + j; if (kk > 0) o[j] += bf2f(rp[4096 - kk]); }
    } else {
      const int j0 = kk0 - 2048;
      const u32x4 w = *(const u32x4*)(rp + 4096 + j0);
#pragma unroll
      for (int j = 0; j < 4; ++j) { o[2 * j] = bf_lo(w[j]); o[2 * j + 1] = bf_hi(w[j]); }
#pragma unroll
      for (int j = 0; j < 8; ++j) { const int jj = j0 + j; if (jj > 0) o[j] -= bf2f(rp[4096 + 4096 - jj]); else o[j] = bf2f(rp[2048]); }
      if (j0 == 0) nyq[rowi] = o[0];
    }
    u32x4 ow = {cvtpk(o[0], o[1]), cvtpk(o[2], o[3]), cvtpk(o[4], o[5]), cvtpk(o[6], o[7])};
    *(u32x4*)(dst + (size_t)rowi * 4096 + kk0) = ow;
  }
}

__device__ __forceinline__ void ph_dftcomb(const Params& p) {
  const bf16_t* PQ = WSP(const bf16_t, OFF_SPEC); const bf16_t* abtf = WSP(const bf16_t, OFF_ABTF); bf16_t* Y = WSP(bf16_t, OFF_YCAT);
  const float sc = 1.f / 1024.f;
  for (int id = blockIdx.x * 512 + otid(); id < 16 * 2048 * 32; id += gridDim.x * 512) {
    const int d8 = (id & 31) * 8, k1 = (id >> 5) & 2047, bg = id >> 16, b = bg >> 2, g = bg & 3;
    const u32x4 wp = *(const u32x4*)(PQ + ((size_t)(2 * bg) * 2048 + k1) * 256 + d8), wq = *(const u32x4*)(PQ + ((size_t)(2 * bg + 1) * 2048 + k1) * 256 + d8);
    float pv[8], qv[8], ny[8];
#pragma unroll
    for (int j = 0; j < 4; ++j) { pv[2 * j] = bf_lo(wp[j]); pv[2 * j + 1] = bf_hi(wp[j]); qv[2 * j] = bf_lo(wq[j]); qv[2 * j + 1] = bf_hi(wq[j]); }
    const float sgn = (k1 & 1) ? -2.f : 2.f;
    { const f32x4 n0 = *(const f32x4*)(WSP(const float, OFF_IDX) + bg * 256 + d8), n1 = *(const f32x4*)(WSP(const float, OFF_IDX) + bg * 256 + d8 + 4);
#pragma unroll
      for (int j = 0; j < 4; ++j) { ny[j] = sgn * n0[j]; ny[4 + j] = sgn * n1[j]; } }
    bf16_t* y0 = Y + ((size_t)b * SEQ + k1) * DM + 1024 + g * 256 + d8;
    u32x4 o;
#pragma unroll
    for (int j = 0; j < 4; ++j) o[j] = cvtpk((pv[2 * j] + qv[2 * j]) * sc, (pv[2 * j + 1] + qv[2 * j + 1]) * sc);
    *(u32x4*)y0 = o;
    if (k1 > 0) {
#pragma unroll
      for (int j = 0; j < 4; ++j) o[j] = cvtpk((pv[2 * j] - qv[2 * j] + ny[2 * j]) * sc, (pv[2 * j + 1] - qv[2 * j + 1] + ny[2 * j + 1]) * sc);
      *(u32x4*)(Y + ((size_t)b * SEQ + (SEQ - k1)) * DM + 1024 + g * 256 + d8) = o;
    }
  }
  const int lane = otid() & 63;
  for (int r = gwave(); r < 16 * 256; r += nwave()) {
    const bf16_t* row = abtf + (size_t)r * 4096;
    float acc = 0.f;
#pragma unroll
    for (int i = 0; i < 4; ++i) { const u32x4 w = *(const u32x4*)(row + i * 512 + lane * 8);
#pragma unroll
      for (int j = 0; j < 4; ++j) acc += bf_lo(w[j]) - bf_hi(w[j]); }
    acc = wave_sum(acc) + bf2f(row[2048]);
    if (lane == 0) { const int bg = r >> 8, d = r & 255; Y[((size_t)(bg >> 2) * SEQ + 2048) * DM + 1024 + (bg & 3) * 256 + d] = f2bf(acc * sc); }
  }
}

__device__ __forceinline__ void ph_pool(const Params& p) {
  const bf16_t* Z = WSP(const bf16_t, OFF_Z);
  for (int id = blockIdx.x * 512 + otid(); id < (NT / 16) * 128; id += gridDim.x * 512) {
    const int rb = id >> 7, c8 = (id & 127) * 8, half = 1 << (c8 >> 8);
    const int b = rb / (SEQ / 16), n0 = (rb % (SEQ / 16)) * 16;
    const bf16_t* zb = Z + (size_t)b * SEQ * 2048 + c8;
    float s[8];
#pragma unroll
    for (int j = 0; j < 8; ++j) s[j] = 0.f;
    for (int t = n0 - half; t < n0 + half; ++t) {
      if (t >= 0 && t < SEQ) { const u32x4 w = *(const u32x4*)(zb + (size_t)t * 2048);
#pragma unroll
        for (int j = 0; j < 4; ++j) { s[2 * j] += bf_lo(w[j]); s[2 * j + 1] += bf_hi(w[j]); } }
    }
#pragma unroll 4
    for (int r = 0; r < 16; ++r) {
      const int n = n0 + r, lo = max(n - half, 0), hi = min(n + half, SEQ);
      const u32x4 w = *(const u32x4*)(zb + (size_t)n * 2048);
      u32x4 wi = {0u, 0u, 0u, 0u}, wo = {0u, 0u, 0u, 0u};
      if (n + half < SEQ) wi = *(const u32x4*)(zb + (size_t)(n + half) * 2048);
      if (n - half >= 0) wo = *(const u32x4*)(zb + (size_t)(n - half) * 2048);
      const float rc = 1.f / (float)(hi - lo);
      u32x4 o;
#pragma unroll
      for (int j = 0; j < 4; ++j) o[j] = cvtpk(s[2 * j] * rc - bf_lo(w[j]), s[2 * j + 1] * rc - bf_hi(w[j]));
      *(u32x4*)(WSP(bf16_t, OFF_POOLED) + (size_t)(b * SEQ + n) * 1024 + c8) = o;
#pragma unroll
      for (int j = 0; j < 4; ++j) { s[2 * j] += bf_lo(wi[j]) - bf_lo(wo[j]); s[2 * j + 1] += bf_hi(wi[j]) - bf_hi(wo[j]); }
    }
  }
}

#define LAS __attribute__((address_space(3)))
__host__ __device__ __forceinline__ constexpr int vt_pos(int kap) { return (((kap >> 2) & 1) << 5) | ((kap >> 5) << 4) | (((kap >> 3) & 3) << 2) | (kap & 3); }
namespace fg {
constexpr int BM = 256, BK = 64, HALF = 128, HTB = HALF * BK * 2, STAGE_BYTES = 8 * HTB;
__device__ __forceinline__ int lds_byte(int r, int c) { const int st = (r >> 4) * 2 + (c >> 5), rr = r & 15, cc = c & 31, ob = rr * 64 + cc * 2; return st * 1024 + (ob ^ (((ob >> 9) & 1) << 5)); }
__device__ __forceinline__ void stage_rc(int b, int& R, int& C) { const int st = b / 1024, sb = b % 1024, swz = sb ^ (((sb >> 9) & 1) << 5); R = (st >> 1) * 16 + swz / 64; C = (st & 1) * 32 + (swz % 64) / 2; }
struct Unit { const char* a; const char* b; int pm, pn, grp; };
typedef int i32x8 __attribute__((ext_vector_type(8)));
typedef int i32x4 __attribute__((ext_vector_type(4)));
__device__ __forceinline__ void mfma_fp8(f32x4& acc, const i32x8& a, const i32x8& b, int scale) {
  asm volatile("s_nop 1\n\tv_mfma_scale_f32_16x16x128_f8f6f4 %0, %1, %2, %0, %3, %3 op_sel_hi:[0,0,0]" : "+v"(acc) : "v"(a), "v"(b), "v"(scale));
}
template <int H> __device__ __forceinline__ bf16x8 half8(i32x8 v) { const i32x4 h = H ? __builtin_shufflevector(v, v, 4, 5, 6, 7) : __builtin_shufflevector(v, v, 0, 1, 2, 3); return __builtin_bit_cast(bf16x8, h); }
__device__ __forceinline__ i32x8 cat8(bf16x8 lo, bf16x8 hi) { const i32x4 a = __builtin_bit_cast(i32x4, lo), b = __builtin_bit_cast(i32x4, hi); return (i32x8){a[0], a[1], a[2], a[3], b[0], b[1], b[2], b[3]}; }
struct Grid {
  const char* A; const char* B; size_t sA, sB; int lda, ldb, nM, nN, ngrp, G, c; int gd = 1; size_t sA2 = 0, sB2 = 0;
  int rot = 0;
  __device__ __forceinline__ bool next(int i, Unit& u) const {
    const int cc = (G == 256) ? (((c & 7) * 32 + (c >> 3) + rot) & 255) : c;
    const int L = i * G + cc, per = nM * nN;
    if (L >= per * ngrp) return false;
    const int g = L / per, w = L - g * per;
    const int nig = 8 * nN, gid = w / nig, fm = gid * 8, gsz = (nM - fm) < 8 ? (nM - fm) : 8, wi = w - gid * nig;
    u.grp = g; u.pn = wi / gsz; u.pm = fm + (wi - u.pn * gsz);
    const int g1 = g / gd, g2 = g - g1 * gd;
    u.a = A + (size_t)g1 * sA + (size_t)g2 * sA2 + (size_t)u.pm * 256 * lda * 2; u.b = B + (size_t)g1 * sB + (size_t)g2 * sB2 + (size_t)u.pn * 256 * ldb * 2;
    return true;
  }
};
template <class Epi, bool GATHER = false, bool FP8 = false>
__device__ __forceinline__ void gemm_fast(LAS unsigned char* lds, const Grid& S, const Epi& E, int K, const int* gidx = nullptr) {
  int tid_ = threadIdx.x; asm volatile("" : "+v"(tid_));
  const int tid = tid_, wid = __builtin_amdgcn_readfirstlane(tid >> 6), lane = tid & 63, wr = wid >> 2, wc = wid & 3, fr = lane & 15, fq = lane >> 4;
  const int nt = K / BK;
  unsigned voffA[2], voffB[2];
#pragma unroll
  for (int i = 0; i < 2; ++i) { int R, C; stage_rc(tid * 16 + i * 8192, R, C); voffA[i] = (unsigned)(R * S.lda + C) * 2u; voffB[i] = (unsigned)(R * S.ldb + C) * 2u; }
  const size_t kstep = (size_t)(BK * 2);
  const size_t hstepA = (size_t)HALF * S.lda * 2, hstepB = (size_t)HALF * S.ldb * 2;
  const unsigned ldsw = (unsigned)wid * 1024u;
  const int aoff = FP8 ? lds_byte(wr * 64 + fr, fq * 16) : lds_byte(wr * 64 + fr, fq * 8), boff = FP8 ? lds_byte(wc * 32 + fr, fq * 16) : lds_byte(wc * 32 + fr, fq * 8);
  constexpr int KOFF = FP8 ? 16 : 1024;
#define FG_SA(b, h) (((b) * 2 + (h)) * HTB)
#define FG_SB(b, h) ((4 + (b) * 2 + (h)) * HTB)
#define FG_STAGE(bufoff, gbase, voff) do { _Pragma("unroll") for (int _i = 0; _i < 2; ++_i) \
    __builtin_amdgcn_global_load_lds((const unsigned*)((const char*)(gbase) + (voff)[_i]), (LAS unsigned*)(lds + (bufoff) + ldsw + _i * 8192), 16, 0, 0); } while (0)
#define FG_STAGE_A(bufoff, usen, kb, h) do { if constexpr (GATHER) { _Pragma("unroll") for (int _i = 0; _i < 2; ++_i) { const unsigned _g = (usen) ? gN[h][_i] : gA[h][_i]; \
      __builtin_amdgcn_global_load_lds((const unsigned*)(S.A + _g + (kb)), (LAS unsigned*)(lds + (bufoff) + ldsw + _i * 8192), 16, 0, 0); } } \
    else { FG_STAGE(bufoff, ((usen) ? nA : cA) + (kb) + (h) * hstepA, voffA); } } while (0)
#define FG_LDA(dst, b, h) do { _Pragma("unroll") for (int m = 0; m < 4; ++m) dst[m] = cat8(*(const LAS bf16x8*)(lds + FG_SA(b, h) + aoff + m * 2048), *(const LAS bf16x8*)(lds + FG_SA(b, h) + aoff + m * 2048 + KOFF)); } while (0)
#define FG_LDB(dst, b, h) do { _Pragma("unroll") for (int n = 0; n < 2; ++n) dst[n] = cat8(*(const LAS bf16x8*)(lds + FG_SB(b, h) + boff + n * 2048), *(const LAS bf16x8*)(lds + FG_SB(b, h) + boff + n * 2048 + KOFF)); } while (0)
#define FG_MMA(ai, bj, At, Bt) do { __builtin_amdgcn_s_setprio(1); _Pragma("unroll") for (int m = 0; m < 4; ++m) _Pragma("unroll") for (int n = 0; n < 2; ++n) { \
    if constexpr (FP8) mfma_fp8(acc[ai][bj][m][n], Bt[n], At[m], one_scale); \
    else { acc[ai][bj][m][n] = __builtin_amdgcn_mfma_f32_16x16x32_bf16(half8<0>(Bt[n]), half8<0>(At[m]), acc[ai][bj][m][n], 0, 0, 0); \
           acc[ai][bj][m][n] = __builtin_amdgcn_mfma_f32_16x16x32_bf16(half8<1>(Bt[n]), half8<1>(At[m]), acc[ai][bj][m][n], 0, 0, 0); } } \
    __builtin_amdgcn_s_setprio(0); } while (0)
#define FG_WAIT_V(n) asm volatile("s_waitcnt vmcnt(" #n ")" ::: "memory")
#define FG_WAIT_L(n) asm volatile("s_waitcnt lgkmcnt(" #n ")" ::: "memory")
#define FG_BAR __builtin_amdgcn_s_barrier()
#define FG_SCHED __builtin_amdgcn_sched_barrier(0)
  Unit cur, nxt; int ui = 0;
  if (!S.next(0, cur)) return;
  f32x4 acc[2][2][4][2];
#pragma unroll
  for (int a = 0; a < 2; ++a)
#pragma unroll
    for (int b = 0; b < 2; ++b)
#pragma unroll
      for (int m = 0; m < 4; ++m)
#pragma unroll
        for (int n = 0; n < 2; ++n) acc[a][b][m][n] = (f32x4){0.f, 0.f, 0.f, 0.f};
  int one_scale = 0x7f7f7f7f; asm volatile("" : "+v"(one_scale));
  i32x8 At[4], B0[2], B1[2];
  const char* cA = cur.a; const char* cB = cur.b; const char* nA = cA;
  unsigned gA[2][2] = {{0u, 0u}, {0u, 0u}}, gN[2][2] = {{0u, 0u}, {0u, 0u}};
  auto goff = [&](const Unit& u, unsigned (&g)[2][2]) {
#pragma unroll
    for (int h = 0; h < 2; ++h)
#pragma unroll
      for (int i = 0; i < 2; ++i) { int R, C; stage_rc(tid * 16 + i * 8192, R, C); const int rr = u.pm * 256 + h * 128 + R, bb = rr >> 9;
        const int tok = bb * SEQ + gidx[(bb * NE + u.grp) * CAP + (rr & 511)]; g[h][i] = (unsigned)(tok * S.lda + C) * 2u; }
  };
  if constexpr (GATHER) goff(cur, gA);
  FG_STAGE(FG_SB(0, 0), cB, voffB); FG_STAGE_A(FG_SA(0, 0), false, 0, 0); FG_STAGE(FG_SB(0, 1), cB + hstepB, voffB); FG_STAGE_A(FG_SA(0, 1), false, 0, 1);
  if (wr == 1) FG_BAR;
  FG_WAIT_V(4); FG_BAR;
  FG_STAGE(FG_SB(1, 0), cB + kstep, voffB); FG_STAGE_A(FG_SA(1, 0), false, kstep, 0); FG_STAGE(FG_SB(1, 1), cB + hstepB + kstep, voffB);
  FG_WAIT_V(6); FG_BAR;
  for (;;) {
    const bool has_next = S.next(ui + 1, nxt);
    nA = has_next ? nxt.a : cA; const char* nB = has_next ? nxt.b : cB;
    if constexpr (GATHER) { if (has_next) goff(nxt, gN); else {
#pragma unroll
      for (int h = 0; h < 2; ++h)
#pragma unroll
        for (int i = 0; i < 2; ++i) gN[h][i] = gA[h][i]; } }
#pragma unroll 1
    for (int t = 0; t < nt; t += 2) {
      const bool last = (t == nt - 2);
      const size_t k1 = (size_t)(t + 1) * kstep, k2 = last ? 0 : (size_t)(t + 2) * kstep, k3 = k2 + kstep;
      const char* b2 = last ? nB : cB + (size_t)(t + 2) * kstep;
      const char* b3 = b2 + kstep;
      FG_LDB(B0, 0, 0); FG_SCHED; FG_LDA(At, 0, 0); FG_STAGE_A(FG_SA(1, 1), false, k1, 1);
      FG_WAIT_L(8); FG_BAR; FG_WAIT_L(0); FG_MMA(0, 0, At, B0); FG_BAR; FG_SCHED;
      FG_LDB(B1, 0, 1); FG_STAGE(FG_SB(0, 0), b2, voffB);
      FG_BAR; FG_WAIT_L(0); FG_MMA(0, 1, At, B1); FG_BAR;
      FG_LDA(At, 0, 1); FG_STAGE_A(FG_SA(0, 0), last, k2, 0);
      FG_BAR; FG_WAIT_L(0); FG_MMA(1, 0, At, B0); FG_BAR; FG_SCHED;
      FG_STAGE(FG_SB(0, 1), b2 + hstepB, voffB);
      FG_WAIT_V(6); FG_BAR; FG_MMA(1, 1, At, B1); FG_BAR;
      FG_LDB(B0, 1, 0); FG_SCHED; FG_LDA(At, 1, 0); FG_STAGE_A(FG_SA(0, 1), last, k2, 1);
      FG_WAIT_L(8); FG_BAR; FG_WAIT_L(0); FG_MMA(0, 0, At, B0); FG_BAR; FG_SCHED;
      FG_LDB(B1, 1, 1); FG_STAGE(FG_SB(1, 0), b3, voffB);
      FG_BAR; FG_WAIT_L(0); FG_MMA(0, 1, At, B1); FG_BAR;
      FG_LDA(At, 1, 1); FG_STAGE_A(FG_SA(1, 0), last, k3, 0);
      FG_BAR; FG_WAIT_L(0); FG_MMA(1, 0, At, B0); FG_BAR; FG_SCHED;
      FG_STAGE(FG_SB(1, 1), b3 + hstepB, voffB);
      FG_WAIT_V(6); FG_BAR; FG_MMA(1, 1, At, B1); FG_BAR;
    }
    if constexpr (FP8) asm volatile("s_nop 15\n\ts_nop 15" ::: "memory");
    {
      int tz = threadIdx.x; asm volatile("" : "+v"(tz));
      const int wz = __builtin_amdgcn_readfirstlane(tz >> 6), lz = tz & 63;
      E(acc, cur, wz >> 2, wz & 3, lz & 15, lz >> 4); }
    if (!has_next) break;
#pragma unroll
    for (int a = 0; a < 2; ++a)
#pragma unroll
      for (int b = 0; b < 2; ++b)
#pragma unroll
        for (int m = 0; m < 4; ++m)
#pragma unroll
          for (int n = 0; n < 2; ++n) acc[a][b][m][n] = (f32x4){0.f, 0.f, 0.f, 0.f};
    cur = nxt; cA = nA; cB = nB; ++ui;
    if constexpr (GATHER) {
#pragma unroll
      for (int h = 0; h < 2; ++h)
#pragma unroll
        for (int i = 0; i < 2; ++i) gA[h][i] = gN[h][i]; }
  }
  FG_WAIT_V(0);
  if (wr == 0) FG_BAR;
  FG_BAR;
#undef FG_SA
#undef FG_SB
#undef FG_STAGE
#undef FG_STAGE_A
#undef FG_LDA
#undef FG_LDB
#undef FG_MMA
#undef FG_WAIT_V
#undef FG_WAIT_L
#undef FG_BAR
#undef FG_SCHED
}
typedef f32x4 Acc[2][2][4][2];
#define FG_FOREACH(...)                                                                                                \
  _Pragma("unroll") for (int ai = 0; ai < 2; ++ai) _Pragma("unroll") for (int m = 0; m < 4; ++m)                       \
  _Pragma("unroll") for (int bj = 0; bj < 2; ++bj) _Pragma("unroll") for (int n = 0; n < 2; ++n) {                     \
    const int row = u.pm * 256 + ai * 128 + wr * 64 + m * 16 + fr, col = u.pn * 256 + bj * 128 + wc * 32 + n * 16 + 4 * fq; \
    const f32x4 v = acc[ai][bj][m][n]; __VA_ARGS__ }
__device__ __forceinline__ u32x2 pack4(f32x4 v) { return (u32x2){cvtpk(v[0], v[1]), cvtpk(v[2], v[3])}; }

struct EpiBf16 {
  bf16_t* O; int ld, nvalid; float scale; int gdiv; size_t s1, s2;
  __device__ __forceinline__ void operator()(const Acc& acc, const Unit& u, int wr, int wc, int fr, int fq) const {
    bf16_t* base = O + (size_t)(u.grp / gdiv) * s1 + (size_t)(u.grp % gdiv) * s2;
    FG_FOREACH(if (col < nvalid) *(u32x2*)(base + (size_t)row * ld + col) = pack4(v * scale);)
  }
};
struct EpiQRope {
  unsigned char* QA;
  __device__ __forceinline__ void operator()(const Acc& acc, const Unit& u, int wr, int wc, int fr, int fq) const {
#pragma unroll
    for (int ai = 0; ai < 2; ++ai)
#pragma unroll
      for (int m = 0; m < 4; ++m)
#pragma unroll
        for (int bj = 0; bj < 2; ++bj) {
          const int row = u.pm * 256 + ai * 128 + wr * 64 + m * 16 + fr, g0 = u.pn * 256 + bj * 128 + wc * 32, w0 = g0 % 192;
          f32x4 x1 = acc[ai][bj][m][0], x2 = acc[ai][bj][m][1];
          if (w0 >= 128) {
            const int ntok = row % SEQ; const float pos = (w0 >= 160) ? (float)(ntok & 63) : (float)(ntok >> 6);
#pragma unroll
            for (int j = 0; j < 4; ++j) { const float ang = pos * rope_inv_freq(4 * fq + j, 16); const float sn = __sinf(ang), cs = __cosf(ang);
              const float a = x1[j], b = x2[j]; x1[j] = a * cs - b * sn; x2[j] = b * cs + a * sn; }
          }
          *(u32x2*)(QA + (size_t)row * 1536 + g0 + 8 * fq) = (u32x2){pack_fp8x4(x1[0], x1[1], x1[2], x1[3]), pack_fp8x4(x2[0], x2[1], x2[2], x2[3])};
        }
  }
};
struct EpiIn0 {
  bf16_t* P0; unsigned char* QD; unsigned char* KD; unsigned char* VD;
  __device__ __forceinline__ void operator()(const Acc& acc, const Unit& u, int wr, int wc, int fr, int fq) const {
    const bool lat = u.pm < NT / 256;
#pragma unroll
    for (int ai = 0; ai < 2; ++ai)
#pragma unroll
      for (int m = 0; m < 4; ++m) {
        const int row = u.pm * 256 + ai * 128 + wr * 64 + m * 16 + fr;
        int keyrow, ntok = 0;
        if (lat) { ntok = row % SEQ; keyrow = (row / SEQ) * NKEY + CTXL + ntok; } else { const int ii = row - NT; keyrow = (ii / CTXL) * NKEY + (ii % CTXL); }
#pragma unroll
        for (int bj = 0; bj < 2; ++bj) {
          const int g0 = u.pn * 256 + bj * 128 + wc * 32;
          f32x4 x1 = acc[ai][bj][m][0] * (1.f / 32.f), x2 = acc[ai][bj][m][1] * (1.f / 32.f);
          if (g0 < P0W) { bf16_t* dst = P0 + (size_t)row * P0W + g0 + 4 * fq; *(u32x2*)dst = pack4(x1); *(u32x2*)(dst + 16) = pack4(x2); }
          else if (g0 < 3136) {
            const int vv = (g0 - 1088) >> 7, sg = ((g0 - 1088) & 127) >> 5, axis = sg >> 1, qh = sg & 1;
            if (lat) { const float pos = axis ? (float)(ntok & 63) : (float)(ntok >> 6);
#pragma unroll
              for (int j = 0; j < 4; ++j) { const float ang = pos * rope_inv_freq(qh * 16 + 4 * fq + j, 32); const float sn = __sinf(ang), cs = __cosf(ang);
                const float a = x1[j], b = x2[j]; x1[j] = a * cs - b * sn; x2[j] = b * cs + a * sn; } }
            const u32x2 pk = {pack_fp8x4(x1[0], x1[1], x1[2], x1[3]), pack_fp8x4(x2[0], x2[1], x2[2], x2[3])};
            if (vv < 8) { if (lat) *(u32x2*)(QD + (size_t)row * 1024 + vv * 128 + sg * 32 + 8 * fq) = pk; }
            else *(u32x2*)(KD + (size_t)keyrow * 1024 + (vv - 8) * 128 + sg * 32 + 8 * fq) = pk;
          }
        }
      }
  }
};
struct EpiKV {
  unsigned char* KA;
  __device__ __forceinline__ void operator()(const Acc& acc, const Unit& u, int wr, int wc, int fr, int fq) const {
#pragma unroll
    for (int ai = 0; ai < 2; ++ai)
#pragma unroll
      for (int m = 0; m < 4; ++m) {
        const int row = u.pm * 256 + ai * 128 + wr * 64 + m * 16 + fr;
        int b; int key; if (row < NT) { b = row / SEQ; key = CTXL + (row % SEQ); } else { const int ii = row - NT; b = ii / CTXL; key = ii % CTXL; }
#pragma unroll
        for (int bj = 0; bj < 2; ++bj) {
          const int g0 = u.pn * 256 + bj * 128 + wc * 32, h = g0 >> 7, w0 = g0 & 127;
          const f32x4 x1 = acc[ai][bj][m][0], x2 = acc[ai][bj][m][1];
          *(u32x2*)(KA + ((size_t)b * NKEY + key) * 1536 + h * 192 + w0 + 8 * fq) = (u32x2){pack_fp8x4(x1[0], x1[1], x1[2], x1[3]), pack_fp8x4(x2[0], x2[1], x2[2], x2[3])};
        }
      }
  }
};
struct EpiVT {
  unsigned char* VT; int dvs, nh; float scale;
  __device__ __forceinline__ void operator()(const Acc& acc, const Unit& u, int wr, int wc, int fr, int fq) const {
    FG_FOREACH(
      int b; int key; if (col < NT) { b = col / SEQ; key = CTXL + (col % SEQ); } else { const int ii = col - NT; b = ii / CTXL; key = ii % CTXL; }
      const int h = row >> dvs; const int d = row & ((1 << dvs) - 1);
      *(unsigned*)(VT + ((((size_t)(b * nh + h) * (NKEY / 64) + (key >> 6)) << dvs) + d) * 64 + vt_pos(key & 63)) = pack_fp8x4(v[0] * scale, v[1] * scale, v[2] * scale, v[3] * scale);)
  }
};
template <bool BASE_F32>
struct EpiResid {
  bf16_t* XL; const void* base; const float* ml;
  __device__ __forceinline__ void operator()(const Acc& acc, const Unit& u, int wr, int wc, int fr, int fq) const {
    const int row0 = u.pm * 256 + wr * 64 + fr, col0 = u.pn * 256 + wc * 32 + 4 * fq;
    const float* gp = ml + (size_t)(row0 / SEQ) * MLW + 4096 + col0;
    f32x4 g[2][2];
#pragma unroll
    for (int bj = 0; bj < 2; ++bj)
#pragma unroll
      for (int n = 0; n < 2; ++n) g[bj][n] = *(const f32x4*)(gp + bj * 128 + n * 16);
#pragma unroll
    for (int ai = 0; ai < 2; ++ai)
#pragma unroll
      for (int mh = 0; mh < 2; ++mh) {
        f32x4 bs[2][2][2];
#pragma unroll
        for (int m2 = 0; m2 < 2; ++m2)
#pragma unroll
          for (int bj = 0; bj < 2; ++bj)
#pragma unroll
            for (int n = 0; n < 2; ++n) { const size_t o = (size_t)(row0 + ai * 128 + (mh * 2 + m2) * 16) * DM + col0 + bj * 128 + n * 16;
              if constexpr (BASE_F32) bs[m2][bj][n] = *(const f32x4*)((const float*)base + o);
              else { const u32x2 w = *(const u32x2*)((const bf16_t*)base + o); bs[m2][bj][n] = (f32x4){bf_lo(w[0]), bf_hi(w[0]), bf_lo(w[1]), bf_hi(w[1])}; } }
        asm volatile("" ::: "memory");
#pragma unroll
        for (int m2 = 0; m2 < 2; ++m2)
#pragma unroll
          for (int bj = 0; bj < 2; ++bj)
#pragma unroll
            for (int n = 0; n < 2; ++n)
              *(u32x2*)(XL + (size_t)(row0 + ai * 128 + (mh * 2 + m2) * 16) * DM + col0 + bj * 128 + n * 16) = pack4(bs[m2][bj][n] + g[bj][n] * acc[ai][bj][mh * 2 + m2][n]);
        asm volatile("" ::: "memory");
      }
  }
};
struct EpiGU {
  unsigned char* HID;
  __device__ __forceinline__ void operator()(const Acc& acc, const Unit& u, int wr, int wc, int fr, int fq) const {
    unsigned char* base = HID + (size_t)u.grp * 2048 * FF;
#pragma unroll
    for (int ai = 0; ai < 2; ++ai)
#pragma unroll
      for (int m = 0; m < 4; ++m)
#pragma unroll
        for (int bj = 0; bj < 2; ++bj) {
          const int row = u.pm * 256 + ai * 128 + wr * 64 + m * 16 + fr, hid = u.pn * 128 + bj * 64 + wc * 16 + 4 * fq;
          const f32x4 g = acc[ai][bj][m][0], up = acc[ai][bj][m][1];
          float r[4];
#pragma unroll
          for (int j = 0; j < 4; ++j) { const float gg = g[j] * (1.f / W8_SCALE), uu = up[j] * (1.f / W8_SCALE); r[j] = gg * __builtin_amdgcn_rcpf(1.f + __expf(-gg)) * uu; }
          *(unsigned*)(base + (size_t)row * FF + hid) = pack_fp8x4(r[0], r[1], r[2], r[3]);
        }
  }
};
struct EpiDown {
  bf16_t* YE; const float* gate;
  __device__ __forceinline__ void operator()(const Acc& acc, const Unit& u, int wr, int wc, int fr, int fq) const {
    bf16_t* base = YE + (size_t)u.grp * 2048 * DM;
    float gt[2][4];
#pragma unroll
    for (int ai = 0; ai < 2; ++ai)
#pragma unroll
      for (int m = 0; m < 4; ++m) { const int row = u.pm * 256 + ai * 128 + wr * 64 + m * 16 + fr; gt[ai][m] = gate[((row >> 9) * NE + u.grp) * CAP + (row & 511)] * (1.f / W8_SCALE); }
    asm volatile("" ::: "memory");
    FG_FOREACH(*(u32x2*)(base + (size_t)row * DM + col) = pack4(v * gt[ai][m]);)
  }
};
struct EpiScaleCol {
  bf16_t* O; const float* cs;
  __device__ __forceinline__ void operator()(const Acc& acc, const Unit& u, int wr, int wc, int fr, int fq) const {
    f32x4 sc[2][2];
#pragma unroll
    for (int bj = 0; bj < 2; ++bj)
#pragma unroll
      for (int n = 0; n < 2; ++n) sc[bj][n] = *(const f32x4*)(cs + u.grp * 256 + u.pn * 256 + bj * 128 + wc * 32 + n * 16 + 4 * fq);
    asm volatile("" ::: "memory");
    FG_FOREACH(*(u32x2*)(O + (size_t)row * DM + u.grp * 256 + col) = pack4(v * sc[bj][n]);)
  }
};
struct EpiChanDft {
  bf16_t* ABT2;
  __device__ __forceinline__ void operator()(const Acc& acc, const Unit& u, int wr, int wc, int fr, int fq) const {
    FG_FOREACH(const int b = col / SEQ, nn = col % SEQ;
               *(u32x2*)(ABT2 + (((size_t)(b * 4 + u.grp) * 256) + (row & 255)) * 8192 + (row >> 8) * 4096 + nn) = pack4(v * 1.f);)
  }
};
}

namespace at {
typedef float f32x16 __attribute__((ext_vector_type(16)));
typedef int i32x8a __attribute__((ext_vector_type(8)));
typedef int i32x4a __attribute__((ext_vector_type(4)));
constexpr int NW = 8, QBLK = 32, KVBLK = 64;
#define SBAR() __builtin_amdgcn_sched_barrier(0)
#define MFMA8(A, B, Cc) __builtin_amdgcn_mfma_scale_f32_32x32x64_f8f6f4(A, B, Cc, 0, 0, 0, 0x7f7f7f7f, 0, 0x7f7f7f7f)
__device__ __forceinline__ int crow(int r, int hi) { return (r & 3) + 8 * (r >> 2) + 4 * hi; }
template <int DK> __device__ __forceinline__ int kswz(int row) { return DK == 192 ? ((row >> 2) & 3) : ((row >> 1) & 7); }
template <int DK>
__device__ __forceinline__ void qkt(f32x16& p0, f32x16& p1, const LAS char* Ks, const i32x8a* qf, int r32, int hi) {
  p0 = f32x16{}; p1 = f32x16{};
  const int s = kswz<DK>(r32);
  const LAS char* kr = Ks + r32 * DK;
#pragma unroll
  for (int t = 0; t < DK / 64; ++t) {
    const int c0 = ((4 * t + 2 * hi) ^ s) << 4, c1 = ((4 * t + 2 * hi + 1) ^ s) << 4;
    const i32x4a a0 = *reinterpret_cast<const LAS i32x4a*>(kr + c0), a1 = *reinterpret_cast<const LAS i32x4a*>(kr + c1);
    const i32x4a b0 = *reinterpret_cast<const LAS i32x4a*>(kr + c0 + 32 * DK), b1 = *reinterpret_cast<const LAS i32x4a*>(kr + c1 + 32 * DK);
    const i32x8a k0 = {a0[0], a0[1], a0[2], a0[3], a1[0], a1[1], a1[2], a1[3]}, k1 = {b0[0], b0[1], b0[2], b0[3], b1[0], b1[1], b1[2], b1[3]};
    p0 = MFMA8(k0, qf[t], p0);
    p1 = MFMA8(k1, qf[t], p1); }
}
constexpr float PBIAS = 4.f, PTHR = 3.f;
__device__ __forceinline__ void softmax8(const f32x16& p0, const f32x16& p1, float& m_reg, float& alpha, i32x8a& pa, float C, float thr_raw) {
  float pmax = p0[0];
#pragma unroll
  for (int r = 1; r < 16; ++r) pmax = fmaxf(pmax, p0[r]);
#pragma unroll
  for (int r = 0; r < 16; ++r) pmax = fmaxf(pmax, p1[r]);
  { auto rr = __builtin_amdgcn_permlane32_swap(__float_as_uint(pmax), __float_as_uint(pmax), false, false);
    pmax = fmaxf(__uint_as_float(rr[0]), __uint_as_float(rr[1])); }
  float mn;
  if (__builtin_expect(__all(pmax - m_reg <= thr_raw), 1)) { mn = m_reg; alpha = 1.f; }
  else { mn = fmaxf(m_reg, pmax); alpha = __builtin_amdgcn_exp2f((m_reg - mn) * C); m_reg = mn; }
  const float C8 = 8.f * C, b8 = 8.f * (PBIAS - mn * C) + 56.f;
#pragma unroll
  for (int w = 0; w < 4; ++w) {
    unsigned v = 0, v2 = 0;
#pragma unroll
    for (int j = 0; j < 4; ++j) { v = __builtin_amdgcn_cvt_pk_u8_f32(fmaf(p0[4 * w + j], C8, b8), j, v); v2 = __builtin_amdgcn_cvt_pk_u8_f32(fmaf(p1[4 * w + j], C8, b8), j, v2); }
    pa[w] = (int)v; pa[4 + w] = (int)v2; }
}
template <int NDB>
__device__ __forceinline__ void pv(f32x16* o, const LAS char* Vs, const i32x8a pa, int r32, int hi) {
  const int s = (r32 >> 2) & 3;
  const LAS char* v0 = Vs + r32 * 64 + (((2 * hi) ^ s) << 4); const LAS char* v1 = Vs + r32 * 64 + (((2 * hi + 1) ^ s) << 4);
#pragma unroll
  for (int d0 = 0; d0 < NDB; ++d0) {
    const i32x4a a = *reinterpret_cast<const LAS i32x4a*>(v0 + d0 * 2048), b = *reinterpret_cast<const LAS i32x4a*>(v1 + d0 * 2048);
    const i32x8a vf = {a[0], a[1], a[2], a[3], b[0], b[1], b[2], b[3]};
    o[d0] = MFMA8(pa, vf, o[d0]); }
  const int one4 = 0x38383838;
  const i32x8a ones = {one4, one4, one4, one4, one4, one4, one4, one4};
  o[NDB] = MFMA8(pa, ones, o[NDB]);
}
template <int DK, int NDB, bool QK_FIRST>
__device__ __forceinline__ void mm_iter(f32x16* o, f32x16& p0, f32x16& p1, const LAS char* Vs, const LAS char* Ks, const i32x8a pa, const i32x8a* qf, int r32, int hi) {
  constexpr int NKF = DK / 32, NL = NKF + NDB;
  const int sk = kswz<DK>(r32), sv = (r32 >> 2) & 3;
  const LAS char* kr = Ks + r32 * DK;
  const LAS char* v0 = Vs + r32 * 64 + (((2 * hi) ^ sv) << 4); const LAS char* v1 = Vs + r32 * 64 + (((2 * hi + 1) ^ sv) << 4);
  i32x8a w[3];
#define MM_ISK(i) (QK_FIRST ? (i) < NKF : (i) >= NDB)
#define MM_LOAD(i) do { i32x4a a_, b_; if (MM_ISK(i)) { const int kk = QK_FIRST ? (i) : (i) - NDB, t = kk >> 1, blk = kk & 1; \
      a_ = *reinterpret_cast<const LAS i32x4a*>(kr + blk * 32 * DK + (((4 * t + 2 * hi) ^ sk) << 4)); b_ = *reinterpret_cast<const LAS i32x4a*>(kr + blk * 32 * DK + (((4 * t + 2 * hi + 1) ^ sk) << 4)); } \
    else { const int d0 = QK_FIRST ? (i) - NKF : (i); a_ = *reinterpret_cast<const LAS i32x4a*>(v0 + d0 * 2048); b_ = *reinterpret_cast<const LAS i32x4a*>(v1 + d0 * 2048); } \
    w[(i) % 3] = (i32x8a){a_[0], a_[1], a_[2], a_[3], b_[0], b_[1], b_[2], b_[3]}; } while (0)
  MM_LOAD(0); MM_LOAD(1);
#pragma unroll
  for (int i = 0; i < NL; ++i) {
    if (i + 2 < NL) MM_LOAD(i + 2);
    if (MM_ISK(i)) { const int kk = QK_FIRST ? i : i - NDB, t = kk >> 1, blk = kk & 1;
      if (blk == 0) { if (t == 0) p0 = MFMA8(w[i % 3], qf[t], f32x16{}); else p0 = MFMA8(w[i % 3], qf[t], p0); }
      else { if (t == 0) p1 = MFMA8(w[i % 3], qf[t], f32x16{}); else p1 = MFMA8(w[i % 3], qf[t], p1); } }
    else { const int d0 = QK_FIRST ? i - NKF : i; o[d0] = MFMA8(pa, w[i % 3], o[d0]);
      if (d0 == NDB - 1) { const int one4 = 0x38383838; const i32x8a ones = {one4, one4, one4, one4, one4, one4, one4, one4}; o[NDB] = MFMA8(pa, ones, o[NDB]); } }
    __builtin_amdgcn_sched_barrier(0x406);
  }
#undef MM_ISK
#undef MM_LOAD
}
template <class VAR>
__device__ __forceinline__ void attn_body(const unsigned char* __restrict__ Qb, const unsigned char* __restrict__ Kh, const unsigned char* __restrict__ VT, bf16_t* __restrict__ Ob, int seq, char* lds) {
  constexpr int DK = VAR::DK, NDB = VAR::NDB, ldq = VAR::LDQ, ldk = VAR::LDK, ldo = VAR::LDO;
  constexpr float C = VAR::SCALE * 1.4426950408889634f, thr_raw = PTHR / VAR::SCALE;
  constexpr int SHM_V = NDB * 32 * 64, SHM_K = KVBLK * DK, SHM_T = SHM_V + SHM_K, NVC = NDB / 4;
  static_assert(DK == 192 || DK == 128, "K staging is written for 128- and 192-byte key rows");
  int tid_ = threadIdx.x; asm volatile("" : "+v"(tid_));
  const int tid = tid_, wid = tid >> 6, lane = tid & 63, r32 = lane & 31, hi = lane >> 5, wu = __builtin_amdgcn_readfirstlane(wid);
  LAS char* L = (LAS char*)lds;
  LAS float* al_l = (LAS float*)(L + VAR::NB * SHM_T) + wid * 32;
  float m_reg = -1e30f; f32x16 o[NDB + 1] = {}; i32x8a qr[DK / 64];
  const unsigned char* Qw = Qb + (size_t)(wid * QBLK + r32) * ldq + hi * 32;
#pragma unroll
  for (int t = 0; t < DK / 64; ++t) { const i32x4a a = *reinterpret_cast<const i32x4a*>(Qw + t * 64), b2 = *reinterpret_cast<const i32x4a*>(Qw + t * 64 + 16);
    qr[t] = (i32x8a){a[0], a[1], a[2], a[3], b2[0], b2[1], b2[2], b2[3]}; }
  const unsigned vsrc = (unsigned)((tid >> 2) * 64 + (((tid & 3) ^ ((tid >> 4) & 3)) << 4));
  unsigned ksrc0, ksrc1 = 0;
  if constexpr (DK == 128) { const int row = tid >> 3; ksrc0 = (unsigned)(row * ldk + (((tid & 7) ^ kswz<DK>(row)) << 4)); }
  else { const int r0 = tid / 12, c0 = tid - 12 * r0, ci = 512 + wid * 32 + r32, r1 = ci / 12, c1 = ci - 12 * r1;
    ksrc0 = (unsigned)(r0 * ldk + ((c0 ^ kswz<DK>(r0)) << 4)); ksrc1 = (unsigned)(r1 * ldk + ((c1 ^ kswz<DK>(r1)) << 4)); }
#define DMA(B, tile) do { const unsigned char* vt_ = VT + (size_t)(tile) * SHM_V; const unsigned char* kt_ = Kh + (size_t)(tile) * (KVBLK * ldk); \
    _Pragma("unroll") for (int _i = 0; _i < NVC; ++_i) __builtin_amdgcn_global_load_lds((const unsigned*)(vt_ + vsrc + _i * 8192), (LAS unsigned*)(L + (B) + wu * 1024 + _i * 8192), 16, 0, 0); \
    __builtin_amdgcn_global_load_lds((const unsigned*)(kt_ + ksrc0), (LAS unsigned*)(L + (B) + SHM_V + wu * 1024), 16, 0, 0); \
    if constexpr (DK == 192) { if (hi == 0) __builtin_amdgcn_global_load_lds((const unsigned*)(kt_ + ksrc1), (LAS unsigned*)(L + (B) + SHM_V + 8192 + wu * 512), 16, 0, 0); } } while (0)
#define DWAIT() asm volatile("s_waitcnt vmcnt(0)" ::: "memory")
#define RESC(a) do { if (__any((a) < 1.f)) { if (hi == 0) al_l[r32] = (a); asm volatile("s_waitcnt lgkmcnt(0)" ::: "memory"); \
    _Pragma("unroll") for (int d = 0; d <= NDB; ++d) _Pragma("unroll") for (int r = 0; r < 16; ++r) o[d][r] *= al_l[crow(r, hi)]; } } while (0)
  const int NTL = seq / KVBLK;
  constexpr int NB = VAR::NB, IPT = NVC + (DK == 192 ? 2 : 1);
  static_assert(NB >= 3 && NB * SHM_T + NW * 128 <= 135168, "attention tile ring must fit the kernel's LDS");
#define DWAITN(NT_) asm volatile("s_waitcnt vmcnt(%0)" :: "n"((NT_) * IPT) : "memory")
  int b0 = 0, b1 = SHM_T, bn = (NB - 1) * SHM_T;
  f32x16 p0, p1; float al; i32x8a pa;
#pragma unroll 1
  for (int t = 0; t < NB - 1; ++t) DMA(t * SHM_T, t < NTL ? t : NTL - 1);
  SBAR(); DWAITN(NB - 3); __syncthreads();
  qkt<DK>(p0, p1, L + b0 + SHM_V, qr, r32, hi); softmax8(p0, p1, m_reg, al, pa, C, thr_raw);
  for (int j = 0; j + 1 < NTL; ++j) {
    { const int nt = j + NB - 1 < NTL ? j + NB - 1 : NTL - 1; DMA(bn, nt); }
    SBAR(); RESC(al); SBAR();
    mm_iter<DK, NDB, VAR::PIPE>(o, p0, p1, L + b0, L + b1 + SHM_V, pa, qr, r32, hi);
    softmax8(p0, p1, m_reg, al, pa, C, thr_raw); SBAR();
    DWAITN(NB - 3); __syncthreads();
    bn = b0; b0 = b1; b1 = b1 + SHM_T == NB * SHM_T ? 0 : b1 + SHM_T;
  }
  RESC(al); pv<NDB>(o, L + b0, pa, r32, hi);
  DWAIT();
#pragma unroll
  for (int r = 0; r < 16; ++r) { const int orow = wid * QBLK + crow(r, hi); const float rl = __builtin_amdgcn_rcpf(o[NDB][r]);
#pragma unroll
    for (int d0 = 0; d0 < NDB; ++d0) Ob[(size_t)orow * ldo + d0 * 32 + r32] = f2bf(o[d0][r] * rl); }
  __syncthreads();
#undef DMA
#undef DWAIT
#undef DWAITN
#undef RESC
}
}

struct VarMla { static constexpr int DK = 192, NDB = 4, LDQ = 1536, LDK = 1536, LDO = 2048, NB = 5; static constexpr bool PIPE = true; static constexpr float SCALE = 0.07216878364870322f; };
struct VarDiff { static constexpr int DK = 128, NDB = 8, LDQ = 1024, LDK = 1024, LDO = 2048, NB = 5; static constexpr bool PIPE = false; static constexpr float SCALE = 0.08838834764831845f; };
constexpr size_t VTA_INST = (size_t)(NKEY / 64) * 128 * 64, VTD_INST = (size_t)(NKEY / 64) * 256 * 64;
__device__ __forceinline__ void attn_unit_mla(const Params& p, char* smem, int inst, int qb) {
  const int b = inst >> 3, h = inst & 7;
  at::attn_body<VarMla>(WSP(const unsigned char, OFF_QA) + ((size_t)b * SEQ + qb * 256) * 1536 + h * 192, WSP(const unsigned char, OFF_KA) + (size_t)b * NKEY * 1536 + h * 192,
                        WSP(const unsigned char, OFF_VA) + (size_t)inst * VTA_INST, WSP(bf16_t, OFF_YIN) + ((size_t)b * SEQ + qb * 256) * 2048 + h * 128, NKEY, smem);
}
__device__ __forceinline__ void attn_unit_diff(const Params& p, char* smem, int inst, int qb) {
  const int b = inst >> 3, m = (inst >> 2) & 1, h = inst & 3;
  at::attn_body<VarDiff>(WSP(const unsigned char, OFF_QD) + ((size_t)b * SEQ + qb * 256) * 1024 + m * 512 + h * 128, WSP(const unsigned char, OFF_KD) + (size_t)b * NKEY * 1024 + m * 512 + h * 128,
                         WSP(const unsigned char, OFF_VD) + (size_t)(b * 4 + h) * VTD_INST, WSP(bf16_t, OFF_OD) + ((size_t)b * SEQ + qb * 256) * 2048 + m * 1024 + h * 256, NKEY, smem);
}
__device__ __forceinline__ void ph_attn_mla(const Params& p, char* smem) {
  for (int u0 = blockIdx.x; u0 < NB * 8 * 16; u0 += gridDim.x) {
    const int u = (gridDim.x == 256) ? ((u0 & ~255) | ((u0 & 7) << 5) | ((u0 >> 3) & 31)) : u0;
    attn_unit_mla(p, smem, u >> 4, u & 15);
  }
}
__device__ __forceinline__ void ph_attn_diff_wide(const Params& p, char* smem) {
  for (int u0 = blockIdx.x; u0 < NB * 8 * 16; u0 += gridDim.x) {
    const int u = (gridDim.x == 256) ? ((u0 & ~255) | ((u0 & 7) << 5) | ((u0 >> 3) & 31)) : u0;
    attn_unit_diff(p, smem, u >> 4, u & 15);
  }
}
constexpr int QPAT = 4, Q_ATT = 128, Q_CONV = 384, Q_WORD0 = 3584;
__device__ __forceinline__ void ph_attn_queue(const Params& p, char* smem, int* slot) {
  const int x = blockIdx.x & 7;
  unsigned* cnt = WSP(unsigned, OFF_BAR) + Q_WORD0 + 16 * x;
  for (;;) {
    if (threadIdx.x == 0) *(volatile int*)slot = (int)__hip_atomic_fetch_add(cnt, 1u, __ATOMIC_RELAXED, __HIP_MEMORY_SCOPE_AGENT);
    __syncthreads();
    const int e = __builtin_amdgcn_readfirstlane(*(volatile int*)slot);
    __syncthreads();
    if (e >= Q_ATT + Q_CONV) break;
    int att = -1, cv = -1;
    constexpr int MIXED = (Q_CONV / (QPAT - 1) < Q_ATT ? Q_CONV / (QPAT - 1) : Q_ATT) * QPAT;
    if (e < MIXED) { if (e % QPAT == 0) att = e / QPAT; else cv = e - e / QPAT - 1; }
    else { const int r = e - MIXED, na = MIXED / QPAT, nc = MIXED - na; if (na + r < Q_ATT) att = na + r; else cv = nc + (r - (Q_ATT - na)); }
    if (att >= 0) { if (att < 64) attn_unit_mla(p, smem, x * 4 + (att >> 4), att & 15); else attn_unit_diff(p, smem, x * 4 + ((att - 64) >> 4), att & 15); }
    else conv_item(p, smem, cv * 8 + x);
  }
}
#define XB_TMO      128
#define XB_XCNT(j)  (256  + 64 * (j))
#define XB_XSUB(j)  (1280 + 64 * (j))
#define XB_XGEN(j)  (2304 + 64 * (j))
#define XB_TOP      3328
#define XB_TOPGEN   3392
#define XCD_BAR_WORDS 3456
#define XB_SPIN_CAP (1u << 18)
__device__ __forceinline__ unsigned xb_ld(unsigned* p)              { return __hip_atomic_load(p, __ATOMIC_RELAXED, __HIP_MEMORY_SCOPE_AGENT); }
__device__ __forceinline__ unsigned xb_add(unsigned* p, unsigned v) { return __hip_atomic_fetch_add(p, v, __ATOMIC_RELAXED, __HIP_MEMORY_SCOPE_AGENT); }
__device__ __forceinline__ unsigned xb_xcc_id() { return (unsigned)__builtin_amdgcn_s_getreg((3 << 11) | 20) & 0xFu; }
#define XB_SPIN(cond, bar) do { unsigned _sp = 0; while (cond) { __builtin_amdgcn_s_sleep(1); \
    if ((++_sp & 255u) == 0u) { if (xb_ld(&(bar)[XB_TMO])) break; if (_sp > XB_SPIN_CAP) { atomicAdd(&(bar)[XB_TMO], 1u); break; } } } } while (0)
struct XcdBarrier { unsigned* bar; unsigned x; volatile LAS unsigned* st; };
__device__ __forceinline__ XcdBarrier xcd_barrier_post(unsigned* bar, volatile LAS unsigned* st) {
    XcdBarrier b; b.bar = bar; b.x = xb_xcc_id(); b.st = st;
    if (threadIdx.x == 0) (void)xb_add(&bar[XB_XCNT(b.x)], 1u);
    return b;
}
__device__ __forceinline__ void xcd_barrier_complete(unsigned* bar, unsigned x, unsigned& nloc, unsigned& nx) {
    const unsigned G = gridDim.x * gridDim.y * gridDim.z;
    unsigned sum, cnt, mine, sp = 0u;
    for (;;) {
        sum = 0u; cnt = 0u; mine = 0u;
#pragma unroll
        for (unsigned j = 0; j < 16; ++j) { const unsigned c = xb_ld(&bar[XB_XCNT(j)]); sum += c; cnt += (c > 0u) ? 1u : 0u; mine = (j == x) ? c : mine; }
        if (sum == G) break;
        __builtin_amdgcn_s_sleep(1);
        if ((++sp & 255u) == 0u) { if (xb_ld(&bar[XB_TMO])) break; if (sp > XB_SPIN_CAP) { atomicAdd(&bar[XB_TMO], 1u); break; } }
    }
    nloc = mine > 0u ? mine : 1u; nx = cnt > 0u ? cnt : 1u;
}
__device__ __forceinline__ void xcd_barrier(const XcdBarrier& b) {
    asm volatile("s_waitcnt vmcnt(0)" ::: "memory");
    __syncthreads();
    if (threadIdx.x == 0) {
        unsigned* bar = b.bar;
        __builtin_amdgcn_s_waitcnt(0);
        unsigned nloc = b.st[0], nx = b.st[1];
        if (nloc == 0u) { xcd_barrier_complete(bar, b.x, nloc, nx); b.st[0] = nloc; b.st[1] = nx; }
        const unsigned old = xb_add(&bar[XB_XSUB(b.x)], 1u);
        const unsigned gen = old / nloc;
        if (old + 1u == (gen + 1u) * nloc) {
            __builtin_amdgcn_fence(__ATOMIC_RELEASE, "agent");
            asm volatile("s_waitcnt vmcnt(0)" ::: "memory");
            const unsigned og = xb_add(&bar[XB_TOP], 1u);
            const unsigned tg = og / nx;
            if (og + 1u == (tg + 1u) * nx) xb_add(&bar[XB_TOPGEN], 1u);
            else XB_SPIN(xb_ld(&bar[XB_TOPGEN]) == tg, bar);
            __builtin_amdgcn_fence(__ATOMIC_ACQUIRE, "agent");
            xb_add(&bar[XB_XGEN(b.x)], 1u);
            asm volatile("s_waitcnt vmcnt(0)" ::: "memory");
        } else {
            XB_SPIN(xb_ld(&bar[XB_XGEN(b.x)]) == gen, bar);
            __builtin_amdgcn_fence(__ATOMIC_ACQUIRE, "agent");
            asm volatile("s_waitcnt vmcnt(0)" ::: "memory");
        }
    }
    __syncthreads();
}

#define FGRID(A_, sA_, lda_, B_, sB_, ldb_, nM_, nN_, ng_) fg::Grid{(const char*)(A_), (const char*)(B_), (size_t)(sA_), (size_t)(sB_), lda_, ldb_, nM_, nN_, ng_, (int)gridDim.x, (int)blockIdx.x}
#define FLDS ((LAS unsigned char*)smem)
constexpr int SMEM_MAIN = 135168;
template <int L> __device__ __forceinline__ void ph_moe_gemms_gu(const Params& p, char* smem) {
  fg::gemm_fast<fg::EpiGU, true, true>(FLDS, FGRID(WSP(char, OFF_H), 0, 1024, WSP(char, OFF_WGU) + (size_t)L * NE * 4096 * 2048, (size_t)4096 * 2048, 1024, 8, 16, NE),
                                       fg::EpiGU{WSP(unsigned char, OFF_HID)}, 1024, WSP(const int, OFF_IDX));
}
template <int L> __device__ __forceinline__ void ph_moe_gemms_down(const Params& p, char* smem) {
  fg::gemm_fast<fg::EpiDown, false, true>(FLDS, FGRID(WSP(char, OFF_HID), (size_t)2048 * 2048, 1024, WSP(char, OFF_WD) + (size_t)L * NE * 2048 * 2048, (size_t)2048 * 2048, 1024, 8, 8, NE),
                                          fg::EpiDown{WSP(bf16_t, OFF_YE), WSP(const float, OFF_GATE)}, 1024);
}
__global__ __launch_bounds__(512, 2) void mega(Params p) {
  __shared__ __attribute__((aligned(16))) char smem[SMEM_MAIN + 32];
  volatile LAS unsigned* xst = (volatile LAS unsigned*)(smem + SMEM_MAIN);
  if (threadIdx.x == 0) { xst[0] = 0u; xst[1] = 0u; xst[2] = 0u; xst[3] = 0u; }
  __syncthreads();
  const XcdBarrier bar = xcd_barrier_post(WSP(unsigned, OFF_BAR), xst);
#define GSYNC() xcd_barrier(bar)
  const bool split = gridDim.x == 256;
  if ((blockIdx.x >> 3) & 1) { ph_twiddle(p, smem); ph_weights_small(p, smem); ph_mod(p, smem); } else { ph_mod(p, smem); ph_weights_small(p, smem); ph_twiddle(p, smem); }
  if (!split) ph_weights_expert(p, smem, blockIdx.x, gridDim.x);
  GSYNC();
  ph_pre0(p); GSYNC();
  fg::gemm_fast<fg::EpiIn0, false, true>(FLDS, FGRID(WSP(char, OFF_H), 0, DM / 2, WSP(char, OFF_WIN0), 0, DM / 2, 68, 13, 1), fg::EpiIn0{WSP(bf16_t, OFF_P0), WSP(unsigned char, OFF_QD), WSP(unsigned char, OFF_KD), WSP(unsigned char, OFF_VD)}, DM / 2);
  { fg::Grid gv = FGRID(WSP(char, OFF_WIN0) + (size_t)3136 * DM, 0, DM / 2, WSP(char, OFF_H), 0, DM / 2, 4, 68, 1); gv.rot = 128;
    fg::gemm_fast<fg::EpiVT, false, true>(FLDS, gv, fg::EpiVT{WSP(unsigned char, OFF_VD), 8, 4, 1.f / 32.f}, DM / 2); }
  GSYNC();
  ph_post_inproj(p); GSYNC();
  fg::gemm_fast(FLDS, FGRID(WSP(bf16_t, OFF_CQN), 0, 512, WSP(bf16_t, OFF_WUQ), 0, 512, 64, 6, 1), fg::EpiQRope{WSP(unsigned char, OFF_QA)}, 512);
  { fg::Grid gk = FGRID(WSP(bf16_t, OFF_CKVN), 0, 512, WSP(bf16_t, OFF_WUKV), 0, 512, 68, 4, 1); gk.rot = 128;
    fg::gemm_fast(FLDS, gk, fg::EpiKV{WSP(unsigned char, OFF_KA)}, 512);
    fg::Grid gv = FGRID(WSP(bf16_t, OFF_WUKV) + (size_t)1024 * 512, 0, 512, WSP(bf16_t, OFF_CKVN), 0, 512, 4, 68, 1); gv.rot = 112;
    fg::gemm_fast(FLDS, gv, fg::EpiVT{WSP(unsigned char, OFF_VA), 7, 8, 1.f}, 512); }
  GSYNC();
  if (split) ph_attn_queue(p, smem, (int*)(smem + SMEM_MAIN + 16)); else { ph_attn_mla(p, smem); ph_attn_diff_wide(p, smem); }
  GSYNC();
  ph_diffcomb(p); GSYNC();
  fg::gemm_fast(FLDS, FGRID(WSP(bf16_t, OFF_YIN), 0, DM, WSP(bf16_t, OFF_WOUT0), 0, DM, 64, 8, 1), fg::EpiResid<true>{WSP(bf16_t, OFF_XL), p.x, WSP(const float, OFF_ML)}, DM); GSYNC();
  ph_ffn_pre(p, 0, smem); GSYNC();
  ph_topk(p, smem); GSYNC();
  ph_moe_gemms_gu<0>(p, smem); GSYNC();
  ph_moe_gemms_down<0>(p, smem); GSYNC();
  ph_combine(p, 0); GSYNC();
  fg::gemm_fast(FLDS, FGRID(WSP(bf16_t, OFF_H), 0, DM, WSP(bf16_t, OFF_WIN1), 0, DM, 64, 8, 1), fg::EpiBf16{WSP(bf16_t, OFF_Z), DM, DM, 1.f, 1, 0, 0}, DM); GSYNC();
  ph_pool(p);
  fg::gemm_fast(FLDS, FGRID(WSP(bf16_t, OFF_MC), (size_t)512 * 256 * 2, 256, WSP(bf16_t, OFF_Z) + 1024, 512, DM, 2, 64, 4), fg::EpiChanDft{WSP(bf16_t, OFF_ABT2)}, 256); GSYNC();
  ph_fold(p);
  fg::gemm_fast(FLDS, FGRID(WSP(bf16_t, OFF_POOLED), 512, 1024, WSP(bf16_t, OFF_WPOOL), 65536 * 2, 256, 64, 1, 4), fg::EpiScaleCol{WSP(bf16_t, OFF_YCAT), p.pool_scale}, 256); GSYNC();
  { fg::Grid gq = FGRID(WSP(bf16_t, OFF_TW), 0, 4096, WSP(bf16_t, OFF_ABTF), (size_t)256 * 4096 * 2, 4096, 8, 1, 32);
    gq.gd = 2; gq.sA2 = (size_t)2048 * 2; gq.sB2 = (size_t)2048 * 2;
    fg::gemm_fast(FLDS, gq, fg::EpiBf16{WSP(bf16_t, OFF_SPEC), 256, 256, 1.f, 1, (size_t)2048 * 256, 0}, 2048); }
  GSYNC();
  ph_dftcomb(p); GSYNC();
  fg::gemm_fast(FLDS, FGRID(WSP(bf16_t, OFF_YCAT), 0, DM, WSP(bf16_t, OFF_WOUT1), 0, DM, 64, 8, 1), fg::EpiResid<false>{WSP(bf16_t, OFF_XL), WSP(const bf16_t, OFF_XL), WSP(const float, OFF_ML) + 5 * MLW}, DM); GSYNC();
  ph_ffn_pre(p, 1, smem); GSYNC();
  ph_topk(p, smem); GSYNC();
  ph_moe_gemms_gu<1>(p, smem); GSYNC();
  ph_moe_gemms_down<1>(p, smem); GSYNC();
  ph_combine(p, 1);
}

extern "C" void kernel_launch(void* const* d_in, const int* in_sizes, int n_in, void* d_out, int out_size, void* d_ws, size_t ws_size, hipStream_t stream) {
  if (n_in != 29 || ws_size < WS_NEED) { fprintf(stderr, "kernel_launch: bad args n_in %d ws %zu need %zu\n", n_in, ws_size, WS_NEED); return; }
  Params p{};
  const float** f = (const float**)&p;
  for (int i = 0; i < 29; ++i) f[i] = (const float*)d_in[i];
  p.out = (float*)d_out; p.ws = (char*)d_ws;
  static int grid = 0;
  if (!grid) {
    int dev = 0, cus = 0, per_cu = 0;
    (void)hipGetDevice(&dev);
    (void)hipDeviceGetAttribute(&cus, hipDeviceAttributeMultiprocessorCount, dev);
    (void)hipOccupancyMaxActiveBlocksPerMultiprocessor(&per_cu, (const void*)mega, 512, 0);
    if (cus <= 0) cus = 256;
    grid = per_cu >= 1 ? cus : 0;
    if (!grid) { fprintf(stderr, "kernel_launch: occupancy query says 0 blocks per CU\n"); return; }
  }
  (void)hipMemsetAsync(d_ws, 0, 16384, stream);
  hipLaunchKernelGGL(mega, dim3(grid), dim3(512), 0, stream, p);
}
```

```cpp
#include <hip/hip_runtime.h>
#include <stdint.h>
#include <cstdio>

typedef unsigned short bf16_t;
typedef short bf16x8 __attribute__((ext_vector_type(8)));
typedef float f32x4 __attribute__((ext_vector_type(4)));
typedef unsigned u32x4 __attribute__((ext_vector_type(4)));
typedef unsigned u32x2 __attribute__((ext_vector_type(2)));

constexpr int DM = 2048, NB = 4, SEQ = 4096, NT = NB * SEQ, CTXL = 256, NC = NB * CTXL, NA = NT + NC, NKEY = SEQ + CTXL;
constexpr int EIN = 4160, EINP = 4352, P0W = 1088;
constexpr int NE = 16, CAP = 512, FF = 2048, MLW = 6 * DM;
constexpr float EPS = 1e-6f;

constexpr size_t al256(size_t x) { return (x + 255) / 256 * 256; }
constexpr size_t OFF_BAR = 0;
constexpr size_t OFF_ML = 16384;
constexpr size_t OFF_AFF = OFF_ML + al256((size_t)2 * 5 * MLW * 4);
constexpr size_t OFF_IDX = OFF_AFF + (size_t)NB * NE * SEQ * 4;
constexpr size_t OFF_GATE = OFF_IDX + (size_t)NB * NE * CAP * 4;
constexpr size_t OFF_INV = OFF_GATE + (size_t)NB * NE * CAP * 4;
constexpr size_t OFF_WIN0 = OFF_INV + (size_t)NT * NE * 4;
constexpr size_t OFF_WUQ = OFF_WIN0 + (size_t)EINP * DM * 2;
constexpr size_t OFF_WUKV = OFF_WUQ + (size_t)1536 * 512 * 2;
constexpr size_t OFF_WOUT0 = OFF_WUKV + (size_t)2048 * 512 * 2;
constexpr size_t OFF_WIN1 = OFF_WOUT0 + (size_t)DM * DM * 2;
constexpr size_t OFF_WOUT1 = OFF_WIN1 + (size_t)DM * DM * 2;
constexpr size_t OFF_WPOOL = OFF_WOUT1 + (size_t)DM * DM * 2;
constexpr size_t OFF_WFOUR = OFF_WPOOL + (size_t)4 * 256 * 256 * 2;
constexpr size_t OFF_MC = OFF_WFOUR + (size_t)4 * 256 * 256 * 2;
constexpr size_t OFF_TW = OFF_MC + (size_t)4 * 512 * 256 * 2;
constexpr size_t OFF_WGU = OFF_TW + (size_t)4096 * 8192 * 2;
constexpr size_t OFF_WD = OFF_WGU + (size_t)2 * NE * 4096 * 2048 * 2;
constexpr size_t OFF_XL = OFF_WD + (size_t)2 * NE * 2048 * 2048 * 2;
constexpr size_t OFF_H = OFF_XL + (size_t)NT * DM * 4;
constexpr size_t OFF_SCR = OFF_H + (size_t)NA * DM * 2;
constexpr size_t OFF_P0 = OFF_SCR;
constexpr size_t OFF_CQN = OFF_P0 + al256((size_t)NA * EIN * 2);
constexpr size_t OFF_CKVN = OFF_CQN + (size_t)NT * 512 * 2;
constexpr size_t OFF_QA = OFF_CKVN + (size_t)NA * 512 * 2;
constexpr size_t OFF_KA = OFF_QA + (size_t)NT * 1536 * 2;
constexpr size_t OFF_VA = OFF_KA + (size_t)NA * 1536 * 2;
constexpr size_t OFF_QD = OFF_VA + (size_t)NA * 1024 * 2;
constexpr size_t OFF_KD = OFF_QD + (size_t)NT * 1024 * 2;
constexpr size_t OFF_VD = OFF_KD + (size_t)NA * 1024 * 2;
constexpr size_t OFF_OD = OFF_VD + (size_t)NA * 1024 * 2;
constexpr size_t OFF_YIN = OFF_OD + (size_t)NT * 2048 * 4;
constexpr size_t OFF_M0END = OFF_YIN + (size_t)NT * 2048 * 2;
constexpr size_t OFF_XE = OFF_SCR;
constexpr size_t OFF_HID = OFF_XE + (size_t)NE * 2048 * 2048 * 2;
constexpr size_t OFF_YE = OFF_HID + (size_t)NE * 2048 * 2048 * 2;
constexpr size_t OFF_Z = OFF_SCR;
constexpr size_t OFF_POOLED = OFF_Z + (size_t)NT * 2048 * 2;
constexpr size_t OFF_ABT2 = OFF_POOLED + (size_t)NT * 1024 * 2;
constexpr size_t OFF_SPEC = OFF_ABT2 + (size_t)16 * 256 * 8192 * 2;
constexpr size_t OFF_YCAT = OFF_SPEC + (size_t)NT * 1024 * 2;
constexpr size_t OFF_ABTF = OFF_YCAT + (size_t)NT * 2048 * 2;
constexpr size_t OFF_SBUF = OFF_M0END;
constexpr size_t OFF_PBUF = OFF_SBUF + (size_t)SEQ * NKEY * 4;
constexpr size_t OFF_VT = OFF_PBUF + (size_t)SEQ * NKEY * 2;
constexpr size_t WS_NEED = OFF_VT + (size_t)256 * NKEY * 2;

struct Params {
  const float *x, *c, *ctx, *c_ctx, *mod_w, *mod_b, *norm_mix, *norm_ffn, *even_w_in, *q_norm, *w_uq, *kv_norm, *w_ukv,
      *lq1, *lk1, *lq2, *lk2, *subln, *even_w_out, *odd_w_in, *pool_w, *pool_scale, *fourier_w, *odd_w_out, *router_w,
      *w_gate, *w_up, *w_down, *final_norm;
  float* out;
  char* ws;
};
#define WSP(T, off) ((T*)(p.ws + (off)))

typedef float f32x2 __attribute__((ext_vector_type(2)));
typedef __bf16 bf16x2_t __attribute__((ext_vector_type(2)));
__device__ __forceinline__ unsigned cvtpk(float lo, float hi) { f32x2 v = {lo, hi}; bf16x2_t r = __builtin_convertvector(v, bf16x2_t); return __builtin_bit_cast(unsigned, r); }
__device__ __forceinline__ unsigned pack_fp8x4(float a, float b, float c, float d) {
  a = __builtin_amdgcn_fmed3f(a, -448.f, 448.f); b = __builtin_amdgcn_fmed3f(b, -448.f, 448.f); c = __builtin_amdgcn_fmed3f(c, -448.f, 448.f); d = __builtin_amdgcn_fmed3f(d, -448.f, 448.f);
  unsigned w = 0; w = __builtin_amdgcn_cvt_pk_fp8_f32(a, b, w, false); w = __builtin_amdgcn_cvt_pk_fp8_f32(c, d, w, true); return w;
}
__device__ __forceinline__ float bf_lo(unsigned w) { return __uint_as_float(w << 16); }
__device__ __forceinline__ float bf_hi(unsigned w) { return __uint_as_float(w & 0xffff0000u); }
__device__ __forceinline__ float bf2f(bf16_t b) { return __uint_as_float(((unsigned)b) << 16); }
__device__ __forceinline__ bf16_t f2bf(float f) { return (bf16_t)(cvtpk(f, 0.f) & 0xffffu); }
__device__ __forceinline__ float wave_sum(float v) {
#pragma unroll
  for (int o = 32; o > 0; o >>= 1) v += __shfl_xor(v, o, 64);
  return v;
}
__device__ __forceinline__ float wave_max(float v) {
#pragma unroll
  for (int o = 32; o > 0; o >>= 1) v = fmaxf(v, __shfl_xor(v, o, 64));
  return v;
}
__device__ __forceinline__ int otid() { int t = threadIdx.x; asm volatile("" : "+v"(t)); return t; }
__device__ __forceinline__ int gwave() { return blockIdx.x * (blockDim.x >> 6) + (otid() >> 6); }
__device__ __forceinline__ int nwave() { return gridDim.x * (blockDim.x >> 6); }
__device__ __forceinline__ const float* mlp(const Params& p, int l, int row) { return WSP(const float, OFF_ML) + ((size_t)l * 5 + row) * MLW; }

template <int MODE>
__device__ __forceinline__ int rowmap(int n) {
  if (MODE == 0) return n;
  if (MODE == 4) return ((n & 255) < 128) ? ((n >> 8) * 128 + (n & 127)) : (1024 + (n >> 8) * 128 + (n & 127));
  if (MODE == 3) { if (n < 1088 || n >= 3136) return n; const int v = (n - 1088) >> 7, e = (n - 1088) & 127;
    return 1088 + v * 128 + ((2 * (e >> 6) + ((e >> 4) & 1)) << 5) + (((e >> 5) & 1) << 4) + (e & 15); }
  return 32 * (n >> 4) + (n & 15) + (MODE == 2 ? 16 : 0);
}
template <int MODE, bool F8 = false>
__device__ __forceinline__ void tconv(const float* __restrict__ src, int K, int N, int Npad, bf16_t* __restrict__ dst, char* smem) {
  float(*tile)[257] = (float(*)[257])smem;
  const int tid = otid(), tk = K / 64, tn = Npad / 256;
  for (int t = blockIdx.x; t < tk * tn; t += gridDim.x) {
    const int k0 = (t % tk) * 64, n0 = (t / tk) * 256;
#pragma unroll
    for (int i = 0; i < 8; ++i) {
      const int id = tid + i * 512, k = id >> 6, n4 = (id & 63) * 4;
      f32x4 v = {0.f, 0.f, 0.f, 0.f};
      if (n0 + n4 < N) v = *(const f32x4*)(src + (size_t)(k0 + k) * N + n0 + n4);
      tile[k][n4 + 0] = v[0]; tile[k][n4 + 1] = v[1]; tile[k][n4 + 2] = v[2]; tile[k][n4 + 3] = v[3];
    }
    __syncthreads();
    {
      const int n = tid >> 1, kh = (tid & 1) * 32;
      if constexpr (F8) {
        unsigned char* drow8 = (unsigned char*)dst + (size_t)rowmap<MODE>(n0 + n) * K + k0 + kh;
#pragma unroll
        for (int i = 0; i < 2; ++i) {
          u32x4 w;
#pragma unroll
          for (int q = 0; q < 4; ++q) { const int kk = kh + i * 16 + q * 4; w[q] = pack_fp8x4(tile[kk][n] * 32.f, tile[kk + 1][n] * 32.f, tile[kk + 2][n] * 32.f, tile[kk + 3][n] * 32.f); }
          *(u32x4*)(drow8 + i * 16) = w;
        }
      } else {
      bf16_t* drow = dst + (size_t)rowmap<MODE>(n0 + n) * K + k0 + kh;
#pragma unroll
      for (int i = 0; i < 4; ++i) {
        u32x4 w;
        w[0] = cvtpk(tile[kh + i * 8 + 0][n], tile[kh + i * 8 + 1][n]);
        w[1] = cvtpk(tile[kh + i * 8 + 2][n], tile[kh + i * 8 + 3][n]);
        w[2] = cvtpk(tile[kh + i * 8 + 4][n], tile[kh + i * 8 + 5][n]);
        w[3] = cvtpk(tile[kh + i * 8 + 6][n], tile[kh + i * 8 + 7][n]);
        *(u32x4*)(drow + i * 8) = w;
      }
      }
    }
    __syncthreads();
  }
}

constexpr float W8_SCALE = 32.f;
__device__ __forceinline__ void tconv8_tile(const float* __restrict__ src, int K, int N, unsigned char* __restrict__ dst, int mode, int k0, int n0, char* smem) {
  unsigned* img = (unsigned*)smem;
  const int tid = otid();
  f32x4 va[8], vb[8];
#define T8_LOAD(V, S) do { _Pragma("unroll") for (int j = 0; j < 2; ++j) { const int id = tid + j * 512; const float* bp = src + (size_t)(k0 + (S) * 16 + (id >> 8) * 4) * N + n0 + (id & 255) * 4; \
    _Pragma("unroll") for (int r = 0; r < 4; ++r) V[j * 4 + r] = __builtin_nontemporal_load((const f32x4*)(bp + (size_t)r * N)); } } while (0)
#define T8_PUT(V, S) do { _Pragma("unroll") for (int j = 0; j < 2; ++j) { const int id = tid + j * 512; unsigned* ip = img + ((id & 255) * 4) * 33 + (S) * 4 + (id >> 8); \
    _Pragma("unroll") for (int q = 0; q < 4; ++q) ip[q * 33] = pack_fp8x4(V[j * 4 + 0][q] * W8_SCALE, V[j * 4 + 1][q] * W8_SCALE, V[j * 4 + 2][q] * W8_SCALE, V[j * 4 + 3][q] * W8_SCALE); } } while (0)
  T8_LOAD(va, 0);
#pragma unroll
  for (int s2 = 0; s2 < 4; ++s2) {
    T8_LOAD(vb, 2 * s2 + 1);
    T8_PUT(va, 2 * s2);
    if (s2 < 3) T8_LOAD(va, 2 * s2 + 2);
    T8_PUT(vb, 2 * s2 + 1);
  }
  __syncthreads();
#pragma unroll
  for (int i = 0; i < 16; ++i) {
    const int idx = tid + i * 512, n = idx >> 3, ch = idx & 7, ng = n0 + n;
    const int drow = mode == 0 ? ng : (32 * (ng >> 4) + (ng & 15) + (mode == 2 ? 16 : 0));
    const unsigned* ip = img + n * 33 + ch * 4;
    const u32x4 w = {ip[0], ip[1], ip[2], ip[3]};
    __builtin_nontemporal_store(w, (u32x4*)(dst + (size_t)drow * K + k0 + ch * 16));
  }
  __syncthreads();
#undef T8_LOAD
#undef T8_PUT
}
__device__ __forceinline__ void ph_weights_small(const Params& p, char* smem) {
  tconv<3, true>(p.even_w_in, DM, EIN, EINP, WSP(bf16_t, OFF_WIN0), smem);
  tconv<0>(p.w_uq, 512, 1536, 1536, WSP(bf16_t, OFF_WUQ), smem);
  tconv<4>(p.w_ukv, 512, 2048, 2048, WSP(bf16_t, OFF_WUKV), smem);
  tconv<0>(p.even_w_out, DM, DM, DM, WSP(bf16_t, OFF_WOUT0), smem);
  tconv<0>(p.odd_w_in, DM, DM, DM, WSP(bf16_t, OFF_WIN1), smem);
  tconv<0>(p.odd_w_out, DM, DM, DM, WSP(bf16_t, OFF_WOUT1), smem);
  for (int g = 0; g < 4; ++g) {
    tconv<0>(p.pool_w + (size_t)g * 65536, 256, 256, 256, WSP(bf16_t, OFF_WPOOL) + (size_t)g * 65536, smem);
  }
}
__device__ __forceinline__ void conv_item(const Params& p, char* smem, int g) {
  const int mat = g >> 5, st = g & 31, le = mat / 3, which = mat - 3 * le, k0 = (st & 15) * 128, n0 = (st >> 4) * 1024;
  const size_t so = (size_t)le * 2048 * 2048;
  const float* src = (which == 0 ? p.w_gate : (which == 1 ? p.w_up : p.w_down)) + so;
  unsigned char* dst = which == 2 ? WSP(unsigned char, OFF_WD) + so : WSP(unsigned char, OFF_WGU) + (size_t)le * 4096 * 2048;
  tconv8_tile(src, 2048, 2048, dst, which == 2 ? 0 : which + 1, k0, n0, smem);
}
__device__ __forceinline__ void ph_weights_expert(const Params& p, char* smem, int widx, int wcount) {
  for (int g = widx; g < 2 * NE * 3 * 32; g += wcount) conv_item(p, smem, g);
}

__device__ __forceinline__ void ph_mod(const Params& p, char* smem) {
  float* sc = (float*)smem;
  float* part = sc + 5 * 2048;
  const int tid = otid();
  for (int i = tid; i < 5 * 2048; i += 512) {
    const int r = i >> 11, k = i & 2047;
    const float v = r < 4 ? p.c[r * 2048 + k] : p.c_ctx[k];
    sc[i] = v / (1.f + __expf(-v));
  }
  __syncthreads();
  for (int cb = blockIdx.x; cb < 256; cb += gridDim.x) {
    const int l = cb >> 7, j0 = (cb & 127) * 96;
    const int c4 = tid % 24, kg = tid / 24;
    if (tid < 504) {
      f32x4 acc[5];
#pragma unroll
      for (int r = 0; r < 5; ++r) acc[r] = (f32x4){0.f, 0.f, 0.f, 0.f};
      const float* wp = p.mod_w + (size_t)l * 2048 * MLW + j0 + c4 * 4;
#pragma unroll 4
      for (int k = kg; k < 2048; k += 21) {
        const f32x4 w = *(const f32x4*)(wp + (size_t)k * MLW);
#pragma unroll
        for (int r = 0; r < 5; ++r) acc[r] += sc[r * 2048 + k] * w;
      }
#pragma unroll
      for (int r = 0; r < 5; ++r)
#pragma unroll
        for (int q = 0; q < 4; ++q) part[(kg * 5 + r) * 96 + c4 * 4 + q] = acc[r][q];
    }
    __syncthreads();
    if (tid < 480) {
      const int r = tid / 96, col = tid % 96;
      float s = p.mod_b[l * MLW + j0 + col];
      for (int g = 0; g < 21; ++g) s += part[(g * 5 + r) * 96 + col];
      WSP(float, OFF_ML)[((size_t)l * 5 + r) * MLW + j0 + col] = s;
    }
    __syncthreads();
  }
}

__device__ __forceinline__ void ph_twiddle(const Params& p, char* smem) {
  float* ct = (float*)smem;
  for (int j = otid(); j < 4096; j += 512) ct[j] = cospif((float)j * (1.f / 2048.f));
  __syncthreads();
  bf16_t* tw = WSP(bf16_t, OFF_TW);
  const size_t nchunk = (size_t)2048 * 512;
  for (size_t q = (size_t)blockIdx.x * 512 + otid(); q < nchunk; q += (size_t)gridDim.x * 512) {
    const int k1 = (int)(q >> 9), kk0 = (int)(q & 511) * 8;
    float v[8];
#pragma unroll
    for (int j = 0; j < 8; ++j) {
      const int kk = kk0 + j;
      if (kk <= 2048) v[j] = ct[(k1 * kk) & 4095];
      else v[j] = -ct[(k1 * (kk - 2048) - 1024) & 4095];
    }
    u32x4 w = {cvtpk(v[0], v[1]), cvtpk(v[2], v[3]), cvtpk(v[4], v[5]), cvtpk(v[6], v[7])};
    *(u32x4*)(tw + q * 8) = w;
  }
  bf16_t* mc = WSP(bf16_t, OFF_MC);
  for (int i = blockIdx.x * 512 + otid(); i < 4 * 256 * 256; i += gridDim.x * 512) {
    const int d = i & 255, c = (i >> 8) & 255, g = i >> 16;
    const float* fw = p.fourier_w + (size_t)g * 65536 + d;
    float ac = 0.f, as = 0.f;
#pragma unroll 8
    for (int k2 = 0; k2 < 256; ++k2) {
      const int ph = ((k2 * c) & 255) * 16; const float f = fw[k2 * 256];
      ac += f * ct[ph]; as += f * ct[(ph - 1024) & 4095];
    }
    mc[((size_t)(g * 512 + d) * 256) + c] = f2bf(ac); mc[((size_t)(g * 512 + 256 + d) * 256) + c] = f2bf(as);
  }
  __syncthreads();
}

struct Row8 { f32x4 v[8]; };
__device__ __forceinline__ float row_load_ss(const float* src, int lane, Row8& r) {
  float ss = 0.f;
#pragma unroll
  for (int i = 0; i < 8; ++i) { r.v[i] = *(const f32x4*)(src + i * 256 + lane * 4); ss += r.v[i][0] * r.v[i][0] + r.v[i][1] * r.v[i][1] + r.v[i][2] * r.v[i][2] + r.v[i][3] * r.v[i][3]; }
  return wave_sum(ss);
}
__device__ __forceinline__ float row_load_ss_bf16(const bf16_t* src, int lane, Row8& r) {
  float ss = 0.f;
#pragma unroll
  for (int i = 0; i < 8; ++i) { const u32x2 w = *(const u32x2*)(src + i * 256 + lane * 4); r.v[i] = (f32x4){bf_lo(w[0]), bf_hi(w[0]), bf_lo(w[1]), bf_hi(w[1])};
    ss += r.v[i][0] * r.v[i][0] + r.v[i][1] * r.v[i][1] + r.v[i][2] * r.v[i][2] + r.v[i][3] * r.v[i][3]; }
  return wave_sum(ss);
}
__device__ __forceinline__ void row_norm_mod(Row8& r, float inv, const float* gain, const float* sc, const float* sh, int lane) {
#pragma unroll
  for (int i = 0; i < 8; ++i) {
    const int j = i * 256 + lane * 4;
    const f32x4 g = *(const f32x4*)(gain + j);
    f32x4 y = r.v[i] * inv * g;
    if (sc) { const f32x4 s1 = *(const f32x4*)(sc + j), s0 = *(const f32x4*)(sh + j); y = y * (1.f + s1) + s0; }
    r.v[i] = y;
  }
}
__device__ __forceinline__ void row_store_fp8(const Row8& r, unsigned char* dst, int lane) {
#pragma unroll
  for (int i = 0; i < 8; ++i) *(unsigned*)(dst + i * 256 + lane * 4) = pack_fp8x4(r.v[i][0], r.v[i][1], r.v[i][2], r.v[i][3]);
}
__device__ __forceinline__ void row_store_bf16(const Row8& r, bf16_t* dst, int lane) {
#pragma unroll
  for (int i = 0; i < 8; ++i) { u32x2 w = {cvtpk(r.v[i][0], r.v[i][1]), cvtpk(r.v[i][2], r.v[i][3])}; *(u32x2*)(dst + i * 256 + lane * 4) = w; }
}

__device__ __forceinline__ void ph_pre0(const Params& p) {
  const int lane = otid() & 63;
  for (int r = gwave(); r < NA; r += nwave()) {
    const float* src = r < NT ? p.x + (size_t)r * DM : p.ctx + (size_t)(r - NT) * DM;
    const float* ml = mlp(p, 0, r < NT ? r / SEQ : 4);
    Row8 row; const float ss = row_load_ss(src, lane, row);
    row_norm_mod(row, rsqrtf(ss * (1.f / DM) + EPS), p.norm_mix, ml + 2048, ml, lane);
    row_store_fp8(row, WSP(unsigned char, OFF_H) + (size_t)r * DM, lane);
  }
}

__device__ __forceinline__ float rope_inv_freq(int q, int quarter) { return exp2f(-(float)q / (float)quarter * 13.287712379549449f); }

__device__ __forceinline__ void ph_post_inproj(const Params& p) {
  const int lane = otid() & 63;
  const bf16_t* P0 = WSP(const bf16_t, OFF_P0);
  for (int r = gwave(); r < NA; r += nwave()) {
    const bool lat = r < NT;
    int b, keyrow, prow = 0, pcol = 0;
    if (lat) { b = r / SEQ; const int n = r % SEQ; keyrow = b * NKEY + CTXL + n; prow = n >> 6; pcol = n & 63; }
    else { const int i = r - NT; b = i / CTXL; keyrow = b * NKEY + (i % CTXL); }
    const bf16_t* row = P0 + (size_t)r * P0W;
    const u32x4 wq = *(const u32x4*)(row + lane * 8), wkv = *(const u32x4*)(row + 512 + lane * 8);
    const float xkr = bf2f(row[1024 + lane]);
    asm volatile("" ::: "memory");
    if (lat) {
      const u32x4 w = wq;
      float v[8] = {bf_lo(w[0]), bf_hi(w[0]), bf_lo(w[1]), bf_hi(w[1]), bf_lo(w[2]), bf_hi(w[2]), bf_lo(w[3]), bf_hi(w[3])};
      float ss = 0.f;
#pragma unroll
      for (int j = 0; j < 8; ++j) ss += v[j] * v[j];
      const float inv = rsqrtf(wave_sum(ss) * (1.f / 512.f) + EPS);
      const f32x4 g0 = *(const f32x4*)(p.q_norm + lane * 8), g1 = *(const f32x4*)(p.q_norm + lane * 8 + 4);
      u32x4 o = {cvtpk(v[0] * inv * g0[0], v[1] * inv * g0[1]), cvtpk(v[2] * inv * g0[2], v[3] * inv * g0[3]),
                 cvtpk(v[4] * inv * g1[0], v[5] * inv * g1[1]), cvtpk(v[6] * inv * g1[2], v[7] * inv * g1[3])};
      *(u32x4*)(WSP(bf16_t, OFF_CQN) + (size_t)r * 512 + lane * 8) = o;
    }
    {
      const u32x4 w = wkv;
      float v[8] = {bf_lo(w[0]), bf_hi(w[0]), bf_lo(w[1]), bf_hi(w[1]), bf_lo(w[2]), bf_hi(w[2]), bf_lo(w[3]), bf_hi(w[3])};
      float ss = 0.f;
#pragma unroll
      for (int j = 0; j < 8; ++j) ss += v[j] * v[j];
      const float inv = rsqrtf(wave_sum(ss) * (1.f / 512.f) + EPS);
      const f32x4 g0 = *(const f32x4*)(p.kv_norm + lane * 8), g1 = *(const f32x4*)(p.kv_norm + lane * 8 + 4);
      u32x4 o = {cvtpk(v[0] * inv * g0[0], v[1] * inv * g0[1]), cvtpk(v[2] * inv * g0[2], v[3] * inv * g0[3]),
                 cvtpk(v[4] * inv * g1[0], v[5] * inv * g1[1]), cvtpk(v[6] * inv * g1[2], v[7] * inv * g1[3])};
      *(u32x4*)(WSP(bf16_t, OFF_CKVN) + (size_t)r * 512 + lane * 8) = o;
    }
    const float pos = (lane >> 5) ? (float)pcol : (float)prow;
    const bool second = (lane >> 4) & 1;
    float c64 = 1.f, s64 = 0.f;
    if (lat) sincosf(pos * rope_inv_freq(lane & 15, 16), &s64, &c64);
    {
      const float xs = xkr;
      const float xp = __shfl_xor(xs, 16, 64);
      const float o = second ? (xs * c64 + xp * s64) : (xs * c64 - xp * s64);
      const unsigned char ob = (unsigned char)(pack_fp8x4(o, o, o, o) & 0xffu);
      unsigned char* ka = WSP(unsigned char, OFF_KA) + (size_t)keyrow * 1536 + 128 + (lane & 32) + 8 * ((lane & 15) >> 2) + 4 * ((lane >> 4) & 1) + (lane & 3);
#pragma unroll
      for (int h = 0; h < 8; ++h) ka[h * 192] = ob;
    }
  }
}

__device__ __forceinline__ void ph_diffcomb(const Params& p) {
  const int lane = otid() & 63;
  float d1 = p.lq1[lane] * p.lk1[lane] + p.lq1[lane + 64] * p.lk1[lane + 64];
  float d2 = p.lq2[lane] * p.lk2[lane] + p.lq2[lane + 64] * p.lk2[lane + 64];
  d1 = wave_sum(d1); d2 = wave_sum(d2);
  const float lam_init = 0.2f;
  const float lam = expf(d1) - expf(d2) + lam_init;
  const f32x4 sg = *(const f32x4*)(p.subln + lane * 4);
  const bf16_t* OD = WSP(const bf16_t, OFF_OD);
  for (int r = gwave(); r < NT; r += nwave()) {
    u32x2 w0[4], w1[4];
#pragma unroll
    for (int h = 0; h < 4; ++h) { w0[h] = *(const u32x2*)(OD + (size_t)r * 2048 + h * 256 + lane * 4); w1[h] = *(const u32x2*)(OD + (size_t)r * 2048 + 1024 + h * 256 + lane * 4); }
    asm volatile("" ::: "memory");
#pragma unroll
    for (int h = 0; h < 4; ++h) {
      const f32x4 o0 = {bf_lo(w0[h][0]), bf_hi(w0[h][0]), bf_lo(w0[h][1]), bf_hi(w0[h][1])}, o1 = {bf_lo(w1[h][0]), bf_hi(w1[h][0]), bf_lo(w1[h][1]), bf_hi(w1[h][1])};
      const f32x4 d = o0 - lam * o1;
      const float ss = wave_sum(d[0] * d[0] + d[1] * d[1] + d[2] * d[2] + d[3] * d[3]);
      const float inv = rsqrtf(ss * (1.f / 256.f) + EPS) * (1.f - lam_init);
      u32x2 w = {cvtpk(d[0] * inv * sg[0], d[1] * inv * sg[1]), cvtpk(d[2] * inv * sg[2], d[3] * inv * sg[3])};
      *(u32x2*)(WSP(bf16_t, OFF_YIN) + (size_t)r * 2048 + 1024 + h * 256 + lane * 4) = w;
    }
  }
}

__device__ __forceinline__ float swapsum32(float a, float b) { auto r = __builtin_amdgcn_permlane32_swap(__float_as_uint(a), __float_as_uint(b), false, false); return __uint_as_float(r[0]) + __uint_as_float(r[1]); }
__device__ __forceinline__ float swapsum16(float a, float b) { auto r = __builtin_amdgcn_permlane16_swap(__float_as_uint(a), __float_as_uint(b), false, false); return __uint_as_float(r[0]) + __uint_as_float(r[1]); }
__device__ __forceinline__ float rowsum16(float v) {
  v += __int_as_float(__builtin_amdgcn_update_dpp(0, __float_as_int(v), 0x128, 0xf, 0xf, false));
  v += __int_as_float(__builtin_amdgcn_update_dpp(0, __float_as_int(v), 0x124, 0xf, 0xf, false));
  v += __int_as_float(__builtin_amdgcn_update_dpp(0, __float_as_int(v), 0x122, 0xf, 0xf, false));
  v += __int_as_float(__builtin_amdgcn_update_dpp(0, __float_as_int(v), 0x121, 0xf, 0xf, false));
  return v;
}
__device__ __forceinline__ void ph_ffn_pre(const Params& p, int l, char* smem) {
  const int lane = otid() & 63, tid = otid();
  float* rw = (float*)smem;
  const float* rsrc = p.router_w + (size_t)l * DM * NE;
  for (int id = tid; id < DM * 4; id += 512) {
    const int j = id >> 2, q = id & 3;
    const f32x4 v = *(const f32x4*)(rsrc + j * 16 + q * 4);
    const int i = j >> 8, ln = (j & 255) >> 2, k = j & 3;
    *(f32x4*)(rw + ((((q * 8 + i) * 4 + k) * 64 + ln) << 2)) = v;
  }
  __syncthreads();
  const int gw = gwave(), nw = nwave();
  const bf16_t* XL = WSP(const bf16_t, OFF_XL);
  for (int pi = gw; pi < NT / 2; pi += nw) {
    u32x2 nx[2][8];
#pragma unroll
    for (int x = 0; x < 2; ++x)
#pragma unroll
      for (int i = 0; i < 8; ++i) nx[x][i] = *(const u32x2*)(XL + (size_t)(2 * pi + x) * DM + i * 256 + lane * 4);
    const int r0 = 2 * pi, b = r0 / SEQ, n0 = r0 % SEQ;
    const float* ml = mlp(p, l, b);
    Row8 row[2]; float ssl[2] = {0.f, 0.f};
#pragma unroll
    for (int x = 0; x < 2; ++x)
#pragma unroll
      for (int i = 0; i < 8; ++i) { const u32x2 w = nx[x][i]; row[x].v[i] = (f32x4){bf_lo(w[0]), bf_hi(w[0]), bf_lo(w[1]), bf_hi(w[1])};
        ssl[x] += row[x].v[i][0] * row[x].v[i][0] + row[x].v[i][1] * row[x].v[i][1] + row[x].v[i][2] * row[x].v[i][2] + row[x].v[i][3] * row[x].v[i][3]; }
    float st = swapsum32(ssl[0], ssl[1]); st = rowsum16(swapsum16(st, st));
    const float inv0 = rsqrtf(__builtin_amdgcn_readlane(st, 0) * (1.f / DM) + EPS), inv1 = rsqrtf(__builtin_amdgcn_readlane(st, 32) * (1.f / DM) + EPS);
#pragma unroll
    for (int i = 0; i < 8; ++i) {
      const int j = i * 256 + lane * 4;
      const f32x4 g = *(const f32x4*)(p.norm_ffn + l * DM + j), s1 = *(const f32x4*)(ml + 8192 + j), s0 = *(const f32x4*)(ml + 6144 + j);
      row[0].v[i] = row[0].v[i] * inv0 * g * (1.f + s1) + s0; row[1].v[i] = row[1].v[i] * inv1 * g * (1.f + s1) + s0;
    }
    row_store_fp8(row[0], WSP(unsigned char, OFF_H) + (size_t)r0 * DM, lane);
    row_store_fp8(row[1], WSP(unsigned char, OFF_H) + (size_t)(r0 + 1) * DM, lane);
    float lg[2][16];
#pragma unroll
    for (int e = 0; e < 16; ++e) { lg[0][e] = 0.f; lg[1][e] = 0.f; }
#pragma unroll
    for (int i = 0; i < 8; ++i) {
      __builtin_amdgcn_sched_barrier(0);
#pragma unroll
      for (int k = 0; k < 4; ++k) {
        __builtin_amdgcn_sched_barrier(0);
        const float h0 = row[0].v[i][k], h1 = row[1].v[i][k];
#pragma unroll
        for (int q = 0; q < 4; ++q) {
          const f32x4 w = *(const f32x4*)(rw + ((((q * 8 + i) * 4 + k) * 64 + lane) << 2));
#pragma unroll
          for (int c = 0; c < 4; ++c) { lg[0][q * 4 + c] += h0 * w[c]; lg[1][q * 4 + c] += h1 * w[c]; }
        }
      }
    }
    float t[8];
#pragma unroll
    for (int e = 0; e < 8; ++e) t[e] = rowsum16(swapsum16(swapsum32(lg[0][e], lg[1][e]), swapsum32(lg[0][e + 8], lg[1][e + 8])));
    float m8 = t[0];
#pragma unroll
    for (int e = 1; e < 8; ++e) m8 = fmaxf(m8, t[e]);
    float mx; { auto r = __builtin_amdgcn_permlane16_swap(__float_as_uint(m8), __float_as_uint(m8), false, false); mx = fmaxf(__uint_as_float(r[0]), __uint_as_float(r[1])); }
    float d8 = 0.f;
#pragma unroll
    for (int e = 0; e < 8; ++e) { t[e] = expf(t[e] - mx); d8 += t[e]; }
    const float rden = 1.f / swapsum16(d8, d8);
    float mine = 0.f;
#pragma unroll
    for (int e = 0; e < 8; ++e) mine = ((lane & 15) == e) ? t[e] * rden : mine;
    if ((lane & 15) < 8) {
      const int x = lane >> 5, e = ((lane >> 4) & 1) * 8 + (lane & 15);
      WSP(float, OFF_AFF)[((size_t)(b * NE + e)) * SEQ + n0 + x] = mine;
      WSP(int, OFF_INV)[(size_t)(r0 + x) * NE + e] = -1;
    }
  }
  __syncthreads();
}

__device__ __forceinline__ void ph_topk(const Params& p, char* smem) {
  unsigned* cnt = (unsigned*)smem;
  const int tid = otid(), lane = tid & 63, wid = tid >> 6;
  for (int be = blockIdx.x; be < NB * NE; be += gridDim.x) {
    const int b = be / NE, e = be % NE;
    const float* src = WSP(const float, OFF_AFF) + (size_t)be * SEQ + tid * 8;
    const f32x4 v0 = *(const f32x4*)src, v1 = *(const f32x4*)(src + 4);
    const float val[8] = {v0[0], v0[1], v0[2], v0[3], v1[0], v1[1], v1[2], v1[3]};
    unsigned key[8];
#pragma unroll
    for (int j = 0; j < 8; ++j) key[j] = __float_as_uint(val[j]);
    unsigned lo = 0u, hi = 0x3f800000u; int par = 0;
    __syncthreads();
    while (lo < hi) {
      const unsigned span = hi - lo + 1u;
      const unsigned t1 = lo + (span >> 2), t2 = lo + (span >> 1), t3 = lo + (span >> 1) + (span >> 2);
      unsigned c1 = 0u, c2 = 0u, c3 = 0u;
#pragma unroll
      for (int k = 0; k < 8; ++k) { c1 += (unsigned)__popcll(__ballot(key[k] >= t1)); c2 += (unsigned)__popcll(__ballot(key[k] >= t2)); c3 += (unsigned)__popcll(__ballot(key[k] >= t3)); }
      if (lane < 3) cnt[par * 32 + wid * 4 + lane] = lane == 0 ? c1 : (lane == 1 ? c2 : c3);
      __syncthreads();
      unsigned s1 = 0u, s2 = 0u, s3 = 0u;
#pragma unroll
      for (int w = 0; w < 8; ++w) { s1 += cnt[par * 32 + w * 4]; s2 += cnt[par * 32 + w * 4 + 1]; s3 += cnt[par * 32 + w * 4 + 2]; }
      par ^= 1;
      if (s1 < (unsigned)CAP) hi = t1 - 1u;
      else if (s2 < (unsigned)CAP) { lo = t1; hi = t2 - 1u; }
      else if (s3 < (unsigned)CAP) { lo = t2; hi = t3 - 1u; }
      else lo = t3;
    }
    const unsigned T = lo;
    int ngt = 0, neq = 0;
#pragma unroll
    for (int j = 0; j < 8; ++j) { ngt += key[j] > T ? 1 : 0; neq += key[j] == T ? 1 : 0; }
    int pk = ngt | (neq << 16);
    int inc = pk;
#pragma unroll
    for (int o = 1; o < 64; o <<= 1) { const int t = __shfl_up(inc, o, 64); if (lane >= o) inc += t; }
    if (lane == 63) cnt[128 + wid] = (unsigned)inc;
    __syncthreads();
    int base = 0, total = 0;
#pragma unroll
    for (int w = 0; w < 8; ++w) { const int t = (int)cnt[128 + w]; total += t; if (w < wid) base += t; }
    const int excl = base + inc - pk;
    int gpos = excl & 0xffff, epos = excl >> 16;
    const int total_gt = total & 0xffff, need = CAP - total_gt;
#pragma unroll
    for (int j = 0; j < 8; ++j) {
      int slot = -1;
      if (key[j] > T) slot = gpos++;
      else if (key[j] == T) { if (epos < need) slot = total_gt + epos; ++epos; }
      if (slot >= 0) {
        const int tok = tid * 8 + j;
        WSP(int, OFF_IDX)[be * CAP + slot] = tok; WSP(float, OFF_GATE)[be * CAP + slot] = val[j];
        WSP(int, OFF_INV)[(size_t)(b * SEQ + tok) * NE + e] = slot;
      }
    }
    __syncthreads();
  }
}

__device__ __forceinline__ void ph_combine(const Params& p, int l) {
  const int lane = otid() & 63;
  for (int r = gwave(); r < NT; r += nwave()) {
    const int b = r / SEQ;
    Row8 acc;
#pragma unroll
    for (int i = 0; i < 8; ++i) acc.v[i] = (f32x4){0.f, 0.f, 0.f, 0.f};
    const int myinv = WSP(const int, OFF_INV)[(size_t)r * NE + (lane & 15)];
    unsigned long long mask = __ballot(myinv >= 0) & 0xffffull;
    bf16_t* xl = WSP(bf16_t, OFF_XL) + (size_t)r * DM;
    u32x2 xw[8];
#pragma unroll
    for (int i = 0; i < 8; ++i) xw[i] = *(const u32x2*)(xl + i * 256 + lane * 4);
    while (mask) {
      const int e = __builtin_ctzll(mask); mask &= mask - 1;
      const int s = __builtin_amdgcn_readlane(myinv, e);
      const bf16_t* ye = WSP(const bf16_t, OFF_YE) + ((size_t)e * 2048 + b * CAP + s) * DM;
#pragma unroll
      for (int i = 0; i < 8; ++i) {
        const u32x2 w = *(const u32x2*)(ye + i * 256 + lane * 4);
        acc.v[i][0] += bf_lo(w[0]); acc.v[i][1] += bf_hi(w[0]); acc.v[i][2] += bf_lo(w[1]); acc.v[i][3] += bf_hi(w[1]);
      }
    }
    const float* ml = mlp(p, l, b);
    Row8 row; float ss = 0.f;
#pragma unroll
    for (int i = 0; i < 8; ++i) {
      const int j = i * 256 + lane * 4;
      const f32x4 g2 = *(const f32x4*)(ml + 10240 + j);
      row.v[i] = (f32x4){bf_lo(xw[i][0]), bf_hi(xw[i][0]), bf_lo(xw[i][1]), bf_hi(xw[i][1])} + g2 * acc.v[i];
      ss += row.v[i][0] * row.v[i][0] + row.v[i][1] * row.v[i][1] + row.v[i][2] * row.v[i][2] + row.v[i][3] * row.v[i][3];
    }
    ss = wave_sum(ss);
    const float inv = rsqrtf(ss * (1.f / DM) + EPS);
    if (l == 0) {
#pragma unroll
      for (int i = 0; i < 8; ++i) { u32x2 w = {cvtpk(row.v[i][0], row.v[i][1]), cvtpk(row.v[i][2], row.v[i][3])}; *(u32x2*)(xl + i * 256 + lane * 4) = w; }
      const float* ml1 = mlp(p, 1, b);
      row_norm_mod(row, inv, p.norm_mix + DM, ml1 + 2048, ml1, lane);
      row_store_bf16(row, WSP(bf16_t, OFF_H) + (size_t)r * DM, lane);
    } else {
      row_norm_mod(row, inv, p.final_norm, nullptr, nullptr, lane);
#pragma unroll
      for (int i = 0; i < 8; ++i) *(f32x4*)(p.out + (size_t)r * DM + i * 256 + lane * 4) = row.v[i];
    }
  }
}

__device__ __forceinline__ void ph_fold(const Params& p) {
  const bf16_t* src = WSP(const bf16_t, OFF_ABT2); bf16_t* dst = WSP(bf16_t, OFF_ABTF);
  float* nyq = WSP(float, OFF_IDX);
  for (int id = blockIdx.x * 512 + otid(); id < 4096 * 512; id += gridDim.x * 512) {
    const int rowi = id >> 9, kk0 = (id & 511) * 8;
    const bf16_t* rp = src + (size_t)rowi * 8192;
    float o[8];
    if (kk0 < 2048) {
      const u32x4 w = *(const u32x4*)(rp + kk0);
#pragma unroll
      for (int j = 0; j < 4; ++j) { o[2 * j] = bf_lo(w[j]); o[2 * j + 1] = bf_hi(w[j]); }
#pragma unroll
      for (int j = 0; j < 8; ++j) { const int kk = kk0 + j; if (kk > 0) o[j] += bf2f(rp[4096 - kk]); }
    } else {
      const int j0 = kk0 - 2048;
      const u32x4 w = *(const u32x4*)(rp + 4096 + j0);
#pragma unroll
      for (int j = 0; j < 4; ++j) { o[2 * j] = bf_lo(w[j]); o[2 * j + 1] = bf_hi(w[j]); }
#pragma unroll
      for (int j = 0; j < 8; ++j) { const int jj = j0 + j; if (jj > 0) o[j] -= bf2f(rp[4096 + 4096 - jj]); else o[j] = bf2f(rp[2048]); }
      if (j0 == 0) nyq[rowi] = o[0];
    }
    u32x4 ow = {cvtpk(o[0], o[1]), cvtpk(o[2], o[3]), cvtpk(o[4], o[5]), cvtpk(o[6], o[7])};
    *(u32x4*)(dst + (size_t)rowi * 4096 + kk0) = ow;
  }
}

__device__ __forceinline__ void ph_dftcomb(const Params& p) {
  const bf16_t* PQ = WSP(const bf16_t, OFF_SPEC); const bf16_t* abtf = WSP(const bf16_t, OFF_ABTF); bf16_t* Y = WSP(bf16_t, OFF_YCAT);
  const float sc = 1.f / 1024.f;
  for (int id = blockIdx.x * 512 + otid(); id < 16 * 2048 * 32; id += gridDim.x * 512) {
    const int d8 = (id & 31) * 8, k1 = (id >> 5) & 2047, bg = id >> 16, b = bg >> 2, g = bg & 3;
    const u32x4 wp = *(const u32x4*)(PQ + ((size_t)(2 * bg) * 2048 + k1) * 256 + d8), wq = *(const u32x4*)(PQ + ((size_t)(2 * bg + 1) * 2048 + k1) * 256 + d8);
    float pv[8], qv[8], ny[8];
#pragma unroll
    for (int j = 0; j < 4; ++j) { pv[2 * j] = bf_lo(wp[j]); pv[2 * j + 1] = bf_hi(wp[j]); qv[2 * j] = bf_lo(wq[j]); qv[2 * j + 1] = bf_hi(wq[j]); }
    const float sgn = (k1 & 1) ? -2.f : 2.f;
    { const f32x4 n0 = *(const f32x4*)(WSP(const float, OFF_IDX) + bg * 256 + d8), n1 = *(const f32x4*)(WSP(const float, OFF_IDX) + bg * 256 + d8 + 4);
#pragma unroll
      for (int j = 0; j < 4; ++j) { ny[j] = sgn * n0[j]; ny[4 + j] = sgn * n1[j]; } }
    bf16_t* y0 = Y + ((size_t)b * SEQ + k1) * DM + 1024 + g * 256 + d8;
    u32x4 o;
#pragma unroll
    for (int j = 0; j < 4; ++j) o[j] = cvtpk((pv[2 * j] + qv[2 * j]) * sc, (pv[2 * j + 1] + qv[2 * j + 1]) * sc);
    *(u32x4*)y0 = o;
    if (k1 > 0) {
#pragma unroll
      for (int j = 0; j < 4; ++j) o[j] = cvtpk((pv[2 * j] - qv[2 * j] + ny[2 * j]) * sc, (pv[2 * j + 1] - qv[2 * j + 1] + ny[2 * j + 1]) * sc);
      *(u32x4*)(Y + ((size_t)b * SEQ + (SEQ - k1)) * DM + 1024 + g * 256 + d8) = o;
    }
  }
  const int lane = otid() & 63;
  for (int r = gwave(); r < 16 * 256; r += nwave()) {
    const bf16_t* row = abtf + (size_t)r * 4096;
    float acc = 0.f;
#pragma unroll
    for (int i = 0; i < 4; ++i) { const u32x4 w = *(const u32x4*)(row + i * 512 + lane * 8);
#pragma unroll
      for (int j = 0; j < 4; ++j) acc += bf_lo(w[j]) - bf_hi(w[j]); }
    acc = wave_sum(acc) + bf2f(row[2048]);
    if (lane == 0) { const int bg = r >> 8, d = r & 255; Y[((size_t)(bg >> 2) * SEQ + 2048) * DM + 1024 + (bg & 3) * 256 + d] = f2bf(acc * sc); }
  }
}

__device__ __forceinline__ void ph_pool(const Params& p) {
  const bf16_t* Z = WSP(const bf16_t, OFF_Z);
  for (int id = blockIdx.x * 512 + otid(); id < (NT / 16) * 128; id += gridDim.x * 512) {
    const int rb = id >> 7, c8 = (id & 127) * 8, half = 1 << (c8 >> 8);
    const int b = rb / (SEQ / 16), n0 = (rb % (SEQ / 16)) * 16;
    const bf16_t* zb = Z + (size_t)b * SEQ * 2048 + c8;
    float s[8];
#pragma unroll
    for (int j = 0; j < 8; ++j) s[j] = 0.f;
    for (int t = n0 - half; t < n0 + half; ++t) {
      if (t >= 0 && t < SEQ) { const u32x4 w = *(const u32x4*)(zb + (size_t)t * 2048);
#pragma unroll
        for (int j = 0; j < 4; ++j) { s[2 * j] += bf_lo(w[j]); s[2 * j + 1] += bf_hi(w[j]); } }
    }
#pragma unroll 4
    for (int r = 0; r < 16; ++r) {
      const int n = n0 + r, lo = max(n - half, 0), hi = min(n + half, SEQ);
      const u32x4 w = *(const u32x4*)(zb + (size_t)n * 2048);
      u32x4 wi = {0u, 0u, 0u, 0u}, wo = {0u, 0u, 0u, 0u};
      if (n + half < SEQ) wi = *(const u32x4*)(zb + (size_t)(n + half) * 2048);
      if (n - half >= 0) wo = *(const u32x4*)(zb + (size_t)(n - half) * 2048);
      const float rc = 1.f / (float)(hi - lo);
      u32x4 o;
#pragma unroll
      for (int j = 0; j < 4; ++j) o[j] = cvtpk(s[2 * j] * rc - bf_lo(w[j]), s[2 * j + 1] * rc - bf_hi(w[j]));
      *(u32x4*)(WSP(bf16_t, OFF_POOLED) + (size_t)(b * SEQ + n) * 1024 + c8) = o;
#pragma unroll
      for (int j = 0; j < 4; ++j) { s[2 * j] += bf_lo(wi[j]) - bf_lo(wo[j]); s[2 * j + 1] += bf_hi(wi[j]) - bf_hi(wo[j]); }
    }
  }
}

#define LAS __attribute__((address_space(3)))
__host__ __device__ __forceinline__ constexpr int vt_pos(int kap) { return (((kap >> 2) & 1) << 5) | ((kap >> 5) << 4) | (((kap >> 3) & 3) << 2) | (kap & 3); }
namespace fg {
constexpr int BM = 256, BK = 64, HALF = 128, HTB = HALF * BK * 2, STAGE_BYTES = 8 * HTB;
__device__ __forceinline__ int lds_byte(int r, int c) { const int st = (r >> 4) * 2 + (c >> 5), rr = r & 15, cc = c & 31, ob = rr * 64 + cc * 2; return st * 1024 + (ob ^ (((ob >> 9) & 1) << 5)); }
__device__ __forceinline__ void stage_rc(int b, int& R, int& C) { const int st = b / 1024, sb = b % 1024, swz = sb ^ (((sb >> 9) & 1) << 5); R = (st >> 1) * 16 + swz / 64; C = (st & 1) * 32 + (swz % 64) / 2; }
struct Unit { const char* a; const char* b; int pm, pn, grp; };
typedef int i32x8 __attribute__((ext_vector_type(8)));
typedef int i32x4 __attribute__((ext_vector_type(4)));
__device__ __forceinline__ void mfma_fp8(f32x4& acc, const i32x8& a, const i32x8& b, int scale) {
  asm volatile("s_nop 1\n\tv_mfma_scale_f32_16x16x128_f8f6f4 %0, %1, %2, %0, %3, %3 op_sel_hi:[0,0,0]" : "+v"(acc) : "v"(a), "v"(b), "v"(scale));
}
template <int H> __device__ __forceinline__ bf16x8 half8(i32x8 v) { const i32x4 h = H ? __builtin_shufflevector(v, v, 4, 5, 6, 7) : __builtin_shufflevector(v, v, 0, 1, 2, 3); return __builtin_bit_cast(bf16x8, h); }
__device__ __forceinline__ i32x8 cat8(bf16x8 lo, bf16x8 hi) { const i32x4 a = __builtin_bit_cast(i32x4, lo), b = __builtin_bit_cast(i32x4, hi); return (i32x8){a[0], a[1], a[2], a[3], b[0], b[1], b[2], b[3]}; }
struct Grid {
  const char* A; const char* B; size_t sA, sB; int lda, ldb, nM, nN, ngrp, G, c; int gd = 1; size_t sA2 = 0, sB2 = 0;
  int rot = 0;
  int dftmap = 0;
  __device__ __forceinline__ bool next(int i, Unit& u) const {
    const int cc = (G == 256) ? (((c & 7) * 32 + (c >> 3) + rot) & 255) : c;
    int L = i * G + cc; const int per = nM * nN;
    if (dftmap && G == 256) { const int x = cc >> 5, sl = cc & 31; L = (2 * (4 * (x >> 1) + (sl >> 3)) + (x & 1)) * 8 + (sl & 7); if (i) return false; }
    if (L >= per * ngrp) return false;
    const int g = L / per, w = L - g * per;
    const int nig = 8 * nN, gid = w / nig, fm = gid * 8, gsz = (nM - fm) < 8 ? (nM - fm) : 8, wi = w - gid * nig;
    u.grp = g; u.pn = wi / gsz; u.pm = fm + (wi - u.pn * gsz);
    const int g1 = g / gd, g2 = g - g1 * gd;
    u.a = A + (size_t)g1 * sA + (size_t)g2 * sA2 + (size_t)u.pm * 256 * lda * 2; u.b = B + (size_t)g1 * sB + (size_t)g2 * sB2 + (size_t)u.pn * 256 * ldb * 2;
    return true;
  }
};
template <class Epi, bool GATHER = false, bool FP8 = false>
__device__ __forceinline__ void gemm_fast(LAS unsigned char* lds, const Grid& S, const Epi& E, int K, const int* gidx = nullptr) {
  int tid_ = threadIdx.x; asm volatile("" : "+v"(tid_));
  const int tid = tid_, wid = __builtin_amdgcn_readfirstlane(tid >> 6), lane = tid & 63, wr = wid >> 2, wc = wid & 3, fr = lane & 15, fq = lane >> 4;
  const int nt = K / BK;
  unsigned voffA[2], voffB[2];
#pragma unroll
  for (int i = 0; i < 2; ++i) { int R, C; stage_rc(tid * 16 + i * 8192, R, C); voffA[i] = (unsigned)(R * S.lda + C) * 2u; voffB[i] = (unsigned)(R * S.ldb + C) * 2u; }
  const size_t kstep = (size_t)(BK * 2);
  const size_t hstepA = (size_t)HALF * S.lda * 2, hstepB = (size_t)HALF * S.ldb * 2;
  const unsigned ldsw = (unsigned)wid * 1024u;
  const int aoff = FP8 ? lds_byte(wr * 64 + fr, fq * 16) : lds_byte(wr * 64 + fr, fq * 8), boff = FP8 ? lds_byte(wc * 32 + fr, fq * 16) : lds_byte(wc * 32 + fr, fq * 8);
  constexpr int KOFF = FP8 ? 16 : 1024;
#define FG_SA(b, h) (((b) * 2 + (h)) * HTB)
#define FG_SB(b, h) ((4 + (b) * 2 + (h)) * HTB)
#define FG_STAGE(bufoff, gbase, voff) do { _Pragma("unroll") for (int _i = 0; _i < 2; ++_i) \
    __builtin_amdgcn_global_load_lds((const unsigned*)((const char*)(gbase) + (voff)[_i]), (LAS unsigned*)(lds + (bufoff) + ldsw + _i * 8192), 16, 0, 0); } while (0)
#define FG_STAGE_A(bufoff, usen, kb, h) do { if constexpr (GATHER) { _Pragma("unroll") for (int _i = 0; _i < 2; ++_i) { const unsigned _g = (usen) ? gN[h][_i] : gA[h][_i]; \
      __builtin_amdgcn_global_load_lds((const unsigned*)(S.A + _g + (kb)), (LAS unsigned*)(lds + (bufoff) + ldsw + _i * 8192), 16, 0, 0); } } \
    else { FG_STAGE(bufoff, ((usen) ? nA : cA) + (kb) + (h) * hstepA, voffA); } } while (0)
#define FG_LDA(dst, b, h) do { _Pragma("unroll") for (int m = 0; m < 4; ++m) dst[m] = cat8(*(const LAS bf16x8*)(lds + FG_SA(b, h) + aoff + m * 2048), *(const LAS bf16x8*)(lds + FG_SA(b, h) + aoff + m * 2048 + KOFF)); } while (0)
#define FG_LDB(dst, b, h) do { _Pragma("unroll") for (int n = 0; n < 2; ++n) dst[n] = cat8(*(const LAS bf16x8*)(lds + FG_SB(b, h) + boff + n * 2048), *(const LAS bf16x8*)(lds + FG_SB(b, h) + boff + n * 2048 + KOFF)); } while (0)
#define FG_MMA(ai, bj, At, Bt) do { __builtin_amdgcn_s_setprio(1); _Pragma("unroll") for (int m = 0; m < 4; ++m) _Pragma("unroll") for (int n = 0; n < 2; ++n) { \
    if constexpr (FP8) mfma_fp8(acc[ai][bj][m][n], Bt[n], At[m], one_scale); \
    else { acc[ai][bj][m][n] = __builtin_amdgcn_mfma_f32_16x16x32_bf16(half8<0>(Bt[n]), half8<0>(At[m]), acc[ai][bj][m][n], 0, 0, 0); \
           acc[ai][bj][m][n] = __builtin_amdgcn_mfma_f32_16x16x32_bf16(half8<1>(Bt[n]), half8<1>(At[m]), acc[ai][bj][m][n], 0, 0, 0); } } \
    __builtin_amdgcn_s_setprio(0); } while (0)
#define FG_WAIT_V(n) asm volatile("s_waitcnt vmcnt(" #n ")" ::: "memory")
#define FG_WAIT_L(n) asm volatile("s_waitcnt lgkmcnt(" #n ")" ::: "memory")
#define FG_BAR __builtin_amdgcn_s_barrier()
#define FG_SCHED __builtin_amdgcn_sched_barrier(0)
  Unit cur, nxt; int ui = 0;
  if (!S.next(0, cur)) return;
  f32x4 acc[2][2][4][2];
#pragma unroll
  for (int a = 0; a < 2; ++a)
#pragma unroll
    for (int b = 0; b < 2; ++b)
#pragma unroll
      for (int m = 0; m < 4; ++m)
#pragma unroll
        for (int n = 0; n < 2; ++n) acc[a][b][m][n] = (f32x4){0.f, 0.f, 0.f, 0.f};
  int one_scale = 0x7f7f7f7f; asm volatile("" : "+v"(one_scale));
  i32x8 At[4], B0[2], B1[2];
  const char* cA = cur.a; const char* cB = cur.b; const char* nA = cA;
  unsigned gA[2][2] = {{0u, 0u}, {0u, 0u}}, gN[2][2] = {{0u, 0u}, {0u, 0u}};
  auto goff = [&](const Unit& u, unsigned (&g)[2][2]) {
#pragma unroll
    for (int h = 0; h < 2; ++h)
#pragma unroll
      for (int i = 0; i < 2; ++i) { int R, C; stage_rc(tid * 16 + i * 8192, R, C); const int rr = u.pm * 256 + h * 128 + R, bb = rr >> 9;
        const int tok = bb * SEQ + gidx[(bb * NE + u.grp) * CAP + (rr & 511)]; g[h][i] = (unsigned)(tok * S.lda + C) * 2u; }
  };
  if constexpr (GATHER) goff(cur, gA);
  FG_STAGE(FG_SB(0, 0), cB, voffB); FG_STAGE_A(FG_SA(0, 0), false, 0, 0); FG_STAGE(FG_SB(0, 1), cB + hstepB, voffB); FG_STAGE_A(FG_SA(0, 1), false, 0, 1);
  if (wr == 1) FG_BAR;
  FG_WAIT_V(4); FG_BAR;
  FG_STAGE(FG_SB(1, 0), cB + kstep, voffB); FG_STAGE_A(FG_SA(1, 0), false, kstep, 0); FG_STAGE(FG_SB(1, 1), cB + hstepB + kstep, voffB);
  FG_WAIT_V(6); FG_BAR;
  for (;;) {
    const bool has_next = S.next(ui + 1, nxt);
    nA = has_next ? nxt.a : cA; const char* nB = has_next ? nxt.b : cB;
    if constexpr (GATHER) { if (has_next) goff(nxt, gN); else {
#pragma unroll
      for (int h = 0; h < 2; ++h)
#pragma unroll
        for (int i = 0; i < 2; ++i) gN[h][i] = gA[h][i]; } }
#pragma unroll 1
    for (int t = 0; t < nt; t += 2) {
      const bool last = (t == nt - 2);
      const size_t k1 = (size_t)(t + 1) * kstep, k2 = last ? 0 : (size_t)(t + 2) * kstep, k3 = k2 + kstep;
      const char* b2 = last ? nB : cB + (size_t)(t + 2) * kstep;
      const char* b3 = b2 + kstep;
      FG_LDB(B0, 0, 0); FG_SCHED; FG_LDA(At, 0, 0); FG_STAGE_A(FG_SA(1, 1), false, k1, 1);
      FG_WAIT_L(8); FG_BAR; FG_WAIT_L(0); FG_MMA(0, 0, At, B0); FG_BAR; FG_SCHED;
      FG_LDB(B1, 0, 1); FG_STAGE(FG_SB(0, 0), b2, voffB);
      FG_BAR; FG_WAIT_L(0); FG_MMA(0, 1, At, B1); FG_BAR;
      FG_LDA(At, 0, 1); FG_STAGE_A(FG_SA(0, 0), last, k2, 0);
      FG_BAR; FG_WAIT_L(0); FG_MMA(1, 0, At, B0); FG_BAR; FG_SCHED;
      FG_STAGE(FG_SB(0, 1), b2 + hstepB, voffB);
      FG_WAIT_V(6); FG_BAR; FG_MMA(1, 1, At, B1); FG_BAR;
      FG_LDB(B0, 1, 0); FG_SCHED; FG_LDA(At, 1, 0); FG_STAGE_A(FG_SA(0, 1), last, k2, 1);
      FG_WAIT_L(8); FG_BAR; FG_WAIT_L(0); FG_MMA(0, 0, At, B0); FG_BAR; FG_SCHED;
      FG_LDB(B1, 1, 1); FG_STAGE(FG_SB(1, 0), b3, voffB);
      FG_BAR; FG_WAIT_L(0); FG_MMA(0, 1, At, B1); FG_BAR;
      FG_LDA(At, 1, 1); FG_STAGE_A(FG_SA(1, 0), last, k3, 0);
      FG_BAR; FG_WAIT_L(0); FG_MMA(1, 0, At, B0); FG_BAR; FG_SCHED;
      FG_STAGE(FG_SB(1, 1), b3 + hstepB, voffB);
      FG_WAIT_V(6); FG_BAR; FG_MMA(1, 1, At, B1); FG_BAR;
    }
    if constexpr (FP8) asm volatile("s_nop 15\n\ts_nop 15" ::: "memory");
    {
      int tz = threadIdx.x; asm volatile("" : "+v"(tz));
      const int wz = __builtin_amdgcn_readfirstlane(tz >> 6), lz = tz & 63;
      E(acc, cur, wz >> 2, wz & 3, lz & 15, lz >> 4); }
    if (!has_next) break;
#pragma unroll
    for (int a = 0; a < 2; ++a)
#pragma unroll
      for (int b = 0; b < 2; ++b)
#pragma unroll
        for (int m = 0; m < 4; ++m)
#pragma unroll
          for (int n = 0; n < 2; ++n) acc[a][b][m][n] = (f32x4){0.f, 0.f, 0.f, 0.f};
    cur = nxt; cA = nA; cB = nB; ++ui;
    if constexpr (GATHER) {
#pragma unroll
      for (int h = 0; h < 2; ++h)
#pragma unroll
        for (int i = 0; i < 2; ++i) gA[h][i] = gN[h][i]; }
  }
  FG_WAIT_V(0);
  if (wr == 0) FG_BAR;
  FG_BAR;
#undef FG_SA
#undef FG_SB
#undef FG_STAGE
#undef FG_STAGE_A
#undef FG_LDA
#undef FG_LDB
#undef FG_MMA
#undef FG_WAIT_V
#undef FG_WAIT_L
#undef FG_BAR
#undef FG_SCHED
}
typedef f32x4 Acc[2][2][4][2];
#define FG_FOREACH(...)                                                                                                \
  _Pragma("unroll") for (int ai = 0; ai < 2; ++ai) _Pragma("unroll") for (int m = 0; m < 4; ++m)                       \
  _Pragma("unroll") for (int bj = 0; bj < 2; ++bj) _Pragma("unroll") for (int n = 0; n < 2; ++n) {                     \
    const int row = u.pm * 256 + ai * 128 + wr * 64 + m * 16 + fr, col = u.pn * 256 + bj * 128 + wc * 32 + n * 16 + 4 * fq; \
    const f32x4 v = acc[ai][bj][m][n]; __VA_ARGS__ }
__device__ __forceinline__ u32x2 pack4(f32x4 v) { return (u32x2){cvtpk(v[0], v[1]), cvtpk(v[2], v[3])}; }

struct EpiBf16 {
  bf16_t* O; int ld, nvalid; float scale; int gdiv; size_t s1, s2;
  __device__ __forceinline__ void operator()(const Acc& acc, const Unit& u, int wr, int wc, int fr, int fq) const {
    bf16_t* base = O + (size_t)(u.grp / gdiv) * s1 + (size_t)(u.grp % gdiv) * s2;
    FG_FOREACH(if (col < nvalid) *(u32x2*)(base + (size_t)row * ld + col) = pack4(v * scale);)
  }
};
struct EpiQRope {
  unsigned char* QA;
  __device__ __forceinline__ void operator()(const Acc& acc, const Unit& u, int wr, int wc, int fr, int fq) const {
#pragma unroll
    for (int ai = 0; ai < 2; ++ai)
#pragma unroll
      for (int m = 0; m < 4; ++m)
#pragma unroll
        for (int bj = 0; bj < 2; ++bj) {
          const int row = u.pm * 256 + ai * 128 + wr * 64 + m * 16 + fr, g0 = u.pn * 256 + bj * 128 + wc * 32, w0 = g0 % 192;
          f32x4 x1 = acc[ai][bj][m][0], x2 = acc[ai][bj][m][1];
          if (w0 >= 128) {
            const int ntok = row % SEQ; const float pos = (w0 >= 160) ? (float)(ntok & 63) : (float)(ntok >> 6);
#pragma unroll
            for (int j = 0; j < 4; ++j) { const float ang = pos * rope_inv_freq(4 * fq + j, 16); const float sn = __sinf(ang), cs = __cosf(ang);
              const float a = x1[j], b = x2[j]; x1[j] = a * cs - b * sn; x2[j] = b * cs + a * sn; }
          }
          *(u32x2*)(QA + (size_t)row * 1536 + g0 + 8 * fq) = (u32x2){pack_fp8x4(x1[0], x1[1], x1[2], x1[3]), pack_fp8x4(x2[0], x2[1], x2[2], x2[3])};
        }
  }
};
struct EpiIn0 {
  bf16_t* P0; unsigned char* QD; unsigned char* KD; unsigned char* VD;
  __device__ __forceinline__ void operator()(const Acc& acc, const Unit& u, int wr, int wc, int fr, int fq) const {
    const bool lat = u.pm < NT / 256;
#pragma unroll
    for (int ai = 0; ai < 2; ++ai)
#pragma unroll
      for (int m = 0; m < 4; ++m) {
        const int row = u.pm * 256 + ai * 128 + wr * 64 + m * 16 + fr;
        int keyrow, ntok = 0;
        if (lat) { ntok = row % SEQ; keyrow = (row / SEQ) * NKEY + CTXL + ntok; } else { const int ii = row - NT; keyrow = (ii / CTXL) * NKEY + (ii % CTXL); }
#pragma unroll
        for (int bj = 0; bj < 2; ++bj) {
          const int g0 = u.pn * 256 + bj * 128 + wc * 32;
          f32x4 x1 = acc[ai][bj][m][0] * (1.f / 32.f), x2 = acc[ai][bj][m][1] * (1.f / 32.f);
          if (g0 < P0W) { bf16_t* dst = P0 + (size_t)row * P0W + g0 + 4 * fq; *(u32x2*)dst = pack4(x1); *(u32x2*)(dst + 16) = pack4(x2); }
          else if (g0 < 3136) {
            const int vv = (g0 - 1088) >> 7, sg = ((g0 - 1088) & 127) >> 5, axis = sg >> 1, qh = sg & 1;
            if (lat) { const float pos = axis ? (float)(ntok & 63) : (float)(ntok >> 6);
#pragma unroll
              for (int j = 0; j < 4; ++j) { const float ang = pos * rope_inv_freq(qh * 16 + 4 * fq + j, 32); const float sn = __sinf(ang), cs = __cosf(ang);
                const float a = x1[j], b = x2[j]; x1[j] = a * cs - b * sn; x2[j] = b * cs + a * sn; } }
            const u32x2 pk = {pack_fp8x4(x1[0], x1[1], x1[2], x1[3]), pack_fp8x4(x2[0], x2[1], x2[2], x2[3])};
            if (vv < 8) { if (lat) *(u32x2*)(QD + (size_t)row * 1024 + vv * 128 + sg * 32 + 8 * fq) = pk; }
            else *(u32x2*)(KD + (size_t)keyrow * 1024 + (vv - 8) * 128 + sg * 32 + 8 * fq) = pk;
          }
        }
      }
  }
};
struct EpiKV {
  unsigned char* KA;
  __device__ __forceinline__ void operator()(const Acc& acc, const Unit& u, int wr, int wc, int fr, int fq) const {
#pragma unroll
    for (int ai = 0; ai < 2; ++ai)
#pragma unroll
      for (int m = 0; m < 4; ++m) {
        const int row = u.pm * 256 + ai * 128 + wr * 64 + m * 16 + fr;
        int b; int key; if (row < NT) { b = row / SEQ; key = CTXL + (row % SEQ); } else { const int ii = row - NT; b = ii / CTXL; key = ii % CTXL; }
#pragma unroll
        for (int bj = 0; bj < 2; ++bj) {
          const int g0 = u.pn * 256 + bj * 128 + wc * 32, h = g0 >> 7, w0 = g0 & 127;
          const f32x4 x1 = acc[ai][bj][m][0], x2 = acc[ai][bj][m][1];
          *(u32x2*)(KA + ((size_t)b * NKEY + key) * 1536 + h * 192 + w0 + 8 * fq) = (u32x2){pack_fp8x4(x1[0], x1[1], x1[2], x1[3]), pack_fp8x4(x2[0], x2[1], x2[2], x2[3])};
        }
      }
  }
};
struct EpiVT {
  unsigned char* VT; int dvs, nh; float scale;
  __device__ __forceinline__ void operator()(const Acc& acc, const Unit& u, int wr, int wc, int fr, int fq) const {
    FG_FOREACH(
      int b; int key; if (col < NT) { b = col / SEQ; key = CTXL + (col % SEQ); } else { const int ii = col - NT; b = ii / CTXL; key = ii % CTXL; }
      const int h = row >> dvs; const int d = row & ((1 << dvs) - 1);
      *(unsigned*)(VT + ((((size_t)(b * nh + h) * (NKEY / 64) + (key >> 6)) << dvs) + d) * 64 + vt_pos(key & 63)) = pack_fp8x4(v[0] * scale, v[1] * scale, v[2] * scale, v[3] * scale);)
  }
};
template <bool BASE_F32>
struct EpiResid {
  bf16_t* XL; const void* base; const float* ml;
  __device__ __forceinline__ void operator()(const Acc& acc, const Unit& u, int wr, int wc, int fr, int fq) const {
    const int row0 = u.pm * 256 + wr * 64 + fr, col0 = u.pn * 256 + wc * 32 + 4 * fq;
    const float* gp = ml + (size_t)(row0 / SEQ) * MLW + 4096 + col0;
    f32x4 g[2][2];
#pragma unroll
    for (int bj = 0; bj < 2; ++bj)
#pragma unroll
      for (int n = 0; n < 2; ++n) g[bj][n] = *(const f32x4*)(gp + bj * 128 + n * 16);
#pragma unroll
    for (int ai = 0; ai < 2; ++ai)
#pragma unroll
      for (int mh = 0; mh < 2; ++mh) {
        f32x4 bs[2][2][2];
#pragma unroll
        for (int m2 = 0; m2 < 2; ++m2)
#pragma unroll
          for (int bj = 0; bj < 2; ++bj)
#pragma unroll
            for (int n = 0; n < 2; ++n) { const size_t o = (size_t)(row0 + ai * 128 + (mh * 2 + m2) * 16) * DM + col0 + bj * 128 + n * 16;
              if constexpr (BASE_F32) bs[m2][bj][n] = *(const f32x4*)((const float*)base + o);
              else { const u32x2 w = *(const u32x2*)((const bf16_t*)base + o); bs[m2][bj][n] = (f32x4){bf_lo(w[0]), bf_hi(w[0]), bf_lo(w[1]), bf_hi(w[1])}; } }
        asm volatile("" ::: "memory");
#pragma unroll
        for (int m2 = 0; m2 < 2; ++m2)
#pragma unroll
          for (int bj = 0; bj < 2; ++bj)
#pragma unroll
            for (int n = 0; n < 2; ++n)
              *(u32x2*)(XL + (size_t)(row0 + ai * 128 + (mh * 2 + m2) * 16) * DM + col0 + bj * 128 + n * 16) = pack4(bs[m2][bj][n] + g[bj][n] * acc[ai][bj][mh * 2 + m2][n]);
        asm volatile("" ::: "memory");
      }
  }
};
struct EpiGU {
  unsigned char* HID;
  __device__ __forceinline__ void operator()(const Acc& acc, const Unit& u, int wr, int wc, int fr, int fq) const {
    unsigned char* base = HID + (size_t)u.grp * 2048 * FF;
#pragma unroll
    for (int ai = 0; ai < 2; ++ai)
#pragma unroll
      for (int m = 0; m < 4; ++m)
#pragma unroll
        for (int bj = 0; bj < 2; ++bj) {
          const int row = u.pm * 256 + ai * 128 + wr * 64 + m * 16 + fr, hid = u.pn * 128 + bj * 64 + wc * 16 + 4 * fq;
          const f32x4 g = acc[ai][bj][m][0], up = acc[ai][bj][m][1];
          float r[4];
#pragma unroll
          for (int j = 0; j < 4; ++j) { const float gg = g[j] * (1.f / W8_SCALE), uu = up[j] * (1.f / W8_SCALE); r[j] = gg * __builtin_amdgcn_rcpf(1.f + __expf(-gg)) * uu; }
          *(unsigned*)(base + (size_t)row * FF + hid) = pack_fp8x4(r[0], r[1], r[2], r[3]);
        }
  }
};
struct EpiDown {
  bf16_t* YE; const float* gate;
  __device__ __forceinline__ void operator()(const Acc& acc, const Unit& u, int wr, int wc, int fr, int fq) const {
    bf16_t* base = YE + (size_t)u.grp * 2048 * DM;
    float gt[2][4];
#pragma unroll
    for (int ai = 0; ai < 2; ++ai)
#pragma unroll
      for (int m = 0; m < 4; ++m) { const int row = u.pm * 256 + ai * 128 + wr * 64 + m * 16 + fr; gt[ai][m] = gate[((row >> 9) * NE + u.grp) * CAP + (row & 511)] * (1.f / W8_SCALE); }
    asm volatile("" ::: "memory");
    FG_FOREACH(*(u32x2*)(base + (size_t)row * DM + col) = pack4(v * gt[ai][m]);)
  }
};
struct EpiScaleCol {
  bf16_t* O; const float* cs;
  __device__ __forceinline__ void operator()(const Acc& acc, const Unit& u, int wr, int wc, int fr, int fq) const {
    f32x4 sc[2][2];
#pragma unroll
    for (int bj = 0; bj < 2; ++bj)
#pragma unroll
      for (int n = 0; n < 2; ++n) sc[bj][n] = *(const f32x4*)(cs + u.grp * 256 + u.pn * 256 + bj * 128 + wc * 32 + n * 16 + 4 * fq);
    asm volatile("" ::: "memory");
    FG_FOREACH(*(u32x2*)(O + (size_t)row * DM + u.grp * 256 + col) = pack4(v * sc[bj][n]);)
  }
};
struct EpiChanDft {
  bf16_t* ABT2;
  __device__ __forceinline__ void operator()(const Acc& acc, const Unit& u, int wr, int wc, int fr, int fq) const {
    FG_FOREACH(const int b = col / SEQ, nn = col % SEQ;
               *(u32x2*)(ABT2 + (((size_t)(b * 4 + u.grp) * 256) + (row & 255)) * 8192 + (row >> 8) * 4096 + nn) = pack4(v * 1.f);)
  }
};
}

namespace at {
typedef float f32x16 __attribute__((ext_vector_type(16)));
typedef int i32x8a __attribute__((ext_vector_type(8)));
typedef int i32x4a __attribute__((ext_vector_type(4)));
constexpr int NW = 8, QBLK = 32, KVBLK = 64;
#define SBAR() __builtin_amdgcn_sched_barrier(0)
#define MFMA8(A, B, Cc) __builtin_amdgcn_mfma_scale_f32_32x32x64_f8f6f4(A, B, Cc, 0, 0, 0, 0x7f7f7f7f, 0, 0x7f7f7f7f)
__device__ __forceinline__ int crow(int r, int hi) { return (r & 3) + 8 * (r >> 2) + 4 * hi; }
template <int DK> __device__ __forceinline__ int kswz(int row) { return DK == 192 ? ((row >> 2) & 3) : ((row >> 1) & 7); }
template <int DK>
__device__ __forceinline__ void qkt(f32x16& p0, f32x16& p1, const LAS char* Ks, const i32x8a* qf, int r32, int hi) {
  p0 = f32x16{}; p1 = f32x16{};
  const int s = kswz<DK>(r32);
  const LAS char* kr = Ks + r32 * DK;
#pragma unroll
  for (int t = 0; t < DK / 64; ++t) {
    const int c0 = ((4 * t + 2 * hi) ^ s) << 4, c1 = ((4 * t + 2 * hi + 1) ^ s) << 4;
    const i32x4a a0 = *reinterpret_cast<const LAS i32x4a*>(kr + c0), a1 = *reinterpret_cast<const LAS i32x4a*>(kr + c1);
    const i32x4a b0 = *reinterpret_cast<const LAS i32x4a*>(kr + c0 + 32 * DK), b1 = *reinterpret_cast<const LAS i32x4a*>(kr + c1 + 32 * DK);
    const i32x8a k0 = {a0[0], a0[1], a0[2], a0[3], a1[0], a1[1], a1[2], a1[3]}, k1 = {b0[0], b0[1], b0[2], b0[3], b1[0], b1[1], b1[2], b1[3]};
    p0 = MFMA8(k0, qf[t], p0);
    p1 = MFMA8(k1, qf[t], p1); }
}
constexpr float PBIAS = 4.f, PTHR = 3.f;
__device__ __forceinline__ void softmax8(const f32x16& p0, const f32x16& p1, float& m_reg, float& alpha, i32x8a& pa, float C, float thr_raw) {
  float pmax = p0[0];
#pragma unroll
  for (int r = 1; r < 16; ++r) pmax = fmaxf(pmax, p0[r]);
#pragma unroll
  for (int r = 0; r < 16; ++r) pmax = fmaxf(pmax, p1[r]);
  { auto rr = __builtin_amdgcn_permlane32_swap(__float_as_uint(pmax), __float_as_uint(pmax), false, false);
    pmax = fmaxf(__uint_as_float(rr[0]), __uint_as_float(rr[1])); }
  float mn;
  if (__builtin_expect(__all(pmax - m_reg <= thr_raw), 1)) { mn = m_reg; alpha = 1.f; }
  else { mn = fmaxf(m_reg, pmax); alpha = __builtin_amdgcn_exp2f((m_reg - mn) * C); m_reg = mn; }
  const float C8 = 8.f * C, b8 = 8.f * (PBIAS - mn * C) + 56.f;
#pragma unroll
  for (int w = 0; w < 4; ++w) {
    unsigned v = 0, v2 = 0;
#pragma unroll
    for (int j = 0; j < 4; ++j) { v = __builtin_amdgcn_cvt_pk_u8_f32(fmaf(p0[4 * w + j], C8, b8), j, v); v2 = __builtin_amdgcn_cvt_pk_u8_f32(fmaf(p1[4 * w + j], C8, b8), j, v2); }
    pa[w] = (int)v; pa[4 + w] = (int)v2; }
}
template <int NDB>
__device__ __forceinline__ void pv(f32x16* o, const LAS char* Vs, const i32x8a pa, int r32, int hi) {
  const int s = (r32 >> 2) & 3;
  const LAS char* v0 = Vs + r32 * 64 + (((2 * hi) ^ s) << 4); const LAS char* v1 = Vs + r32 * 64 + (((2 * hi + 1) ^ s) << 4);
#pragma unroll
  for (int d0 = 0; d0 < NDB; ++d0) {
    const i32x4a a = *reinterpret_cast<const LAS i32x4a*>(v0 + d0 * 2048), b = *reinterpret_cast<const LAS i32x4a*>(v1 + d0 * 2048);
    const i32x8a vf = {a[0], a[1], a[2], a[3], b[0], b[1], b[2], b[3]};
    o[d0] = MFMA8(pa, vf, o[d0]); }
  const int one4 = 0x38383838;
  const i32x8a ones = {one4, one4, one4, one4, one4, one4, one4, one4};
  o[NDB] = MFMA8(pa, ones, o[NDB]);
}
template <int DK, int NDB, bool QK_FIRST>
__device__ __forceinline__ void mm_iter(f32x16* o, f32x16& p0, f32x16& p1, const LAS char* Vs, const LAS char* Ks, const i32x8a pa, const i32x8a* qf, int r32, int hi) {
  constexpr int NKF = DK / 32, NL = NKF + NDB;
  const int sk = kswz<DK>(r32), sv = (r32 >> 2) & 3;
  const LAS char* kr = Ks + r32 * DK;
  const LAS char* v0 = Vs + r32 * 64 + (((2 * hi) ^ sv) << 4); const LAS char* v1 = Vs + r32 * 64 + (((2 * hi + 1) ^ sv) << 4);
  i32x8a w[3];
#define MM_ISK(i) (QK_FIRST ? (i) < NKF : (i) >= NDB)
#define MM_LOAD(i) do { i32x4a a_, b_; if (MM_ISK(i)) { const int kk = QK_FIRST ? (i) : (i) - NDB, t = kk >> 1, blk = kk & 1; \
      a_ = *reinterpret_cast<const LAS i32x4a*>(kr + blk * 32 * DK + (((4 * t + 2 * hi) ^ sk) << 4)); b_ = *reinterpret_cast<const LAS i32x4a*>(kr + blk * 32 * DK + (((4 * t + 2 * hi + 1) ^ sk) << 4)); } \
    else { const int d0 = QK_FIRST ? (i) - NKF : (i); a_ = *reinterpret_cast<const LAS i32x4a*>(v0 + d0 * 2048); b_ = *reinterpret_cast<const LAS i32x4a*>(v1 + d0 * 2048); } \
    w[(i) % 3] = (i32x8a){a_[0], a_[1], a_[2], a_[3], b_[0], b_[1], b_[2], b_[3]}; } while (0)
  MM_LOAD(0); MM_LOAD(1);
#pragma unroll
  for (int i = 0; i < NL; ++i) {
    if (i + 2 < NL) MM_LOAD(i + 2);
    if (MM_ISK(i)) { const int kk = QK_FIRST ? i : i - NDB, t = kk >> 1, blk = kk & 1;
      if (blk == 0) { if (t == 0) p0 = MFMA8(w[i % 3], qf[t], f32x16{}); else p0 = MFMA8(w[i % 3], qf[t], p0); }
      else { if (t == 0) p1 = MFMA8(w[i % 3], qf[t], f32x16{}); else p1 = MFMA8(w[i % 3], qf[t], p1); } }
    else { const int d0 = QK_FIRST ? i - NKF : i; o[d0] = MFMA8(pa, w[i % 3], o[d0]);
      if (d0 == NDB - 1) { const int one4 = 0x38383838; const i32x8a ones = {one4, one4, one4, one4, one4, one4, one4, one4}; o[NDB] = MFMA8(pa, ones, o[NDB]); } }
    __builtin_amdgcn_sched_barrier(0x406);
  }
#undef MM_ISK
#undef MM_LOAD
}
template <class VAR>
__device__ __forceinline__ void attn_body(const unsigned char* __restrict__ Qb, const unsigned char* __restrict__ Kh, const unsigned char* __restrict__ VT, bf16_t* __restrict__ Ob, int seq, char* lds) {
  constexpr int DK = VAR::DK, NDB = VAR::NDB, ldq = VAR::LDQ, ldk = VAR::LDK, ldo = VAR::LDO;
  constexpr float C = VAR::SCALE * 1.4426950408889634f, thr_raw = PTHR / VAR::SCALE;
  constexpr int SHM_V = NDB * 32 * 64, SHM_K = KVBLK * DK, SHM_T = SHM_V + SHM_K, NVC = NDB / 4;
  static_assert(DK == 192 || DK == 128, "K staging is written for 128- and 192-byte key rows");
  int tid_ = threadIdx.x; asm volatile("" : "+v"(tid_));
  const int tid = tid_, wid = tid >> 6, lane = tid & 63, r32 = lane & 31, hi = lane >> 5, wu = __builtin_amdgcn_readfirstlane(wid);
  LAS char* L = (LAS char*)lds;
  LAS float* al_l = (LAS float*)(L + VAR::NB * SHM_T) + wid * 32;
  float m_reg = -1e30f; f32x16 o[NDB + 1] = {}; i32x8a qr[DK / 64];
  const unsigned char* Qw = Qb + (size_t)(wid * QBLK + r32) * ldq + hi * 32;
#pragma unroll
  for (int t = 0; t < DK / 64; ++t) { const i32x4a a = *reinterpret_cast<const i32x4a*>(Qw + t * 64), b2 = *reinterpret_cast<const i32x4a*>(Qw + t * 64 + 16);
    qr[t] = (i32x8a){a[0], a[1], a[2], a[3], b2[0], b2[1], b2[2], b2[3]}; }
  const unsigned vsrc = (unsigned)((tid >> 2) * 64 + (((tid & 3) ^ ((tid >> 4) & 3)) << 4));
  unsigned ksrc0, ksrc1 = 0;
  if constexpr (DK == 128) { const int row = tid >> 3; ksrc0 = (unsigned)(row * ldk + (((tid & 7) ^ kswz<DK>(row)) << 4)); }
  else { const int r0 = tid / 12, c0 = tid - 12 * r0, ci = 512 + wid * 32 + r32, r1 = ci / 12, c1 = ci - 12 * r1;
    ksrc0 = (unsigned)(r0 * ldk + ((c0 ^ kswz<DK>(r0)) << 4)); ksrc1 = (unsigned)(r1 * ldk + ((c1 ^ kswz<DK>(r1)) << 4)); }
#define DMA(B, tile) do { const unsigned char* vt_ = VT + (size_t)(tile) * SHM_V; const unsigned char* kt_ = Kh + (size_t)(tile) * (KVBLK * ldk); \
    _Pragma("unroll") for (int _i = 0; _i < NVC; ++_i) __builtin_amdgcn_global_load_lds((const unsigned*)(vt_ + vsrc + _i * 8192), (LAS unsigned*)(L + (B) + wu * 1024 + _i * 8192), 16, 0, 0); \
    __builtin_amdgcn_global_load_lds((const unsigned*)(kt_ + ksrc0), (LAS unsigned*)(L + (B) + SHM_V + wu * 1024), 16, 0, 0); \
    if constexpr (DK == 192) { if (hi == 0) __builtin_amdgcn_global_load_lds((const unsigned*)(kt_ + ksrc1), (LAS unsigned*)(L + (B) + SHM_V + 8192 + wu * 512), 16, 0, 0); } } while (0)
#define DWAIT() asm volatile("s_waitcnt vmcnt(0)" ::: "memory")
#define RESC(a) do { if (__any((a) < 1.f)) { if (hi == 0) al_l[r32] = (a); asm volatile("s_waitcnt lgkmcnt(0)" ::: "memory"); \
    _Pragma("unroll") for (int d = 0; d <= NDB; ++d) _Pragma("unroll") for (int r = 0; r < 16; ++r) o[d][r] *= al_l[crow(r, hi)]; } } while (0)
  const int NTL = seq / KVBLK;
  constexpr int NB = VAR::NB, IPT = NVC + (DK == 192 ? 2 : 1);
  static_assert(NB >= 3 && NB * SHM_T + NW * 128 <= 135168, "attention tile ring must fit the kernel's LDS");
#define DWAITN(NT_) asm volatile("s_waitcnt vmcnt(%0)" :: "n"((NT_) * IPT) : "memory")
  int b0 = 0, b1 = SHM_T, bn = (NB - 1) * SHM_T;
  f32x16 p0, p1; float al; i32x8a pa;
#pragma unroll 1
  for (int t = 0; t < NB - 1; ++t) DMA(t * SHM_T, t < NTL ? t : NTL - 1);
  SBAR(); DWAITN(NB - 3); __syncthreads();
  qkt<DK>(p0, p1, L + b0 + SHM_V, qr, r32, hi); softmax8(p0, p1, m_reg, al, pa, C, thr_raw);
  for (int j = 0; j + 1 < NTL; ++j) {
    { const int nt = j + NB - 1 < NTL ? j + NB - 1 : NTL - 1; DMA(bn, nt); }
    SBAR(); RESC(al); SBAR();
    mm_iter<DK, NDB, VAR::PIPE>(o, p0, p1, L + b0, L + b1 + SHM_V, pa, qr, r32, hi);
    softmax8(p0, p1, m_reg, al, pa, C, thr_raw); SBAR();
    DWAITN(NB - 3); __syncthreads();
    bn = b0; b0 = b1; b1 = b1 + SHM_T == NB * SHM_T ? 0 : b1 + SHM_T;
  }
  RESC(al); pv<NDB>(o, L + b0, pa, r32, hi);
  DWAIT();
#pragma unroll
  for (int r = 0; r < 16; ++r) { const int orow = wid * QBLK + crow(r, hi); const float rl = __builtin_amdgcn_rcpf(o[NDB][r]);
#pragma unroll
    for (int d0 = 0; d0 < NDB; ++d0) Ob[(size_t)orow * ldo + d0 * 32 + r32] = f2bf(o[d0][r] * rl); }
  __syncthreads();
#undef DMA
#undef DWAIT
#undef DWAITN
#undef RESC
}
}

struct VarMla { static constexpr int DK = 192, NDB = 4, LDQ = 1536, LDK = 1536, LDO = 2048, NB = 5; static constexpr bool PIPE = true; static constexpr float SCALE = 0.07216878364870322f; };
struct VarDiff { static constexpr int DK = 128, NDB = 8, LDQ = 1024, LDK = 1024, LDO = 2048, NB = 5; static constexpr bool PIPE = false; static constexpr float SCALE = 0.08838834764831845f; };
constexpr size_t VTA_INST = (size_t)(NKEY / 64) * 128 * 64, VTD_INST = (size_t)(NKEY / 64) * 256 * 64;
__device__ __forceinline__ void attn_unit_mla(const Params& p, char* smem, int inst, int qb) {
  const int b = inst >> 3, h = inst & 7;
  at::attn_body<VarMla>(WSP(const unsigned char, OFF_QA) + ((size_t)b * SEQ + qb * 256) * 1536 + h * 192, WSP(const unsigned char, OFF_KA) + (size_t)b * NKEY * 1536 + h * 192,
                        WSP(const unsigned char, OFF_VA) + (size_t)inst * VTA_INST, WSP(bf16_t, OFF_YIN) + ((size_t)b * SEQ + qb * 256) * 2048 + h * 128, NKEY, smem);
}
__device__ __forceinline__ void attn_unit_diff(const Params& p, char* smem, int inst, int qb) {
  const int b = inst >> 3, m = (inst >> 2) & 1, h = inst & 3;
  at::attn_body<VarDiff>(WSP(const unsigned char, OFF_QD) + ((size_t)b * SEQ + qb * 256) * 1024 + m * 512 + h * 128, WSP(const unsigned char, OFF_KD) + (size_t)b * NKEY * 1024 + m * 512 + h * 128,
                         WSP(const unsigned char, OFF_VD) + (size_t)(b * 4 + h) * VTD_INST, WSP(bf16_t, OFF_OD) + ((size_t)b * SEQ + qb * 256) * 2048 + m * 1024 + h * 256, NKEY, smem);
}
__device__ __forceinline__ void ph_attn_mla(const Params& p, char* smem) {
  for (int u0 = blockIdx.x; u0 < NB * 8 * 16; u0 += gridDim.x) {
    const int u = (gridDim.x == 256) ? ((u0 & ~255) | ((u0 & 7) << 5) | ((u0 >> 3) & 31)) : u0;
    attn_unit_mla(p, smem, u >> 4, u & 15);
  }
}
__device__ __forceinline__ void ph_attn_diff_wide(const Params& p, char* smem) {
  for (int u0 = blockIdx.x; u0 < NB * 8 * 16; u0 += gridDim.x) {
    const int u = (gridDim.x == 256) ? ((u0 & ~255) | ((u0 & 7) << 5) | ((u0 >> 3) & 31)) : u0;
    attn_unit_diff(p, smem, u >> 4, u & 15);
  }
}
constexpr int QPAT = 4, Q_ATT = 128, Q_CONV = 384, Q_WORD0 = 3584;
__device__ __forceinline__ void ph_attn_queue(const Params& p, char* smem, int* slot) {
  const int x = blockIdx.x & 7;
  unsigned* cnt = WSP(unsigned, OFF_BAR) + Q_WORD0 + 16 * x;
  for (;;) {
    if (threadIdx.x == 0) *(volatile int*)slot = (int)__hip_atomic_fetch_add(cnt, 1u, __ATOMIC_RELAXED, __HIP_MEMORY_SCOPE_AGENT);
    __syncthreads();
    const int e = __builtin_amdgcn_readfirstlane(*(volatile int*)slot);
    __syncthreads();
    if (e >= Q_ATT + Q_CONV) break;
    int att = -1, cv = -1;
    constexpr int MIXED = (Q_CONV / (QPAT - 1) < Q_ATT ? Q_CONV / (QPAT - 1) : Q_ATT) * QPAT;
    if (e < MIXED) { if (e % QPAT == 0) att = e / QPAT; else cv = e - e / QPAT - 1; }
    else { const int r = e - MIXED, na = MIXED / QPAT, nc = MIXED - na; if (na + r < Q_ATT) att = na + r; else cv = nc + (r - (Q_ATT - na)); }
    if (att >= 0) { if (att < 64) attn_unit_mla(p, smem, x * 4 + (att >> 4), att & 15); else attn_unit_diff(p, smem, x * 4 + ((att - 64) >> 4), att & 15); }
    else conv_item(p, smem, cv * 8 + x);
  }
}
#define XB_TMO      128
#define XB_XCNT(j)  (256  + 64 * (j))
#define XB_XSUB(j)  (1280 + 64 * (j))
#define XB_XGEN(j)  (2304 + 64 * (j))
#define XB_TOP      3328
#define XB_TOPGEN   3392
#define XCD_BAR_WORDS 3456
#define XB_SPIN_CAP (1u << 18)
__device__ __forceinline__ unsigned xb_ld(unsigned* p)              { return __hip_atomic_load(p, __ATOMIC_RELAXED, __HIP_MEMORY_SCOPE_AGENT); }
__device__ __forceinline__ unsigned xb_add(unsigned* p, unsigned v) { return __hip_atomic_fetch_add(p, v, __ATOMIC_RELAXED, __HIP_MEMORY_SCOPE_AGENT); }
__device__ __forceinline__ unsigned xb_xcc_id() { return (unsigned)__builtin_amdgcn_s_getreg((3 << 11) | 20) & 0xFu; }
#define XB_SPIN(cond, bar) do { unsigned _sp = 0; while (cond) { __builtin_amdgcn_s_sleep(1); \
    if ((++_sp & 255u) == 0u) { if (xb_ld(&(bar)[XB_TMO])) break; if (_sp > XB_SPIN_CAP) { atomicAdd(&(bar)[XB_TMO], 1u); break; } } } } while (0)
struct XcdBarrier { unsigned* bar; unsigned x; volatile LAS unsigned* st; };
__device__ __forceinline__ XcdBarrier xcd_barrier_post(unsigned* bar, volatile LAS unsigned* st) {
    XcdBarrier b; b.bar = bar; b.x = xb_xcc_id(); b.st = st;
    if (threadIdx.x == 0) (void)xb_add(&bar[XB_XCNT(b.x)], 1u);
    return b;
}
__device__ __forceinline__ void xcd_barrier_complete(unsigned* bar, unsigned x, unsigned& nloc, unsigned& nx) {
    const unsigned G = gridDim.x * gridDim.y * gridDim.z;
    unsigned sum, cnt, mine, sp = 0u;
    for (;;) {
        sum = 0u; cnt = 0u; mine = 0u;
#pragma unroll
        for (unsigned j = 0; j < 16; ++j) { const unsigned c = xb_ld(&bar[XB_XCNT(j)]); sum += c; cnt += (c > 0u) ? 1u : 0u; mine = (j == x) ? c : mine; }
        if (sum == G) break;
        __builtin_amdgcn_s_sleep(1);
        if ((++sp & 255u) == 0u) { if (xb_ld(&bar[XB_TMO])) break; if (sp > XB_SPIN_CAP) { atomicAdd(&bar[XB_TMO], 1u); break; } }
    }
    nloc = mine > 0u ? mine : 1u; nx = cnt > 0u ? cnt : 1u;
}
__device__ __forceinline__ void xcd_barrier(const XcdBarrier& b) {
    asm volatile("s_waitcnt vmcnt(0)" ::: "memory");
    __syncthreads();
    if (threadIdx.x == 0) {
        unsigned* bar = b.bar;
        __builtin_amdgcn_s_waitcnt(0);
        unsigned nloc = b.st[0], nx = b.st[1];
        if (nloc == 0u) { xcd_barrier_complete(bar, b.x, nloc, nx); b.st[0] = nloc; b.st[1] = nx; }
        const unsigned old = xb_add(&bar[XB_XSUB(b.x)], 1u);
        const unsigned gen = old / nloc;
        if (old + 1u == (gen + 1u) * nloc) {
            __builtin_amdgcn_fence(__ATOMIC_RELEASE, "agent");
            asm volatile("s_waitcnt vmcnt(0)" ::: "memory");
            const unsigned og = xb_add(&bar[XB_TOP], 1u);
            const unsigned tg = og / nx;
            if (og + 1u == (tg + 1u) * nx) xb_add(&bar[XB_TOPGEN], 1u);
            else XB_SPIN(xb_ld(&bar[XB_TOPGEN]) == tg, bar);
            __builtin_amdgcn_fence(__ATOMIC_ACQUIRE, "agent");
            xb_add(&bar[XB_XGEN(b.x)], 1u);
            asm volatile("s_waitcnt vmcnt(0)" ::: "memory");
        } else {
            XB_SPIN(xb_ld(&bar[XB_XGEN(b.x)]) == gen, bar);
            __builtin_amdgcn_fence(__ATOMIC_ACQUIRE, "agent");
            asm volatile("s_waitcnt vmcnt(0)" ::: "memory");
        }
    }
    __syncthreads();
}

#define FGRID(A_, sA_, lda_, B_, sB_, ldb_, nM_, nN_, ng_) fg::Grid{(const char*)(A_), (const char*)(B_), (size_t)(sA_), (size_t)(sB_), lda_, ldb_, nM_, nN_, ng_, (int)gridDim.x, (int)blockIdx.x}
#define FLDS ((LAS unsigned char*)smem)
constexpr int SMEM_MAIN = 135168;
template <int L> __device__ __forceinline__ void ph_moe_gemms_gu(const Params& p, char* smem) {
  fg::gemm_fast<fg::EpiGU, true, true>(FLDS, FGRID(WSP(char, OFF_H), 0, 1024, WSP(char, OFF_WGU) + (size_t)L * NE * 4096 * 2048, (size_t)4096 * 2048, 1024, 8, 16, NE),
                                       fg::EpiGU{WSP(unsigned char, OFF_HID)}, 1024, WSP(const int, OFF_IDX));
}
template <int L> __device__ __forceinline__ void ph_moe_gemms_down(const Params& p, char* smem) {
  fg::gemm_fast<fg::EpiDown, false, true>(FLDS, FGRID(WSP(char, OFF_HID), (size_t)2048 * 2048, 1024, WSP(char, OFF_WD) + (size_t)L * NE * 2048 * 2048, (size_t)2048 * 2048, 1024, 8, 8, NE),
                                          fg::EpiDown{WSP(bf16_t, OFF_YE), WSP(const float, OFF_GATE)}, 1024);
}
__global__ __launch_bounds__(512, 2) void mega(Params p) {
  __shared__ __attribute__((aligned(16))) char smem[SMEM_MAIN + 32];
  volatile LAS unsigned* xst = (volatile LAS unsigned*)(smem + SMEM_MAIN);
  if (threadIdx.x == 0) { xst[0] = 0u; xst[1] = 0u; xst[2] = 0u; xst[3] = 0u; }
  __syncthreads();
  const XcdBarrier bar = xcd_barrier_post(WSP(unsigned, OFF_BAR), xst);
#define GSYNC() xcd_barrier(bar)
  const bool split = gridDim.x == 256;
  if ((blockIdx.x >> 3) & 1) { ph_twiddle(p, smem); ph_weights_small(p, smem); ph_mod(p, smem); } else { ph_mod(p, smem); ph_weights_small(p, smem); ph_twiddle(p, smem); }
  if (!split) ph_weights_expert(p, smem, blockIdx.x, gridDim.x);
  GSYNC();
  ph_pre0(p); GSYNC();
  fg::gemm_fast<fg::EpiIn0, false, true>(FLDS, FGRID(WSP(char, OFF_H), 0, DM / 2, WSP(char, OFF_WIN0), 0, DM / 2, 68, 13, 1), fg::EpiIn0{WSP(bf16_t, OFF_P0), WSP(unsigned char, OFF_QD), WSP(unsigned char, OFF_KD), WSP(unsigned char, OFF_VD)}, DM / 2);
  { fg::Grid gv = FGRID(WSP(char, OFF_WIN0) + (size_t)3136 * DM, 0, DM / 2, WSP(char, OFF_H), 0, DM / 2, 4, 68, 1); gv.rot = 128;
    fg::gemm_fast<fg::EpiVT, false, true>(FLDS, gv, fg::EpiVT{WSP(unsigned char, OFF_VD), 8, 4, 1.f / 32.f}, DM / 2); }
  GSYNC();
  ph_post_inproj(p); GSYNC();
  fg::gemm_fast(FLDS, FGRID(WSP(bf16_t, OFF_CQN), 0, 512, WSP(bf16_t, OFF_WUQ), 0, 512, 64, 6, 1), fg::EpiQRope{WSP(unsigned char, OFF_QA)}, 512);
  { fg::Grid gk = FGRID(WSP(bf16_t, OFF_CKVN), 0, 512, WSP(bf16_t, OFF_WUKV), 0, 512, 68, 4, 1); gk.rot = 128;
    fg::gemm_fast(FLDS, gk, fg::EpiKV{WSP(unsigned char, OFF_KA)}, 512);
    fg::Grid gv = FGRID(WSP(bf16_t, OFF_WUKV) + (size_t)1024 * 512, 0, 512, WSP(bf16_t, OFF_CKVN), 0, 512, 4, 68, 1); gv.rot = 112;
    fg::gemm_fast(FLDS, gv, fg::EpiVT{WSP(unsigned char, OFF_VA), 7, 8, 1.f}, 512); }
  GSYNC();
  if (split) ph_attn_queue(p, smem, (int*)(smem + SMEM_MAIN + 16)); else { ph_attn_mla(p, smem); ph_attn_diff_wide(p, smem); }
  GSYNC();
  ph_diffcomb(p); GSYNC();
  fg::gemm_fast(FLDS, FGRID(WSP(bf16_t, OFF_YIN), 0, DM, WSP(bf16_t, OFF_WOUT0), 0, DM, 64, 8, 1), fg::EpiResid<true>{WSP(bf16_t, OFF_XL), p.x, WSP(const float, OFF_ML)}, DM); GSYNC();
  ph_ffn_pre(p, 0, smem); GSYNC();
  ph_topk(p, smem); GSYNC();
  ph_moe_gemms_gu<0>(p, smem); GSYNC();
  ph_moe_gemms_down<0>(p, smem); GSYNC();
  ph_combine(p, 0); GSYNC();
  fg::gemm_fast(FLDS, FGRID(WSP(bf16_t, OFF_H), 0, DM, WSP(bf16_t, OFF_WIN1), 0, DM, 64, 8, 1), fg::EpiBf16{WSP(bf16_t, OFF_Z), DM, DM, 1.f, 1, 0, 0}, DM); GSYNC();
  ph_pool(p);
  fg::gemm_fast(FLDS, FGRID(WSP(bf16_t, OFF_MC), (size_t)512 * 256 * 2, 256, WSP(bf16_t, OFF_Z) + 1024, 512, DM, 2, 64, 4), fg::EpiChanDft{WSP(bf16_t, OFF_ABT2)}, 256); GSYNC();
  ph_fold(p);
  fg::gemm_fast(FLDS, FGRID(WSP(bf16_t, OFF_POOLED), 512, 1024, WSP(bf16_t, OFF_WPOOL), 65536 * 2, 256, 64, 1, 4), fg::EpiScaleCol{WSP(bf16_t, OFF_YCAT), p.pool_scale}, 256); GSYNC();
  { fg::Grid gq = FGRID(WSP(bf16_t, OFF_TW), 0, 4096, WSP(bf16_t, OFF_ABTF), (size_t)256 * 4096 * 2, 4096, 8, 1, 32);
    gq.gd = 2; gq.sA2 = (size_t)2048 * 2; gq.sB2 = (size_t)2048 * 2; gq.dftmap = 1;
    fg::gemm_fast(FLDS, gq, fg::EpiBf16{WSP(bf16_t, OFF_SPEC), 256, 256, 1.f, 1, (size_t)2048 * 256, 0}, 2048); }
  GSYNC();
  ph_dftcomb(p); GSYNC();
  fg::gemm_fast(FLDS, FGRID(WSP(bf16_t, OFF_YCAT), 0, DM, WSP(bf16_t, OFF_WOUT1), 0, DM, 64, 8, 1), fg::EpiResid<false>{WSP(bf16_t, OFF_XL), WSP(const bf16_t, OFF_XL), WSP(const float, OFF_ML) + 5 * MLW}, DM); GSYNC();
  ph_ffn_pre(p, 1, smem); GSYNC();
  ph_topk(p, smem); GSYNC();
  ph_moe_gemms_gu<1>(p, smem); GSYNC();
  ph_moe_gemms_down<1>(p, smem); GSYNC();
  ph_combine(p, 1);
}

extern "C" void kernel_launch(void* const* d_in, const int* in_sizes, int n_in, void* d_out, int out_size, void* d_ws, size_t ws_size, hipStream_t stream) {
  if (n_in != 29 || ws_size < WS_NEED) { fprintf(stderr, "kernel_launch: bad args n_in %d ws %zu need %zu\n", n_in, ws_size, WS_NEED); return; }
  Params p{};
  const float** f = (const float**)&p;
  for (int i = 0; i < 29; ++i) f[i] = (const float*)d_in[i];
  p.out = (float*)d_out; p.ws = (char*)d_ws;
  static int grid = 0;
  if (!grid) {
    int dev = 0, cus = 0, per_cu = 0;
    (void)hipGetDevice(&dev);
    (void)hipDeviceGetAttribute(&cus, hipDeviceAttributeMultiprocessorCount, dev);
    (void)hipOccupancyMaxActiveBlocksPerMultiprocessor(&per_cu, (const void*)mega, 512, 0);
    if (cus <= 0) cus = 256;
    grid = per_cu >= 1 ? cus : 0;
    if (!grid) { fprintf(stderr, "kernel_launch: occupancy query says 0 blocks per CU\n"); return; }
  }
  (void)hipMemsetAsync(d_ws, 0, 16384, stream);
  hipLaunchKernelGGL(mega, dim3(grid), dim3(512), 0, stream, p);
}
```
